# Optimizing an MI355X kernel written in HIP

```python
import math
import jax, jax.numpy as jnp
from jax import lax
import numpy as np

D_MODEL = 4096
BATCH = 4
SEQ = 2048
DEPTH = 1
DEC_BATCH = 128
DEC_SEQ = 1
PAST_LEN = 16384
PAGE_SIZE = 128

MIX_WIDTH = 2 * D_MODEL
SSD_WIDTH = MIX_WIDTH // 2
GDN_WIDTH = MIX_WIDTH - SSD_WIDTH
SSD_HEAD_DIM = 64
SSD_HEADS = SSD_WIDTH // SSD_HEAD_DIM
SSD_GROUPS = 8
SSD_HPG = SSD_HEADS // SSD_GROUPS
SSD_STATE = 128
SSD_CONV_DIM = SSD_WIDTH + 2 * SSD_GROUPS * SSD_STATE
GDN_HEAD_DIM = 128
GDN_HEADS = GDN_WIDTH // GDN_HEAD_DIM
GDN_QK_WIDTH = GDN_HEADS * GDN_HEAD_DIM
GDN_CONV_DIM = 2 * GDN_QK_WIDTH + GDN_WIDTH
CONV_K = 4
CHUNK = 64
D_IN_PROJ = SSD_WIDTH + SSD_CONV_DIM + SSD_HEADS + GDN_CONV_DIM + GDN_WIDTH + 2 * GDN_HEADS
ALPHA = (2 * DEPTH) ** 0.25
DEEPNORM_BETA = (8 * DEPTH) ** -0.25
NORM_EPS = 1e-6

kernel_name = 'hymba_ssd_gdn_deepnorm_step'


def _split_points():
    sizes = [SSD_WIDTH, SSD_CONV_DIM, SSD_HEADS, GDN_CONV_DIM, GDN_WIDTH, GDN_HEADS, GDN_HEADS]
    pts, acc = [], 0
    for s in sizes[:-1]:
        acc += s
        pts.append(acc)
    return pts


def _causal_conv_silu(u, prev, w, b):
    L = u.shape[1]
    full = jnp.concatenate([prev.astype(u.dtype), u], axis=1)
    acc = full[:, 0:L] * w[0]
    for j in range(1, CONV_K):
        acc = acc + full[:, j:j + L] * w[j]
    if b is not None:
        acc = acc + b
    return jax.nn.silu(acc), full[:, L:]


def _to_chunks(a, q, nc):
    pad = nc * q - a.shape[1]
    a = jnp.pad(a, [(0, 0), (0, pad)] + [(0, 0)] * (a.ndim - 2))
    a = a.reshape((a.shape[0], nc, q) + a.shape[2:])
    return jnp.moveaxis(a, 1, 0)


def _from_chunks(ys, L):
    ys = jnp.moveaxis(ys, 0, 1)
    return ys.reshape((ys.shape[0], -1) + ys.shape[3:])[:, :L]


def _ssd_scan(xdt, dA, Bm, Cm, h0):
    L = xdt.shape[1]
    q = min(CHUNK, L)
    nc = -(-L // q)
    tri = jnp.tril(jnp.ones((q, q), bool))[None, :, :, None, None]

    def step(h, inp):
        xdt_c, dA_c, B_c, C_c = inp
        cum = jnp.cumsum(dA_c, axis=1)
        decay = jnp.exp(jnp.where(tri, cum[:, :, None] - cum[:, None, :], -jnp.inf))
        cb = jnp.einsum('btgn,bsgn->btsg', C_c, B_c)
        y = jnp.einsum('btsg,btsgh,bsghp->btghp', cb, decay, xdt_c)
        y = y + jnp.einsum('btgn,bghpn->btghp', C_c, h) * jnp.exp(cum)[..., None]
        last = cum[:, -1]
        w_s = jnp.exp(last[:, None] - cum)
        h = h * jnp.exp(last)[..., None, None] + jnp.einsum('bsgn,bsgh,bsghp->bghpn', B_c, w_s, xdt_c)
        return h, y

    hT, ys = lax.scan(step, h0, (_to_chunks(xdt, q, nc), _to_chunks(dA, q, nc),
                                 _to_chunks(Bm, q, nc), _to_chunks(Cm, q, nc)))
    return _from_chunks(ys, L), hT


def _gdn_scan(qh, kh, vh, g, beta, S0):
    L = qh.shape[1]
    q = min(CHUNK, L)
    nc = -(-L // q)
    tri = jnp.tril(jnp.ones((q, q), bool))
    tri_strict = jnp.tril(jnp.ones((q, q), bool), -1)
    eye = jnp.eye(q, dtype=jnp.float32)

    def step(S, inp):
        q_c, k_c, v_c, g_c, b_c = inp
        cum = jnp.cumsum(g_c, axis=1)
        cum_h = jnp.moveaxis(cum, 1, 2)
        b_h = jnp.moveaxis(b_c, 1, 2)
        decay = jnp.exp(jnp.where(tri, cum_h[..., :, None] - cum_h[..., None, :], -jnp.inf))
        kk = jnp.einsum('bthd,bshd->bhts', k_c, k_c)
        M = jnp.where(tri_strict, kk * decay * b_h[..., :, None], 0.0) + eye
        v_beta = jnp.einsum('bthd,bth->bhtd', v_c, b_c)
        k_beta = jnp.einsum('bthd,bth->bhtd', k_c, b_c * jnp.exp(cum))
        U = lax.linalg.triangular_solve(M, v_beta, left_side=True, lower=True)
        W = lax.linalg.triangular_solve(M, k_beta, left_side=True, lower=True)
        v_new = U - jnp.einsum('bhtk,bhkv->bhtv', W, S)
        qk = jnp.einsum('bthd,bshd->bhts', q_c, k_c) * decay
        o = (jnp.einsum('bthk,bhkv->bthv', q_c * jnp.exp(cum)[..., None], S)
             + jnp.einsum('bhts,bhsv->bthv', qk, v_new))
        last = cum_h[..., -1]
        S = (S * jnp.exp(last)[..., None, None]
             + jnp.einsum('bshk,bhs,bhsv->bhkv', k_c, jnp.exp(last[..., None] - cum_h), v_new))
        return S, o

    ST, os_ = lax.scan(step, S0, (_to_chunks(qh, q, nc), _to_chunks(kh, q, nc), _to_chunks(vh, q, nc),
                                  _to_chunks(g, q, nc), _to_chunks(beta, q, nc)))
    return _from_chunks(os_, L), ST


def _rms(x):
    return x * lax.rsqrt(jnp.mean(x * x, axis=-1, keepdims=True) + NORM_EPS)


def _l2norm(x):
    return x * lax.rsqrt(jnp.sum(x * x, axis=-1, keepdims=True) + NORM_EPS)


def _layernorm(x, g, b):
    xf = x.astype(jnp.float32)
    mu = jnp.mean(xf, axis=-1, keepdims=True)
    xc = xf - mu
    var = jnp.mean(xc * xc, axis=-1, keepdims=True)
    return (xc * lax.rsqrt(var + 1e-5) * g + b).astype(x.dtype)


def _layer(x, h_ssd, conv_ssd, s_gdn, conv_gdn, w_in, ssd_conv_w, ssd_conv_b, ssd_dt_bias, ssd_a_log,
           ssd_d, ssd_norm_w, gdn_conv_w, gdn_dt_bias, gdn_a_log, gdn_norm_w, w_out, ln_g, ln_b):
    f32 = jnp.float32
    Bsz, L, _ = x.shape
    proj = x @ w_in
    z_s, xbc, dt_raw, qkv, z_g, b_raw, a_raw = jnp.split(proj, _split_points(), axis=-1)

    xbc, conv_ssd_new = _causal_conv_silu(xbc, conv_ssd, ssd_conv_w, ssd_conv_b)
    xs, Bm, Cm = jnp.split(xbc.astype(f32), [SSD_WIDTH, SSD_WIDTH + SSD_GROUPS * SSD_STATE], axis=-1)
    xs = xs.reshape(Bsz, L, SSD_GROUPS, SSD_HPG, SSD_HEAD_DIM)
    Bm = Bm.reshape(Bsz, L, SSD_GROUPS, SSD_STATE)
    Cm = Cm.reshape(Bsz, L, SSD_GROUPS, SSD_STATE)
    dt = jax.nn.softplus(dt_raw.astype(f32) + ssd_dt_bias).reshape(Bsz, L, SSD_GROUPS, SSD_HPG)
    A = -jnp.exp(ssd_a_log.astype(f32)).reshape(SSD_GROUPS, SSD_HPG)
    h0 = h_ssd.astype(f32).reshape(Bsz, SSD_GROUPS, SSD_HPG, SSD_HEAD_DIM, SSD_STATE)
    y, h_new = _ssd_scan(xs * dt[..., None], dt * A, Bm, Cm, h0)
    y = y + xs * ssd_d.astype(f32).reshape(SSD_GROUPS, SSD_HPG)[..., None]
    u = y.reshape(Bsz, L, SSD_WIDTH) * jax.nn.silu(z_s.astype(f32))
    y_ssd = _rms(u.reshape(Bsz, L, SSD_GROUPS, -1)).reshape(Bsz, L, SSD_WIDTH) * ssd_norm_w

    qkv, conv_gdn_new = _causal_conv_silu(qkv, conv_gdn, gdn_conv_w, None)
    qg, kg, vg = jnp.split(qkv.astype(f32), [GDN_QK_WIDTH, 2 * GDN_QK_WIDTH], axis=-1)
    qg = _l2norm(qg.reshape(Bsz, L, GDN_HEADS, GDN_HEAD_DIM)) * (GDN_HEAD_DIM ** -0.5)
    kg = _l2norm(kg.reshape(Bsz, L, GDN_HEADS, GDN_HEAD_DIM))
    vg = vg.reshape(Bsz, L, GDN_HEADS, GDN_HEAD_DIM)
    beta = jax.nn.sigmoid(b_raw.astype(f32))
    g = -jnp.exp(gdn_a_log.astype(f32)) * jax.nn.softplus(a_raw.astype(f32) + gdn_dt_bias)
    o, s_new = _gdn_scan(qg, kg, vg, g, beta, s_gdn.astype(f32))
    zg = jax.nn.silu(z_g.astype(f32)).reshape(Bsz, L, GDN_HEADS, GDN_HEAD_DIM)
    y_gdn = (_rms(o) * gdn_norm_w * zg).reshape(Bsz, L, GDN_WIDTH)

    mix = jnp.concatenate([y_ssd, y_gdn], axis=-1).astype(x.dtype)
    out = mix @ w_out
    x_new = _layernorm(ALPHA * x + out, ln_g, ln_b)
    h_new = h_new.reshape(Bsz, SSD_HEADS, SSD_HEAD_DIM, SSD_STATE)
    return x_new, h_new, conv_ssd_new, s_new, conv_gdn_new


def setup_inputs(seed: int = 0) -> dict:
    key = jax.random.key(seed)
    ks = jax.random.split(key, 24)
    f32 = jnp.float32

    def nrm(k, shape, s):
        return s * jax.random.normal(k, shape, f32)

    def dt_bias(k, n):
        dt = jnp.exp(jax.random.uniform(k, (DEPTH, n), f32, math.log(1e-3), math.log(1e-1)))
        return dt + jnp.log(-jnp.expm1(-dt))

    def a_log(k, n):
        return jnp.log(jax.random.uniform(k, (DEPTH, n), f32, 1.0, 16.0))

    return {
        'x_prompt': nrm(ks[0], (BATCH, SEQ, D_MODEL), 1.0),
        'x_sample': nrm(ks[1], (DEC_BATCH, DEC_SEQ, D_MODEL), 1.0),
        'state_ssd': nrm(ks[2], (DEPTH, DEC_BATCH, SSD_HEADS, SSD_HEAD_DIM, SSD_STATE), 0.5),
        'state_ssd_conv': nrm(ks[3], (DEPTH, DEC_BATCH, CONV_K - 1, SSD_CONV_DIM), 1.0),
        'state_gdn': nrm(ks[4], (DEPTH, DEC_BATCH, GDN_HEADS, GDN_HEAD_DIM, GDN_HEAD_DIM), GDN_HEAD_DIM ** -0.5),
        'state_gdn_conv': nrm(ks[5], (DEPTH, DEC_BATCH, CONV_K - 1, GDN_CONV_DIM), 1.0),
        'w_in': nrm(ks[6], (DEPTH, D_MODEL, D_IN_PROJ), D_MODEL ** -0.5),
        'ssd_conv_w': nrm(ks[7], (DEPTH, CONV_K, SSD_CONV_DIM), CONV_K ** -0.5),
        'ssd_conv_b': nrm(ks[8], (DEPTH, SSD_CONV_DIM), 0.02),
        'ssd_dt_bias': dt_bias(ks[9], SSD_HEADS),
        'ssd_a_log': a_log(ks[10], SSD_HEADS),
        'ssd_d': 1.0 + nrm(ks[11], (DEPTH, SSD_HEADS), 0.1),
        'ssd_norm_w': 1.0 + nrm(ks[12], (DEPTH, SSD_WIDTH), 0.1),
        'gdn_conv_w': nrm(ks[13], (DEPTH, CONV_K, GDN_CONV_DIM), CONV_K ** -0.5),
        'gdn_dt_bias': dt_bias(ks[14], GDN_HEADS),
        'gdn_a_log': a_log(ks[15], GDN_HEADS),
        'gdn_norm_w': 1.0 + nrm(ks[16], (DEPTH, GDN_HEAD_DIM), 0.1),
        'w_out': nrm(ks[17], (DEPTH, MIX_WIDTH, D_MODEL), DEEPNORM_BETA * MIX_WIDTH ** -0.5),
        'ln_g': 1.0 + nrm(ks[18], (DEPTH, D_MODEL), 0.1),
        'ln_b': nrm(ks[19], (DEPTH, D_MODEL), 0.02),
    }


def reference(x_prompt, x_sample, state_ssd, state_ssd_conv, state_gdn, state_gdn_conv, w_in, ssd_conv_w,
              ssd_conv_b, ssd_dt_bias, ssd_a_log, ssd_d, ssd_norm_w, gdn_conv_w, gdn_dt_bias, gdn_a_log,
              gdn_norm_w, w_out, ln_g, ln_b):
    bp = x_prompt.shape[0]
    hp, hs = x_prompt, x_sample
    p_ssd, p_ssd_conv, p_gdn, p_gdn_conv = [], [], [], []
    s_ssd, s_ssd_conv, s_gdn, s_gdn_conv = [], [], [], []
    for l in range(DEPTH):
        wl = (w_in[l], ssd_conv_w[l], ssd_conv_b[l], ssd_dt_bias[l], ssd_a_log[l], ssd_d[l], ssd_norm_w[l],
              gdn_conv_w[l], gdn_dt_bias[l], gdn_a_log[l], gdn_norm_w[l], w_out[l], ln_g[l], ln_b[l])
        hp, a1, a2, a3, a4 = _layer(
            hp,
            jnp.zeros((bp, SSD_HEADS, SSD_HEAD_DIM, SSD_STATE), jnp.float32),
            jnp.zeros((bp, CONV_K - 1, SSD_CONV_DIM), x_prompt.dtype),
            jnp.zeros((bp, GDN_HEADS, GDN_HEAD_DIM, GDN_HEAD_DIM), jnp.float32),
            jnp.zeros((bp, CONV_K - 1, GDN_CONV_DIM), x_prompt.dtype),
            *wl)
        p_ssd.append(a1); p_ssd_conv.append(a2); p_gdn.append(a3); p_gdn_conv.append(a4)
        hs, b1, b2, b3, b4 = _layer(hs, state_ssd[l], state_ssd_conv[l], state_gdn[l], state_gdn_conv[l], *wl)
        s_ssd.append(b1); s_ssd_conv.append(b2); s_gdn.append(b3); s_gdn_conv.append(b4)
    return (hp, hs,
            jnp.stack(p_ssd), jnp.stack(p_ssd_conv), jnp.stack(p_gdn), jnp.stack(p_gdn_conv),
            jnp.stack(s_ssd), jnp.stack(s_ssd_conv), jnp.stack(s_gdn), jnp.stack(s_gdn_conv))
```

```cpp
#include <hip/hip_runtime.h>
#include <cstdio>
#include <cstdint>

#ifndef MK_FUSED
#define MK_FUSED 0
#endif

#define LAS __attribute__((address_space(3)))
typedef unsigned short bf16_t;
typedef short bf16x8 __attribute__((ext_vector_type(8)));
typedef float f32x4 __attribute__((ext_vector_type(4)));
typedef float f32x2v __attribute__((ext_vector_type(2)));
typedef unsigned u32x4 __attribute__((ext_vector_type(4)));
typedef unsigned u32x2 __attribute__((ext_vector_type(2)));

constexpr int DM = 4096, NTP = 8192, NTS = 128, NTOK = 8320, MPAD = 8448;
constexpr int NPROJ = 26752, P_LD = 26624, NPAD = 26880, MIXW = 8192, G_LD = 256;
constexpr int C_ZS = 0, C_XBC = 4096, C_QKV = 10240, C_ZG = 22528;
constexpr float ALPHA = 1.189207115002721f;
constexpr int LDS_BYTES = 147456;
constexpr int LDS_MISC = LDS_BYTES - 64;

constexpr size_t OFF_BAR = 0;
constexpr size_t OFF_XB  = 16384;
constexpr size_t OFF_WB  = OFF_XB  + (size_t)MPAD * DM * 2;
constexpr size_t OFF_WOB = OFF_WB  + (size_t)NPAD * DM * 2;
constexpr size_t OFF_P   = OFF_WOB + (size_t)DM * MIXW * 2;
constexpr size_t OFF_G32 = OFF_P   + (size_t)MPAD * P_LD * 2;
constexpr size_t OFF_MIX = OFF_G32 + (size_t)MPAD * G_LD * 4;
constexpr size_t OFF_U32 = OFF_MIX + (size_t)MPAD * MIXW * 2;
constexpr size_t OFF_R   = OFF_U32 + (size_t)MPAD * DM * 4;
constexpr size_t WS_END  = OFF_R   + (size_t)MPAD * DM * 4;
constexpr int QCTR_WORD = 3584;

constexpr size_t O_YP = 0;
constexpr size_t O_YS = O_YP + (size_t)NTP * DM;
constexpr size_t O_SSD_P = O_YS + (size_t)NTS * DM;
constexpr size_t O_SSDC_P = O_SSD_P + (size_t)4 * 64 * 64 * 128;
constexpr size_t O_GDN_P = O_SSDC_P + (size_t)4 * 3 * 6144;
constexpr size_t O_GDNC_P = O_GDN_P + (size_t)4 * 32 * 128 * 128;
constexpr size_t O_SSD_S = O_GDNC_P + (size_t)4 * 3 * 12288;
constexpr size_t O_SSDC_S = O_SSD_S + (size_t)128 * 64 * 64 * 128;
constexpr size_t O_GDN_S = O_SSDC_S + (size_t)128 * 3 * 6144;
constexpr size_t O_GDNC_S = O_GDN_S + (size_t)128 * 32 * 128 * 128;

struct Params {
    const float* x_prompt; const float* x_sample; const float* state_ssd; const float* state_ssd_conv; const float* state_gdn; const float* state_gdn_conv;
    const float* w_in; const float* ssd_conv_w; const float* ssd_conv_b; const float* ssd_dt_bias; const float* ssd_a_log; const float* ssd_d; const float* ssd_norm_w;
    const float* gdn_conv_w; const float* gdn_dt_bias; const float* gdn_a_log; const float* gdn_norm_w; const float* w_out; const float* ln_g; const float* ln_b;
    float* out; unsigned char* ws;
};

__device__ __forceinline__ unsigned cvt_pk_bf16(float lo, float hi) { unsigned r; asm volatile("v_cvt_pk_bf16_f32 %0, %1, %2" : "=v"(r) : "v"(lo), "v"(hi)); return r; }
__device__ __forceinline__ float bf2f(bf16_t v) { return __uint_as_float(((unsigned)v) << 16); }
__device__ __forceinline__ bf16_t f2bf(float f) { unsigned u = __float_as_uint(f); u += 0x7FFFu + ((u >> 16) & 1u); return (bf16_t)(u >> 16); }
__device__ __forceinline__ float silu_f(float x) { return x / (1.f + __expf(-x)); }
__device__ __forceinline__ float sigmoid_f(float x) { return 1.f / (1.f + __expf(-x)); }
__device__ __forceinline__ float softplus_f(float x) { return x > 20.f ? x : log1pf(expf(x)); }
__device__ __forceinline__ f32x4 ldbf4(const bf16_t* p) { const u32x2 v = *(const u32x2*)p; f32x4 r; r[0] = __uint_as_float(v[0] << 16); r[1] = __uint_as_float(v[0] & 0xffff0000u); r[2] = __uint_as_float(v[1] << 16); r[3] = __uint_as_float(v[1] & 0xffff0000u); return r; }
__device__ __forceinline__ float wave_sum(float v) {
#pragma unroll
    for (int m = 32; m >= 1; m >>= 1) v += __shfl_xor(v, m);
    return v;
}

#define XB_TMO      128
#define XB_XCNT(j)  (256  + 64 * (j))
#define XB_XSUB(j)  (1280 + 64 * (j))
#define XB_XGEN(j)  (2304 + 64 * (j))
#define XB_TOP      3328
#define XB_TOPGEN   3392
#define XCD_BAR_WORDS 3456
#define XB_SPIN_CAP (1u << 18)
__device__ __forceinline__ unsigned xb_ld(unsigned* p)              { return __hip_atomic_load(p, __ATOMIC_RELAXED, __HIP_MEMORY_SCOPE_AGENT); }
__device__ __forceinline__ unsigned xb_add(unsigned* p, unsigned v) { return __hip_atomic_fetch_add(p, v, __ATOMIC_RELAXED, __HIP_MEMORY_SCOPE_AGENT); }
__device__ __forceinline__ unsigned xb_xcc_id() { return (unsigned)__builtin_amdgcn_s_getreg((3 << 11) | 20) & 0xFu; }
#define XB_SPIN(cond, bar) do { unsigned _sp = 0; while (cond) { __builtin_amdgcn_s_sleep(1); \
    if ((++_sp & 255u) == 0u) { if (xb_ld(&(bar)[XB_TMO])) break; if (_sp > XB_SPIN_CAP) { atomicAdd(&(bar)[XB_TMO], 1u); break; } } } } while (0)
struct XcdBarrier { unsigned* bar; unsigned x; volatile LAS unsigned* st; };
__device__ __forceinline__ XcdBarrier xcd_barrier_post(unsigned* bar, volatile LAS unsigned* st) {
    XcdBarrier b; b.bar = bar; b.x = xb_xcc_id(); b.st = st;
    if (threadIdx.x == 0) (void)xb_add(&bar[XB_XCNT(b.x)], 1u);
    return b;
}
__device__ __forceinline__ void xcd_barrier_complete(unsigned* bar, unsigned x, unsigned& nloc, unsigned& nx) {
    const unsigned G = gridDim.x * gridDim.y * gridDim.z;
    unsigned sum, cnt, mine, sp = 0u;
    for (;;) {
        sum = 0u; cnt = 0u; mine = 0u;
#pragma unroll
        for (unsigned j = 0; j < 16; ++j) { const unsigned c = xb_ld(&bar[XB_XCNT(j)]); sum += c; cnt += (c > 0u) ? 1u : 0u; mine = (j == x) ? c : mine; }
        if (sum == G) break;
        __builtin_amdgcn_s_sleep(1);
        if ((++sp & 255u) == 0u) { if (xb_ld(&bar[XB_TMO])) break; if (sp > XB_SPIN_CAP) { atomicAdd(&bar[XB_TMO], 1u); break; } }
    }
    nloc = mine > 0u ? mine : 1u; nx = cnt > 0u ? cnt : 1u;
}
__device__ __forceinline__ void xcd_barrier(const XcdBarrier& b) {
    asm volatile("s_waitcnt vmcnt(0)" ::: "memory");
    __syncthreads();
    if (threadIdx.x == 0) {
        unsigned* bar = b.bar;
        __builtin_amdgcn_s_waitcnt(0);
        unsigned nloc = b.st[0], nx = b.st[1];
        if (nloc == 0u) { xcd_barrier_complete(bar, b.x, nloc, nx); b.st[0] = nloc; b.st[1] = nx; }
        const unsigned old = xb_add(&bar[XB_XSUB(b.x)], 1u);
        const unsigned gen = old / nloc;
        if (old + 1u == (gen + 1u) * nloc) {
            __builtin_amdgcn_fence(__ATOMIC_RELEASE, "agent");
            asm volatile("s_waitcnt vmcnt(0)" ::: "memory");
            const unsigned og = xb_add(&bar[XB_TOP], 1u);
            const unsigned tg = og / nx;
            if (og + 1u == (tg + 1u) * nx) xb_add(&bar[XB_TOPGEN], 1u);
            else XB_SPIN(xb_ld(&bar[XB_TOPGEN]) == tg, bar);
            __builtin_amdgcn_fence(__ATOMIC_ACQUIRE, "agent");
            xb_add(&bar[XB_XGEN(b.x)], 1u);
            asm volatile("s_waitcnt vmcnt(0)" ::: "memory");
        } else {
            XB_SPIN(xb_ld(&bar[XB_XGEN(b.x)]) == gen, bar);
            __builtin_amdgcn_fence(__ATOMIC_ACQUIRE, "agent");
            asm volatile("s_waitcnt vmcnt(0)" ::: "memory");
        }
    }
    __syncthreads();
}

namespace pg8 {
constexpr int BM = 256, BK = 64, HALF = 128, HTB = HALF * BK * 2, STAGE_BYTES = 8 * HTB, NXCD = 8, WGM = 8;
__host__ __device__ __forceinline__ int lds_byte(int r, int c) { const int st = (r >> 4) * 2 + (c >> 5), rr = r & 15, cc = c & 31, ob = rr * 64 + cc * 2; return st * 1024 + (ob ^ (((ob >> 9) & 1) << 5)); }
__host__ __device__ __forceinline__ void stage_rc(int b, int& R, int& C) { const int st = b / 1024, sb = b % 1024, swz = sb ^ (((sb >> 9) & 1) << 5); R = (st >> 1) * 16 + swz / 64; C = (st & 1) * 32 + (swz % 64) / 2; }
__host__ __device__ __forceinline__ int perm32(int rho) { const int n = rho >> 4, i = rho & 15; return 8 * (i >> 2) + 4 * n + (i & 3); }
struct Unit { int pm, pn; };
struct Gemm { const bf16_t* A; const bf16_t* Bt; int M, N, K; };
struct StaticOrder {
    int nM, nN, nwg, G, c;
    __host__ __device__ void init(int M, int N, int G_, int c_) { nM = M / BM; nN = N / BM; nwg = nM * nN; G = G_; c = c_; }
    __host__ __device__ bool next(int i, Unit& u) const {
        const long L = (long)i * G + c; if (L >= nwg) return false;
        int wgid = (int)L; { const int q = nwg / NXCD, r = nwg % NXCD, xcd = wgid % NXCD, off = wgid / NXCD; wgid = (xcd < r ? xcd * (q + 1) : r * (q + 1) + (xcd - r) * q) + off; }
        const int nig = WGM * nN, gid = wgid / nig, fm = gid * WGM, gsz = (nM - fm) < WGM ? (nM - fm) : WGM;
        u.pm = fm + ((wgid % nig) % gsz); u.pn = (wgid % nig) / gsz; return true;
    }
    __device__ __forceinline__ void a_ready(const Unit&) const {}
    __device__ __forceinline__ void done(const Unit&) const {}
};

struct EpiProj {
    static constexpr bool PERM = true, AFTER_DRAIN = false;
    bf16_t* P; float* G;
    __device__ __forceinline__ void operator()(const f32x4 (&acc)[2][2][4][2], const Unit& u, int wr, int wc, int fr, int fq) const {
        const int row0 = u.pm * BM + wr * 64 + fr;
        if (u.pn < 104) {
            const int col0 = u.pn * BM + wc * 32 + 8 * fq;
#pragma unroll
            for (int ai = 0; ai < 2; ++ai)
#pragma unroll
                for (int m = 0; m < 4; ++m) { bf16_t* rowp = P + (size_t)(row0 + ai * HALF + m * 16) * P_LD + col0;
#pragma unroll
                    for (int bj = 0; bj < 2; ++bj) { const f32x4 v0 = acc[ai][bj][m][0], v1 = acc[ai][bj][m][1];
                        u32x4 w; w[0] = cvt_pk_bf16(v0[0], v0[1]); w[1] = cvt_pk_bf16(v0[2], v0[3]); w[2] = cvt_pk_bf16(v1[0], v1[1]); w[3] = cvt_pk_bf16(v1[2], v1[3]);
                        *(u32x4*)(rowp + bj * HALF) = w; } }
        } else {
#pragma unroll
            for (int ai = 0; ai < 2; ++ai)
#pragma unroll
                for (int m = 0; m < 4; ++m) { float* rowp = G + (size_t)(row0 + ai * HALF + m * 16) * G_LD + wc * 32 + 8 * fq;
                    *(f32x4*)(rowp) = acc[ai][0][m][0]; *(f32x4*)(rowp + 4) = acc[ai][0][m][1]; }
        }
    }
};
struct EpiOut {
    static constexpr bool PERM = false, AFTER_DRAIN = false;
    float* R; const float* xp; const float* xs;
    __device__ __forceinline__ void operator()(const f32x4 (&acc)[2][2][4][2], const Unit& u, int wr, int wc, int fr, int fq) const {
        const int row0 = u.pm * BM + wr * 64 + fr, col0 = u.pn * BM + wc * 32 + 4 * fq;
#pragma unroll
        for (int ai = 0; ai < 2; ++ai)
#pragma unroll
            for (int m = 0; m < 4; ++m) { const int r = row0 + ai * HALF + m * 16;
                if (r < NTOK) { const float* xr = r < NTP ? xp + (size_t)r * DM : xs + (size_t)(r - NTP) * DM; float* rr = R + (size_t)r * DM;
#pragma unroll
                    for (int bj = 0; bj < 2; ++bj)
#pragma unroll
                        for (int n = 0; n < 2; ++n) { const int c = col0 + bj * HALF + n * 16; const f32x4 xv = *(const f32x4*)(xr + c); *(f32x4*)(rr + c) = acc[ai][bj][m][n] + ALPHA * xv; } } }
    }
};

template <class Epi, class Sched, bool ALIGN_EPI = false, bool SP2 = false>
__device__ __forceinline__ void gemm_phase(LAS unsigned char* lds, const Gemm g, const Sched& S, const Epi& E) {
    const int tid = threadIdx.x, wid = __builtin_amdgcn_readfirstlane(tid >> 6), lane = tid & 63, wr = wid >> 2, wc = wid & 3, fr = lane & 15, fq = lane >> 4;
    const int K = g.K, nt = K / BK;
    unsigned voffA[2], voffB[2];
#pragma unroll
    for (int i = 0; i < 2; ++i) { int R, C; stage_rc(tid * 16 + i * 8192, R, C); const int Rb = Epi::PERM ? ((R & ~31) + perm32(R & 31)) : R;
        voffA[i] = (unsigned)(R * K + C) * 2u; voffB[i] = (unsigned)(Rb * K + C) * 2u; }
    const size_t kstep = (size_t)(BK * 2);
    const size_t hstep = (size_t)HALF * K * 2;
    const size_t tstep = 2 * hstep;
    const unsigned ldsw = (unsigned)wid * 1024u;
    const int aoff = lds_byte(wr * 64 + fr, fq * 8), boff = lds_byte(wc * 32 + fr, fq * 8);
#define PG8_SA(b, h) (((b) * 2 + (h)) * HTB)
#define PG8_SB(b, h) ((4 + (b) * 2 + (h)) * HTB)
#define PG8_STAGE(bufoff, gbase, voff) do { _Pragma("unroll") for (int _i = 0; _i < 2; ++_i) \
        __builtin_amdgcn_global_load_lds((const unsigned*)((const char*)(gbase) + (voff)[_i]), (LAS unsigned*)(lds + (bufoff) + ldsw + _i * 8192), 16, 0, 0); } while (0)
#define PG8_LDA(dst, b, h) do { _Pragma("unroll") for (int m = 0; m < 4; ++m) _Pragma("unroll") for (int k = 0; k < 2; ++k) dst[m][k] = *(const LAS bf16x8*)(lds + PG8_SA(b, h) + aoff + m * 2048 + k * 1024); } while (0)
#define PG8_LDB(dst, b, h) do { _Pragma("unroll") for (int n = 0; n < 2; ++n) _Pragma("unroll") for (int k = 0; k < 2; ++k) dst[n][k] = *(const LAS bf16x8*)(lds + PG8_SB(b, h) + boff + n * 2048 + k * 1024); } while (0)
#define PG8_MMA(ai, bj, At, Bt) do { __builtin_amdgcn_s_setprio(1); _Pragma("unroll") for (int m = 0; m < 4; ++m) _Pragma("unroll") for (int n = 0; n < 2; ++n) _Pragma("unroll") for (int k = 0; k < 2; ++k) \
        acc[ai][bj][m][n] = __builtin_amdgcn_mfma_f32_16x16x32_bf16(Bt[n][k], At[m][k], acc[ai][bj][m][n], 0, 0, 0); __builtin_amdgcn_s_setprio(0); } while (0)
#define PG8_WAIT_V(n) asm volatile("s_waitcnt vmcnt(" #n ")" ::: "memory")
#define PG8_WAIT_L(n) asm volatile("s_waitcnt lgkmcnt(" #n ")" ::: "memory")
#define PG8_BAR __builtin_amdgcn_s_barrier()
#define PG8_SCHED __builtin_amdgcn_sched_barrier(0)
    Unit cur, nxt; int ui = 0;
    if (!S.next(0, cur)) return;
    f32x4 acc[2][2][4][2];
#pragma unroll
    for (int a = 0; a < 2; ++a)
#pragma unroll
        for (int b = 0; b < 2; ++b)
#pragma unroll
            for (int m = 0; m < 4; ++m)
#pragma unroll
                for (int n = 0; n < 2; ++n) acc[a][b][m][n] = (f32x4){0.f, 0.f, 0.f, 0.f};
    bf16x8 At[4][2], B0[2][2], B1[2][2];
    const char* cA = (const char*)g.A + (size_t)cur.pm * tstep; const char* cB = (const char*)g.Bt + (size_t)cur.pn * tstep;
    S.a_ready(cur);
    if constexpr (SP2) {
        PG8_STAGE(PG8_SB(0, 0), cB, voffB); PG8_STAGE(PG8_SB(0, 1), cB + hstep, voffB); PG8_STAGE(PG8_SA(0, 0), cA, voffA); PG8_STAGE(PG8_SA(0, 1), cA + hstep, voffA);
        if (wr == 1) PG8_BAR;
        PG8_WAIT_V(2); PG8_BAR;
        PG8_STAGE(PG8_SB(1, 0), cB + kstep, voffB); PG8_STAGE(PG8_SA(1, 0), cA + kstep, voffA); PG8_STAGE(PG8_SB(1, 1), cB + hstep + kstep, voffB);
        PG8_WAIT_V(6); PG8_BAR;
    } else {
        PG8_STAGE(PG8_SB(0, 0), cB, voffB); PG8_STAGE(PG8_SA(0, 0), cA, voffA); PG8_STAGE(PG8_SB(0, 1), cB + hstep, voffB); PG8_STAGE(PG8_SA(0, 1), cA + hstep, voffA);
        if (wr == 1) PG8_BAR;
        PG8_WAIT_V(4); PG8_BAR;
        PG8_STAGE(PG8_SB(1, 0), cB + kstep, voffB); PG8_STAGE(PG8_SA(1, 0), cA + kstep, voffA); PG8_STAGE(PG8_SB(1, 1), cB + hstep + kstep, voffB);
        PG8_WAIT_V(6); PG8_BAR;
    }
    for (;;) {
        const bool has_next = S.next(ui + 1, nxt);
        const char* nA = has_next ? (const char*)g.A + (size_t)nxt.pm * tstep : cA; const char* nB = has_next ? (const char*)g.Bt + (size_t)nxt.pn * tstep : cB;
        for (int t = 0; t < nt; t += 2) {
            const bool last = (t == nt - 2);
            const char* a1 = cA + (size_t)(t + 1) * kstep;
            const char* a2 = last ? nA : cA + (size_t)(t + 2) * kstep; const char* b2 = last ? nB : cB + (size_t)(t + 2) * kstep;
            const char* a3 = a2 + kstep; const char* b3 = b2 + kstep;
            if (last && has_next) S.a_ready(nxt);
            if constexpr (SP2) {
            PG8_LDB(B0, 0, 0); PG8_LDB(B1, 0, 1); PG8_SCHED; PG8_LDA(At, 0, 0); PG8_STAGE(PG8_SA(1, 1), a1 + hstep, voffA);
            PG8_WAIT_V(8); PG8_WAIT_L(0); PG8_BAR; PG8_MMA(0, 0, At, B0); PG8_MMA(0, 1, At, B1); PG8_BAR; PG8_SCHED;
            PG8_LDA(At, 0, 1); PG8_STAGE(PG8_SB(0, 0), b2, voffB); PG8_STAGE(PG8_SB(0, 1), b2 + hstep, voffB); PG8_STAGE(PG8_SA(0, 0), a2, voffA);
            PG8_WAIT_V(8); PG8_WAIT_L(0); PG8_BAR; PG8_MMA(1, 0, At, B0); PG8_MMA(1, 1, At, B1); PG8_BAR; PG8_SCHED;
            PG8_LDB(B0, 1, 0); PG8_LDB(B1, 1, 1); PG8_SCHED; PG8_LDA(At, 1, 0); PG8_STAGE(PG8_SA(0, 1), a2 + hstep, voffA);
            PG8_WAIT_V(8); PG8_WAIT_L(0); PG8_BAR; PG8_MMA(0, 0, At, B0); PG8_MMA(0, 1, At, B1); PG8_BAR; PG8_SCHED;
            PG8_LDA(At, 1, 1); PG8_STAGE(PG8_SB(1, 0), b3, voffB); PG8_STAGE(PG8_SB(1, 1), b3 + hstep, voffB); PG8_STAGE(PG8_SA(1, 0), a3, voffA);
            PG8_WAIT_V(8); PG8_WAIT_L(0); PG8_BAR; PG8_MMA(1, 0, At, B0); PG8_MMA(1, 1, At, B1); PG8_BAR; PG8_SCHED;
            } else {
            PG8_LDB(B0, 0, 0); PG8_SCHED; PG8_LDA(At, 0, 0); PG8_STAGE(PG8_SA(1, 1), a1 + hstep, voffA);
            PG8_WAIT_L(8); PG8_BAR; PG8_WAIT_L(0); PG8_MMA(0, 0, At, B0); PG8_BAR; PG8_SCHED;
            PG8_LDB(B1, 0, 1); PG8_STAGE(PG8_SB(0, 0), b2, voffB);
            PG8_BAR; PG8_WAIT_L(0); PG8_MMA(0, 1, At, B1); PG8_BAR;
            PG8_LDA(At, 0, 1); PG8_STAGE(PG8_SA(0, 0), a2, voffA);
            PG8_BAR; PG8_WAIT_L(0); PG8_MMA(1, 0, At, B0); PG8_BAR; PG8_SCHED;
            PG8_STAGE(PG8_SB(0, 1), b2 + hstep, voffB);
            PG8_WAIT_V(6); PG8_BAR; PG8_MMA(1, 1, At, B1); PG8_BAR;
            PG8_LDB(B0, 1, 0); PG8_SCHED; PG8_LDA(At, 1, 0); PG8_STAGE(PG8_SA(0, 1), a2 + hstep, voffA);
            PG8_WAIT_L(8); PG8_BAR; PG8_WAIT_L(0); PG8_MMA(0, 0, At, B0); PG8_BAR; PG8_SCHED;
            PG8_LDB(B1, 1, 1); PG8_STAGE(PG8_SB(1, 0), b3, voffB);
            PG8_BAR; PG8_WAIT_L(0); PG8_MMA(0, 1, At, B1); PG8_BAR;
            PG8_LDA(At, 1, 1); PG8_STAGE(PG8_SA(1, 0), a3, voffA);
            PG8_BAR; PG8_WAIT_L(0); PG8_MMA(1, 0, At, B0); PG8_BAR; PG8_SCHED;
            PG8_STAGE(PG8_SB(1, 1), b3 + hstep, voffB);
            PG8_WAIT_V(6); PG8_BAR; PG8_MMA(1, 1, At, B1); PG8_BAR;
            }
        }
        if constexpr (ALIGN_EPI) { if (wr == 0) PG8_BAR; }
        if constexpr (!Epi::AFTER_DRAIN) { E(acc, cur, wr, wc, fr, fq); S.done(cur); }
        if (!has_next) break;
#pragma unroll
        for (int a = 0; a < 2; ++a)
#pragma unroll
            for (int b = 0; b < 2; ++b)
#pragma unroll
                for (int m = 0; m < 4; ++m)
#pragma unroll
                    for (int n = 0; n < 2; ++n) acc[a][b][m][n] = (f32x4){0.f, 0.f, 0.f, 0.f};
        cur = nxt; cA = nA; cB = nB; ++ui;
        if constexpr (ALIGN_EPI) { if (wr == 1) PG8_BAR; }
    }
    PG8_WAIT_V(0);
    if constexpr (!ALIGN_EPI) { if (wr == 0) PG8_BAR; }
    PG8_BAR;
#undef PG8_SA
#undef PG8_SB
#undef PG8_STAGE
#undef PG8_LDA
#undef PG8_LDB
#undef PG8_MMA
#undef PG8_WAIT_V
#undef PG8_WAIT_L
#undef PG8_BAR
#undef PG8_SCHED
}
}

template <bool REMAP>
__device__ __forceinline__ void tconv(const float* __restrict__ src, int ldsrc, bf16_t* __restrict__ dst, int K, int ntn, LAS unsigned char* lds) {
    LAS unsigned* T = (LAS unsigned*)lds;
    const int tid = threadIdx.x, nkt = K / 128, total = nkt * ntn;
    for (int tile = blockIdx.x; tile < total; tile += gridDim.x) {
        const int nt = tile / nkt, kt = tile - nt * nkt, n0 = nt * 64, k0 = kt * 128;
        int on0 = n0; bool zero = false;
        if (REMAP) { if (n0 < 10240) on0 = n0; else if (n0 < 26624) on0 = n0 + 64; else if (n0 < 26688) on0 = n0 - 26624 + 10240; else if (n0 < 26752) on0 = n0; else zero = true; }
#pragma unroll
        for (int i = 0; i < 2; ++i) {
            const int rp = (tid >> 4) + 32 * i, c4 = tid & 15;
            f32x4 v0 = (f32x4){0.f, 0.f, 0.f, 0.f}, v1 = v0;
            if (!zero) { const float* s = src + (size_t)(k0 + 2 * rp) * ldsrc + on0 + c4 * 4; v0 = *(const f32x4*)s; v1 = *(const f32x4*)(s + ldsrc); }
#pragma unroll
            for (int j = 0; j < 4; ++j) T[(c4 * 4 + j) * 65 + rp] = cvt_pk_bf16(v0[j], v1[j]);
        }
        __syncthreads();
#pragma unroll
        for (int i = 0; i < 2; ++i) {
            const int n = (tid >> 4) + 32 * i, kc = tid & 15;
            u32x4 v; v[0] = T[n * 65 + kc * 4]; v[1] = T[n * 65 + kc * 4 + 1]; v[2] = T[n * 65 + kc * 4 + 2]; v[3] = T[n * 65 + kc * 4 + 3];
            *(u32x4*)(dst + (size_t)(n0 + n) * K + k0 + kc * 8) = v;
        }
        __syncthreads();
    }
}
__device__ __forceinline__ void phase_convert(const Params& p, LAS unsigned char* lds) {
    bf16_t* Xb = (bf16_t*)(p.ws + OFF_XB);
    const size_t n8 = (size_t)MPAD * DM / 8;
    for (size_t i = (size_t)blockIdx.x * 512 + threadIdx.x; i < n8; i += (size_t)gridDim.x * 512) {
        const size_t e = i * 8; const int row = (int)(e / DM);
        f32x4 a = (f32x4){0.f, 0.f, 0.f, 0.f}, b = a;
        if (row < NTP) { a = *(const f32x4*)(p.x_prompt + e); b = *(const f32x4*)(p.x_prompt + e + 4); }
        else if (row < NTOK) { const size_t e2 = e - (size_t)NTP * DM; a = *(const f32x4*)(p.x_sample + e2); b = *(const f32x4*)(p.x_sample + e2 + 4); }
        u32x4 o; o[0] = cvt_pk_bf16(a[0], a[1]); o[1] = cvt_pk_bf16(a[2], a[3]); o[2] = cvt_pk_bf16(b[0], b[1]); o[3] = cvt_pk_bf16(b[2], b[3]);
        *(u32x4*)(Xb + e) = o;
    }
    { u32x4* mz = (u32x4*)((bf16_t*)(p.ws + OFF_MIX) + (size_t)NTOK * MIXW); const size_t nz = (size_t)(MPAD - NTOK) * MIXW / 8;
      for (size_t i = (size_t)blockIdx.x * 512 + threadIdx.x; i < nz; i += (size_t)gridDim.x * 512) mz[i] = (u32x4){0u, 0u, 0u, 0u}; }
    tconv<true>(p.w_in, NPROJ, (bf16_t*)(p.ws + OFF_WB), DM, NPAD / 64, lds);
    tconv<false>(p.w_out, DM, (bf16_t*)(p.ws + OFF_WOB), MIXW, DM / 64, lds);
}

constexpr int N_GDN_P = 128, N_SSD_P = 256, N_GDN_S = 4096, N_SSD_S = 8192, N_ITEMS = N_GDN_P + N_SSD_P + N_GDN_S + N_SSD_S;
constexpr int GA_LD = 388, GO_LD = 132, SA_LD = 324, SY_LD = 68;

template <bool SAMPLE>
__device__ __forceinline__ void gdn_item(const Params& p, LAS unsigned char* lds, const int b, const int h) {
    LAS float* act = (LAS float*)lds;
    LAS float* tok = (LAS float*)(lds + 64 * GA_LD * 4);
    LAS float* obuf = (LAS float*)(lds + 64 * GA_LD * 4 + 1024);
    const bf16_t* P = (const bf16_t*)(p.ws + OFF_P); const float* G = (const float*)(p.ws + OFF_G32); bf16_t* MIX = (bf16_t*)(p.ws + OFF_MIX);
    const int tid = threadIdx.x, w = tid >> 6, lane = tid & 63, dgrp = lane >> 4, ecol = w * 16 + (lane & 15);
    float s[32];
    if (SAMPLE) { const float* S0 = p.state_gdn + (size_t)(b * 32 + h) * 16384;
#pragma unroll
        for (int i = 0; i < 32; ++i) s[i] = S0[(dgrp * 32 + i) * 128 + ecol]; }
    else {
#pragma unroll
        for (int i = 0; i < 32; ++i) s[i] = 0.f; }
    const int T = SAMPLE ? 1 : 64, NC = SAMPLE ? 1 : 32;
    const size_t rowbase = SAMPLE ? (size_t)(NTP + b) : (size_t)b * 2048;
    const float Aneg = -expf(p.gdn_a_log[h]), dtb = p.gdn_dt_bias[h];
    float* convout = p.out + (SAMPLE ? O_GDNC_S : O_GDNC_P);
    for (int c = 0; c < NC; ++c) {
        const int t0 = c * 64;
        for (int idx = tid; idx < T * 96; idx += 512) {
            const int t = idx / 96, cq = idx - t * 96, col = cq * 4, ch = (col >> 7) * 4096 + h * 128 + (col & 127);
            f32x4 a = (f32x4){0.f, 0.f, 0.f, 0.f};
#pragma unroll
            for (int j = 0; j < 4; ++j) {
                const f32x4 wv = *(const f32x4*)(p.gdn_conv_w + j * 12288 + ch);
                f32x4 rv = (f32x4){0.f, 0.f, 0.f, 0.f};
                if (SAMPLE) { if (j < 3) rv = *(const f32x4*)(p.state_gdn_conv + ((size_t)b * 3 + j) * 12288 + ch); else rv = ldbf4(P + rowbase * P_LD + C_QKV + ch);
                    if (j >= 1) *(f32x4*)(convout + ((size_t)b * 3 + (j - 1)) * 12288 + ch) = rv; }
                else { const int tt = t0 + t - 3 + j; if (tt >= 0) rv = ldbf4(P + (rowbase + tt) * P_LD + C_QKV + ch);
                    if (j == 3 && c == 31 && t >= 61) *(f32x4*)(convout + ((size_t)b * 3 + (t - 61)) * 12288 + ch) = rv; }
                a += wv * rv;
            }
            f32x4 o; o[0] = silu_f(a[0]); o[1] = silu_f(a[1]); o[2] = silu_f(a[2]); o[3] = silu_f(a[3]);
            *(LAS f32x4*)(act + t * GA_LD + col) = o;
        }
        __syncthreads();
#pragma unroll 1
        for (int r = 0; r < 8; ++r) { const int t = w * 8 + r; if (t < T) {
            LAS float* ar = act + t * GA_LD;
            const float q0 = ar[lane], q1 = ar[64 + lane], k0 = ar[128 + lane], k1 = ar[192 + lane];
            const float sq = wave_sum(q0 * q0 + q1 * q1), sk = wave_sum(k0 * k0 + k1 * k1);
            const float rq = rsqrtf(sq + 1e-6f) * 0.08838834764831845f, rk = rsqrtf(sk + 1e-6f);
            ar[lane] = q0 * rq; ar[64 + lane] = q1 * rq; ar[128 + lane] = k0 * rk; ar[192 + lane] = k1 * rk; } }
        if (tid < T) { const size_t row = rowbase + t0 + tid; const float araw = G[row * G_LD + 96 + h], braw = G[row * G_LD + 64 + h];
            tok[tid * 2] = sigmoid_f(braw); tok[tid * 2 + 1] = expf(Aneg * softplus_f(araw + dtb)); }
        __syncthreads();
#pragma unroll 1
        for (int t = 0; t < T; ++t) {
            LAS float* ar = act + t * GA_LD;
            const float beta = tok[t * 2], eg = tok[t * 2 + 1];
            float kk[32], qq[32];
#pragma unroll
            for (int i = 0; i < 8; ++i) { const f32x4 kv = *(LAS f32x4*)(ar + 128 + dgrp * 32 + i * 4); kk[4 * i] = kv[0]; kk[4 * i + 1] = kv[1]; kk[4 * i + 2] = kv[2]; kk[4 * i + 3] = kv[3]; }
            float ks = 0.f;
#pragma unroll
            for (int i = 0; i < 32; ++i) ks += kk[i] * s[i];
            ks += __shfl_xor(ks, 16); ks += __shfl_xor(ks, 32);
            const float vnew = beta * (ar[256 + ecol] - eg * ks);
#pragma unroll
            for (int i = 0; i < 8; ++i) { const f32x4 qv = *(LAS f32x4*)(ar + dgrp * 32 + i * 4); qq[4 * i] = qv[0]; qq[4 * i + 1] = qv[1]; qq[4 * i + 2] = qv[2]; qq[4 * i + 3] = qv[3]; }
            float o = 0.f;
#pragma unroll
            for (int i = 0; i < 32; ++i) { s[i] = eg * s[i] + kk[i] * vnew; o += qq[i] * s[i]; }
            o += __shfl_xor(o, 16); o += __shfl_xor(o, 32);
            if (dgrp == 0) obuf[t * GO_LD + ecol] = o;
        }
        __syncthreads();
#pragma unroll 1
        for (int r = 0; r < 8; ++r) { const int t = w * 8 + r; if (t < T) {
            const float o0 = obuf[t * GO_LD + lane], o1 = obuf[t * GO_LD + 64 + lane];
            const float rs = rsqrtf(wave_sum(o0 * o0 + o1 * o1) * (1.f / 128.f) + 1e-6f);
            const size_t row = rowbase + t0 + t;
            const float z0 = bf2f(P[row * P_LD + C_ZG + h * 128 + lane]), z1 = bf2f(P[row * P_LD + C_ZG + h * 128 + 64 + lane]);
            MIX[row * MIXW + 4096 + h * 128 + lane] = f2bf(o0 * rs * p.gdn_norm_w[lane] * silu_f(z0));
            MIX[row * MIXW + 4096 + h * 128 + 64 + lane] = f2bf(o1 * rs * p.gdn_norm_w[64 + lane] * silu_f(z1)); } }
        __syncthreads();
    }
    float* So = p.out + (SAMPLE ? O_GDN_S : O_GDN_P) + (size_t)(b * 32 + h) * 16384;
#pragma unroll
    for (int i = 0; i < 32; ++i) So[(dgrp * 32 + i) * 128 + ecol] = s[i];
}

template <bool SAMPLE>
__device__ __forceinline__ void ssd_item(const Params& p, LAS unsigned char* lds, const int b, const int h) {
    LAS float* act = (LAS float*)lds;
    LAS float* tok = (LAS float*)(lds + 64 * SA_LD * 4);
    LAS float* ybuf = (LAS float*)(lds + 64 * SA_LD * 4 + 1024);
    const bf16_t* P = (const bf16_t*)(p.ws + OFF_P); const float* G = (const float*)(p.ws + OFF_G32); float* U = (float*)(p.ws + OFF_U32);
    const int tid = threadIdx.x, w = tid >> 6, lane = tid & 63, pp = w * 8 + (lane >> 3), nch = lane & 7, g = h >> 3;
    float hs[16];
    if (SAMPLE) { const float* H0 = p.state_ssd + ((size_t)(b * 64 + h) * 64 + pp) * 128;
#pragma unroll
        for (int i = 0; i < 4; ++i) { const f32x4 v = *(const f32x4*)(H0 + i * 32 + nch * 4); hs[4 * i] = v[0]; hs[4 * i + 1] = v[1]; hs[4 * i + 2] = v[2]; hs[4 * i + 3] = v[3]; } }
    else {
#pragma unroll
        for (int i = 0; i < 16; ++i) hs[i] = 0.f; }
    const int T = SAMPLE ? 1 : 64, NC = SAMPLE ? 1 : 32;
    const size_t rowbase = SAMPLE ? (size_t)(NTP + b) : (size_t)b * 2048;
    const float Aneg = -expf(p.ssd_a_log[h]), dtb = p.ssd_dt_bias[h], Dh = p.ssd_d[h];
    float* convout = p.out + (SAMPLE ? O_SSDC_S : O_SSDC_P);
    for (int c = 0; c < NC; ++c) {
        const int t0 = c * 64;
        for (int idx = tid; idx < T * 80; idx += 512) {
            const int t = idx / 80, cq = idx - t * 80, col = cq * 4;
            const int ch = col < 64 ? h * 64 + col : (col < 192 ? 4096 + g * 128 + (col - 64) : 5120 + g * 128 + (col - 192));
            const bool wr_state = (col < 64) || ((h & 7) == 0);
            f32x4 a = *(const f32x4*)(p.ssd_conv_b + ch);
#pragma unroll
            for (int j = 0; j < 4; ++j) {
                const f32x4 wv = *(const f32x4*)(p.ssd_conv_w + j * 6144 + ch);
                f32x4 rv = (f32x4){0.f, 0.f, 0.f, 0.f};
                if (SAMPLE) { if (j < 3) rv = *(const f32x4*)(p.state_ssd_conv + ((size_t)b * 3 + j) * 6144 + ch); else rv = ldbf4(P + rowbase * P_LD + C_XBC + ch);
                    if (j >= 1 && wr_state) *(f32x4*)(convout + ((size_t)b * 3 + (j - 1)) * 6144 + ch) = rv; }
                else { const int tt = t0 + t - 3 + j; if (tt >= 0) rv = ldbf4(P + (rowbase + tt) * P_LD + C_XBC + ch);
                    if (j == 3 && c == 31 && t >= 61 && wr_state) *(f32x4*)(convout + ((size_t)b * 3 + (t - 61)) * 6144 + ch) = rv; }
                a += wv * rv;
            }
            f32x4 o; o[0] = silu_f(a[0]); o[1] = silu_f(a[1]); o[2] = silu_f(a[2]); o[3] = silu_f(a[3]);
            *(LAS f32x4*)(act + t * SA_LD + col) = o;
        }
        if (tid < T) { const size_t row = rowbase + t0 + tid; const float dt = softplus_f(G[row * G_LD + h] + dtb);
            tok[tid * 2] = dt; tok[tid * 2 + 1] = expf(dt * Aneg); }
        __syncthreads();
#pragma unroll 1
        for (int t = 0; t < T; ++t) {
            LAS float* ar = act + t * SA_LD;
            const float dt = tok[t * 2], eA = tok[t * 2 + 1];
            const float xdt = ar[pp] * dt;
            float y = 0.f;
#pragma unroll
            for (int i = 0; i < 4; ++i) { const f32x4 bv = *(LAS f32x4*)(ar + 64 + i * 32 + nch * 4), cv = *(LAS f32x4*)(ar + 192 + i * 32 + nch * 4);
#pragma unroll
                for (int j = 0; j < 4; ++j) { hs[4 * i + j] = eA * hs[4 * i + j] + xdt * bv[j]; y += cv[j] * hs[4 * i + j]; } }
            y += __shfl_xor(y, 1); y += __shfl_xor(y, 2); y += __shfl_xor(y, 4);
            if (nch == 0) ybuf[t * SY_LD + pp] = y;
        }
        __syncthreads();
        for (int idx = tid; idx < T * 64; idx += 512) { const int t = idx >> 6, q = idx & 63; const size_t row = rowbase + t0 + t;
            const float z = bf2f(P[row * P_LD + C_ZS + h * 64 + q]);
            U[row * DM + h * 64 + q] = (ybuf[t * SY_LD + q] + act[t * SA_LD + q] * Dh) * silu_f(z); }
        __syncthreads();
    }
    float* Ho = p.out + (SAMPLE ? O_SSD_S : O_SSD_P) + ((size_t)(b * 64 + h) * 64 + pp) * 128;
#pragma unroll
    for (int i = 0; i < 4; ++i) { f32x4 v; v[0] = hs[4 * i]; v[1] = hs[4 * i + 1]; v[2] = hs[4 * i + 2]; v[3] = hs[4 * i + 3]; *(f32x4*)(Ho + i * 32 + nch * 4) = v; }
}

__device__ __forceinline__ void phase_scan(const Params& p, LAS unsigned char* lds) {
    LAS int* qslot = (LAS int*)(lds + LDS_MISC + 16);
    unsigned* qctr = (unsigned*)(p.ws + OFF_BAR) + QCTR_WORD;
    for (;;) {
        __syncthreads();
        if (threadIdx.x == 0) *qslot = (int)__hip_atomic_fetch_add(qctr, 1u, __ATOMIC_RELAXED, __HIP_MEMORY_SCOPE_AGENT);
        __syncthreads();
        const int item = __builtin_amdgcn_readfirstlane(*qslot);
        if (item >= N_ITEMS) break;
        if (item < N_GDN_P) gdn_item<false>(p, lds, item >> 5, item & 31);
        else if (item < N_GDN_P + N_SSD_P) { const int i = item - N_GDN_P; ssd_item<false>(p, lds, i >> 6, i & 63); }
        else if (item < N_GDN_P + N_SSD_P + N_GDN_S) { const int i = item - N_GDN_P - N_SSD_P; gdn_item<true>(p, lds, i >> 5, i & 31); }
        else { const int i = item - N_GDN_P - N_SSD_P - N_GDN_S; ssd_item<true>(p, lds, i >> 6, i & 63); }
    }
}

__device__ __forceinline__ void phase_ssdnorm(const Params& p) {
    const float* U = (const float*)(p.ws + OFF_U32); bf16_t* MIX = (bf16_t*)(p.ws + OFF_MIX);
    const int lane = threadIdx.x & 63, gw = blockIdx.x * 8 + (threadIdx.x >> 6), nw = gridDim.x * 8;
    for (int it = gw; it < NTOK * 8; it += nw) {
        const int row = it >> 3, g = it & 7; const size_t off = (size_t)row * DM + g * 512 + lane * 8;
        const f32x4 a = *(const f32x4*)(U + off), b = *(const f32x4*)(U + off + 4);
        const float ss = wave_sum(a[0] * a[0] + a[1] * a[1] + a[2] * a[2] + a[3] * a[3] + b[0] * b[0] + b[1] * b[1] + b[2] * b[2] + b[3] * b[3]);
        const float rs = rsqrtf(ss * (1.f / 512.f) + 1e-6f);
        const f32x4 wa = *(const f32x4*)(p.ssd_norm_w + g * 512 + lane * 8), wb = *(const f32x4*)(p.ssd_norm_w + g * 512 + lane * 8 + 4);
        u32x4 o; o[0] = cvt_pk_bf16(a[0] * rs * wa[0], a[1] * rs * wa[1]); o[1] = cvt_pk_bf16(a[2] * rs * wa[2], a[3] * rs * wa[3]);
        o[2] = cvt_pk_bf16(b[0] * rs * wb[0], b[1] * rs * wb[1]); o[3] = cvt_pk_bf16(b[2] * rs * wb[2], b[3] * rs * wb[3]);
        *(u32x4*)(MIX + (size_t)row * MIXW + g * 512 + lane * 8) = o;
    }
}

__device__ __forceinline__ void phase_ln(const Params& p) {
    const float* R = (const float*)(p.ws + OFF_R);
    const int lane = threadIdx.x & 63, gw = blockIdx.x * 8 + (threadIdx.x >> 6), nw = gridDim.x * 8;
    for (int row = gw; row < NTOK; row += nw) {
        const float* rr = R + (size_t)row * DM;
        f32x4 v[16]; float sum = 0.f;
#pragma unroll
        for (int i = 0; i < 16; ++i) { v[i] = *(const f32x4*)(rr + (i * 64 + lane) * 4); sum += v[i][0] + v[i][1] + v[i][2] + v[i][3]; }
        const float mu = wave_sum(sum) * (1.f / 4096.f);
        float sq = 0.f;
#pragma unroll
        for (int i = 0; i < 16; ++i) { v[i] = v[i] - mu; sq += v[i][0] * v[i][0] + v[i][1] * v[i][1] + v[i][2] * v[i][2] + v[i][3] * v[i][3]; }
        const float rs = rsqrtf(wave_sum(sq) * (1.f / 4096.f) + 1e-5f);
        float* o = p.out + (row < NTP ? O_YP + (size_t)row * DM : O_YS + (size_t)(row - NTP) * DM);
#pragma unroll
        for (int i = 0; i < 16; ++i) { const int c = (i * 64 + lane) * 4; const f32x4 gg = *(const f32x4*)(p.ln_g + c), bb = *(const f32x4*)(p.ln_b + c);
            *(f32x4*)(o + c) = v[i] * rs * gg + bb; }
    }
}

template <int PH>
__global__ __launch_bounds__(512, 2) void mk_fwd(Params p) {
    extern __shared__ __attribute__((aligned(16))) unsigned char smem[];
    LAS unsigned char* lds = (LAS unsigned char*)smem;
    XcdBarrier bar;
    if (PH < 0) {
        if (threadIdx.x == 0) *(LAS u32x4*)(lds + LDS_MISC) = (u32x4){0u, 0u, 0u, 0u};
        __syncthreads();
        bar = xcd_barrier_post((unsigned*)(p.ws + OFF_BAR), (volatile LAS unsigned*)(lds + LDS_MISC));
    }
    if (PH < 0 || PH == 0) phase_convert(p, lds);
    if (PH < 0) xcd_barrier(bar);
    if (PH < 0 || PH == 1) {
        pg8::Gemm g{(const bf16_t*)(p.ws + OFF_XB), (const bf16_t*)(p.ws + OFF_WB), MPAD, NPAD, DM};
        pg8::StaticOrder S; S.init(MPAD, NPAD, (int)gridDim.x, (int)blockIdx.x);
        pg8::EpiProj E{(bf16_t*)(p.ws + OFF_P), (float*)(p.ws + OFF_G32)};
        pg8::gemm_phase<pg8::EpiProj, pg8::StaticOrder, true, true>(lds, g, S, E);
    }
    if (PH < 0) xcd_barrier(bar);
    if (PH < 0 || PH == 2) phase_scan(p, lds);
    if (PH < 0) xcd_barrier(bar);
    if (PH < 0 || PH == 3) phase_ssdnorm(p);
    if (PH < 0) xcd_barrier(bar);
    if (PH < 0 || PH == 4) {
        pg8::Gemm g{(const bf16_t*)(p.ws + OFF_MIX), (const bf16_t*)(p.ws + OFF_WOB), MPAD, DM, MIXW};
        pg8::StaticOrder S; S.init(MPAD, DM, (int)gridDim.x, (int)blockIdx.x);
        pg8::EpiOut E{(float*)(p.ws + OFF_R), p.x_prompt, p.x_sample};
        pg8::gemm_phase<pg8::EpiOut, pg8::StaticOrder, true, true>(lds, g, S, E);
    }
    if (PH < 0) xcd_barrier(bar);
    if (PH < 0 || PH == 5) phase_ln(p);
}

template <int PH> static void launch_phase(const Params& p, int grid, hipStream_t stream) {
    static bool attr = false;
    if (!attr) { (void)hipFuncSetAttribute((const void*)mk_fwd<PH>, hipFuncAttributeMaxDynamicSharedMemorySize, LDS_BYTES); attr = true; }
    hipLaunchKernelGGL((mk_fwd<PH>), dim3(grid), dim3(512), LDS_BYTES, stream, p);
}

extern "C" void kernel_launch(void* const* d_in, const int* in_sizes, int n_in, void* d_out, int out_size, void* d_ws, size_t ws_size, hipStream_t stream) {
    (void)in_sizes; (void)n_in; (void)out_size;
    if (ws_size < WS_END) { fprintf(stderr, "workspace too small: %zu < %zu\n", ws_size, (size_t)WS_END); return; }
    Params p{};
    p.x_prompt = (const float*)d_in[0]; p.x_sample = (const float*)d_in[1]; p.state_ssd = (const float*)d_in[2]; p.state_ssd_conv = (const float*)d_in[3];
    p.state_gdn = (const float*)d_in[4]; p.state_gdn_conv = (const float*)d_in[5]; p.w_in = (const float*)d_in[6]; p.ssd_conv_w = (const float*)d_in[7];
    p.ssd_conv_b = (const float*)d_in[8]; p.ssd_dt_bias = (const float*)d_in[9]; p.ssd_a_log = (const float*)d_in[10]; p.ssd_d = (const float*)d_in[11];
    p.ssd_norm_w = (const float*)d_in[12]; p.gdn_conv_w = (const float*)d_in[13]; p.gdn_dt_bias = (const float*)d_in[14]; p.gdn_a_log = (const float*)d_in[15];
    p.gdn_norm_w = (const float*)d_in[16]; p.w_out = (const float*)d_in[17]; p.ln_g = (const float*)d_in[18]; p.ln_b = (const float*)d_in[19];
    p.out = (float*)d_out; p.ws = (unsigned char*)d_ws;
    static int grid = 0;
    if (!grid) { int dev = 0, cus = 0; (void)hipGetDevice(&dev); (void)hipDeviceGetAttribute(&cus, hipDeviceAttributeMultiprocessorCount, dev); grid = cus > 0 ? cus : 256; }
    (void)hipMemsetAsync(d_ws, 0, 16384, stream);
#if MK_FUSED
    launch_phase<-1>(p, grid, stream);
#else
    launch_phase<0>(p, grid, stream); launch_phase<1>(p, grid, stream); launch_phase<2>(p, grid, stream);
    launch_phase<3>(p, grid, stream); launch_phase<4>(p, grid, stream); launch_phase<5>(p, grid, stream);
#endif
}
```

```cpp
#include <hip/hip_runtime.h>
#include <cstdio>
#include <cstdint>

#ifndef MK_FUSED
#define MK_FUSED 1
#endif

#define LAS __attribute__((address_space(3)))
typedef unsigned short bf16_t;
typedef short bf16x8 __attribute__((ext_vector_type(8)));
typedef float f32x4 __attribute__((ext_vector_type(4)));
typedef float f32x2v __attribute__((ext_vector_type(2)));
typedef unsigned u32x4 __attribute__((ext_vector_type(4)));
typedef unsigned u32x2 __attribute__((ext_vector_type(2)));

constexpr int DM = 4096, NTP = 8192, NTS = 128, NTOK = 8320, MPAD = 8448;
constexpr int NPROJ = 26752, P_LD = 26624, NPAD = 26880, MIXW = 8192, G_LD = 256;
constexpr int C_ZS = 0, C_XBC = 4096, C_QKV = 10240, C_ZG = 22528;
constexpr float ALPHA = 1.189207115002721f;
constexpr int LDS_BYTES = 147456;
constexpr int LDS_MISC = LDS_BYTES - 64;

constexpr size_t OFF_BAR = 0;
constexpr size_t OFF_XB  = 16384;
constexpr size_t OFF_WB  = OFF_XB  + (size_t)MPAD * DM * 2;
constexpr size_t OFF_WOB = OFF_WB  + (size_t)NPAD * DM * 2;
constexpr size_t OFF_P   = OFF_WOB + (size_t)DM * MIXW * 2;
constexpr size_t OFF_G32 = OFF_P   + (size_t)MPAD * P_LD * 2;
constexpr size_t OFF_MIX = OFF_G32 + (size_t)MPAD * G_LD * 4;
constexpr size_t OFF_U32 = OFF_MIX + (size_t)MPAD * MIXW * 2;
constexpr size_t OFF_R   = OFF_U32 + (size_t)MPAD * DM * 4;
constexpr size_t WS_END  = OFF_R   + (size_t)MPAD * DM * 4;
constexpr int QCTR_WORD = 3584;

constexpr size_t O_YP = 0;
constexpr size_t O_YS = O_YP + (size_t)NTP * DM;
constexpr size_t O_SSD_P = O_YS + (size_t)NTS * DM;
constexpr size_t O_SSDC_P = O_SSD_P + (size_t)4 * 64 * 64 * 128;
constexpr size_t O_GDN_P = O_SSDC_P + (size_t)4 * 3 * 6144;
constexpr size_t O_GDNC_P = O_GDN_P + (size_t)4 * 32 * 128 * 128;
constexpr size_t O_SSD_S = O_GDNC_P + (size_t)4 * 3 * 12288;
constexpr size_t O_SSDC_S = O_SSD_S + (size_t)128 * 64 * 64 * 128;
constexpr size_t O_GDN_S = O_SSDC_S + (size_t)128 * 3 * 6144;
constexpr size_t O_GDNC_S = O_GDN_S + (size_t)128 * 32 * 128 * 128;

struct Params {
    const float* x_prompt; const float* x_sample; const float* state_ssd; const float* state_ssd_conv; const float* state_gdn; const float* state_gdn_conv;
    const float* w_in; const float* ssd_conv_w; const float* ssd_conv_b; const float* ssd_dt_bias; const float* ssd_a_log; const float* ssd_d; const float* ssd_norm_w;
    const float* gdn_conv_w; const float* gdn_dt_bias; const float* gdn_a_log; const float* gdn_norm_w; const float* w_out; const float* ln_g; const float* ln_b;
    float* out; unsigned char* ws;
};

__device__ __forceinline__ unsigned cvt_pk_bf16(float lo, float hi) { unsigned r; asm volatile("v_cvt_pk_bf16_f32 %0, %1, %2" : "=v"(r) : "v"(lo), "v"(hi)); return r; }
__device__ __forceinline__ float bf2f(bf16_t v) { return __uint_as_float(((unsigned)v) << 16); }
__device__ __forceinline__ bf16_t f2bf(float f) { unsigned u = __float_as_uint(f); u += 0x7FFFu + ((u >> 16) & 1u); return (bf16_t)(u >> 16); }
__device__ __forceinline__ float silu_f(float x) { return x / (1.f + __expf(-x)); }
__device__ __forceinline__ float sigmoid_f(float x) { return 1.f / (1.f + __expf(-x)); }
__device__ __forceinline__ float softplus_f(float x) { return x > 20.f ? x : log1pf(expf(x)); }
__device__ __forceinline__ f32x4 ldbf4(const bf16_t* p) { const u32x2 v = *(const u32x2*)p; f32x4 r; r[0] = __uint_as_float(v[0] << 16); r[1] = __uint_as_float(v[0] & 0xffff0000u); r[2] = __uint_as_float(v[1] << 16); r[3] = __uint_as_float(v[1] & 0xffff0000u); return r; }
__device__ __forceinline__ float wave_sum(float v) {
#pragma unroll
    for (int m = 32; m >= 1; m >>= 1) v += __shfl_xor(v, m);
    return v;
}

#define XB_TMO      128
#define XB_XCNT(j)  (256  + 64 * (j))
#define XB_XSUB(j)  (1280 + 64 * (j))
#define XB_XGEN(j)  (2304 + 64 * (j))
#define XB_TOP      3328
#define XB_TOPGEN   3392
#define XCD_BAR_WORDS 3456
#define XB_SPIN_CAP (1u << 18)
__device__ __forceinline__ unsigned xb_ld(unsigned* p)              { return __hip_atomic_load(p, __ATOMIC_RELAXED, __HIP_MEMORY_SCOPE_AGENT); }
__device__ __forceinline__ unsigned xb_add(unsigned* p, unsigned v) { return __hip_atomic_fetch_add(p, v, __ATOMIC_RELAXED, __HIP_MEMORY_SCOPE_AGENT); }
__device__ __forceinline__ unsigned xb_xcc_id() { return (unsigned)__builtin_amdgcn_s_getreg((3 << 11) | 20) & 0xFu; }
#define XB_SPIN(cond, bar) do { unsigned _sp = 0; while (cond) { __builtin_amdgcn_s_sleep(1); \
    if ((++_sp & 255u) == 0u) { if (xb_ld(&(bar)[XB_TMO])) break; if (_sp > XB_SPIN_CAP) { atomicAdd(&(bar)[XB_TMO], 1u); break; } } } } while (0)
struct XcdBarrier { unsigned* bar; unsigned x; volatile LAS unsigned* st; };
__device__ __forceinline__ XcdBarrier xcd_barrier_post(unsigned* bar, volatile LAS unsigned* st) {
    XcdBarrier b; b.bar = bar; b.x = xb_xcc_id(); b.st = st;
    if (threadIdx.x == 0) (void)xb_add(&bar[XB_XCNT(b.x)], 1u);
    return b;
}
__device__ __forceinline__ void xcd_barrier_complete(unsigned* bar, unsigned x, unsigned& nloc, unsigned& nx) {
    const unsigned G = gridDim.x * gridDim.y * gridDim.z;
    unsigned sum, cnt, mine, sp = 0u;
    for (;;) {
        sum = 0u; cnt = 0u; mine = 0u;
#pragma unroll
        for (unsigned j = 0; j < 16; ++j) { const unsigned c = xb_ld(&bar[XB_XCNT(j)]); sum += c; cnt += (c > 0u) ? 1u : 0u; mine = (j == x) ? c : mine; }
        if (sum == G) break;
        __builtin_amdgcn_s_sleep(1);
        if ((++sp & 255u) == 0u) { if (xb_ld(&bar[XB_TMO])) break; if (sp > XB_SPIN_CAP) { atomicAdd(&bar[XB_TMO], 1u); break; } }
    }
    nloc = mine > 0u ? mine : 1u; nx = cnt > 0u ? cnt : 1u;
}
__device__ __forceinline__ void xcd_barrier(const XcdBarrier& b) {
    asm volatile("s_waitcnt vmcnt(0)" ::: "memory");
    __syncthreads();
    if (threadIdx.x == 0) {
        unsigned* bar = b.bar;
        __builtin_amdgcn_s_waitcnt(0);
        unsigned nloc = b.st[0], nx = b.st[1];
        if (nloc == 0u) { xcd_barrier_complete(bar, b.x, nloc, nx); b.st[0] = nloc; b.st[1] = nx; }
        const unsigned old = xb_add(&bar[XB_XSUB(b.x)], 1u);
        const unsigned gen = old / nloc;
        if (old + 1u == (gen + 1u) * nloc) {
            __builtin_amdgcn_fence(__ATOMIC_RELEASE, "agent");
            asm volatile("s_waitcnt vmcnt(0)" ::: "memory");
            const unsigned og = xb_add(&bar[XB_TOP], 1u);
            const unsigned tg = og / nx;
            if (og + 1u == (tg + 1u) * nx) xb_add(&bar[XB_TOPGEN], 1u);
            else XB_SPIN(xb_ld(&bar[XB_TOPGEN]) == tg, bar);
            __builtin_amdgcn_fence(__ATOMIC_ACQUIRE, "agent");
            xb_add(&bar[XB_XGEN(b.x)], 1u);
            asm volatile("s_waitcnt vmcnt(0)" ::: "memory");
        } else {
            XB_SPIN(xb_ld(&bar[XB_XGEN(b.x)]) == gen, bar);
            __builtin_amdgcn_fence(__ATOMIC_ACQUIRE, "agent");
            asm volatile("s_waitcnt vmcnt(0)" ::: "memory");
        }
    }
    __syncthreads();
}

namespace pg8 {
constexpr int BM = 256, BK = 64, HALF = 128, HTB = HALF * BK * 2, STAGE_BYTES = 8 * HTB, NXCD = 8, WGM = 8;
__host__ __device__ __forceinline__ int lds_byte(int r, int c) { const int st = (r >> 4) * 2 + (c >> 5), rr = r & 15, cc = c & 31, ob = rr * 64 + cc * 2; return st * 1024 + (ob ^ (((ob >> 9) & 1) << 5)); }
__host__ __device__ __forceinline__ void stage_rc(int b, int& R, int& C) { const int st = b / 1024, sb = b % 1024, swz = sb ^ (((sb >> 9) & 1) << 5); R = (st >> 1) * 16 + swz / 64; C = (st & 1) * 32 + (swz % 64) / 2; }
__host__ __device__ __forceinline__ int perm32(int rho) { const int n = rho >> 4, i = rho & 15; return 8 * (i >> 2) + 4 * n + (i & 3); }
struct Unit { int pm, pn; };
struct Gemm { const bf16_t* A; const bf16_t* Bt; int M, N, K; };
struct StaticOrder {
    int nM, nN, nwg, G, c;
    __host__ __device__ void init(int M, int N, int G_, int c_) { nM = M / BM; nN = N / BM; nwg = nM * nN; G = G_; c = c_; }
    __host__ __device__ bool next(int i, Unit& u) const {
        const long L = (long)i * G + c; if (L >= nwg) return false;
        int wgid = (int)L; { const int q = nwg / NXCD, r = nwg % NXCD, xcd = wgid % NXCD, off = wgid / NXCD; wgid = (xcd < r ? xcd * (q + 1) : r * (q + 1) + (xcd - r) * q) + off; }
        const int nig = WGM * nN, gid = wgid / nig, fm = gid * WGM, gsz = (nM - fm) < WGM ? (nM - fm) : WGM;
        u.pm = fm + ((wgid % nig) % gsz); u.pn = (wgid % nig) / gsz; return true;
    }
    __device__ __forceinline__ void a_ready(const Unit&) const {}
    __device__ __forceinline__ void done(const Unit&) const {}
};

struct EpiProj {
    static constexpr bool PERM = true, AFTER_DRAIN = false;
    bf16_t* P; float* G;
    __device__ __forceinline__ void operator()(const f32x4 (&acc)[2][2][4][2], const Unit& u, int wr, int wc, int fr, int fq) const {
        const int row0 = u.pm * BM + wr * 64 + fr;
        if (u.pn < 104) {
            const int col0 = u.pn * BM + wc * 32 + 8 * fq;
#pragma unroll
            for (int ai = 0; ai < 2; ++ai)
#pragma unroll
                for (int m = 0; m < 4; ++m) { bf16_t* rowp = P + (size_t)(row0 + ai * HALF + m * 16) * P_LD + col0;
#pragma unroll
                    for (int bj = 0; bj < 2; ++bj) { const f32x4 v0 = acc[ai][bj][m][0], v1 = acc[ai][bj][m][1];
                        u32x4 w; w[0] = cvt_pk_bf16(v0[0], v0[1]); w[1] = cvt_pk_bf16(v0[2], v0[3]); w[2] = cvt_pk_bf16(v1[0], v1[1]); w[3] = cvt_pk_bf16(v1[2], v1[3]);
                        *(u32x4*)(rowp + bj * HALF) = w; } }
        } else {
#pragma unroll
            for (int ai = 0; ai < 2; ++ai)
#pragma unroll
                for (int m = 0; m < 4; ++m) { float* rowp = G + (size_t)(row0 + ai * HALF + m * 16) * G_LD + wc * 32 + 8 * fq;
                    *(f32x4*)(rowp) = acc[ai][0][m][0]; *(f32x4*)(rowp + 4) = acc[ai][0][m][1]; }
        }
    }
};
struct EpiOut {
    static constexpr bool PERM = false, AFTER_DRAIN = false;
    float* R; const float* xp; const float* xs;
    __device__ __forceinline__ void operator()(const f32x4 (&acc)[2][2][4][2], const Unit& u, int wr, int wc, int fr, int fq) const {
        const int row0 = u.pm * BM + wr * 64 + fr, col0 = u.pn * BM + wc * 32 + 4 * fq;
#pragma unroll
        for (int ai = 0; ai < 2; ++ai)
#pragma unroll
            for (int m = 0; m < 4; ++m) { const int r = row0 + ai * HALF + m * 16;
                if (r < NTOK) { const float* xr = r < NTP ? xp + (size_t)r * DM : xs + (size_t)(r - NTP) * DM; float* rr = R + (size_t)r * DM;
#pragma unroll
                    for (int bj = 0; bj < 2; ++bj)
#pragma unroll
                        for (int n = 0; n < 2; ++n) { const int c = col0 + bj * HALF + n * 16; const f32x4 xv = *(const f32x4*)(xr + c); *(f32x4*)(rr + c) = acc[ai][bj][m][n] + ALPHA * xv; } } }
    }
};

template <class Epi, class Sched, bool ALIGN_EPI = false, bool SP2 = false>
__device__ __forceinline__ void gemm_phase(LAS unsigned char* lds, const Gemm g, const Sched& S, const Epi& E) {
    const int tid = threadIdx.x, wid = __builtin_amdgcn_readfirstlane(tid >> 6), lane = tid & 63, wr = wid >> 2, wc = wid & 3, fr = lane & 15, fq = lane >> 4;
    const int K = g.K, nt = K / BK;
    unsigned voffA[2], voffB[2];
#pragma unroll
    for (int i = 0; i < 2; ++i) { int R, C; stage_rc(tid * 16 + i * 8192, R, C); const int Rb = Epi::PERM ? ((R & ~31) + perm32(R & 31)) : R;
        voffA[i] = (unsigned)(R * K + C) * 2u; voffB[i] = (unsigned)(Rb * K + C) * 2u; }
    const size_t kstep = (size_t)(BK * 2);
    const size_t hstep = (size_t)HALF * K * 2;
    const size_t tstep = 2 * hstep;
    const unsigned ldsw = (unsigned)wid * 1024u;
    const int aoff = lds_byte(wr * 64 + fr, fq * 8), boff = lds_byte(wc * 32 + fr, fq * 8);
#define PG8_SA(b, h) (((b) * 2 + (h)) * HTB)
#define PG8_SB(b, h) ((4 + (b) * 2 + (h)) * HTB)
#define PG8_STAGE(bufoff, gbase, voff) do { _Pragma("unroll") for (int _i = 0; _i < 2; ++_i) \
        __builtin_amdgcn_global_load_lds((const unsigned*)((const char*)(gbase) + (voff)[_i]), (LAS unsigned*)(lds + (bufoff) + ldsw + _i * 8192), 16, 0, 0); } while (0)
#define PG8_LDA(dst, b, h) do { _Pragma("unroll") for (int m = 0; m < 4; ++m) _Pragma("unroll") for (int k = 0; k < 2; ++k) dst[m][k] = *(const LAS bf16x8*)(lds + PG8_SA(b, h) + aoff + m * 2048 + k * 1024); } while (0)
#define PG8_LDB(dst, b, h) do { _Pragma("unroll") for (int n = 0; n < 2; ++n) _Pragma("unroll") for (int k = 0; k < 2; ++k) dst[n][k] = *(const LAS bf16x8*)(lds + PG8_SB(b, h) + boff + n * 2048 + k * 1024); } while (0)
#define PG8_MMA(ai, bj, At, Bt) do { __builtin_amdgcn_s_setprio(1); _Pragma("unroll") for (int m = 0; m < 4; ++m) _Pragma("unroll") for (int n = 0; n < 2; ++n) _Pragma("unroll") for (int k = 0; k < 2; ++k) \
        acc[ai][bj][m][n] = __builtin_amdgcn_mfma_f32_16x16x32_bf16(Bt[n][k], At[m][k], acc[ai][bj][m][n], 0, 0, 0); __builtin_amdgcn_s_setprio(0); } while (0)
#define PG8_WAIT_V(n) asm volatile("s_waitcnt vmcnt(" #n ")" ::: "memory")
#define PG8_WAIT_L(n) asm volatile("s_waitcnt lgkmcnt(" #n ")" ::: "memory")
#define PG8_BAR __builtin_amdgcn_s_barrier()
#define PG8_SCHED __builtin_amdgcn_sched_barrier(0)
    Unit cur, nxt; int ui = 0;
    if (!S.next(0, cur)) return;
    f32x4 acc[2][2][4][2];
#pragma unroll
    for (int a = 0; a < 2; ++a)
#pragma unroll
        for (int b = 0; b < 2; ++b)
#pragma unroll
            for (int m = 0; m < 4; ++m)
#pragma unroll
                for (int n = 0; n < 2; ++n) acc[a][b][m][n] = (f32x4){0.f, 0.f, 0.f, 0.f};
    bf16x8 At[4][2], B0[2][2], B1[2][2];
    const char* cA = (const char*)g.A + (size_t)cur.pm * tstep; const char* cB = (const char*)g.Bt + (size_t)cur.pn * tstep;
    S.a_ready(cur);
    if constexpr (SP2) {
        PG8_STAGE(PG8_SB(0, 0), cB, voffB); PG8_STAGE(PG8_SB(0, 1), cB + hstep, voffB); PG8_STAGE(PG8_SA(0, 0), cA, voffA); PG8_STAGE(PG8_SA(0, 1), cA + hstep, voffA);
        if (wr == 1) PG8_BAR;
        PG8_WAIT_V(2); PG8_BAR;
        PG8_STAGE(PG8_SB(1, 0), cB + kstep, voffB); PG8_STAGE(PG8_SA(1, 0), cA + kstep, voffA); PG8_STAGE(PG8_SB(1, 1), cB + hstep + kstep, voffB);
        PG8_WAIT_V(6); PG8_BAR;
    } else {
        PG8_STAGE(PG8_SB(0, 0), cB, voffB); PG8_STAGE(PG8_SA(0, 0), cA, voffA); PG8_STAGE(PG8_SB(0, 1), cB + hstep, voffB); PG8_STAGE(PG8_SA(0, 1), cA + hstep, voffA);
        if (wr == 1) PG8_BAR;
        PG8_WAIT_V(4); PG8_BAR;
        PG8_STAGE(PG8_SB(1, 0), cB + kstep, voffB); PG8_STAGE(PG8_SA(1, 0), cA + kstep, voffA); PG8_STAGE(PG8_SB(1, 1), cB + hstep + kstep, voffB);
        PG8_WAIT_V(6); PG8_BAR;
    }
    for (;;) {
        const bool has_next = S.next(ui + 1, nxt);
        const char* nA = has_next ? (const char*)g.A + (size_t)nxt.pm * tstep : cA; const char* nB = has_next ? (const char*)g.Bt + (size_t)nxt.pn * tstep : cB;
        for (int t = 0; t < nt; t += 2) {
            const bool last = (t == nt - 2);
            const char* a1 = cA + (size_t)(t + 1) * kstep;
            const char* a2 = last ? nA : cA + (size_t)(t + 2) * kstep; const char* b2 = last ? nB : cB + (size_t)(t + 2) * kstep;
            const char* a3 = a2 + kstep; const char* b3 = b2 + kstep;
            if (last && has_next) S.a_ready(nxt);
            if constexpr (SP2) {
            PG8_LDB(B0, 0, 0); PG8_LDB(B1, 0, 1); PG8_SCHED; PG8_LDA(At, 0, 0); PG8_STAGE(PG8_SA(1, 1), a1 + hstep, voffA);
            PG8_WAIT_V(8); PG8_WAIT_L(0); PG8_BAR; PG8_MMA(0, 0, At, B0); PG8_MMA(0, 1, At, B1); PG8_BAR; PG8_SCHED;
            PG8_LDA(At, 0, 1); PG8_STAGE(PG8_SB(0, 0), b2, voffB); PG8_STAGE(PG8_SB(0, 1), b2 + hstep, voffB); PG8_STAGE(PG8_SA(0, 0), a2, voffA);
            PG8_WAIT_V(8); PG8_WAIT_L(0); PG8_BAR; PG8_MMA(1, 0, At, B0); PG8_MMA(1, 1, At, B1); PG8_BAR; PG8_SCHED;
            PG8_LDB(B0, 1, 0); PG8_LDB(B1, 1, 1); PG8_SCHED; PG8_LDA(At, 1, 0); PG8_STAGE(PG8_SA(0, 1), a2 + hstep, voffA);
            PG8_WAIT_V(8); PG8_WAIT_L(0); PG8_BAR; PG8_MMA(0, 0, At, B0); PG8_MMA(0, 1, At, B1); PG8_BAR; PG8_SCHED;
            PG8_LDA(At, 1, 1); PG8_STAGE(PG8_SB(1, 0), b3, voffB); PG8_STAGE(PG8_SB(1, 1), b3 + hstep, voffB); PG8_STAGE(PG8_SA(1, 0), a3, voffA);
            PG8_WAIT_V(8); PG8_WAIT_L(0); PG8_BAR; PG8_MMA(1, 0, At, B0); PG8_MMA(1, 1, At, B1); PG8_BAR; PG8_SCHED;
            } else {
            PG8_LDB(B0, 0, 0); PG8_SCHED; PG8_LDA(At, 0, 0); PG8_STAGE(PG8_SA(1, 1), a1 + hstep, voffA);
            PG8_WAIT_L(8); PG8_BAR; PG8_WAIT_L(0); PG8_MMA(0, 0, At, B0); PG8_BAR; PG8_SCHED;
            PG8_LDB(B1, 0, 1); PG8_STAGE(PG8_SB(0, 0), b2, voffB);
            PG8_BAR; PG8_WAIT_L(0); PG8_MMA(0, 1, At, B1); PG8_BAR;
            PG8_LDA(At, 0, 1); PG8_STAGE(PG8_SA(0, 0), a2, voffA);
            PG8_BAR; PG8_WAIT_L(0); PG8_MMA(1, 0, At, B0); PG8_BAR; PG8_SCHED;
            PG8_STAGE(PG8_SB(0, 1), b2 + hstep, voffB);
            PG8_WAIT_V(6); PG8_BAR; PG8_MMA(1, 1, At, B1); PG8_BAR;
            PG8_LDB(B0, 1, 0); PG8_SCHED; PG8_LDA(At, 1, 0); PG8_STAGE(PG8_SA(0, 1), a2 + hstep, voffA);
            PG8_WAIT_L(8); PG8_BAR; PG8_WAIT_L(0); PG8_MMA(0, 0, At, B0); PG8_BAR; PG8_SCHED;
            PG8_LDB(B1, 1, 1); PG8_STAGE(PG8_SB(1, 0), b3, voffB);
            PG8_BAR; PG8_WAIT_L(0); PG8_MMA(0, 1, At, B1); PG8_BAR;
            PG8_LDA(At, 1, 1); PG8_STAGE(PG8_SA(1, 0), a3, voffA);
            PG8_BAR; PG8_WAIT_L(0); PG8_MMA(1, 0, At, B0); PG8_BAR; PG8_SCHED;
            PG8_STAGE(PG8_SB(1, 1), b3 + hstep, voffB);
            PG8_WAIT_V(6); PG8_BAR; PG8_MMA(1, 1, At, B1); PG8_BAR;
            }
        }
        if constexpr (ALIGN_EPI) { if (wr == 0) PG8_BAR; }
        if constexpr (!Epi::AFTER_DRAIN) { E(acc, cur, wr, wc, fr, fq); S.done(cur); }
        if (!has_next) break;
#pragma unroll
        for (int a = 0; a < 2; ++a)
#pragma unroll
            for (int b = 0; b < 2; ++b)
#pragma unroll
                for (int m = 0; m < 4; ++m)
#pragma unroll
                    for (int n = 0; n < 2; ++n) acc[a][b][m][n] = (f32x4){0.f, 0.f, 0.f, 0.f};
        cur = nxt; cA = nA; cB = nB; ++ui;
        if constexpr (ALIGN_EPI) { if (wr == 1) PG8_BAR; }
    }
    PG8_WAIT_V(0);
    if constexpr (!ALIGN_EPI) { if (wr == 0) PG8_BAR; }
    PG8_BAR;
#undef PG8_SA
#undef PG8_SB
#undef PG8_STAGE
#undef PG8_LDA
#undef PG8_LDB
#undef PG8_MMA
#undef PG8_WAIT_V
#undef PG8_WAIT_L
#undef PG8_BAR
#undef PG8_SCHED
}
}

template <bool REMAP>
__device__ __forceinline__ void tconv(const float* __restrict__ src, int ldsrc, bf16_t* __restrict__ dst, int K, int ntn, LAS unsigned char* lds) {
    LAS unsigned* T = (LAS unsigned*)lds;
    const int tid = threadIdx.x, nkt = K / 128, total = nkt * ntn;
    for (int tile = blockIdx.x; tile < total; tile += gridDim.x) {
        const int nt = tile / nkt, kt = tile - nt * nkt, n0 = nt * 64, k0 = kt * 128;
        int on0 = n0; bool zero = false;
        if (REMAP) { if (n0 < 10240) on0 = n0; else if (n0 < 26624) on0 = n0 + 64; else if (n0 < 26688) on0 = n0 - 26624 + 10240; else if (n0 < 26752) on0 = n0; else zero = true; }
#pragma unroll
        for (int i = 0; i < 2; ++i) {
            const int rp = (tid >> 4) + 32 * i, c4 = tid & 15;
            f32x4 v0 = (f32x4){0.f, 0.f, 0.f, 0.f}, v1 = v0;
            if (!zero) { const float* s = src + (size_t)(k0 + 2 * rp) * ldsrc + on0 + c4 * 4; v0 = *(const f32x4*)s; v1 = *(const f32x4*)(s + ldsrc); }
#pragma unroll
            for (int j = 0; j < 4; ++j) T[(c4 * 4 + j) * 65 + rp] = cvt_pk_bf16(v0[j], v1[j]);
        }
        __syncthreads();
#pragma unroll
        for (int i = 0; i < 2; ++i) {
            const int n = (tid >> 4) + 32 * i, kc = tid & 15;
            u32x4 v; v[0] = T[n * 65 + kc * 4]; v[1] = T[n * 65 + kc * 4 + 1]; v[2] = T[n * 65 + kc * 4 + 2]; v[3] = T[n * 65 + kc * 4 + 3];
            *(u32x4*)(dst + (size_t)(n0 + n) * K + k0 + kc * 8) = v;
        }
        __syncthreads();
    }
}
__device__ __forceinline__ void phase_convert(const Params& p, LAS unsigned char* lds) {
    bf16_t* Xb = (bf16_t*)(p.ws + OFF_XB);
    const size_t n8 = (size_t)MPAD * DM / 8;
    for (size_t i = (size_t)blockIdx.x * 512 + threadIdx.x; i < n8; i += (size_t)gridDim.x * 512) {
        const size_t e = i * 8; const int row = (int)(e / DM);
        f32x4 a = (f32x4){0.f, 0.f, 0.f, 0.f}, b = a;
        if (row < NTP) { a = *(const f32x4*)(p.x_prompt + e); b = *(const f32x4*)(p.x_prompt + e + 4); }
        else if (row < NTOK) { const size_t e2 = e - (size_t)NTP * DM; a = *(const f32x4*)(p.x_sample + e2); b = *(const f32x4*)(p.x_sample + e2 + 4); }
        u32x4 o; o[0] = cvt_pk_bf16(a[0], a[1]); o[1] = cvt_pk_bf16(a[2], a[3]); o[2] = cvt_pk_bf16(b[0], b[1]); o[3] = cvt_pk_bf16(b[2], b[3]);
        *(u32x4*)(Xb + e) = o;
    }
    { u32x4* mz = (u32x4*)((bf16_t*)(p.ws + OFF_MIX) + (size_t)NTOK * MIXW); const size_t nz = (size_t)(MPAD - NTOK) * MIXW / 8;
      for (size_t i = (size_t)blockIdx.x * 512 + threadIdx.x; i < nz; i += (size_t)gridDim.x * 512) mz[i] = (u32x4){0u, 0u, 0u, 0u}; }
    tconv<true>(p.w_in, NPROJ, (bf16_t*)(p.ws + OFF_WB), DM, NPAD / 64, lds);
    tconv<false>(p.w_out, DM, (bf16_t*)(p.ws + OFF_WOB), MIXW, DM / 64, lds);
}

constexpr int N_GDN_P = 128, N_SSD_P = 256, N_GDN_S = 4096, N_SSD_S = 8192, N_ITEMS = N_GDN_P + N_SSD_P + N_GDN_S + N_SSD_S;
constexpr int GA_LD = 388, GO_LD = 132, SA_LD = 324, SY_LD = 68;

template <bool SAMPLE>
__device__ __forceinline__ void gdn_item(const Params& p, LAS unsigned char* lds, const int b, const int h) {
    LAS float* act = (LAS float*)lds;
    LAS float* tok = (LAS float*)(lds + 64 * GA_LD * 4);
    LAS float* obuf = (LAS float*)(lds + 64 * GA_LD * 4 + 1024);
    const bf16_t* P = (const bf16_t*)(p.ws + OFF_P); const float* G = (const float*)(p.ws + OFF_G32); bf16_t* MIX = (bf16_t*)(p.ws + OFF_MIX);
    const int tid = threadIdx.x, w = tid >> 6, lane = tid & 63, dgrp = lane >> 4, ecol = w * 16 + (lane & 15);
    float s[32];
    if (SAMPLE) { const float* S0 = p.state_gdn + (size_t)(b * 32 + h) * 16384;
#pragma unroll
        for (int i = 0; i < 32; ++i) s[i] = S0[(dgrp * 32 + i) * 128 + ecol]; }
    else {
#pragma unroll
        for (int i = 0; i < 32; ++i) s[i] = 0.f; }
    const int T = SAMPLE ? 1 : 64, NC = SAMPLE ? 1 : 32;
    const size_t rowbase = SAMPLE ? (size_t)(NTP + b) : (size_t)b * 2048;
    const float Aneg = -expf(p.gdn_a_log[h]), dtb = p.gdn_dt_bias[h];
    float* convout = p.out + (SAMPLE ? O_GDNC_S : O_GDNC_P);
    for (int c = 0; c < NC; ++c) {
        const int t0 = c * 64;
        for (int idx = tid; idx < T * 96; idx += 512) {
            const int t = idx / 96, cq = idx - t * 96, col = cq * 4, ch = (col >> 7) * 4096 + h * 128 + (col & 127);
            f32x4 a = (f32x4){0.f, 0.f, 0.f, 0.f};
#pragma unroll
            for (int j = 0; j < 4; ++j) {
                const f32x4 wv = *(const f32x4*)(p.gdn_conv_w + j * 12288 + ch);
                f32x4 rv = (f32x4){0.f, 0.f, 0.f, 0.f};
                if (SAMPLE) { if (j < 3) rv = *(const f32x4*)(p.state_gdn_conv + ((size_t)b * 3 + j) * 12288 + ch); else rv = ldbf4(P + rowbase * P_LD + C_QKV + ch);
                    if (j >= 1) *(f32x4*)(convout + ((size_t)b * 3 + (j - 1)) * 12288 + ch) = rv; }
                else { const int tt = t0 + t - 3 + j; if (tt >= 0) rv = ldbf4(P + (rowbase + tt) * P_LD + C_QKV + ch);
                    if (j == 3 && c == 31 && t >= 61) *(f32x4*)(convout + ((size_t)b * 3 + (t - 61)) * 12288 + ch) = rv; }
                a += wv * rv;
            }
            f32x4 o; o[0] = silu_f(a[0]); o[1] = silu_f(a[1]); o[2] = silu_f(a[2]); o[3] = silu_f(a[3]);
            *(LAS f32x4*)(act + t * GA_LD + col) = o;
        }
        __syncthreads();
#pragma unroll 1
        for (int r = 0; r < 8; ++r) { const int t = w * 8 + r; if (t < T) {
            LAS float* ar = act + t * GA_LD;
            const float q0 = ar[lane], q1 = ar[64 + lane], k0 = ar[128 + lane], k1 = ar[192 + lane];
            const float sq = wave_sum(q0 * q0 + q1 * q1), sk = wave_sum(k0 * k0 + k1 * k1);
            const float rq = rsqrtf(sq + 1e-6f) * 0.08838834764831845f, rk = rsqrtf(sk + 1e-6f);
            ar[lane] = q0 * rq; ar[64 + lane] = q1 * rq; ar[128 + lane] = k0 * rk; ar[192 + lane] = k1 * rk; } }
        if (tid < T) { const size_t row = rowbase + t0 + tid; const float araw = G[row * G_LD + 96 + h], braw = G[row * G_LD + 64 + h];
            tok[tid * 2] = sigmoid_f(braw); tok[tid * 2 + 1] = expf(Aneg * softplus_f(araw + dtb)); }
        __syncthreads();
#pragma unroll 1
        for (int t = 0; t < T; ++t) {
            LAS float* ar = act + t * GA_LD;
            const float beta = tok[t * 2], eg = tok[t * 2 + 1];
            float kk[32], qq[32];
#pragma unroll
            for (int i = 0; i < 8; ++i) { const f32x4 kv = *(LAS f32x4*)(ar + 128 + dgrp * 32 + i * 4); kk[4 * i] = kv[0]; kk[4 * i + 1] = kv[1]; kk[4 * i + 2] = kv[2]; kk[4 * i + 3] = kv[3]; }
            float ks = 0.f;
#pragma unroll
            for (int i = 0; i < 32; ++i) ks += kk[i] * s[i];
            ks += __shfl_xor(ks, 16); ks += __shfl_xor(ks, 32);
            const float vnew = beta * (ar[256 + ecol] - eg * ks);
#pragma unroll
            for (int i = 0; i < 8; ++i) { const f32x4 qv = *(LAS f32x4*)(ar + dgrp * 32 + i * 4); qq[4 * i] = qv[0]; qq[4 * i + 1] = qv[1]; qq[4 * i + 2] = qv[2]; qq[4 * i + 3] = qv[3]; }
            float o = 0.f;
#pragma unroll
            for (int i = 0; i < 32; ++i) { s[i] = eg * s[i] + kk[i] * vnew; o += qq[i] * s[i]; }
            o += __shfl_xor(o, 16); o += __shfl_xor(o, 32);
            if (dgrp == 0) obuf[t * GO_LD + ecol] = o;
        }
        __syncthreads();
#pragma unroll 1
        for (int r = 0; r < 8; ++r) { const int t = w * 8 + r; if (t < T) {
            const float o0 = obuf[t * GO_LD + lane], o1 = obuf[t * GO_LD + 64 + lane];
            const float rs = rsqrtf(wave_sum(o0 * o0 + o1 * o1) * (1.f / 128.f) + 1e-6f);
            const size_t row = rowbase + t0 + t;
            const float z0 = bf2f(P[row * P_LD + C_ZG + h * 128 + lane]), z1 = bf2f(P[row * P_LD + C_ZG + h * 128 + 64 + lane]);
            MIX[row * MIXW + 4096 + h * 128 + lane] = f2bf(o0 * rs * p.gdn_norm_w[lane] * silu_f(z0));
            MIX[row * MIXW + 4096 + h * 128 + 64 + lane] = f2bf(o1 * rs * p.gdn_norm_w[64 + lane] * silu_f(z1)); } }
        __syncthreads();
    }
    float* So = p.out + (SAMPLE ? O_GDN_S : O_GDN_P) + (size_t)(b * 32 + h) * 16384;
#pragma unroll
    for (int i = 0; i < 32; ++i) So[(dgrp * 32 + i) * 128 + ecol] = s[i];
}

template <bool SAMPLE>
__device__ __forceinline__ void ssd_item(const Params& p, LAS unsigned char* lds, const int b, const int h) {
    LAS float* act = (LAS float*)lds;
    LAS float* tok = (LAS float*)(lds + 64 * SA_LD * 4);
    LAS float* ybuf = (LAS float*)(lds + 64 * SA_LD * 4 + 1024);
    const bf16_t* P = (const bf16_t*)(p.ws + OFF_P); const float* G = (const float*)(p.ws + OFF_G32); float* U = (float*)(p.ws + OFF_U32);
    const int tid = threadIdx.x, w = tid >> 6, lane = tid & 63, pp = w * 8 + (lane >> 3), nch = lane & 7, g = h >> 3;
    float hs[16];
    if (SAMPLE) { const float* H0 = p.state_ssd + ((size_t)(b * 64 + h) * 64 + pp) * 128;
#pragma unroll
        for (int i = 0; i < 4; ++i) { const f32x4 v = *(const f32x4*)(H0 + i * 32 + nch * 4); hs[4 * i] = v[0]; hs[4 * i + 1] = v[1]; hs[4 * i + 2] = v[2]; hs[4 * i + 3] = v[3]; } }
    else {
#pragma unroll
        for (int i = 0; i < 16; ++i) hs[i] = 0.f; }
    const int T = SAMPLE ? 1 : 64, NC = SAMPLE ? 1 : 32;
    const size_t rowbase = SAMPLE ? (size_t)(NTP + b) : (size_t)b * 2048;
    const float Aneg = -expf(p.ssd_a_log[h]), dtb = p.ssd_dt_bias[h], Dh = p.ssd_d[h];
    float* convout = p.out + (SAMPLE ? O_SSDC_S : O_SSDC_P);
    for (int c = 0; c < NC; ++c) {
        const int t0 = c * 64;
        for (int idx = tid; idx < T * 80; idx += 512) {
            const int t = idx / 80, cq = idx - t * 80, col = cq * 4;
            const int ch = col < 64 ? h * 64 + col : (col < 192 ? 4096 + g * 128 + (col - 64) : 5120 + g * 128 + (col - 192));
            const bool wr_state = (col < 64) || ((h & 7) == 0);
            f32x4 a = *(const f32x4*)(p.ssd_conv_b + ch);
#pragma unroll
            for (int j = 0; j < 4; ++j) {
                const f32x4 wv = *(const f32x4*)(p.ssd_conv_w + j * 6144 + ch);
                f32x4 rv = (f32x4){0.f, 0.f, 0.f, 0.f};
                if (SAMPLE) { if (j < 3) rv = *(const f32x4*)(p.state_ssd_conv + ((size_t)b * 3 + j) * 6144 + ch); else rv = ldbf4(P + rowbase * P_LD + C_XBC + ch);
                    if (j >= 1 && wr_state) *(f32x4*)(convout + ((size_t)b * 3 + (j - 1)) * 6144 + ch) = rv; }
                else { const int tt = t0 + t - 3 + j; if (tt >= 0) rv = ldbf4(P + (rowbase + tt) * P_LD + C_XBC + ch);
                    if (j == 3 && c == 31 && t >= 61 && wr_state) *(f32x4*)(convout + ((size_t)b * 3 + (t - 61)) * 6144 + ch) = rv; }
                a += wv * rv;
            }
            f32x4 o; o[0] = silu_f(a[0]); o[1] = silu_f(a[1]); o[2] = silu_f(a[2]); o[3] = silu_f(a[3]);
            *(LAS f32x4*)(act + t * SA_LD + col) = o;
        }
        if (tid < T) { const size_t row = rowbase + t0 + tid; const float dt = softplus_f(G[row * G_LD + h] + dtb);
            tok[tid * 2] = dt; tok[tid * 2 + 1] = expf(dt * Aneg); }
        __syncthreads();
#pragma unroll 1
        for (int t = 0; t < T; ++t) {
            LAS float* ar = act + t * SA_LD;
            const float dt = tok[t * 2], eA = tok[t * 2 + 1];
            const float xdt = ar[pp] * dt;
            float y = 0.f;
#pragma unroll
            for (int i = 0; i < 4; ++i) { const f32x4 bv = *(LAS f32x4*)(ar + 64 + i * 32 + nch * 4), cv = *(LAS f32x4*)(ar + 192 + i * 32 + nch * 4);
#pragma unroll
                for (int j = 0; j < 4; ++j) { hs[4 * i + j] = eA * hs[4 * i + j] + xdt * bv[j]; y += cv[j] * hs[4 * i + j]; } }
            y += __shfl_xor(y, 1); y += __shfl_xor(y, 2); y += __shfl_xor(y, 4);
            if (nch == 0) ybuf[t * SY_LD + pp] = y;
        }
        __syncthreads();
        for (int idx = tid; idx < T * 64; idx += 512) { const int t = idx >> 6, q = idx & 63; const size_t row = rowbase + t0 + t;
            const float z = bf2f(P[row * P_LD + C_ZS + h * 64 + q]);
            U[row * DM + h * 64 + q] = (ybuf[t * SY_LD + q] + act[t * SA_LD + q] * Dh) * silu_f(z); }
        __syncthreads();
    }
    float* Ho = p.out + (SAMPLE ? O_SSD_S : O_SSD_P) + ((size_t)(b * 64 + h) * 64 + pp) * 128;
#pragma unroll
    for (int i = 0; i < 4; ++i) { f32x4 v; v[0] = hs[4 * i]; v[1] = hs[4 * i + 1]; v[2] = hs[4 * i + 2]; v[3] = hs[4 * i + 3]; *(f32x4*)(Ho + i * 32 + nch * 4) = v; }
}

__device__ __forceinline__ void phase_scan(const Params& p, LAS unsigned char* lds) {
    LAS int* qslot = (LAS int*)(lds + LDS_MISC + 16);
    unsigned* qctr = (unsigned*)(p.ws + OFF_BAR) + QCTR_WORD;
    for (;;) {
        __syncthreads();
        if (threadIdx.x == 0) *qslot = (int)__hip_atomic_fetch_add(qctr, 1u, __ATOMIC_RELAXED, __HIP_MEMORY_SCOPE_AGENT);
        __syncthreads();
        const int item = __builtin_amdgcn_readfirstlane(*qslot);
        if (item >= N_ITEMS) break;
        if (item < N_GDN_P) gdn_item<false>(p, lds, item >> 5, item & 31);
        else if (item < N_GDN_P + N_SSD_P) { const int i = item - N_GDN_P; ssd_item<false>(p, lds, i >> 6, i & 63); }
        else if (item < N_GDN_P + N_SSD_P + N_GDN_S) { const int i = item - N_GDN_P - N_SSD_P; gdn_item<true>(p, lds, i >> 5, i & 31); }
        else { const int i = item - N_GDN_P - N_SSD_P - N_GDN_S; ssd_item<true>(p, lds, i >> 6, i & 63); }
    }
}

__device__ __forceinline__ void phase_ssdnorm(const Params& p) {
    const float* U = (const float*)(p.ws + OFF_U32); bf16_t* MIX = (bf16_t*)(p.ws + OFF_MIX);
    const int lane = threadIdx.x & 63, gw = blockIdx.x * 8 + (threadIdx.x >> 6), nw = gridDim.x * 8;
    for (int it = gw; it < NTOK * 8; it += nw) {
        const int row = it >> 3, g = it & 7; const size_t off = (size_t)row * DM + g * 512 + lane * 8;
        const f32x4 a = *(const f32x4*)(U + off), b = *(const f32x4*)(U + off + 4);
        const float ss = wave_sum(a[0] * a[0] + a[1] * a[1] + a[2] * a[2] + a[3] * a[3] + b[0] * b[0] + b[1] * b[1] + b[2] * b[2] + b[3] * b[3]);
        const float rs = rsqrtf(ss * (1.f / 512.f) + 1e-6f);
        const f32x4 wa = *(const f32x4*)(p.ssd_norm_w + g * 512 + lane * 8), wb = *(const f32x4*)(p.ssd_norm_w + g * 512 + lane * 8 + 4);
        u32x4 o; o[0] = cvt_pk_bf16(a[0] * rs * wa[0], a[1] * rs * wa[1]); o[1] = cvt_pk_bf16(a[2] * rs * wa[2], a[3] * rs * wa[3]);
        o[2] = cvt_pk_bf16(b[0] * rs * wb[0], b[1] * rs * wb[1]); o[3] = cvt_pk_bf16(b[2] * rs * wb[2], b[3] * rs * wb[3]);
        *(u32x4*)(MIX + (size_t)row * MIXW + g * 512 + lane * 8) = o;
    }
}

__device__ __forceinline__ void phase_ln(const Params& p) {
    const float* R = (const float*)(p.ws + OFF_R);
    const int lane = threadIdx.x & 63, gw = blockIdx.x * 8 + (threadIdx.x >> 6), nw = gridDim.x * 8;
    for (int row = gw; row < NTOK; row += nw) {
        const float* rr = R + (size_t)row * DM;
        f32x4 v[16]; float sum = 0.f;
#pragma unroll
        for (int i = 0; i < 16; ++i) { v[i] = *(const f32x4*)(rr + (i * 64 + lane) * 4); sum += v[i][0] + v[i][1] + v[i][2] + v[i][3]; }
        const float mu = wave_sum(sum) * (1.f / 4096.f);
        float sq = 0.f;
#pragma unroll
        for (int i = 0; i < 16; ++i) { v[i] = v[i] - mu; sq += v[i][0] * v[i][0] + v[i][1] * v[i][1] + v[i][2] * v[i][2] + v[i][3] * v[i][3]; }
        const float rs = rsqrtf(wave_sum(sq) * (1.f / 4096.f) + 1e-5f);
        float* o = p.out + (row < NTP ? O_YP + (size_t)row * DM : O_YS + (size_t)(row - NTP) * DM);
#pragma unroll
        for (int i = 0; i < 16; ++i) { const int c = (i * 64 + lane) * 4; const f32x4 gg = *(const f32x4*)(p.ln_g + c), bb = *(const f32x4*)(p.ln_b + c);
            *(f32x4*)(o + c) = v[i] * rs * gg + bb; }
    }
}

template <int PH>
__global__ __launch_bounds__(512, 2) void mk_fwd(Params p) {
    extern __shared__ __attribute__((aligned(16))) unsigned char smem[];
    LAS unsigned char* lds = (LAS unsigned char*)smem;
    XcdBarrier bar;
    if (PH < 0) {
        if (threadIdx.x == 0) *(LAS u32x4*)(lds + LDS_MISC) = (u32x4){0u, 0u, 0u, 0u};
        __syncthreads();
        bar = xcd_barrier_post((unsigned*)(p.ws + OFF_BAR), (volatile LAS unsigned*)(lds + LDS_MISC));
    }
    if (PH < 0 || PH == 0) phase_convert(p, lds);
    if (PH < 0) xcd_barrier(bar);
    if (PH < 0 || PH == 1) {
        pg8::Gemm g{(const bf16_t*)(p.ws + OFF_XB), (const bf16_t*)(p.ws + OFF_WB), MPAD, NPAD, DM};
        pg8::StaticOrder S; S.init(MPAD, NPAD, (int)gridDim.x, (int)blockIdx.x);
        pg8::EpiProj E{(bf16_t*)(p.ws + OFF_P), (float*)(p.ws + OFF_G32)};
        pg8::gemm_phase<pg8::EpiProj, pg8::StaticOrder, true, true>(lds, g, S, E);
    }
    if (PH < 0) xcd_barrier(bar);
    if (PH < 0 || PH == 2) phase_scan(p, lds);
    if (PH < 0) xcd_barrier(bar);
    if (PH < 0 || PH == 3) phase_ssdnorm(p);
    if (PH < 0) xcd_barrier(bar);
    if (PH < 0 || PH == 4) {
        pg8::Gemm g{(const bf16_t*)(p.ws + OFF_MIX), (const bf16_t*)(p.ws + OFF_WOB), MPAD, DM, MIXW};
        pg8::StaticOrder S; S.init(MPAD, DM, (int)gridDim.x, (int)blockIdx.x);
        pg8::EpiOut E{(float*)(p.ws + OFF_R), p.x_prompt, p.x_sample};
        pg8::gemm_phase<pg8::EpiOut, pg8::StaticOrder, true, true>(lds, g, S, E);
    }
    if (PH < 0) xcd_barrier(bar);
    if (PH < 0 || PH == 5) phase_ln(p);
}

template <int PH> static void launch_phase(const Params& p, int grid, hipStream_t stream) {
    static bool attr = false;
    if (!attr) { (void)hipFuncSetAttribute((const void*)mk_fwd<PH>, hipFuncAttributeMaxDynamicSharedMemorySize, LDS_BYTES); attr = true; }
    hipLaunchKernelGGL((mk_fwd<PH>), dim3(grid), dim3(512), LDS_BYTES, stream, p);
}

extern "C" void kernel_launch(void* const* d_in, const int* in_sizes, int n_in, void* d_out, int out_size, void* d_ws, size_t ws_size, hipStream_t stream) {
    (void)in_sizes; (void)n_in; (void)out_size;
    if (ws_size < WS_END) { fprintf(stderr, "workspace too small: %zu < %zu\n", ws_size, (size_t)WS_END); return; }
    Params p{};
    p.x_prompt = (const float*)d_in[0]; p.x_sample = (const float*)d_in[1]; p.state_ssd = (const float*)d_in[2]; p.state_ssd_conv = (const float*)d_in[3];
    p.state_gdn = (const float*)d_in[4]; p.state_gdn_conv = (const float*)d_in[5]; p.w_in = (const float*)d_in[6]; p.ssd_conv_w = (const float*)d_in[7];
    p.ssd_conv_b = (const float*)d_in[8]; p.ssd_dt_bias = (const float*)d_in[9]; p.ssd_a_log = (const float*)d_in[10]; p.ssd_d = (const float*)d_in[11];
    p.ssd_norm_w = (const float*)d_in[12]; p.gdn_conv_w = (const float*)d_in[13]; p.gdn_dt_bias = (const float*)d_in[14]; p.gdn_a_log = (const float*)d_in[15];
    p.gdn_norm_w = (const float*)d_in[16]; p.w_out = (const float*)d_in[17]; p.ln_g = (const float*)d_in[18]; p.ln_b = (const float*)d_in[19];
    p.out = (float*)d_out; p.ws = (unsigned char*)d_ws;
    static int grid = 0;
    if (!grid) { int dev = 0, cus = 0; (void)hipGetDevice(&dev); (void)hipDeviceGetAttribute(&cus, hipDeviceAttributeMultiprocessorCount, dev); grid = cus > 0 ? cus : 256; }
    (void)hipMemsetAsync(d_ws, 0, 16384, stream);
#if MK_FUSED
    launch_phase<-1>(p, grid, stream);
#else
    launch_phase<0>(p, grid, stream); launch_phase<1>(p, grid, stream); launch_phase<2>(p, grid, stream);
    launch_phase<3>(p, grid, stream); launch_phase<4>(p, grid, stream); launch_phase<5>(p, grid, stream);
#endif
}
```

```cpp
#include <hip/hip_runtime.h>
#include <cstdio>
#include <cstdint>

#ifndef MK_FUSED
#define MK_FUSED 1
#endif

#define LAS __attribute__((address_space(3)))
typedef unsigned short bf16_t;
typedef short bf16x8 __attribute__((ext_vector_type(8)));
typedef float f32x4 __attribute__((ext_vector_type(4)));
typedef float f32x2v __attribute__((ext_vector_type(2)));
typedef unsigned u32x4 __attribute__((ext_vector_type(4)));
typedef unsigned u32x2 __attribute__((ext_vector_type(2)));

constexpr int DM = 4096, NTP = 8192, NTS = 128, NTOK = 8320, MPAD = 8448;
constexpr int NPROJ = 26752, P_LD = 26624, NPAD = 26880, MIXW = 8192, G_LD = 256;
constexpr int C_ZS = 0, C_XBC = 4096, C_QKV = 10240, C_ZG = 22528;
constexpr float ALPHA = 1.189207115002721f;
constexpr int LDS_BYTES = 147456;
constexpr int LDS_MISC = LDS_BYTES - 64;

constexpr size_t OFF_BAR = 0;
constexpr size_t OFF_XB  = 16384;
constexpr size_t OFF_WB  = OFF_XB  + (size_t)MPAD * DM * 2;
constexpr size_t OFF_WOB = OFF_WB  + (size_t)NPAD * DM * 2;
constexpr size_t OFF_P   = OFF_WOB + (size_t)DM * MIXW * 2;
constexpr size_t OFF_G32 = OFF_P   + (size_t)MPAD * P_LD * 2;
constexpr size_t OFF_MIX = OFF_G32 + (size_t)MPAD * G_LD * 4;
constexpr size_t OFF_U32 = OFF_MIX + (size_t)MPAD * MIXW * 2;
constexpr size_t OFF_R   = OFF_U32 + (size_t)MPAD * DM * 4;
constexpr size_t WS_END  = OFF_R   + (size_t)MPAD * DM * 4;
constexpr int QCTR_WORD = 3584;

constexpr size_t O_YP = 0;
constexpr size_t O_YS = O_YP + (size_t)NTP * DM;
constexpr size_t O_SSD_P = O_YS + (size_t)NTS * DM;
constexpr size_t O_SSDC_P = O_SSD_P + (size_t)4 * 64 * 64 * 128;
constexpr size_t O_GDN_P = O_SSDC_P + (size_t)4 * 3 * 6144;
constexpr size_t O_GDNC_P = O_GDN_P + (size_t)4 * 32 * 128 * 128;
constexpr size_t O_SSD_S = O_GDNC_P + (size_t)4 * 3 * 12288;
constexpr size_t O_SSDC_S = O_SSD_S + (size_t)128 * 64 * 64 * 128;
constexpr size_t O_GDN_S = O_SSDC_S + (size_t)128 * 3 * 6144;
constexpr size_t O_GDNC_S = O_GDN_S + (size_t)128 * 32 * 128 * 128;

struct Params {
    const float* x_prompt; const float* x_sample; const float* state_ssd; const float* state_ssd_conv; const float* state_gdn; const float* state_gdn_conv;
    const float* w_in; const float* ssd_conv_w; const float* ssd_conv_b; const float* ssd_dt_bias; const float* ssd_a_log; const float* ssd_d; const float* ssd_norm_w;
    const float* gdn_conv_w; const float* gdn_dt_bias; const float* gdn_a_log; const float* gdn_norm_w; const float* w_out; const float* ln_g; const float* ln_b;
    float* out; unsigned char* ws;
};

__device__ __forceinline__ unsigned cvt_pk_bf16(float lo, float hi) { unsigned r; asm volatile("v_cvt_pk_bf16_f32 %0, %1, %2" : "=v"(r) : "v"(lo), "v"(hi)); return r; }
__device__ __forceinline__ float bf2f(bf16_t v) { return __uint_as_float(((unsigned)v) << 16); }
__device__ __forceinline__ bf16_t f2bf(float f) { unsigned u = __float_as_uint(f); u += 0x7FFFu + ((u >> 16) & 1u); return (bf16_t)(u >> 16); }
__device__ __forceinline__ float silu_f(float x) { return x / (1.f + __expf(-x)); }
__device__ __forceinline__ float sigmoid_f(float x) { return 1.f / (1.f + __expf(-x)); }
__device__ __forceinline__ float softplus_f(float x) { return x > 20.f ? x : log1pf(expf(x)); }
__device__ __forceinline__ f32x4 ldbf4(const bf16_t* p) { const u32x2 v = *(const u32x2*)p; f32x4 r; r[0] = __uint_as_float(v[0] << 16); r[1] = __uint_as_float(v[0] & 0xffff0000u); r[2] = __uint_as_float(v[1] << 16); r[3] = __uint_as_float(v[1] & 0xffff0000u); return r; }
__device__ __forceinline__ int opaque_tid() { int t = threadIdx.x; asm volatile("" : "+v"(t)); return t; }
__device__ __forceinline__ float wave_sum(float v) {
#pragma unroll
    for (int m = 32; m >= 1; m >>= 1) v += __shfl_xor(v, m);
    return v;
}

#define XB_TMO      128
#define XB_XCNT(j)  (256  + 64 * (j))
#define XB_XSUB(j)  (1280 + 64 * (j))
#define XB_XGEN(j)  (2304 + 64 * (j))
#define XB_TOP      3328
#define XB_TOPGEN   3392
#define XCD_BAR_WORDS 3456
#define XB_SPIN_CAP (1u << 18)
__device__ __forceinline__ unsigned xb_ld(unsigned* p)              { return __hip_atomic_load(p, __ATOMIC_RELAXED, __HIP_MEMORY_SCOPE_AGENT); }
__device__ __forceinline__ unsigned xb_add(unsigned* p, unsigned v) { return __hip_atomic_fetch_add(p, v, __ATOMIC_RELAXED, __HIP_MEMORY_SCOPE_AGENT); }
__device__ __forceinline__ unsigned xb_xcc_id() { return (unsigned)__builtin_amdgcn_s_getreg((3 << 11) | 20) & 0xFu; }
#define XB_SPIN(cond, bar) do { unsigned _sp = 0; while (cond) { __builtin_amdgcn_s_sleep(1); \
    if ((++_sp & 255u) == 0u) { if (xb_ld(&(bar)[XB_TMO])) break; if (_sp > XB_SPIN_CAP) { atomicAdd(&(bar)[XB_TMO], 1u); break; } } } } while (0)
struct XcdBarrier { unsigned* bar; unsigned x; volatile LAS unsigned* st; };
__device__ __forceinline__ XcdBarrier xcd_barrier_post(unsigned* bar, volatile LAS unsigned* st) {
    XcdBarrier b; b.bar = bar; b.x = xb_xcc_id(); b.st = st;
    if (threadIdx.x == 0) (void)xb_add(&bar[XB_XCNT(b.x)], 1u);
    return b;
}
__device__ __forceinline__ void xcd_barrier_complete(unsigned* bar, unsigned x, unsigned& nloc, unsigned& nx) {
    const unsigned G = gridDim.x * gridDim.y * gridDim.z;
    unsigned sum, cnt, mine, sp = 0u;
    for (;;) {
        sum = 0u; cnt = 0u; mine = 0u;
#pragma unroll
        for (unsigned j = 0; j < 16; ++j) { const unsigned c = xb_ld(&bar[XB_XCNT(j)]); sum += c; cnt += (c > 0u) ? 1u : 0u; mine = (j == x) ? c : mine; }
        if (sum == G) break;
        __builtin_amdgcn_s_sleep(1);
        if ((++sp & 255u) == 0u) { if (xb_ld(&bar[XB_TMO])) break; if (sp > XB_SPIN_CAP) { atomicAdd(&bar[XB_TMO], 1u); break; } }
    }
    nloc = mine > 0u ? mine : 1u; nx = cnt > 0u ? cnt : 1u;
}
__device__ __forceinline__ void xcd_barrier(const XcdBarrier& b) {
    asm volatile("s_waitcnt vmcnt(0)" ::: "memory");
    __syncthreads();
    if (threadIdx.x == 0) {
        unsigned* bar = b.bar;
        __builtin_amdgcn_s_waitcnt(0);
        unsigned nloc = b.st[0], nx = b.st[1];
        if (nloc == 0u) { xcd_barrier_complete(bar, b.x, nloc, nx); b.st[0] = nloc; b.st[1] = nx; }
        const unsigned old = xb_add(&bar[XB_XSUB(b.x)], 1u);
        const unsigned gen = old / nloc;
        if (old + 1u == (gen + 1u) * nloc) {
            __builtin_amdgcn_fence(__ATOMIC_RELEASE, "agent");
            asm volatile("s_waitcnt vmcnt(0)" ::: "memory");
            const unsigned og = xb_add(&bar[XB_TOP], 1u);
            const unsigned tg = og / nx;
            if (og + 1u == (tg + 1u) * nx) xb_add(&bar[XB_TOPGEN], 1u);
            else XB_SPIN(xb_ld(&bar[XB_TOPGEN]) == tg, bar);
            __builtin_amdgcn_fence(__ATOMIC_ACQUIRE, "agent");
            xb_add(&bar[XB_XGEN(b.x)], 1u);
            asm volatile("s_waitcnt vmcnt(0)" ::: "memory");
        } else {
            XB_SPIN(xb_ld(&bar[XB_XGEN(b.x)]) == gen, bar);
            __builtin_amdgcn_fence(__ATOMIC_ACQUIRE, "agent");
            asm volatile("s_waitcnt vmcnt(0)" ::: "memory");
        }
    }
    __syncthreads();
}

namespace pg8 {
constexpr int BM = 256, BK = 64, HALF = 128, HTB = HALF * BK * 2, STAGE_BYTES = 8 * HTB, NXCD = 8, WGM = 8;
__host__ __device__ __forceinline__ int lds_byte(int r, int c) { const int st = (r >> 4) * 2 + (c >> 5), rr = r & 15, cc = c & 31, ob = rr * 64 + cc * 2; return st * 1024 + (ob ^ (((ob >> 9) & 1) << 5)); }
__host__ __device__ __forceinline__ void stage_rc(int b, int& R, int& C) { const int st = b / 1024, sb = b % 1024, swz = sb ^ (((sb >> 9) & 1) << 5); R = (st >> 1) * 16 + swz / 64; C = (st & 1) * 32 + (swz % 64) / 2; }
__host__ __device__ __forceinline__ int perm32(int rho) { const int n = rho >> 4, i = rho & 15; return 8 * (i >> 2) + 4 * n + (i & 3); }
struct Unit { int pm, pn; };
struct Gemm { const bf16_t* A; const bf16_t* Bt; int M, N, K; };
struct StaticOrder {
    int nM, nN, nwg, G, c;
    __host__ __device__ void init(int M, int N, int G_, int c_) { nM = M / BM; nN = N / BM; nwg = nM * nN; G = G_; c = c_; }
    __host__ __device__ bool next(int i, Unit& u) const {
        const long L = (long)i * G + c; if (L >= nwg) return false;
        int wgid = (int)L; { const int q = nwg / NXCD, r = nwg % NXCD, xcd = wgid % NXCD, off = wgid / NXCD; wgid = (xcd < r ? xcd * (q + 1) : r * (q + 1) + (xcd - r) * q) + off; }
        const int nig = WGM * nN, gid = wgid / nig, fm = gid * WGM, gsz = (nM - fm) < WGM ? (nM - fm) : WGM;
        u.pm = fm + ((wgid % nig) % gsz); u.pn = (wgid % nig) / gsz; return true;
    }
    __device__ __forceinline__ void a_ready(const Unit&) const {}
    __device__ __forceinline__ void done(const Unit&) const {}
};

struct EpiProj {
    static constexpr bool PERM = true, AFTER_DRAIN = false;
    bf16_t* P; float* G;
    __device__ __forceinline__ void operator()(const f32x4 (&acc)[2][2][4][2], const Unit& u, int wr, int wc, int fr, int fq) const {
        const int row0 = u.pm * BM + wr * 64 + fr;
        if (u.pn < 104) {
            const int col0 = u.pn * BM + wc * 32 + 8 * fq;
#pragma unroll
            for (int ai = 0; ai < 2; ++ai)
#pragma unroll
                for (int m = 0; m < 4; ++m) { bf16_t* rowp = P + (size_t)(row0 + ai * HALF + m * 16) * P_LD + col0;
#pragma unroll
                    for (int bj = 0; bj < 2; ++bj) { const f32x4 v0 = acc[ai][bj][m][0], v1 = acc[ai][bj][m][1];
                        u32x4 w; w[0] = cvt_pk_bf16(v0[0], v0[1]); w[1] = cvt_pk_bf16(v0[2], v0[3]); w[2] = cvt_pk_bf16(v1[0], v1[1]); w[3] = cvt_pk_bf16(v1[2], v1[3]);
                        *(u32x4*)(rowp + bj * HALF) = w; } }
        } else {
#pragma unroll
            for (int ai = 0; ai < 2; ++ai)
#pragma unroll
                for (int m = 0; m < 4; ++m) { float* rowp = G + (size_t)(row0 + ai * HALF + m * 16) * G_LD + wc * 32 + 8 * fq;
                    *(f32x4*)(rowp) = acc[ai][0][m][0]; *(f32x4*)(rowp + 4) = acc[ai][0][m][1]; }
        }
    }
};
struct EpiOut {
    static constexpr bool PERM = false, AFTER_DRAIN = false;
    float* R; const float* xp; const float* xs;
    __device__ __forceinline__ void operator()(const f32x4 (&acc)[2][2][4][2], const Unit& u, int wr, int wc, int fr, int fq) const {
        const int row0 = u.pm * BM + wr * 64 + fr, col0 = u.pn * BM + wc * 32 + 4 * fq;
#pragma unroll
        for (int ai = 0; ai < 2; ++ai)
#pragma unroll
            for (int m = 0; m < 4; ++m) { const int r = row0 + ai * HALF + m * 16;
                if (r < NTOK) { const float* xr = r < NTP ? xp + (size_t)r * DM : xs + (size_t)(r - NTP) * DM; float* rr = R + (size_t)r * DM;
#pragma unroll
                    for (int bj = 0; bj < 2; ++bj)
#pragma unroll
                        for (int n = 0; n < 2; ++n) { const int c = col0 + bj * HALF + n * 16; const f32x4 xv = *(const f32x4*)(xr + c); *(f32x4*)(rr + c) = acc[ai][bj][m][n] + ALPHA * xv; } } }
    }
};

template <class Epi, class Sched, bool ALIGN_EPI = false, bool SP2 = false>
__device__ __forceinline__ void gemm_phase(LAS unsigned char* lds, const Gemm g, const Sched& S, const Epi& E) {
    const int tid = threadIdx.x, wid = __builtin_amdgcn_readfirstlane(tid >> 6), lane = tid & 63, wr = wid >> 2, wc = wid & 3, fr = lane & 15, fq = lane >> 4;
    const int K = g.K, nt = K / BK;
    unsigned voffA[2], voffB[2];
#pragma unroll
    for (int i = 0; i < 2; ++i) { int R, C; stage_rc(tid * 16 + i * 8192, R, C); const int Rb = Epi::PERM ? ((R & ~31) + perm32(R & 31)) : R;
        voffA[i] = (unsigned)(R * K + C) * 2u; voffB[i] = (unsigned)(Rb * K + C) * 2u; }
    const size_t kstep = (size_t)(BK * 2);
    const size_t hstep = (size_t)HALF * K * 2;
    const size_t tstep = 2 * hstep;
    const unsigned ldsw = (unsigned)wid * 1024u;
    const int aoff = lds_byte(wr * 64 + fr, fq * 8), boff = lds_byte(wc * 32 + fr, fq * 8);
#define PG8_SA(b, h) (((b) * 2 + (h)) * HTB)
#define PG8_SB(b, h) ((4 + (b) * 2 + (h)) * HTB)
#define PG8_STAGE(bufoff, gbase, voff) do { _Pragma("unroll") for (int _i = 0; _i < 2; ++_i) \
        __builtin_amdgcn_global_load_lds((const unsigned*)((const char*)(gbase) + (voff)[_i]), (LAS unsigned*)(lds + (bufoff) + ldsw + _i * 8192), 16, 0, 0); } while (0)
#define PG8_LDA(dst, b, h) do { _Pragma("unroll") for (int m = 0; m < 4; ++m) _Pragma("unroll") for (int k = 0; k < 2; ++k) dst[m][k] = *(const LAS bf16x8*)(lds + PG8_SA(b, h) + aoff + m * 2048 + k * 1024); } while (0)
#define PG8_LDB(dst, b, h) do { _Pragma("unroll") for (int n = 0; n < 2; ++n) _Pragma("unroll") for (int k = 0; k < 2; ++k) dst[n][k] = *(const LAS bf16x8*)(lds + PG8_SB(b, h) + boff + n * 2048 + k * 1024); } while (0)
#define PG8_MMA(ai, bj, At, Bt) do { __builtin_amdgcn_s_setprio(1); _Pragma("unroll") for (int m = 0; m < 4; ++m) _Pragma("unroll") for (int n = 0; n < 2; ++n) _Pragma("unroll") for (int k = 0; k < 2; ++k) \
        acc[ai][bj][m][n] = __builtin_amdgcn_mfma_f32_16x16x32_bf16(Bt[n][k], At[m][k], acc[ai][bj][m][n], 0, 0, 0); __builtin_amdgcn_s_setprio(0); } while (0)
#define PG8_WAIT_V(n) asm volatile("s_waitcnt vmcnt(" #n ")" ::: "memory")
#define PG8_WAIT_L(n) asm volatile("s_waitcnt lgkmcnt(" #n ")" ::: "memory")
#define PG8_BAR __builtin_amdgcn_s_barrier()
#define PG8_SCHED __builtin_amdgcn_sched_barrier(0)
    Unit cur, nxt; int ui = 0;
    if (!S.next(0, cur)) return;
    f32x4 acc[2][2][4][2];
#pragma unroll
    for (int a = 0; a < 2; ++a)
#pragma unroll
        for (int b = 0; b < 2; ++b)
#pragma unroll
            for (int m = 0; m < 4; ++m)
#pragma unroll
                for (int n = 0; n < 2; ++n) acc[a][b][m][n] = (f32x4){0.f, 0.f, 0.f, 0.f};
    bf16x8 At[4][2], B0[2][2], B1[2][2];
    const char* cA = (const char*)g.A + (size_t)cur.pm * tstep; const char* cB = (const char*)g.Bt + (size_t)cur.pn * tstep;
    S.a_ready(cur);
    if constexpr (SP2) {
        PG8_STAGE(PG8_SB(0, 0), cB, voffB); PG8_STAGE(PG8_SB(0, 1), cB + hstep, voffB); PG8_STAGE(PG8_SA(0, 0), cA, voffA); PG8_STAGE(PG8_SA(0, 1), cA + hstep, voffA);
        if (wr == 1) PG8_BAR;
        PG8_WAIT_V(2); PG8_BAR;
        PG8_STAGE(PG8_SB(1, 0), cB + kstep, voffB); PG8_STAGE(PG8_SA(1, 0), cA + kstep, voffA); PG8_STAGE(PG8_SB(1, 1), cB + hstep + kstep, voffB);
        PG8_WAIT_V(6); PG8_BAR;
    } else {
        PG8_STAGE(PG8_SB(0, 0), cB, voffB); PG8_STAGE(PG8_SA(0, 0), cA, voffA); PG8_STAGE(PG8_SB(0, 1), cB + hstep, voffB); PG8_STAGE(PG8_SA(0, 1), cA + hstep, voffA);
        if (wr == 1) PG8_BAR;
        PG8_WAIT_V(4); PG8_BAR;
        PG8_STAGE(PG8_SB(1, 0), cB + kstep, voffB); PG8_STAGE(PG8_SA(1, 0), cA + kstep, voffA); PG8_STAGE(PG8_SB(1, 1), cB + hstep + kstep, voffB);
        PG8_WAIT_V(6); PG8_BAR;
    }
    for (;;) {
        const bool has_next = S.next(ui + 1, nxt);
        const char* nA = has_next ? (const char*)g.A + (size_t)nxt.pm * tstep : cA; const char* nB = has_next ? (const char*)g.Bt + (size_t)nxt.pn * tstep : cB;
        for (int t = 0; t < nt; t += 2) {
            const bool last = (t == nt - 2);
            const char* a1 = cA + (size_t)(t + 1) * kstep;
            const char* a2 = last ? nA : cA + (size_t)(t + 2) * kstep; const char* b2 = last ? nB : cB + (size_t)(t + 2) * kstep;
            const char* a3 = a2 + kstep; const char* b3 = b2 + kstep;
            if (last && has_next) S.a_ready(nxt);
            if constexpr (SP2) {
            PG8_LDB(B0, 0, 0); PG8_LDB(B1, 0, 1); PG8_SCHED; PG8_LDA(At, 0, 0); PG8_STAGE(PG8_SA(1, 1), a1 + hstep, voffA);
            PG8_WAIT_V(8); PG8_WAIT_L(0); PG8_BAR; PG8_MMA(0, 0, At, B0); PG8_MMA(0, 1, At, B1); PG8_BAR; PG8_SCHED;
            PG8_LDA(At, 0, 1); PG8_STAGE(PG8_SB(0, 0), b2, voffB); PG8_STAGE(PG8_SB(0, 1), b2 + hstep, voffB); PG8_STAGE(PG8_SA(0, 0), a2, voffA);
            PG8_WAIT_V(8); PG8_WAIT_L(0); PG8_BAR; PG8_MMA(1, 0, At, B0); PG8_MMA(1, 1, At, B1); PG8_BAR; PG8_SCHED;
            PG8_LDB(B0, 1, 0); PG8_LDB(B1, 1, 1); PG8_SCHED; PG8_LDA(At, 1, 0); PG8_STAGE(PG8_SA(0, 1), a2 + hstep, voffA);
            PG8_WAIT_V(8); PG8_WAIT_L(0); PG8_BAR; PG8_MMA(0, 0, At, B0); PG8_MMA(0, 1, At, B1); PG8_BAR; PG8_SCHED;
            PG8_LDA(At, 1, 1); PG8_STAGE(PG8_SB(1, 0), b3, voffB); PG8_STAGE(PG8_SB(1, 1), b3 + hstep, voffB); PG8_STAGE(PG8_SA(1, 0), a3, voffA);
            PG8_WAIT_V(8); PG8_WAIT_L(0); PG8_BAR; PG8_MMA(1, 0, At, B0); PG8_MMA(1, 1, At, B1); PG8_BAR; PG8_SCHED;
            } else {
            PG8_LDB(B0, 0, 0); PG8_SCHED; PG8_LDA(At, 0, 0); PG8_STAGE(PG8_SA(1, 1), a1 + hstep, voffA);
            PG8_WAIT_L(8); PG8_BAR; PG8_WAIT_L(0); PG8_MMA(0, 0, At, B0); PG8_BAR; PG8_SCHED;
            PG8_LDB(B1, 0, 1); PG8_STAGE(PG8_SB(0, 0), b2, voffB);
            PG8_BAR; PG8_WAIT_L(0); PG8_MMA(0, 1, At, B1); PG8_BAR;
            PG8_LDA(At, 0, 1); PG8_STAGE(PG8_SA(0, 0), a2, voffA);
            PG8_BAR; PG8_WAIT_L(0); PG8_MMA(1, 0, At, B0); PG8_BAR; PG8_SCHED;
            PG8_STAGE(PG8_SB(0, 1), b2 + hstep, voffB);
            PG8_WAIT_V(6); PG8_BAR; PG8_MMA(1, 1, At, B1); PG8_BAR;
            PG8_LDB(B0, 1, 0); PG8_SCHED; PG8_LDA(At, 1, 0); PG8_STAGE(PG8_SA(0, 1), a2 + hstep, voffA);
            PG8_WAIT_L(8); PG8_BAR; PG8_WAIT_L(0); PG8_MMA(0, 0, At, B0); PG8_BAR; PG8_SCHED;
            PG8_LDB(B1, 1, 1); PG8_STAGE(PG8_SB(1, 0), b3, voffB);
            PG8_BAR; PG8_WAIT_L(0); PG8_MMA(0, 1, At, B1); PG8_BAR;
            PG8_LDA(At, 1, 1); PG8_STAGE(PG8_SA(1, 0), a3, voffA);
            PG8_BAR; PG8_WAIT_L(0); PG8_MMA(1, 0, At, B0); PG8_BAR; PG8_SCHED;
            PG8_STAGE(PG8_SB(1, 1), b3 + hstep, voffB);
            PG8_WAIT_V(6); PG8_BAR; PG8_MMA(1, 1, At, B1); PG8_BAR;
            }
        }
        if constexpr (ALIGN_EPI) { if (wr == 0) PG8_BAR; }
        if constexpr (!Epi::AFTER_DRAIN) { E(acc, cur, wr, wc, fr, fq); S.done(cur); }
        if (!has_next) break;
#pragma unroll
        for (int a = 0; a < 2; ++a)
#pragma unroll
            for (int b = 0; b < 2; ++b)
#pragma unroll
                for (int m = 0; m < 4; ++m)
#pragma unroll
                    for (int n = 0; n < 2; ++n) acc[a][b][m][n] = (f32x4){0.f, 0.f, 0.f, 0.f};
        cur = nxt; cA = nA; cB = nB; ++ui;
        if constexpr (ALIGN_EPI) { if (wr == 1) PG8_BAR; }
    }
    PG8_WAIT_V(0);
    if constexpr (!ALIGN_EPI) { if (wr == 0) PG8_BAR; }
    PG8_BAR;
#undef PG8_SA
#undef PG8_SB
#undef PG8_STAGE
#undef PG8_LDA
#undef PG8_LDB
#undef PG8_MMA
#undef PG8_WAIT_V
#undef PG8_WAIT_L
#undef PG8_BAR
#undef PG8_SCHED
}
}

template <bool REMAP>
__device__ __forceinline__ void tconv(const float* __restrict__ src, int ldsrc, bf16_t* __restrict__ dst, int K, int ntn, LAS unsigned char* lds) {
    LAS unsigned* T = (LAS unsigned*)lds;
    const int tid = threadIdx.x, nkt = K / 128, total = nkt * ntn;
    for (int tile = blockIdx.x; tile < total; tile += gridDim.x) {
        const int nt = tile / nkt, kt = tile - nt * nkt, n0 = nt * 64, k0 = kt * 128;
        int on0 = n0; bool zero = false;
        if (REMAP) { if (n0 < 10240) on0 = n0; else if (n0 < 26624) on0 = n0 + 64; else if (n0 < 26688) on0 = n0 - 26624 + 10240; else if (n0 < 26752) on0 = n0; else zero = true; }
#pragma unroll
        for (int i = 0; i < 2; ++i) {
            const int rp = (tid >> 4) + 32 * i, c4 = tid & 15;
            f32x4 v0 = (f32x4){0.f, 0.f, 0.f, 0.f}, v1 = v0;
            if (!zero) { const float* s = src + (size_t)(k0 + 2 * rp) * ldsrc + on0 + c4 * 4; v0 = *(const f32x4*)s; v1 = *(const f32x4*)(s + ldsrc); }
#pragma unroll
            for (int j = 0; j < 4; ++j) T[(c4 * 4 + j) * 65 + rp] = cvt_pk_bf16(v0[j], v1[j]);
        }
        __syncthreads();
#pragma unroll
        for (int i = 0; i < 2; ++i) {
            const int n = (tid >> 4) + 32 * i, kc = tid & 15;
            u32x4 v; v[0] = T[n * 65 + kc * 4]; v[1] = T[n * 65 + kc * 4 + 1]; v[2] = T[n * 65 + kc * 4 + 2]; v[3] = T[n * 65 + kc * 4 + 3];
            *(u32x4*)(dst + (size_t)(n0 + n) * K + k0 + kc * 8) = v;
        }
        __syncthreads();
    }
}
__device__ __forceinline__ void phase_convert(const Params& p, LAS unsigned char* lds) {
    bf16_t* Xb = (bf16_t*)(p.ws + OFF_XB);
    const size_t n8 = (size_t)MPAD * DM / 8;
    for (size_t i = (size_t)blockIdx.x * 512 + threadIdx.x; i < n8; i += (size_t)gridDim.x * 512) {
        const size_t e = i * 8; const int row = (int)(e / DM);
        f32x4 a = (f32x4){0.f, 0.f, 0.f, 0.f}, b = a;
        if (row < NTP) { a = *(const f32x4*)(p.x_prompt + e); b = *(const f32x4*)(p.x_prompt + e + 4); }
        else if (row < NTOK) { const size_t e2 = e - (size_t)NTP * DM; a = *(const f32x4*)(p.x_sample + e2); b = *(const f32x4*)(p.x_sample + e2 + 4); }
        u32x4 o; o[0] = cvt_pk_bf16(a[0], a[1]); o[1] = cvt_pk_bf16(a[2], a[3]); o[2] = cvt_pk_bf16(b[0], b[1]); o[3] = cvt_pk_bf16(b[2], b[3]);
        *(u32x4*)(Xb + e) = o;
    }
    { u32x4* mz = (u32x4*)((bf16_t*)(p.ws + OFF_MIX) + (size_t)NTOK * MIXW); const size_t nz = (size_t)(MPAD - NTOK) * MIXW / 8;
      for (size_t i = (size_t)blockIdx.x * 512 + threadIdx.x; i < nz; i += (size_t)gridDim.x * 512) mz[i] = (u32x4){0u, 0u, 0u, 0u}; }
    tconv<true>(p.w_in, NPROJ, (bf16_t*)(p.ws + OFF_WB), DM, NPAD / 64, lds);
    tconv<false>(p.w_out, DM, (bf16_t*)(p.ws + OFF_WOB), MIXW, DM / 64, lds);
}

constexpr int N_GDN_P = 128, N_SSD_P = 128, N_GDN_S = 4096, N_SSD_S = 8192, N_ITEMS = N_GDN_P + N_SSD_P + N_GDN_S + N_SSD_S;
constexpr int GA_LD = 388, GO_LD = 132, SA_LD = 324, SY_LD = 68;

template <bool SAMPLE>
__device__ __forceinline__ void gdn_item(const Params& p, LAS unsigned char* lds, const int b, const int h) {
    LAS float* act = (LAS float*)lds;
    LAS float* tok = (LAS float*)(lds + 64 * GA_LD * 4);
    LAS float* obuf = (LAS float*)(lds + 64 * GA_LD * 4 + 1024);
    const bf16_t* P = (const bf16_t*)(p.ws + OFF_P); const float* G = (const float*)(p.ws + OFF_G32); bf16_t* MIX = (bf16_t*)(p.ws + OFF_MIX);
    const int tid = opaque_tid(), w = tid >> 6, lane = tid & 63, dgrp = lane >> 4, ecol = w * 16 + (lane & 15);
    float s[32];
    if (SAMPLE) { const float* S0 = p.state_gdn + (size_t)(b * 32 + h) * 16384;
#pragma unroll
        for (int i = 0; i < 32; ++i) s[i] = S0[(dgrp * 32 + i) * 128 + ecol]; }
    else {
#pragma unroll
        for (int i = 0; i < 32; ++i) s[i] = 0.f; }
    const int T = SAMPLE ? 1 : 64, NC = SAMPLE ? 1 : 32;
    const size_t rowbase = SAMPLE ? (size_t)(NTP + b) : (size_t)b * 2048;
    const float Aneg = -expf(p.gdn_a_log[h]), dtb = p.gdn_dt_bias[h];
    float* convout = p.out + (SAMPLE ? O_GDNC_S : O_GDNC_P);
    for (int c = 0; c < NC; ++c) {
        const int t0 = c * 64;
        for (int idx = tid; idx < T * 96; idx += 512) {
            const int t = idx / 96, cq = idx - t * 96, col = cq * 4, ch = (col >> 7) * 4096 + h * 128 + (col & 127);
            f32x4 a = (f32x4){0.f, 0.f, 0.f, 0.f};
#pragma unroll
            for (int j = 0; j < 4; ++j) {
                const f32x4 wv = *(const f32x4*)(p.gdn_conv_w + j * 12288 + ch);
                f32x4 rv = (f32x4){0.f, 0.f, 0.f, 0.f};
                if (SAMPLE) { if (j < 3) rv = *(const f32x4*)(p.state_gdn_conv + ((size_t)b * 3 + j) * 12288 + ch); else rv = ldbf4(P + rowbase * P_LD + C_QKV + ch);
                    if (j >= 1) *(f32x4*)(convout + ((size_t)b * 3 + (j - 1)) * 12288 + ch) = rv; }
                else { const int tt = t0 + t - 3 + j; if (tt >= 0) rv = ldbf4(P + (rowbase + tt) * P_LD + C_QKV + ch);
                    if (j == 3 && c == 31 && t >= 61) *(f32x4*)(convout + ((size_t)b * 3 + (t - 61)) * 12288 + ch) = rv; }
                a += wv * rv;
            }
            f32x4 o; o[0] = silu_f(a[0]); o[1] = silu_f(a[1]); o[2] = silu_f(a[2]); o[3] = silu_f(a[3]);
            *(LAS f32x4*)(act + t * GA_LD + col) = o;
        }
        __syncthreads();
#pragma unroll 1
        for (int r = 0; r < 8; ++r) { const int t = w * 8 + r; if (t < T) {
            LAS float* ar = act + t * GA_LD;
            const float q0 = ar[lane], q1 = ar[64 + lane], k0 = ar[128 + lane], k1 = ar[192 + lane];
            const float sq = wave_sum(q0 * q0 + q1 * q1), sk = wave_sum(k0 * k0 + k1 * k1);
            const float rq = rsqrtf(sq + 1e-6f) * 0.08838834764831845f, rk = rsqrtf(sk + 1e-6f);
            ar[lane] = q0 * rq; ar[64 + lane] = q1 * rq; ar[128 + lane] = k0 * rk; ar[192 + lane] = k1 * rk; } }
        if (tid < T) { const size_t row = rowbase + t0 + tid; const float araw = G[row * G_LD + 96 + h], braw = G[row * G_LD + 64 + h];
            tok[tid * 2] = sigmoid_f(braw); tok[tid * 2 + 1] = expf(Aneg * softplus_f(araw + dtb)); }
        __syncthreads();
#pragma unroll 1
        for (int t = 0; t < T; ++t) {
            LAS float* ar = act + t * GA_LD;
            const float beta = tok[t * 2], eg = tok[t * 2 + 1];
            float kk[32], qq[32];
#pragma unroll
            for (int i = 0; i < 8; ++i) { const f32x4 kv = *(LAS f32x4*)(ar + 128 + dgrp * 32 + i * 4); kk[4 * i] = kv[0]; kk[4 * i + 1] = kv[1]; kk[4 * i + 2] = kv[2]; kk[4 * i + 3] = kv[3]; }
            float ks = 0.f;
#pragma unroll
            for (int i = 0; i < 32; ++i) ks += kk[i] * s[i];
            ks += __shfl_xor(ks, 16); ks += __shfl_xor(ks, 32);
            const float vnew = beta * (ar[256 + ecol] - eg * ks);
#pragma unroll
            for (int i = 0; i < 8; ++i) { const f32x4 qv = *(LAS f32x4*)(ar + dgrp * 32 + i * 4); qq[4 * i] = qv[0]; qq[4 * i + 1] = qv[1]; qq[4 * i + 2] = qv[2]; qq[4 * i + 3] = qv[3]; }
            float o = 0.f;
#pragma unroll
            for (int i = 0; i < 32; ++i) { s[i] = eg * s[i] + kk[i] * vnew; o += qq[i] * s[i]; }
            o += __shfl_xor(o, 16); o += __shfl_xor(o, 32);
            if (dgrp == 0) obuf[t * GO_LD + ecol] = o;
        }
        __syncthreads();
#pragma unroll 1
        for (int r = 0; r < 8; ++r) { const int t = w * 8 + r; if (t < T) {
            const float o0 = obuf[t * GO_LD + lane], o1 = obuf[t * GO_LD + 64 + lane];
            const float rs = rsqrtf(wave_sum(o0 * o0 + o1 * o1) * (1.f / 128.f) + 1e-6f);
            const size_t row = rowbase + t0 + t;
            const float z0 = bf2f(P[row * P_LD + C_ZG + h * 128 + lane]), z1 = bf2f(P[row * P_LD + C_ZG + h * 128 + 64 + lane]);
            MIX[row * MIXW + 4096 + h * 128 + lane] = f2bf(o0 * rs * p.gdn_norm_w[lane] * silu_f(z0));
            MIX[row * MIXW + 4096 + h * 128 + 64 + lane] = f2bf(o1 * rs * p.gdn_norm_w[64 + lane] * silu_f(z1)); } }
        __syncthreads();
    }
    float* So = p.out + (SAMPLE ? O_GDN_S : O_GDN_P) + (size_t)(b * 32 + h) * 16384;
#pragma unroll
    for (int i = 0; i < 32; ++i) So[(dgrp * 32 + i) * 128 + ecol] = s[i];
}

template <bool SAMPLE>
__device__ __forceinline__ void ssd_item(const Params& p, LAS unsigned char* lds, const int b, const int h) {
    LAS float* act = (LAS float*)lds;
    LAS float* tok = (LAS float*)(lds + 64 * SA_LD * 4);
    LAS float* ybuf = (LAS float*)(lds + 64 * SA_LD * 4 + 1024);
    const bf16_t* P = (const bf16_t*)(p.ws + OFF_P); const float* G = (const float*)(p.ws + OFF_G32); float* U = (float*)(p.ws + OFF_U32);
    const int tid = opaque_tid(), w = tid >> 6, lane = tid & 63, pp = w * 8 + (lane >> 3), nch = lane & 7, g = h >> 3;
    float hs[16];
    if (SAMPLE) { const float* H0 = p.state_ssd + ((size_t)(b * 64 + h) * 64 + pp) * 128;
#pragma unroll
        for (int i = 0; i < 4; ++i) { const f32x4 v = *(const f32x4*)(H0 + i * 32 + nch * 4); hs[4 * i] = v[0]; hs[4 * i + 1] = v[1]; hs[4 * i + 2] = v[2]; hs[4 * i + 3] = v[3]; } }
    else {
#pragma unroll
        for (int i = 0; i < 16; ++i) hs[i] = 0.f; }
    const int T = SAMPLE ? 1 : 64, NC = SAMPLE ? 1 : 32;
    const size_t rowbase = SAMPLE ? (size_t)(NTP + b) : (size_t)b * 2048;
    const float Aneg = -expf(p.ssd_a_log[h]), dtb = p.ssd_dt_bias[h], Dh = p.ssd_d[h];
    float* convout = p.out + (SAMPLE ? O_SSDC_S : O_SSDC_P);
    for (int c = 0; c < NC; ++c) {
        const int t0 = c * 64;
        for (int idx = tid; idx < T * 80; idx += 512) {
            const int t = idx / 80, cq = idx - t * 80, col = cq * 4;
            const int ch = col < 64 ? h * 64 + col : (col < 192 ? 4096 + g * 128 + (col - 64) : 5120 + g * 128 + (col - 192));
            const bool wr_state = (col < 64) || ((h & 7) == 0);
            f32x4 a = *(const f32x4*)(p.ssd_conv_b + ch);
#pragma unroll
            for (int j = 0; j < 4; ++j) {
                const f32x4 wv = *(const f32x4*)(p.ssd_conv_w + j * 6144 + ch);
                f32x4 rv = (f32x4){0.f, 0.f, 0.f, 0.f};
                if (SAMPLE) { if (j < 3) rv = *(const f32x4*)(p.state_ssd_conv + ((size_t)b * 3 + j) * 6144 + ch); else rv = ldbf4(P + rowbase * P_LD + C_XBC + ch);
                    if (j >= 1 && wr_state) *(f32x4*)(convout + ((size_t)b * 3 + (j - 1)) * 6144 + ch) = rv; }
                else { const int tt = t0 + t - 3 + j; if (tt >= 0) rv = ldbf4(P + (rowbase + tt) * P_LD + C_XBC + ch);
                    if (j == 3 && c == 31 && t >= 61 && wr_state) *(f32x4*)(convout + ((size_t)b * 3 + (t - 61)) * 6144 + ch) = rv; }
                a += wv * rv;
            }
            f32x4 o; o[0] = silu_f(a[0]); o[1] = silu_f(a[1]); o[2] = silu_f(a[2]); o[3] = silu_f(a[3]);
            *(LAS f32x4*)(act + t * SA_LD + col) = o;
        }
        if (tid < T) { const size_t row = rowbase + t0 + tid; const float dt = softplus_f(G[row * G_LD + h] + dtb);
            tok[tid * 2] = dt; tok[tid * 2 + 1] = expf(dt * Aneg); }
        __syncthreads();
#pragma unroll 1
        for (int t = 0; t < T; ++t) {
            LAS float* ar = act + t * SA_LD;
            const float dt = tok[t * 2], eA = tok[t * 2 + 1];
            const float xdt = ar[pp] * dt;
            float y = 0.f;
#pragma unroll
            for (int i = 0; i < 4; ++i) { const f32x4 bv = *(LAS f32x4*)(ar + 64 + i * 32 + nch * 4), cv = *(LAS f32x4*)(ar + 192 + i * 32 + nch * 4);
#pragma unroll
                for (int j = 0; j < 4; ++j) { hs[4 * i + j] = eA * hs[4 * i + j] + xdt * bv[j]; y += cv[j] * hs[4 * i + j]; } }
            y += __shfl_xor(y, 1); y += __shfl_xor(y, 2); y += __shfl_xor(y, 4);
            if (nch == 0) ybuf[t * SY_LD + pp] = y;
        }
        __syncthreads();
        for (int idx = tid; idx < T * 64; idx += 512) { const int t = idx >> 6, q = idx & 63; const size_t row = rowbase + t0 + t;
            const float z = bf2f(P[row * P_LD + C_ZS + h * 64 + q]);
            U[row * DM + h * 64 + q] = (ybuf[t * SY_LD + q] + act[t * SA_LD + q] * Dh) * silu_f(z); }
        __syncthreads();
    }
    float* Ho = p.out + (SAMPLE ? O_SSD_S : O_SSD_P) + ((size_t)(b * 64 + h) * 64 + pp) * 128;
#pragma unroll
    for (int i = 0; i < 4; ++i) { f32x4 v; v[0] = hs[4 * i]; v[1] = hs[4 * i + 1]; v[2] = hs[4 * i + 2]; v[3] = hs[4 * i + 3]; *(f32x4*)(Ho + i * 32 + nch * 4) = v; }
}

typedef __bf16 bf16x2_t __attribute__((ext_vector_type(2)));
typedef short bf16x4 __attribute__((ext_vector_type(4)));
__device__ __forceinline__ unsigned pk_bf16(float lo, float hi) { const f32x2v v = {lo, hi}; return __builtin_bit_cast(unsigned, __builtin_convertvector(v, bf16x2_t)); }
__device__ __forceinline__ bf16x8 pack2(const f32x4 lo, const f32x4 hi) { u32x4 r; r[0] = pk_bf16(lo[0], lo[1]); r[1] = pk_bf16(lo[2], lo[3]); r[2] = pk_bf16(hi[0], hi[1]); r[3] = pk_bf16(hi[2], hi[3]); return __builtin_bit_cast(bf16x8, r); }
__device__ __forceinline__ bf16x8 ld_perm(const LAS bf16_t* rowp, int q) { const u32x2 a = *(const LAS u32x2*)(rowp + 4 * q), b = *(const LAS u32x2*)(rowp + 16 + 4 * q); u32x4 r; r[0] = a[0]; r[1] = a[1]; r[2] = b[0]; r[3] = b[1]; return __builtin_bit_cast(bf16x8, r); }
__device__ __forceinline__ bf16x8 ld_nat(const LAS bf16_t* rowp, int q) { return *(const LAS bf16x8*)(rowp + 8 * q); }
#define MFMA16(a, b, c) __builtin_amdgcn_mfma_f32_16x16x32_bf16((a), (b), (c), 0, 0, 0)

constexpr int GL_QA = 0, GL_KA = 17408, GL_VA = 34816, GL_OB = GL_KA  , GL_KAT = 52224, GL_WL = 70656, GL_AB = 88064, GL_QK = 97280,
              GL_ADT = 106496, GL_TF = 110592, GL_TOK = 112640, GL_SSQ = 113664, GL_LAST = 114176;
__device__ __forceinline__ void gdn_chunk_item(const Params& p, LAS unsigned char* lds, const int b, const int h) {
    const bf16_t* P = (const bf16_t*)(p.ws + OFF_P); const float* G = (const float*)(p.ws + OFF_G32); bf16_t* MIX = (bf16_t*)(p.ws + OFF_MIX);
    const size_t rowbase = (size_t)b * 2048;
    const float Aneg = -expf(p.gdn_a_log[h]), dtb = p.gdn_dt_bias[h];
    float* convout = p.out + O_GDNC_P;
    f32x4 Sacc[8];
#pragma unroll
    for (int j = 0; j < 8; ++j) Sacc[j] = (f32x4){0.f, 0.f, 0.f, 0.f};
    for (int i = threadIdx.x; i < (9216 * 2) / 4; i += 512) ((LAS unsigned*)(lds + GL_AB))[i] = 0u;
#pragma unroll 1
    for (int c = 0; c < 32; ++c) {
        const int t0 = c * 64;
        {
            const int tid = opaque_tid(), lane = tid & 63;
#pragma unroll 1
            for (int it = 0; it < 12; ++it) {
                const int idx = tid + it * 512, t = idx / 96, cq = idx - t * 96, sec = cq >> 5, dcol = (cq & 31) * 4, ch = sec * 4096 + h * 128 + dcol;
                f32x4 a = (f32x4){0.f, 0.f, 0.f, 0.f};
#pragma unroll
                for (int j = 0; j < 4; ++j) {
                    const f32x4 wv = *(const f32x4*)(p.gdn_conv_w + j * 12288 + ch);
                    f32x4 rv = (f32x4){0.f, 0.f, 0.f, 0.f};
                    const int tt = t0 + t - 3 + j; if (tt >= 0) rv = ldbf4(P + (rowbase + tt) * P_LD + C_QKV + ch);
                    if (j == 3 && c == 31 && t >= 61) *(f32x4*)(convout + ((size_t)b * 3 + (t - 61)) * 12288 + ch) = rv;
                    a += wv * rv;
                }
                f32x4 o; o[0] = silu_f(a[0]); o[1] = silu_f(a[1]); o[2] = silu_f(a[2]); o[3] = silu_f(a[3]);
                u32x2 pk; pk[0] = pk_bf16(o[0], o[1]); pk[1] = pk_bf16(o[2], o[3]);
                float ss = o[0] * o[0] + o[1] * o[1] + o[2] * o[2] + o[3] * o[3];
                ss += __shfl_xor(ss, 1); ss += __shfl_xor(ss, 2); ss += __shfl_xor(ss, 4); ss += __shfl_xor(ss, 8); ss += __shfl_xor(ss, 16);
                LAS float* ssq = (LAS float*)(lds + GL_SSQ);
                if (sec == 0) { *(LAS u32x2*)(lds + GL_QA + (t * 136 + dcol) * 2) = pk; if ((lane & 31) == 0) ssq[t * 2] = ss; }
                else if (sec == 1) { *(LAS u32x2*)(lds + GL_KA + (t * 136 + dcol) * 2) = pk; if ((lane & 31) == 0) ssq[t * 2 + 1] = ss;
                    LAS bf16_t* kt = (LAS bf16_t*)(lds + GL_KAT) + dcol * 72 + t;
                    kt[0] = (bf16_t)(pk[0] & 0xffffu); kt[72] = (bf16_t)(pk[0] >> 16); kt[144] = (bf16_t)(pk[1] & 0xffffu); kt[216] = (bf16_t)(pk[1] >> 16); }
                else *(LAS u32x2*)(lds + GL_VA + (t * 136 + dcol) * 2) = pk;
            }
        }
        __syncthreads();
        {
            const int tid = opaque_tid(), lane = tid & 63;
            if ((tid >> 6) == 0) {
                LAS float* ssq = (LAS float*)(lds + GL_SSQ);
                const size_t row = rowbase + t0 + lane; const float araw = G[row * G_LD + 96 + h], braw = G[row * G_LD + 64 + h];
                float cs = Aneg * softplus_f(araw + dtb);
#pragma unroll
                for (int d = 1; d < 64; d <<= 1) { const float n = __shfl_up(cs, d); if (lane >= d) cs += n; }
                f32x4 tv; tv[0] = rsqrtf(ssq[lane * 2] + 1e-6f) * 0.08838834764831845f; tv[1] = rsqrtf(ssq[lane * 2 + 1] + 1e-6f); tv[2] = sigmoid_f(braw); tv[3] = cs;
                ((LAS f32x4*)(lds + GL_TOK))[lane] = tv; if (lane == 63) *(LAS float*)(lds + GL_LAST) = cs;
            }
        }
        __syncthreads();
        {
            const int tid = opaque_tid(), w = tid >> 6, lane = tid & 63, r = lane & 15, q = lane >> 4;
#pragma unroll 1
            for (int job = w; job < 20; job += 8) {
                const int tj = job < 10 ? job : job - 10; const bool isQK = job >= 10;
                const int ti = tj >= 6 ? 3 : (tj >= 3 ? 2 : (tj >= 1 ? 1 : 0)), si = tj - (ti * (ti + 1)) / 2;
                const LAS bf16_t* Ab = (const LAS bf16_t*)(lds + (isQK ? GL_QA : GL_KA)) + (ti * 16 + r) * 136 + 8 * q; const LAS bf16_t* Bb = (const LAS bf16_t*)(lds + GL_KA) + (si * 16 + r) * 136 + 8 * q;
                f32x4 acc = (f32x4){0.f, 0.f, 0.f, 0.f};
#pragma unroll
                for (int kk = 0; kk < 4; ++kk) acc = MFMA16(*(const LAS bf16x8*)(Ab + kk * 32), *(const LAS bf16x8*)(Bb + kk * 32), acc);
                const int s = si * 16 + r; const f32x4 ts = ((const LAS f32x4*)(lds + GL_TOK))[s];
                const LAS f32x4* tq = (const LAS f32x4*)(lds + GL_TOK) + ti * 16 + 4 * q;
                float val[4];
#pragma unroll
                for (int reg = 0; reg < 4; ++reg) { const int t = ti * 16 + 4 * q + reg; const f32x4 tt = tq[reg]; const float dec = __expf(tt[3] - ts[3]);
                    val[reg] = isQK ? (s <= t ? acc[reg] * tt[0] * ts[1] * dec : 0.f) : (s < t ? -(acc[reg] * tt[1] * ts[1] * tt[2] * dec) : 0.f); }
                LAS bf16_t* dst = (LAS bf16_t*)(lds + (isQK ? GL_QK : GL_AB)) + (ti * 16 + 4 * q) * 72 + s;
                const bool diagKK = (!isQK) && (ti == si);
#pragma unroll
                for (int reg = 0; reg < 4; ++reg) dst[reg * 72] = diagKK ? (bf16_t)0 : (bf16_t)(pk_bf16(val[reg], 0.f) & 0xffffu);
                if (diagKK) *(LAS f32x4*)((LAS float*)(lds + GL_ADT) + (ti * 16 + r) * 16 + 4 * q) = (f32x4){val[0], val[1], val[2], val[3]};
            }
        }
        __syncthreads();
        {
            const int tid = opaque_tid(), w = tid >> 6, lane = tid & 63, r = lane & 15, q = lane >> 4;
            if (w < 4) {
                const LAS float* A = (const LAS float*)(lds + GL_ADT) + w * 256;
                float tr[16];
#pragma unroll
                for (int j = 15; j >= 0; --j) { float v = (j == r) ? 1.f : 0.f;
#pragma unroll
                    for (int k = j + 1; k < 16; ++k) v += tr[k] * A[j * 16 + k];
                    tr[j] = v; }
                const float s0 = q == 0 ? tr[0] : (q == 1 ? tr[4] : (q == 2 ? tr[8] : tr[12])), s1 = q == 0 ? tr[1] : (q == 1 ? tr[5] : (q == 2 ? tr[9] : tr[13]));
                const float s2 = q == 0 ? tr[2] : (q == 1 ? tr[6] : (q == 2 ? tr[10] : tr[14])), s3 = q == 0 ? tr[3] : (q == 1 ? tr[7] : (q == 2 ? tr[11] : tr[15]));
                u32x2 tv; tv[0] = pk_bf16(s0, s1); tv[1] = pk_bf16(s2, s3); ((LAS u32x2*)(lds + GL_TF))[w * 64 + lane] = tv;
            }
        }
        __syncthreads();
        f32x4 U[4];
        {
            const int tid = opaque_tid(), w = tid >> 6, lane = tid & 63, r = lane & 15, q = lane >> 4, E = w * 16 + r;
            const LAS f32x4* tq = (const LAS f32x4*)(lds + GL_TOK) + 4 * q;
            const LAS bf16_t* VaE = (const LAS bf16_t*)(lds + GL_VA) + (4 * q) * 136 + E; const LAS bf16_t* KaE = (const LAS bf16_t*)(lds + GL_KA) + (4 * q) * 136 + E;
            const LAS bf16_t* AbR = (const LAS bf16_t*)(lds + GL_AB) + r * 72 + 4 * q;
            const LAS u32x2* TfL = (const LAS u32x2*)(lds + GL_TF) + lane;
            LAS bf16_t* WlE = (LAS bf16_t*)(lds + GL_WL) + (4 * q) * 136 + E;
            u32x4 XU[2], XW[2];
            XU[0] = XU[1] = XW[0] = XW[1] = (u32x4){0u, 0u, 0u, 0u};
#pragma unroll
            for (int i = 0; i < 4; ++i) {
                f32x4 au, aw;
#pragma unroll
                for (int reg = 0; reg < 4; ++reg) { const f32x4 tt = tq[16 * i + reg];
                    au[reg] = bf2f(VaE[(16 * i + reg) * 136]) * tt[2]; aw[reg] = bf2f(KaE[(16 * i + reg) * 136]) * (tt[1] * tt[2] * __expf(tt[3])); }
                if (i >= 1) { const u32x2 a0 = *(const LAS u32x2*)(AbR + 16 * i * 72), a1 = *(const LAS u32x2*)(AbR + 16 * i * 72 + 16); const bf16x8 a = __builtin_bit_cast(bf16x8, (u32x4){a0[0], a0[1], a1[0], a1[1]});
                    au = MFMA16(a, __builtin_bit_cast(bf16x8, XU[0]), au); aw = MFMA16(a, __builtin_bit_cast(bf16x8, XW[0]), aw); }
                if (i == 3) { const u32x2 a0 = *(const LAS u32x2*)(AbR + 48 * 72 + 32), a1 = *(const LAS u32x2*)(AbR + 48 * 72 + 48); const bf16x8 a = __builtin_bit_cast(bf16x8, (u32x4){a0[0], a0[1], a1[0], a1[1]});
                    au = MFMA16(a, __builtin_bit_cast(bf16x8, XU[1]), au); aw = MFMA16(a, __builtin_bit_cast(bf16x8, XW[1]), aw); }
                const u32x2 tf = TfL[i * 64]; const u32x4 ta = (u32x4){tf[0], tf[1], 0u, 0u};
                const u32x4 yu = (u32x4){pk_bf16(au[0], au[1]), pk_bf16(au[2], au[3]), 0u, 0u}, yw = (u32x4){pk_bf16(aw[0], aw[1]), pk_bf16(aw[2], aw[3]), 0u, 0u};
                const f32x4 z4 = (f32x4){0.f, 0.f, 0.f, 0.f};
                const f32x4 xu = MFMA16(__builtin_bit_cast(bf16x8, ta), __builtin_bit_cast(bf16x8, yu), z4), xw = MFMA16(__builtin_bit_cast(bf16x8, ta), __builtin_bit_cast(bf16x8, yw), z4);
                U[i] = xu;
                XU[i >> 1][2 * (i & 1)] = pk_bf16(xu[0], xu[1]); XU[i >> 1][2 * (i & 1) + 1] = pk_bf16(xu[2], xu[3]);
                XW[i >> 1][2 * (i & 1)] = pk_bf16(xw[0], xw[1]); XW[i >> 1][2 * (i & 1) + 1] = pk_bf16(xw[2], xw[3]);
#pragma unroll
                for (int reg = 0; reg < 4; ++reg) WlE[(16 * i + reg) * 136] = (bf16_t)(pk_bf16(-xw[reg], 0.f) & 0xffffu);
            }
        }
        __syncthreads();
        {
            const int tid = opaque_tid(), w = tid >> 6, lane = tid & 63, r = lane & 15, q = lane >> 4, E = w * 16 + r;
            const LAS f32x4* tq = (const LAS f32x4*)(lds + GL_TOK) + 4 * q;
            const LAS bf16_t* WlR = (const LAS bf16_t*)(lds + GL_WL) + r * 136 + 4 * q; const LAS bf16_t* QaR = (const LAS bf16_t*)(lds + GL_QA) + r * 136 + 4 * q;
            const LAS bf16_t* QkR = (const LAS bf16_t*)(lds + GL_QK) + r * 72 + 4 * q; const LAS bf16_t* KtR = (const LAS bf16_t*)(lds + GL_KAT) + r * 72 + 4 * q;
            LAS float* obE = (LAS float*)(lds + GL_OB) + (4 * q) * GO_LD + E;
#define LDP(base, off) __builtin_bit_cast(bf16x8, (u32x4){(*(const LAS u32x2*)((base) + (off)))[0], (*(const LAS u32x2*)((base) + (off)))[1], (*(const LAS u32x2*)((base) + (off) + 16))[0], (*(const LAS u32x2*)((base) + (off) + 16))[1]})
            bf16x8 Sb[4];
#pragma unroll
            for (int kp = 0; kp < 4; ++kp) Sb[kp] = pack2(Sacc[2 * kp], Sacc[2 * kp + 1]);
            const float last = *(const LAS float*)(lds + GL_LAST);
            f32x4 vn[4], oo[4], vs[4];
#pragma unroll
            for (int i = 0; i < 4; ++i) { f32x4 acc = U[i];
#pragma unroll
                for (int kp = 0; kp < 4; ++kp) acc = MFMA16(LDP(WlR, 16 * i * 136 + 32 * kp), Sb[kp], acc);
                vn[i] = acc; }
#pragma unroll
            for (int i = 0; i < 4; ++i) { f32x4 acc = (f32x4){0.f, 0.f, 0.f, 0.f};
#pragma unroll
                for (int kp = 0; kp < 4; ++kp) acc = MFMA16(LDP(QaR, 16 * i * 136 + 32 * kp), Sb[kp], acc);
#pragma unroll
                for (int reg = 0; reg < 4; ++reg) { const f32x4 tt = tq[16 * i + reg]; acc[reg] *= tt[0] * __expf(tt[3]); vs[i][reg] = vn[i][reg] * (tt[1] * __expf(last - tt[3])); }
                oo[i] = acc; }
            bf16x8 Vn[2], Vs[2];
            Vn[0] = pack2(vn[0], vn[1]); Vn[1] = pack2(vn[2], vn[3]); Vs[0] = pack2(vs[0], vs[1]); Vs[1] = pack2(vs[2], vs[3]);
#pragma unroll
            for (int i = 0; i < 4; ++i) {
                oo[i] = MFMA16(LDP(QkR, 16 * i * 72), Vn[0], oo[i]);
                if (i >= 2) oo[i] = MFMA16(LDP(QkR, 16 * i * 72 + 32), Vn[1], oo[i]);
            }
            const float el = __expf(last);
#pragma unroll
            for (int j = 0; j < 8; ++j) { f32x4 acc = Sacc[j] * el;
                acc = MFMA16(LDP(KtR, 16 * j * 72), Vs[0], acc); acc = MFMA16(LDP(KtR, 16 * j * 72 + 32), Vs[1], acc);
                Sacc[j] = acc; }
#pragma unroll
            for (int i = 0; i < 4; ++i)
#pragma unroll
                for (int reg = 0; reg < 4; ++reg) obE[(16 * i + reg) * GO_LD] = oo[i][reg];
        }
        __syncthreads();
        {
            const int tid = opaque_tid(), w = tid >> 6, lane = tid & 63;
            const LAS float* obuf = (const LAS float*)(lds + GL_OB);
#pragma unroll 1
            for (int rr = 0; rr < 8; ++rr) { const int t = w * 8 + rr;
                const float o0 = obuf[t * GO_LD + lane], o1 = obuf[t * GO_LD + 64 + lane];
                const float rs = rsqrtf(wave_sum(o0 * o0 + o1 * o1) * (1.f / 128.f) + 1e-6f);
                const size_t row = rowbase + t0 + t;
                const float z0 = bf2f(P[row * P_LD + C_ZG + h * 128 + lane]), z1 = bf2f(P[row * P_LD + C_ZG + h * 128 + 64 + lane]);
                MIX[row * MIXW + 4096 + h * 128 + lane] = f2bf(o0 * rs * p.gdn_norm_w[lane] * silu_f(z0));
                MIX[row * MIXW + 4096 + h * 128 + 64 + lane] = f2bf(o1 * rs * p.gdn_norm_w[64 + lane] * silu_f(z1)); }
        }
        __syncthreads();
    }
    {
        const int tid = opaque_tid(), w = tid >> 6, lane = tid & 63, r = lane & 15, q = lane >> 4, E = w * 16 + r;
        float* So = p.out + O_GDN_P + (size_t)(b * 32 + h) * 16384 + (4 * q) * 128 + E;
#pragma unroll
        for (int j = 0; j < 8; ++j)
#pragma unroll
            for (int reg = 0; reg < 4; ++reg) So[(16 * j + reg) * 128] = Sacc[j][reg];
    }
}

constexpr int SL_CA = 0, SL_BA = 17408, SL_BAT = 34816, SL_XST = 53248, SL_CBF = 71680, SL_TOK = 89088, SL_LAST = 91136, SL_YB = 91200;
__device__ __forceinline__ void ssd_chunk_item(const Params& p, LAS unsigned char* lds, const int b, const int g, const int hp) {
    LAS bf16_t* Ca = (LAS bf16_t*)(lds + SL_CA); LAS bf16_t* Ba = (LAS bf16_t*)(lds + SL_BA); LAS bf16_t* BaT = (LAS bf16_t*)(lds + SL_BAT); LAS bf16_t* XsT = (LAS bf16_t*)(lds + SL_XST);
    LAS float* CBf = (LAS float*)(lds + SL_CBF); LAS f32x2v* tokr = (LAS f32x2v*)(lds + SL_TOK); LAS float* lastp = (LAS float*)(lds + SL_LAST); LAS float* ybuf = (LAS float*)(lds + SL_YB);
    const bf16_t* P = (const bf16_t*)(p.ws + OFF_P); const float* G = (const float*)(p.ws + OFF_G32); float* Uo = (float*)(p.ws + OFF_U32);
    const int tid = opaque_tid(), w = tid >> 6, lane = tid & 63, r = lane & 15, q = lane >> 4, hl = w >> 2, Pc = (w & 3) * 16 + r, h0 = g * 8 + hp * 2, h = h0 + hl;
    const size_t rowbase = (size_t)b * 2048;
    const float Dh = p.ssd_d[h];
    float* convout = p.out + O_SSDC_P;
    f32x4 Hacc[8];
#pragma unroll
    for (int j = 0; j < 8; ++j) Hacc[j] = (f32x4){0.f, 0.f, 0.f, 0.f};
    for (int c = 0; c < 32; ++c) {
        const int t0 = c * 64;
#pragma unroll 1
        for (int it = 0; it < 12; ++it) {
            const int idx = tid + it * 512, t = idx / 96, cq = idx - t * 96, sec = cq >> 5, dcol = (cq & 31) * 4;
            const int ch = sec == 0 ? h0 * 64 + dcol : (sec == 1 ? 4096 + g * 128 + dcol : 5120 + g * 128 + dcol);
            const bool wr_state = (sec == 0) || (hp == 0);
            f32x4 a = *(const f32x4*)(p.ssd_conv_b + ch);
#pragma unroll
            for (int j = 0; j < 4; ++j) {
                const f32x4 wv = *(const f32x4*)(p.ssd_conv_w + j * 6144 + ch);
                f32x4 rv = (f32x4){0.f, 0.f, 0.f, 0.f};
                const int tt = t0 + t - 3 + j; if (tt >= 0) rv = ldbf4(P + (rowbase + tt) * P_LD + C_XBC + ch);
                if (j == 3 && c == 31 && t >= 61 && wr_state) *(f32x4*)(convout + ((size_t)b * 3 + (t - 61)) * 6144 + ch) = rv;
                a += wv * rv;
            }
            u32x2 pk; pk[0] = pk_bf16(silu_f(a[0]), silu_f(a[1])); pk[1] = pk_bf16(silu_f(a[2]), silu_f(a[3]));
            if (sec == 2) *(LAS u32x2*)(Ca + t * 136 + dcol) = pk;
            else { LAS bf16_t* Tt = sec == 0 ? XsT : BaT;
                if (sec == 1) *(LAS u32x2*)(Ba + t * 136 + dcol) = pk;
                Tt[(dcol + 0) * 72 + t] = (bf16_t)(pk[0] & 0xffffu); Tt[(dcol + 1) * 72 + t] = (bf16_t)(pk[0] >> 16); Tt[(dcol + 2) * 72 + t] = (bf16_t)(pk[1] & 0xffffu); Tt[(dcol + 3) * 72 + t] = (bf16_t)(pk[1] >> 16); }
        }
        __syncthreads();
        if (w < 2) {
            const int hh = h0 + w; const size_t row = rowbase + t0 + lane;
            const float dt = softplus_f(G[row * G_LD + hh] + p.ssd_dt_bias[hh]);
            float cs = -expf(p.ssd_a_log[hh]) * dt;
#pragma unroll
            for (int d = 1; d < 64; d <<= 1) { const float n = __shfl_up(cs, d); if (lane >= d) cs += n; }
            tokr[w * 64 + lane] = (f32x2v){dt, cs}; if (lane == 63) lastp[w] = cs;
        } else {
#pragma unroll 1
            for (int job = w - 2; job < 10; job += 6) {
                const int ti = job >= 6 ? 3 : (job >= 3 ? 2 : (job >= 1 ? 1 : 0)), si = job - (ti * (ti + 1)) / 2;
                const LAS bf16_t* Ab = Ca + (ti * 16 + r) * 136; const LAS bf16_t* Bb = Ba + (si * 16 + r) * 136;
                f32x4 acc = (f32x4){0.f, 0.f, 0.f, 0.f};
#pragma unroll
                for (int kk = 0; kk < 4; ++kk) acc = MFMA16(ld_nat(Ab + kk * 32, q), ld_nat(Bb + kk * 32, q), acc);
#pragma unroll
                for (int reg = 0; reg < 4; ++reg) CBf[(ti * 16 + 4 * q + reg) * 68 + si * 16 + r] = acc[reg];
            }
        }
        __syncthreads();
        {
            const LAS f32x2v* tk = tokr + hl * 64; const float last = lastp[hl];
            bf16x8 Hb[4];
#pragma unroll
            for (int kp = 0; kp < 4; ++kp) Hb[kp] = pack2(Hacc[2 * kp], Hacc[2 * kp + 1]);
            bf16x8 xf[2], xw[2];
#pragma unroll
            for (int kp = 0; kp < 2; ++kp) { const u32x4 xv = *(const LAS u32x4*)(XsT + (hl * 64 + Pc) * 72 + 32 * kp + 8 * q); xf[kp] = __builtin_bit_cast(bf16x8, xv);
                u32x4 xs;
#pragma unroll
                for (int e2 = 0; e2 < 4; ++e2) { const f32x2v ta = tk[32 * kp + 8 * q + 2 * e2], tb = tk[32 * kp + 8 * q + 2 * e2 + 1];
                    const float lo = __uint_as_float(xv[e2] << 16) * (ta[0] * __expf(last - ta[1])), hi = __uint_as_float(xv[e2] & 0xffff0000u) * (tb[0] * __expf(last - tb[1]));
                    xs[e2] = pk_bf16(lo, hi); }
                xw[kp] = __builtin_bit_cast(bf16x8, xs); }
#pragma unroll
            for (int i = 0; i < 4; ++i) {
                f32x4 acc = (f32x4){0.f, 0.f, 0.f, 0.f};
#pragma unroll
                for (int kp = 0; kp < 4; ++kp) acc = MFMA16(ld_perm(Ca + (16 * i + r) * 136 + 32 * kp, q), Hb[kp], acc);
#pragma unroll
                for (int reg = 0; reg < 4; ++reg) acc[reg] *= __expf(tk[16 * i + 4 * q + reg][1]);
                const int t = 16 * i + r; const float cum_t = tk[t][1];
#pragma unroll
                for (int kp = 0; kp < 2; ++kp) { if (kp <= (i >> 1)) {
                    const f32x4 c0 = *(const LAS f32x4*)(CBf + t * 68 + 32 * kp + 8 * q), c1 = *(const LAS f32x4*)(CBf + t * 68 + 32 * kp + 8 * q + 4);
                    float lv[8];
#pragma unroll
                    for (int jj = 0; jj < 8; ++jj) { const int s = 32 * kp + 8 * q + jj; const f32x2v ts = tk[s]; const float cb = jj < 4 ? c0[jj & 3] : c1[jj & 3];
                        lv[jj] = s <= t ? cb * __expf(cum_t - ts[1]) * ts[0] : 0.f; }
                    u32x4 lw; lw[0] = pk_bf16(lv[0], lv[1]); lw[1] = pk_bf16(lv[2], lv[3]); lw[2] = pk_bf16(lv[4], lv[5]); lw[3] = pk_bf16(lv[6], lv[7]);
                    acc = MFMA16(__builtin_bit_cast(bf16x8, lw), xf[kp], acc); } }
                const u32x2 xd = *(const LAS u32x2*)(XsT + (hl * 64 + Pc) * 72 + 16 * i + 4 * q);
                acc[0] += __uint_as_float(xd[0] << 16) * Dh; acc[1] += __uint_as_float(xd[0] & 0xffff0000u) * Dh; acc[2] += __uint_as_float(xd[1] << 16) * Dh; acc[3] += __uint_as_float(xd[1] & 0xffff0000u) * Dh;
#pragma unroll
                for (int reg = 0; reg < 4; ++reg) ybuf[(16 * i + 4 * q + reg) * GO_LD + hl * 64 + Pc] = acc[reg];
            }
            const float el = __expf(last);
#pragma unroll
            for (int j = 0; j < 8; ++j) { f32x4 acc = Hacc[j] * el;
                acc = MFMA16(ld_nat(BaT + (16 * j + r) * 72, q), xw[0], acc); acc = MFMA16(ld_nat(BaT + (16 * j + r) * 72 + 32, q), xw[1], acc);
                Hacc[j] = acc; }
        }
        __syncthreads();
#pragma unroll 1
        for (int it = 0; it < 16; ++it) { const int idx = tid + it * 512, t = idx >> 7, cc = idx & 127; const size_t row = rowbase + t0 + t;
            const float z = bf2f(P[row * P_LD + C_ZS + h0 * 64 + cc]);
            Uo[row * DM + h0 * 64 + cc] = ybuf[t * GO_LD + cc] * silu_f(z); }
        __syncthreads();
    }
    float* Ho = p.out + O_SSD_P + ((size_t)(b * 64 + h) * 64 + Pc) * 128;
#pragma unroll
    for (int j = 0; j < 8; ++j) *(f32x4*)(Ho + 16 * j + 4 * q) = Hacc[j];
}

__device__ __forceinline__ void phase_scan(const Params& p, LAS unsigned char* lds) {
    LAS int* qslot = (LAS int*)(lds + LDS_MISC + 16);
    unsigned* qctr = (unsigned*)(p.ws + OFF_BAR) + QCTR_WORD;
    for (;;) {
        __syncthreads();
        if (threadIdx.x == 0) *qslot = (int)__hip_atomic_fetch_add(qctr, 1u, __ATOMIC_RELAXED, __HIP_MEMORY_SCOPE_AGENT);
        __syncthreads();
        const int item = __builtin_amdgcn_readfirstlane(*qslot);
        if (item >= N_ITEMS) break;
        if (item < N_GDN_P) gdn_chunk_item(p, lds, item >> 5, item & 31);
        else if (item < N_GDN_P + N_SSD_P) { const int i = item - N_GDN_P; ssd_chunk_item(p, lds, i >> 5, (i >> 2) & 7, i & 3); }
        else if (item < N_GDN_P + N_SSD_P + N_GDN_S) { const int i = item - N_GDN_P - N_SSD_P; gdn_item<true>(p, lds, i >> 5, i & 31); }
        else { const int i = item - N_GDN_P - N_SSD_P - N_GDN_S; ssd_item<true>(p, lds, i >> 6, i & 63); }
    }
}

__device__ __forceinline__ void phase_ssdnorm(const Params& p) {
    const float* U = (const float*)(p.ws + OFF_U32); bf16_t* MIX = (bf16_t*)(p.ws + OFF_MIX);
    const int lane = threadIdx.x & 63, gw = blockIdx.x * 8 + (threadIdx.x >> 6), nw = gridDim.x * 8;
    for (int it = gw; it < NTOK * 8; it += nw) {
        const int row = it >> 3, g = it & 7; const size_t off = (size_t)row * DM + g * 512 + lane * 8;
        const f32x4 a = *(const f32x4*)(U + off), b = *(const f32x4*)(U + off + 4);
        const float ss = wave_sum(a[0] * a[0] + a[1] * a[1] + a[2] * a[2] + a[3] * a[3] + b[0] * b[0] + b[1] * b[1] + b[2] * b[2] + b[3] * b[3]);
        const float rs = rsqrtf(ss * (1.f / 512.f) + 1e-6f);
        const f32x4 wa = *(const f32x4*)(p.ssd_norm_w + g * 512 + lane * 8), wb = *(const f32x4*)(p.ssd_norm_w + g * 512 + lane * 8 + 4);
        u32x4 o; o[0] = cvt_pk_bf16(a[0] * rs * wa[0], a[1] * rs * wa[1]); o[1] = cvt_pk_bf16(a[2] * rs * wa[2], a[3] * rs * wa[3]);
        o[2] = cvt_pk_bf16(b[0] * rs * wb[0], b[1] * rs * wb[1]); o[3] = cvt_pk_bf16(b[2] * rs * wb[2], b[3] * rs * wb[3]);
        *(u32x4*)(MIX + (size_t)row * MIXW + g * 512 + lane * 8) = o;
    }
}

__device__ __forceinline__ void phase_ln(const Params& p) {
    const float* R = (const float*)(p.ws + OFF_R);
    const int lane = threadIdx.x & 63, gw = blockIdx.x * 8 + (threadIdx.x >> 6), nw = gridDim.x * 8;
    for (int row = gw; row < NTOK; row += nw) {
        const float* rr = R + (size_t)row * DM;
        f32x4 v[16]; float sum = 0.f;
#pragma unroll
        for (int i = 0; i < 16; ++i) { v[i] = *(const f32x4*)(rr + (i * 64 + lane) * 4); sum += v[i][0] + v[i][1] + v[i][2] + v[i][3]; }
        const float mu = wave_sum(sum) * (1.f / 4096.f);
        float sq = 0.f;
#pragma unroll
        for (int i = 0; i < 16; ++i) { v[i] = v[i] - mu; sq += v[i][0] * v[i][0] + v[i][1] * v[i][1] + v[i][2] * v[i][2] + v[i][3] * v[i][3]; }
        const float rs = rsqrtf(wave_sum(sq) * (1.f / 4096.f) + 1e-5f);
        float* o = p.out + (row < NTP ? O_YP + (size_t)row * DM : O_YS + (size_t)(row - NTP) * DM);
#pragma unroll
        for (int i = 0; i < 16; ++i) { const int c = (i * 64 + lane) * 4; const f32x4 gg = *(const f32x4*)(p.ln_g + c), bb = *(const f32x4*)(p.ln_b + c);
            *(f32x4*)(o + c) = v[i] * rs * gg + bb; }
    }
}

template <int PH>
__global__ __launch_bounds__(512, 2) void mk_fwd(Params p) {
    extern __shared__ __attribute__((aligned(16))) unsigned char smem[];
    LAS unsigned char* lds = (LAS unsigned char*)smem;
    XcdBarrier bar;
    if (PH < 0) {
        if (threadIdx.x == 0) *(LAS u32x4*)(lds + LDS_MISC) = (u32x4){0u, 0u, 0u, 0u};
        __syncthreads();
        bar = xcd_barrier_post((unsigned*)(p.ws + OFF_BAR), (volatile LAS unsigned*)(lds + LDS_MISC));
    }
    if (PH < 0 || PH == 0) phase_convert(p, lds);
    if (PH < 0) xcd_barrier(bar);
    if (PH < 0 || PH == 1) {
        pg8::Gemm g{(const bf16_t*)(p.ws + OFF_XB), (const bf16_t*)(p.ws + OFF_WB), MPAD, NPAD, DM};
        pg8::StaticOrder S; S.init(MPAD, NPAD, (int)gridDim.x, (int)blockIdx.x);
        pg8::EpiProj E{(bf16_t*)(p.ws + OFF_P), (float*)(p.ws + OFF_G32)};
        pg8::gemm_phase<pg8::EpiProj, pg8::StaticOrder, true, true>(lds, g, S, E);
    }
    if (PH < 0) xcd_barrier(bar);
    if (PH < 0 || PH == 2) phase_scan(p, lds);
    if (PH < 0) xcd_barrier(bar);
    if (PH < 0 || PH == 3) phase_ssdnorm(p);
    if (PH < 0) xcd_barrier(bar);
    if (PH < 0 || PH == 4) {
        pg8::Gemm g{(const bf16_t*)(p.ws + OFF_MIX), (const bf16_t*)(p.ws + OFF_WOB), MPAD, DM, MIXW};
        pg8::StaticOrder S; S.init(MPAD, DM, (int)gridDim.x, (int)blockIdx.x);
        pg8::EpiOut E{(float*)(p.ws + OFF_R), p.x_prompt, p.x_sample};
        pg8::gemm_phase<pg8::EpiOut, pg8::StaticOrder, true, true>(lds, g, S, E);
    }
    if (PH < 0) xcd_barrier(bar);
    if (PH < 0 || PH == 5) phase_ln(p);
}

template <int PH> static void launch_phase(const Params& p, int grid, hipStream_t stream) {
    static bool attr = false;
    if (!attr) { (void)hipFuncSetAttribute((const void*)mk_fwd<PH>, hipFuncAttributeMaxDynamicSharedMemorySize, LDS_BYTES); attr = true; }
    hipLaunchKernelGGL((mk_fwd<PH>), dim3(grid), dim3(512), LDS_BYTES, stream, p);
}

extern "C" void kernel_launch(void* const* d_in, const int* in_sizes, int n_in, void* d_out, int out_size, void* d_ws, size_t ws_size, hipStream_t stream) {
    (void)in_sizes; (void)n_in; (void)out_size;
    if (ws_size < WS_END) { fprintf(stderr, "workspace too small: %zu < %zu\n", ws_size, (size_t)WS_END); return; }
    Params p{};
    p.x_prompt = (const float*)d_in[0]; p.x_sample = (const float*)d_in[1]; p.state_ssd = (const float*)d_in[2]; p.state_ssd_conv = (const float*)d_in[3];
    p.state_gdn = (const float*)d_in[4]; p.state_gdn_conv = (const float*)d_in[5]; p.w_in = (const float*)d_in[6]; p.ssd_conv_w = (const float*)d_in[7];
    p.ssd_conv_b = (const float*)d_in[8]; p.ssd_dt_bias = (const float*)d_in[9]; p.ssd_a_log = (const float*)d_in[10]; p.ssd_d = (const float*)d_in[11];
    p.ssd_norm_w = (const float*)d_in[12]; p.gdn_conv_w = (const float*)d_in[13]; p.gdn_dt_bias = (const float*)d_in[14]; p.gdn_a_log = (const float*)d_in[15];
    p.gdn_norm_w = (const float*)d_in[16]; p.w_out = (const float*)d_in[17]; p.ln_g = (const float*)d_in[18]; p.ln_b = (const float*)d_in[19];
    p.out = (float*)d_out; p.ws = (unsigned char*)d_ws;
    static int grid = 0;
    if (!grid) { int dev = 0, cus = 0; (void)hipGetDevice(&dev); (void)hipDeviceGetAttribute(&cus, hipDeviceAttributeMultiprocessorCount, dev); grid = cus > 0 ? cus : 256; }
    (void)hipMemsetAsync(d_ws, 0, 16384, stream);
#if MK_FUSED
    launch_phase<-1>(p, grid, stream);
#else
    launch_phase<0>(p, grid, stream); launch_phase<1>(p, grid, stream); launch_phase<2>(p, grid, stream);
    launch_phase<3>(p, grid, stream); launch_phase<4>(p, grid, stream); launch_phase<5>(p, grid, stream);
#endif
}
```

```cpp
#include <hip/hip_runtime.h>
#include <cstdio>
#include <cstdint>

#ifndef PROBE_REP
#define PROBE_REP 0
#endif
#ifndef MK_FUSED
#define MK_FUSED 1
#endif

#define LAS __attribute__((address_space(3)))
typedef unsigned short bf16_t;
typedef short bf16x8 __attribute__((ext_vector_type(8)));
typedef float f32x4 __attribute__((ext_vector_type(4)));
typedef float f32x2v __attribute__((ext_vector_type(2)));
typedef unsigned u32x4 __attribute__((ext_vector_type(4)));
typedef unsigned u32x2 __attribute__((ext_vector_type(2)));

constexpr int DM = 4096, NTP = 8192, NTS = 128, NTOK = 8320, MPAD = 8448;
constexpr int NPROJ = 26752, P_LD = 26624, NPAD = 26880, MIXW = 8192, G_LD = 256;
constexpr int C_ZS = 0, C_XBC = 4096, C_QKV = 10240, C_ZG = 22528;
constexpr float ALPHA = 1.189207115002721f;
constexpr int LDS_BYTES = 163840;
constexpr int LDS_MISC = LDS_BYTES - 64;

constexpr size_t OFF_BAR = 0;
constexpr size_t OFF_XB  = 16384;
constexpr size_t OFF_WB  = OFF_XB  + (size_t)MPAD * DM * 2;
constexpr size_t OFF_WOB = OFF_WB  + (size_t)NPAD * DM * 2;
constexpr size_t OFF_P   = OFF_WOB + (size_t)DM * MIXW * 2;
constexpr size_t OFF_G32 = OFF_P   + (size_t)MPAD * P_LD * 2;
constexpr size_t OFF_MIX = OFF_G32 + (size_t)MPAD * G_LD * 4;
constexpr size_t OFF_U32 = OFF_MIX + (size_t)MPAD * MIXW * 2;
constexpr size_t OFF_R   = OFF_U32 + (size_t)MPAD * DM * 4;
constexpr size_t WS_END  = OFF_R   + (size_t)MPAD * DM * 4;
constexpr int QCTR_WORD = 3584;

constexpr size_t O_YP = 0;
constexpr size_t O_YS = O_YP + (size_t)NTP * DM;
constexpr size_t O_SSD_P = O_YS + (size_t)NTS * DM;
constexpr size_t O_SSDC_P = O_SSD_P + (size_t)4 * 64 * 64 * 128;
constexpr size_t O_GDN_P = O_SSDC_P + (size_t)4 * 3 * 6144;
constexpr size_t O_GDNC_P = O_GDN_P + (size_t)4 * 32 * 128 * 128;
constexpr size_t O_SSD_S = O_GDNC_P + (size_t)4 * 3 * 12288;
constexpr size_t O_SSDC_S = O_SSD_S + (size_t)128 * 64 * 64 * 128;
constexpr size_t O_GDN_S = O_SSDC_S + (size_t)128 * 3 * 6144;
constexpr size_t O_GDNC_S = O_GDN_S + (size_t)128 * 32 * 128 * 128;

struct Params {
    const float* x_prompt; const float* x_sample; const float* state_ssd; const float* state_ssd_conv; const float* state_gdn; const float* state_gdn_conv;
    const float* w_in; const float* ssd_conv_w; const float* ssd_conv_b; const float* ssd_dt_bias; const float* ssd_a_log; const float* ssd_d; const float* ssd_norm_w;
    const float* gdn_conv_w; const float* gdn_dt_bias; const float* gdn_a_log; const float* gdn_norm_w; const float* w_out; const float* ln_g; const float* ln_b;
    float* out; unsigned char* ws;
};

__device__ __forceinline__ unsigned cvt_pk_bf16(float lo, float hi) { unsigned r; asm volatile("v_cvt_pk_bf16_f32 %0, %1, %2" : "=v"(r) : "v"(lo), "v"(hi)); return r; }
__device__ __forceinline__ float bf2f(bf16_t v) { return __uint_as_float(((unsigned)v) << 16); }
__device__ __forceinline__ bf16_t f2bf(float f) { unsigned u = __float_as_uint(f); u += 0x7FFFu + ((u >> 16) & 1u); return (bf16_t)(u >> 16); }
__device__ __forceinline__ float silu_f(float x) { return x / (1.f + __expf(-x)); }
__device__ __forceinline__ float sigmoid_f(float x) { return 1.f / (1.f + __expf(-x)); }
__device__ __forceinline__ float softplus_f(float x) { return x > 20.f ? x : log1pf(expf(x)); }
__device__ __forceinline__ f32x4 ldbf4(const bf16_t* p) { const u32x2 v = *(const u32x2*)p; f32x4 r; r[0] = __uint_as_float(v[0] << 16); r[1] = __uint_as_float(v[0] & 0xffff0000u); r[2] = __uint_as_float(v[1] << 16); r[3] = __uint_as_float(v[1] & 0xffff0000u); return r; }
__device__ __forceinline__ int opaque_tid() { int t = threadIdx.x; asm volatile("" : "+v"(t)); return t; }
__device__ __forceinline__ float wave_sum(float v) {
#pragma unroll
    for (int m = 32; m >= 1; m >>= 1) v += __shfl_xor(v, m);
    return v;
}

#define XB_TMO      128
#define XB_XCNT(j)  (256  + 64 * (j))
#define XB_XSUB(j)  (1280 + 64 * (j))
#define XB_XGEN(j)  (2304 + 64 * (j))
#define XB_TOP      3328
#define XB_TOPGEN   3392
#define XCD_BAR_WORDS 3456
#define XB_SPIN_CAP (1u << 18)
__device__ __forceinline__ unsigned xb_ld(unsigned* p)              { return __hip_atomic_load(p, __ATOMIC_RELAXED, __HIP_MEMORY_SCOPE_AGENT); }
__device__ __forceinline__ unsigned xb_add(unsigned* p, unsigned v) { return __hip_atomic_fetch_add(p, v, __ATOMIC_RELAXED, __HIP_MEMORY_SCOPE_AGENT); }
__device__ __forceinline__ unsigned xb_xcc_id() { return (unsigned)__builtin_amdgcn_s_getreg((3 << 11) | 20) & 0xFu; }
#define XB_SPIN(cond, bar) do { unsigned _sp = 0; while (cond) { __builtin_amdgcn_s_sleep(1); \
    if ((++_sp & 255u) == 0u) { if (xb_ld(&(bar)[XB_TMO])) break; if (_sp > XB_SPIN_CAP) { atomicAdd(&(bar)[XB_TMO], 1u); break; } } } } while (0)
struct XcdBarrier { unsigned* bar; unsigned x; volatile LAS unsigned* st; };
__device__ __forceinline__ XcdBarrier xcd_barrier_post(unsigned* bar, volatile LAS unsigned* st) {
    XcdBarrier b; b.bar = bar; b.x = xb_xcc_id(); b.st = st;
    if (threadIdx.x == 0) (void)xb_add(&bar[XB_XCNT(b.x)], 1u);
    return b;
}
__device__ __forceinline__ void xcd_barrier_complete(unsigned* bar, unsigned x, unsigned& nloc, unsigned& nx) {
    const unsigned G = gridDim.x * gridDim.y * gridDim.z;
    unsigned sum, cnt, mine, sp = 0u;
    for (;;) {
        sum = 0u; cnt = 0u; mine = 0u;
#pragma unroll
        for (unsigned j = 0; j < 16; ++j) { const unsigned c = xb_ld(&bar[XB_XCNT(j)]); sum += c; cnt += (c > 0u) ? 1u : 0u; mine = (j == x) ? c : mine; }
        if (sum == G) break;
        __builtin_amdgcn_s_sleep(1);
        if ((++sp & 255u) == 0u) { if (xb_ld(&bar[XB_TMO])) break; if (sp > XB_SPIN_CAP) { atomicAdd(&bar[XB_TMO], 1u); break; } }
    }
    nloc = mine > 0u ? mine : 1u; nx = cnt > 0u ? cnt : 1u;
}
__device__ __forceinline__ void xcd_barrier(const XcdBarrier& b) {
    asm volatile("s_waitcnt vmcnt(0)" ::: "memory");
    __syncthreads();
    if (threadIdx.x == 0) {
        unsigned* bar = b.bar;
        __builtin_amdgcn_s_waitcnt(0);
        unsigned nloc = b.st[0], nx = b.st[1];
        if (nloc == 0u) { xcd_barrier_complete(bar, b.x, nloc, nx); b.st[0] = nloc; b.st[1] = nx; }
        const unsigned old = xb_add(&bar[XB_XSUB(b.x)], 1u);
        const unsigned gen = old / nloc;
        if (old + 1u == (gen + 1u) * nloc) {
            __builtin_amdgcn_fence(__ATOMIC_RELEASE, "agent");
            asm volatile("s_waitcnt vmcnt(0)" ::: "memory");
            const unsigned og = xb_add(&bar[XB_TOP], 1u);
            const unsigned tg = og / nx;
            if (og + 1u == (tg + 1u) * nx) xb_add(&bar[XB_TOPGEN], 1u);
            else XB_SPIN(xb_ld(&bar[XB_TOPGEN]) == tg, bar);
            __builtin_amdgcn_fence(__ATOMIC_ACQUIRE, "agent");
            xb_add(&bar[XB_XGEN(b.x)], 1u);
            asm volatile("s_waitcnt vmcnt(0)" ::: "memory");
        } else {
            XB_SPIN(xb_ld(&bar[XB_XGEN(b.x)]) == gen, bar);
            __builtin_amdgcn_fence(__ATOMIC_ACQUIRE, "agent");
            asm volatile("s_waitcnt vmcnt(0)" ::: "memory");
        }
    }
    __syncthreads();
}

namespace pg8 {
constexpr int BM = 256, BK = 64, HALF = 128, HTB = HALF * BK * 2, STAGE_BYTES = 8 * HTB, NXCD = 8, WGM = 8;
__host__ __device__ __forceinline__ int lds_byte(int r, int c) { const int st = (r >> 4) * 2 + (c >> 5), rr = r & 15, cc = c & 31, ob = rr * 64 + cc * 2; return st * 1024 + (ob ^ (((ob >> 9) & 1) << 5)); }
__host__ __device__ __forceinline__ void stage_rc(int b, int& R, int& C) { const int st = b / 1024, sb = b % 1024, swz = sb ^ (((sb >> 9) & 1) << 5); R = (st >> 1) * 16 + swz / 64; C = (st & 1) * 32 + (swz % 64) / 2; }
__host__ __device__ __forceinline__ int perm32(int rho) { const int n = rho >> 4, i = rho & 15; return 8 * (i >> 2) + 4 * n + (i & 3); }
struct Unit { int pm, pn; };
struct Gemm { const bf16_t* A; const bf16_t* Bt; int M, N, K; };
struct StaticOrder {
    int nM, nN, nwg, G, c;
    __host__ __device__ void init(int M, int N, int G_, int c_) { nM = M / BM; nN = N / BM; nwg = nM * nN; G = G_; c = c_; }
    __host__ __device__ bool next(int i, Unit& u) const {
        const long L = (long)i * G + c; if (L >= nwg) return false;
        int wgid = (int)L; { const int q = nwg / NXCD, r = nwg % NXCD, xcd = wgid % NXCD, off = wgid / NXCD; wgid = (xcd < r ? xcd * (q + 1) : r * (q + 1) + (xcd - r) * q) + off; }
        const int nig = WGM * nN, gid = wgid / nig, fm = gid * WGM, gsz = (nM - fm) < WGM ? (nM - fm) : WGM;
        u.pm = fm + ((wgid % nig) % gsz); u.pn = (wgid % nig) / gsz; return true;
    }
    __device__ __forceinline__ void a_ready(const Unit&) const {}
    __device__ __forceinline__ void done(const Unit&) const {}
};

struct EpiProj {
    static constexpr bool PERM = true, AFTER_DRAIN = false;
    bf16_t* P; float* G;
    __device__ __forceinline__ void operator()(const f32x4 (&acc)[2][2][4][2], const Unit& u, int wr, int wc, int fr, int fq) const {
        const int row0 = u.pm * BM + wr * 64 + fr;
        if (u.pn < 104) {
            const int col0 = u.pn * BM + wc * 32 + 8 * fq;
#pragma unroll
            for (int ai = 0; ai < 2; ++ai)
#pragma unroll
                for (int m = 0; m < 4; ++m) { bf16_t* rowp = P + (size_t)(row0 + ai * HALF + m * 16) * P_LD + col0;
#pragma unroll
                    for (int bj = 0; bj < 2; ++bj) { const f32x4 v0 = acc[ai][bj][m][0], v1 = acc[ai][bj][m][1];
                        u32x4 w; w[0] = cvt_pk_bf16(v0[0], v0[1]); w[1] = cvt_pk_bf16(v0[2], v0[3]); w[2] = cvt_pk_bf16(v1[0], v1[1]); w[3] = cvt_pk_bf16(v1[2], v1[3]);
                        *(u32x4*)(rowp + bj * HALF) = w; } }
        } else {
#pragma unroll
            for (int ai = 0; ai < 2; ++ai)
#pragma unroll
                for (int m = 0; m < 4; ++m) { float* rowp = G + (size_t)(row0 + ai * HALF + m * 16) * G_LD + wc * 32 + 8 * fq;
                    *(f32x4*)(rowp) = acc[ai][0][m][0]; *(f32x4*)(rowp + 4) = acc[ai][0][m][1]; }
        }
    }
};
struct EpiOut {
    static constexpr bool PERM = false, AFTER_DRAIN = false;
    float* R; const float* xp; const float* xs;
    __device__ __forceinline__ void operator()(const f32x4 (&acc)[2][2][4][2], const Unit& u, int wr, int wc, int fr, int fq) const {
        const int row0 = u.pm * BM + wr * 64 + fr, col0 = u.pn * BM + wc * 32 + 4 * fq;
#pragma unroll
        for (int ai = 0; ai < 2; ++ai)
#pragma unroll
            for (int m = 0; m < 4; ++m) { const int r = row0 + ai * HALF + m * 16;
                if (r < NTOK) { const float* xr = r < NTP ? xp + (size_t)r * DM : xs + (size_t)(r - NTP) * DM; float* rr = R + (size_t)r * DM;
#pragma unroll
                    for (int bj = 0; bj < 2; ++bj)
#pragma unroll
                        for (int n = 0; n < 2; ++n) { const int c = col0 + bj * HALF + n * 16; const f32x4 xv = *(const f32x4*)(xr + c); *(f32x4*)(rr + c) = acc[ai][bj][m][n] + ALPHA * xv; } } }
    }
};

template <class Epi, class Sched, bool ALIGN_EPI = false, bool SP2 = false>
__device__ __forceinline__ void gemm_phase(LAS unsigned char* lds, const Gemm g, const Sched& S, const Epi& E) {
    const int tid = threadIdx.x, wid = __builtin_amdgcn_readfirstlane(tid >> 6), lane = tid & 63, wr = wid >> 2, wc = wid & 3, fr = lane & 15, fq = lane >> 4;
    const int K = g.K, nt = K / BK;
    unsigned voffA[2], voffB[2];
#pragma unroll
    for (int i = 0; i < 2; ++i) { int R, C; stage_rc(tid * 16 + i * 8192, R, C); const int Rb = Epi::PERM ? ((R & ~31) + perm32(R & 31)) : R;
        voffA[i] = (unsigned)(R * K + C) * 2u; voffB[i] = (unsigned)(Rb * K + C) * 2u; }
    const size_t kstep = (size_t)(BK * 2);
    const size_t hstep = (size_t)HALF * K * 2;
    const size_t tstep = 2 * hstep;
    const unsigned ldsw = (unsigned)wid * 1024u;
    const int aoff = lds_byte(wr * 64 + fr, fq * 8), boff = lds_byte(wc * 32 + fr, fq * 8);
#define PG8_SA(b, h) (((b) * 2 + (h)) * HTB)
#define PG8_SB(b, h) ((4 + (b) * 2 + (h)) * HTB)
#define PG8_STAGE(bufoff, gbase, voff) do { _Pragma("unroll") for (int _i = 0; _i < 2; ++_i) \
        __builtin_amdgcn_global_load_lds((const unsigned*)((const char*)(gbase) + (voff)[_i]), (LAS unsigned*)(lds + (bufoff) + ldsw + _i * 8192), 16, 0, 0); } while (0)
#define PG8_LDA(dst, b, h) do { _Pragma("unroll") for (int m = 0; m < 4; ++m) _Pragma("unroll") for (int k = 0; k < 2; ++k) dst[m][k] = *(const LAS bf16x8*)(lds + PG8_SA(b, h) + aoff + m * 2048 + k * 1024); } while (0)
#define PG8_LDB(dst, b, h) do { _Pragma("unroll") for (int n = 0; n < 2; ++n) _Pragma("unroll") for (int k = 0; k < 2; ++k) dst[n][k] = *(const LAS bf16x8*)(lds + PG8_SB(b, h) + boff + n * 2048 + k * 1024); } while (0)
#define PG8_MMA(ai, bj, At, Bt) do { __builtin_amdgcn_s_setprio(1); _Pragma("unroll") for (int m = 0; m < 4; ++m) _Pragma("unroll") for (int n = 0; n < 2; ++n) _Pragma("unroll") for (int k = 0; k < 2; ++k) \
        acc[ai][bj][m][n] = __builtin_amdgcn_mfma_f32_16x16x32_bf16(Bt[n][k], At[m][k], acc[ai][bj][m][n], 0, 0, 0); __builtin_amdgcn_s_setprio(0); } while (0)
#define PG8_WAIT_V(n) asm volatile("s_waitcnt vmcnt(" #n ")" ::: "memory")
#define PG8_WAIT_L(n) asm volatile("s_waitcnt lgkmcnt(" #n ")" ::: "memory")
#define PG8_BAR __builtin_amdgcn_s_barrier()
#define PG8_SCHED __builtin_amdgcn_sched_barrier(0)
    Unit cur, nxt; int ui = 0;
    if (!S.next(0, cur)) return;
    f32x4 acc[2][2][4][2];
#pragma unroll
    for (int a = 0; a < 2; ++a)
#pragma unroll
        for (int b = 0; b < 2; ++b)
#pragma unroll
            for (int m = 0; m < 4; ++m)
#pragma unroll
                for (int n = 0; n < 2; ++n) acc[a][b][m][n] = (f32x4){0.f, 0.f, 0.f, 0.f};
    bf16x8 At[4][2], B0[2][2], B1[2][2];
    const char* cA = (const char*)g.A + (size_t)cur.pm * tstep; const char* cB = (const char*)g.Bt + (size_t)cur.pn * tstep;
    S.a_ready(cur);
    if constexpr (SP2) {
        PG8_STAGE(PG8_SB(0, 0), cB, voffB); PG8_STAGE(PG8_SB(0, 1), cB + hstep, voffB); PG8_STAGE(PG8_SA(0, 0), cA, voffA); PG8_STAGE(PG8_SA(0, 1), cA + hstep, voffA);
        if (wr == 1) PG8_BAR;
        PG8_WAIT_V(2); PG8_BAR;
        PG8_STAGE(PG8_SB(1, 0), cB + kstep, voffB); PG8_STAGE(PG8_SA(1, 0), cA + kstep, voffA); PG8_STAGE(PG8_SB(1, 1), cB + hstep + kstep, voffB);
        PG8_WAIT_V(6); PG8_BAR;
    } else {
        PG8_STAGE(PG8_SB(0, 0), cB, voffB); PG8_STAGE(PG8_SA(0, 0), cA, voffA); PG8_STAGE(PG8_SB(0, 1), cB + hstep, voffB); PG8_STAGE(PG8_SA(0, 1), cA + hstep, voffA);
        if (wr == 1) PG8_BAR;
        PG8_WAIT_V(4); PG8_BAR;
        PG8_STAGE(PG8_SB(1, 0), cB + kstep, voffB); PG8_STAGE(PG8_SA(1, 0), cA + kstep, voffA); PG8_STAGE(PG8_SB(1, 1), cB + hstep + kstep, voffB);
        PG8_WAIT_V(6); PG8_BAR;
    }
    for (;;) {
        const bool has_next = S.next(ui + 1, nxt);
        const char* nA = has_next ? (const char*)g.A + (size_t)nxt.pm * tstep : cA; const char* nB = has_next ? (const char*)g.Bt + (size_t)nxt.pn * tstep : cB;
        for (int t = 0; t < nt; t += 2) {
            const bool last = (t == nt - 2);
            const char* a1 = cA + (size_t)(t + 1) * kstep;
            const char* a2 = last ? nA : cA + (size_t)(t + 2) * kstep; const char* b2 = last ? nB : cB + (size_t)(t + 2) * kstep;
            const char* a3 = a2 + kstep; const char* b3 = b2 + kstep;
            if (last && has_next) S.a_ready(nxt);
            if constexpr (SP2) {
            PG8_LDB(B0, 0, 0); PG8_LDB(B1, 0, 1); PG8_SCHED; PG8_LDA(At, 0, 0); PG8_STAGE(PG8_SA(1, 1), a1 + hstep, voffA);
            PG8_WAIT_V(8); PG8_WAIT_L(0); PG8_BAR; PG8_MMA(0, 0, At, B0); PG8_MMA(0, 1, At, B1); PG8_BAR; PG8_SCHED;
            PG8_LDA(At, 0, 1); PG8_STAGE(PG8_SB(0, 0), b2, voffB); PG8_STAGE(PG8_SB(0, 1), b2 + hstep, voffB); PG8_STAGE(PG8_SA(0, 0), a2, voffA);
            PG8_WAIT_V(8); PG8_WAIT_L(0); PG8_BAR; PG8_MMA(1, 0, At, B0); PG8_MMA(1, 1, At, B1); PG8_BAR; PG8_SCHED;
            PG8_LDB(B0, 1, 0); PG8_LDB(B1, 1, 1); PG8_SCHED; PG8_LDA(At, 1, 0); PG8_STAGE(PG8_SA(0, 1), a2 + hstep, voffA);
            PG8_WAIT_V(8); PG8_WAIT_L(0); PG8_BAR; PG8_MMA(0, 0, At, B0); PG8_MMA(0, 1, At, B1); PG8_BAR; PG8_SCHED;
            PG8_LDA(At, 1, 1); PG8_STAGE(PG8_SB(1, 0), b3, voffB); PG8_STAGE(PG8_SB(1, 1), b3 + hstep, voffB); PG8_STAGE(PG8_SA(1, 0), a3, voffA);
            PG8_WAIT_V(8); PG8_WAIT_L(0); PG8_BAR; PG8_MMA(1, 0, At, B0); PG8_MMA(1, 1, At, B1); PG8_BAR; PG8_SCHED;
            } else {
            PG8_LDB(B0, 0, 0); PG8_SCHED; PG8_LDA(At, 0, 0); PG8_STAGE(PG8_SA(1, 1), a1 + hstep, voffA);
            PG8_WAIT_L(8); PG8_BAR; PG8_WAIT_L(0); PG8_MMA(0, 0, At, B0); PG8_BAR; PG8_SCHED;
            PG8_LDB(B1, 0, 1); PG8_STAGE(PG8_SB(0, 0), b2, voffB);
            PG8_BAR; PG8_WAIT_L(0); PG8_MMA(0, 1, At, B1); PG8_BAR;
            PG8_LDA(At, 0, 1); PG8_STAGE(PG8_SA(0, 0), a2, voffA);
            PG8_BAR; PG8_WAIT_L(0); PG8_MMA(1, 0, At, B0); PG8_BAR; PG8_SCHED;
            PG8_STAGE(PG8_SB(0, 1), b2 + hstep, voffB);
            PG8_WAIT_V(6); PG8_BAR; PG8_MMA(1, 1, At, B1); PG8_BAR;
            PG8_LDB(B0, 1, 0); PG8_SCHED; PG8_LDA(At, 1, 0); PG8_STAGE(PG8_SA(0, 1), a2 + hstep, voffA);
            PG8_WAIT_L(8); PG8_BAR; PG8_WAIT_L(0); PG8_MMA(0, 0, At, B0); PG8_BAR; PG8_SCHED;
            PG8_LDB(B1, 1, 1); PG8_STAGE(PG8_SB(1, 0), b3, voffB);
            PG8_BAR; PG8_WAIT_L(0); PG8_MMA(0, 1, At, B1); PG8_BAR;
            PG8_LDA(At, 1, 1); PG8_STAGE(PG8_SA(1, 0), a3, voffA);
            PG8_BAR; PG8_WAIT_L(0); PG8_MMA(1, 0, At, B0); PG8_BAR; PG8_SCHED;
            PG8_STAGE(PG8_SB(1, 1), b3 + hstep, voffB);
            PG8_WAIT_V(6); PG8_BAR; PG8_MMA(1, 1, At, B1); PG8_BAR;
            }
        }
        if constexpr (ALIGN_EPI) { if (wr == 0) PG8_BAR; }
        if constexpr (!Epi::AFTER_DRAIN) { E(acc, cur, wr, wc, fr, fq); S.done(cur); }
        if (!has_next) break;
#pragma unroll
        for (int a = 0; a < 2; ++a)
#pragma unroll
            for (int b = 0; b < 2; ++b)
#pragma unroll
                for (int m = 0; m < 4; ++m)
#pragma unroll
                    for (int n = 0; n < 2; ++n) acc[a][b][m][n] = (f32x4){0.f, 0.f, 0.f, 0.f};
        cur = nxt; cA = nA; cB = nB; ++ui;
        if constexpr (ALIGN_EPI) { if (wr == 1) PG8_BAR; }
    }
    PG8_WAIT_V(0);
    if constexpr (!ALIGN_EPI) { if (wr == 0) PG8_BAR; }
    PG8_BAR;
#undef PG8_SA
#undef PG8_SB
#undef PG8_STAGE
#undef PG8_LDA
#undef PG8_LDB
#undef PG8_MMA
#undef PG8_WAIT_V
#undef PG8_WAIT_L
#undef PG8_BAR
#undef PG8_SCHED
}
}

template <bool REMAP>
__device__ __forceinline__ void tconv(const float* __restrict__ src, int ldsrc, bf16_t* __restrict__ dst, int K, int ntn, LAS unsigned char* lds) {
    LAS unsigned* T = (LAS unsigned*)lds;
    const int tid = threadIdx.x, nkt = K / 128, total = nkt * ntn;
    for (int tile = blockIdx.x; tile < total; tile += gridDim.x) {
        const int nt = tile / nkt, kt = tile - nt * nkt, n0 = nt * 64, k0 = kt * 128;
        int on0 = n0; bool zero = false;
        if (REMAP) { if (n0 < 10240) on0 = n0; else if (n0 < 26624) on0 = n0 + 64; else if (n0 < 26688) on0 = n0 - 26624 + 10240; else if (n0 < 26752) on0 = n0; else zero = true; }
#pragma unroll
        for (int i = 0; i < 2; ++i) {
            const int rp = (tid >> 4) + 32 * i, c4 = tid & 15;
            f32x4 v0 = (f32x4){0.f, 0.f, 0.f, 0.f}, v1 = v0;
            if (!zero) { const float* s = src + (size_t)(k0 + 2 * rp) * ldsrc + on0 + c4 * 4; v0 = *(const f32x4*)s; v1 = *(const f32x4*)(s + ldsrc); }
#pragma unroll
            for (int j = 0; j < 4; ++j) T[(c4 * 4 + j) * 65 + rp] = cvt_pk_bf16(v0[j], v1[j]);
        }
        __syncthreads();
#pragma unroll
        for (int i = 0; i < 2; ++i) {
            const int n = (tid >> 4) + 32 * i, kc = tid & 15;
            u32x4 v; v[0] = T[n * 65 + kc * 4]; v[1] = T[n * 65 + kc * 4 + 1]; v[2] = T[n * 65 + kc * 4 + 2]; v[3] = T[n * 65 + kc * 4 + 3];
            *(u32x4*)(dst + (size_t)(n0 + n) * K + k0 + kc * 8) = v;
        }
        __syncthreads();
    }
}
__device__ __forceinline__ void phase_convert(const Params& p, LAS unsigned char* lds) {
    bf16_t* Xb = (bf16_t*)(p.ws + OFF_XB);
    const size_t n8 = (size_t)MPAD * DM / 8;
    for (size_t i = (size_t)blockIdx.x * 512 + threadIdx.x; i < n8; i += (size_t)gridDim.x * 512) {
        const size_t e = i * 8; const int row = (int)(e / DM);
        f32x4 a = (f32x4){0.f, 0.f, 0.f, 0.f}, b = a;
        if (row < NTP) { a = *(const f32x4*)(p.x_prompt + e); b = *(const f32x4*)(p.x_prompt + e + 4); }
        else if (row < NTOK) { const size_t e2 = e - (size_t)NTP * DM; a = *(const f32x4*)(p.x_sample + e2); b = *(const f32x4*)(p.x_sample + e2 + 4); }
        u32x4 o; o[0] = cvt_pk_bf16(a[0], a[1]); o[1] = cvt_pk_bf16(a[2], a[3]); o[2] = cvt_pk_bf16(b[0], b[1]); o[3] = cvt_pk_bf16(b[2], b[3]);
        *(u32x4*)(Xb + e) = o;
    }
    { u32x4* mz = (u32x4*)((bf16_t*)(p.ws + OFF_MIX) + (size_t)NTOK * MIXW); const size_t nz = (size_t)(MPAD - NTOK) * MIXW / 8;
      for (size_t i = (size_t)blockIdx.x * 512 + threadIdx.x; i < nz; i += (size_t)gridDim.x * 512) mz[i] = (u32x4){0u, 0u, 0u, 0u}; }
    tconv<true>(p.w_in, NPROJ, (bf16_t*)(p.ws + OFF_WB), DM, NPAD / 64, lds);
    tconv<false>(p.w_out, DM, (bf16_t*)(p.ws + OFF_WOB), MIXW, DM / 64, lds);
}

constexpr int N_GDN_P = 128, N_SSD_P = 128, N_GDN_S = 4096, N_SSD_S = 8192, N_ITEMS = N_GDN_P + N_SSD_P + N_GDN_S + N_SSD_S;
constexpr int GA_LD = 388, GO_LD = 132, SA_LD = 324, SY_LD = 68;

template <bool SAMPLE>
__device__ __forceinline__ void gdn_item(const Params& p, LAS unsigned char* lds, const int b, const int h) {
    LAS float* act = (LAS float*)lds;
    LAS float* tok = (LAS float*)(lds + 64 * GA_LD * 4);
    LAS float* obuf = (LAS float*)(lds + 64 * GA_LD * 4 + 1024);
    const bf16_t* P = (const bf16_t*)(p.ws + OFF_P); const float* G = (const float*)(p.ws + OFF_G32); bf16_t* MIX = (bf16_t*)(p.ws + OFF_MIX);
    const int tid = opaque_tid(), w = tid >> 6, lane = tid & 63, dgrp = lane >> 4, ecol = w * 16 + (lane & 15);
    float s[32];
    if (SAMPLE) { const float* S0 = p.state_gdn + (size_t)(b * 32 + h) * 16384;
#pragma unroll
        for (int i = 0; i < 32; ++i) s[i] = S0[(dgrp * 32 + i) * 128 + ecol]; }
    else {
#pragma unroll
        for (int i = 0; i < 32; ++i) s[i] = 0.f; }
    const int T = SAMPLE ? 1 : 64, NC = SAMPLE ? 1 : 32;
    const size_t rowbase = SAMPLE ? (size_t)(NTP + b) : (size_t)b * 2048;
    const float Aneg = -expf(p.gdn_a_log[h]), dtb = p.gdn_dt_bias[h];
    float* convout = p.out + (SAMPLE ? O_GDNC_S : O_GDNC_P);
    for (int c = 0; c < NC; ++c) {
        const int t0 = c * 64;
        for (int idx = tid; idx < T * 96; idx += 512) {
            const int t = idx / 96, cq = idx - t * 96, col = cq * 4, ch = (col >> 7) * 4096 + h * 128 + (col & 127);
            f32x4 a = (f32x4){0.f, 0.f, 0.f, 0.f};
#pragma unroll
            for (int j = 0; j < 4; ++j) {
                const f32x4 wv = *(const f32x4*)(p.gdn_conv_w + j * 12288 + ch);
                f32x4 rv = (f32x4){0.f, 0.f, 0.f, 0.f};
                if (SAMPLE) { if (j < 3) rv = *(const f32x4*)(p.state_gdn_conv + ((size_t)b * 3 + j) * 12288 + ch); else rv = ldbf4(P + rowbase * P_LD + C_QKV + ch);
                    if (j >= 1) *(f32x4*)(convout + ((size_t)b * 3 + (j - 1)) * 12288 + ch) = rv; }
                else { const int tt = t0 + t - 3 + j; if (tt >= 0) rv = ldbf4(P + (rowbase + tt) * P_LD + C_QKV + ch);
                    if (j == 3 && c == 31 && t >= 61) *(f32x4*)(convout + ((size_t)b * 3 + (t - 61)) * 12288 + ch) = rv; }
                a += wv * rv;
            }
            f32x4 o; o[0] = silu_f(a[0]); o[1] = silu_f(a[1]); o[2] = silu_f(a[2]); o[3] = silu_f(a[3]);
            *(LAS f32x4*)(act + t * GA_LD + col) = o;
        }
        __syncthreads();
#pragma unroll 1
        for (int r = 0; r < 8; ++r) { const int t = w * 8 + r; if (t < T) {
            LAS float* ar = act + t * GA_LD;
            const float q0 = ar[lane], q1 = ar[64 + lane], k0 = ar[128 + lane], k1 = ar[192 + lane];
            const float sq = wave_sum(q0 * q0 + q1 * q1), sk = wave_sum(k0 * k0 + k1 * k1);
            const float rq = rsqrtf(sq + 1e-6f) * 0.08838834764831845f, rk = rsqrtf(sk + 1e-6f);
            ar[lane] = q0 * rq; ar[64 + lane] = q1 * rq; ar[128 + lane] = k0 * rk; ar[192 + lane] = k1 * rk; } }
        if (tid < T) { const size_t row = rowbase + t0 + tid; const float araw = G[row * G_LD + 96 + h], braw = G[row * G_LD + 64 + h];
            tok[tid * 2] = sigmoid_f(braw); tok[tid * 2 + 1] = expf(Aneg * softplus_f(araw + dtb)); }
        __syncthreads();
#pragma unroll 1
        for (int t = 0; t < T; ++t) {
            LAS float* ar = act + t * GA_LD;
            const float beta = tok[t * 2], eg = tok[t * 2 + 1];
            float kk[32], qq[32];
#pragma unroll
            for (int i = 0; i < 8; ++i) { const f32x4 kv = *(LAS f32x4*)(ar + 128 + dgrp * 32 + i * 4); kk[4 * i] = kv[0]; kk[4 * i + 1] = kv[1]; kk[4 * i + 2] = kv[2]; kk[4 * i + 3] = kv[3]; }
            float ks = 0.f;
#pragma unroll
            for (int i = 0; i < 32; ++i) ks += kk[i] * s[i];
            ks += __shfl_xor(ks, 16); ks += __shfl_xor(ks, 32);
            const float vnew = beta * (ar[256 + ecol] - eg * ks);
#pragma unroll
            for (int i = 0; i < 8; ++i) { const f32x4 qv = *(LAS f32x4*)(ar + dgrp * 32 + i * 4); qq[4 * i] = qv[0]; qq[4 * i + 1] = qv[1]; qq[4 * i + 2] = qv[2]; qq[4 * i + 3] = qv[3]; }
            float o = 0.f;
#pragma unroll
            for (int i = 0; i < 32; ++i) { s[i] = eg * s[i] + kk[i] * vnew; o += qq[i] * s[i]; }
            o += __shfl_xor(o, 16); o += __shfl_xor(o, 32);
            if (dgrp == 0) obuf[t * GO_LD + ecol] = o;
        }
        __syncthreads();
#pragma unroll 1
        for (int r = 0; r < 8; ++r) { const int t = w * 8 + r; if (t < T) {
            const float o0 = obuf[t * GO_LD + lane], o1 = obuf[t * GO_LD + 64 + lane];
            const float rs = rsqrtf(wave_sum(o0 * o0 + o1 * o1) * (1.f / 128.f) + 1e-6f);
            const size_t row = rowbase + t0 + t;
            const float z0 = bf2f(P[row * P_LD + C_ZG + h * 128 + lane]), z1 = bf2f(P[row * P_LD + C_ZG + h * 128 + 64 + lane]);
            MIX[row * MIXW + 4096 + h * 128 + lane] = f2bf(o0 * rs * p.gdn_norm_w[lane] * silu_f(z0));
            MIX[row * MIXW + 4096 + h * 128 + 64 + lane] = f2bf(o1 * rs * p.gdn_norm_w[64 + lane] * silu_f(z1)); } }
        __syncthreads();
    }
    float* So = p.out + (SAMPLE ? O_GDN_S : O_GDN_P) + (size_t)(b * 32 + h) * 16384;
#pragma unroll
    for (int i = 0; i < 32; ++i) So[(dgrp * 32 + i) * 128 + ecol] = s[i];
}

template <bool SAMPLE>
__device__ __forceinline__ void ssd_item(const Params& p, LAS unsigned char* lds, const int b, const int h) {
    LAS float* act = (LAS float*)lds;
    LAS float* tok = (LAS float*)(lds + 64 * SA_LD * 4);
    LAS float* ybuf = (LAS float*)(lds + 64 * SA_LD * 4 + 1024);
    const bf16_t* P = (const bf16_t*)(p.ws + OFF_P); const float* G = (const float*)(p.ws + OFF_G32); float* U = (float*)(p.ws + OFF_U32);
    const int tid = opaque_tid(), w = tid >> 6, lane = tid & 63, pp = w * 8 + (lane >> 3), nch = lane & 7, g = h >> 3;
    float hs[16];
    if (SAMPLE) { const float* H0 = p.state_ssd + ((size_t)(b * 64 + h) * 64 + pp) * 128;
#pragma unroll
        for (int i = 0; i < 4; ++i) { const f32x4 v = *(const f32x4*)(H0 + i * 32 + nch * 4); hs[4 * i] = v[0]; hs[4 * i + 1] = v[1]; hs[4 * i + 2] = v[2]; hs[4 * i + 3] = v[3]; } }
    else {
#pragma unroll
        for (int i = 0; i < 16; ++i) hs[i] = 0.f; }
    const int T = SAMPLE ? 1 : 64, NC = SAMPLE ? 1 : 32;
    const size_t rowbase = SAMPLE ? (size_t)(NTP + b) : (size_t)b * 2048;
    const float Aneg = -expf(p.ssd_a_log[h]), dtb = p.ssd_dt_bias[h], Dh = p.ssd_d[h];
    float* convout = p.out + (SAMPLE ? O_SSDC_S : O_SSDC_P);
    for (int c = 0; c < NC; ++c) {
        const int t0 = c * 64;
        for (int idx = tid; idx < T * 80; idx += 512) {
            const int t = idx / 80, cq = idx - t * 80, col = cq * 4;
            const int ch = col < 64 ? h * 64 + col : (col < 192 ? 4096 + g * 128 + (col - 64) : 5120 + g * 128 + (col - 192));
            const bool wr_state = (col < 64) || ((h & 7) == 0);
            f32x4 a = *(const f32x4*)(p.ssd_conv_b + ch);
#pragma unroll
            for (int j = 0; j < 4; ++j) {
                const f32x4 wv = *(const f32x4*)(p.ssd_conv_w + j * 6144 + ch);
                f32x4 rv = (f32x4){0.f, 0.f, 0.f, 0.f};
                if (SAMPLE) { if (j < 3) rv = *(const f32x4*)(p.state_ssd_conv + ((size_t)b * 3 + j) * 6144 + ch); else rv = ldbf4(P + rowbase * P_LD + C_XBC + ch);
                    if (j >= 1 && wr_state) *(f32x4*)(convout + ((size_t)b * 3 + (j - 1)) * 6144 + ch) = rv; }
                else { const int tt = t0 + t - 3 + j; if (tt >= 0) rv = ldbf4(P + (rowbase + tt) * P_LD + C_XBC + ch);
                    if (j == 3 && c == 31 && t >= 61 && wr_state) *(f32x4*)(convout + ((size_t)b * 3 + (t - 61)) * 6144 + ch) = rv; }
                a += wv * rv;
            }
            f32x4 o; o[0] = silu_f(a[0]); o[1] = silu_f(a[1]); o[2] = silu_f(a[2]); o[3] = silu_f(a[3]);
            *(LAS f32x4*)(act + t * SA_LD + col) = o;
        }
        if (tid < T) { const size_t row = rowbase + t0 + tid; const float dt = softplus_f(G[row * G_LD + h] + dtb);
            tok[tid * 2] = dt; tok[tid * 2 + 1] = expf(dt * Aneg); }
        __syncthreads();
#pragma unroll 1
        for (int t = 0; t < T; ++t) {
            LAS float* ar = act + t * SA_LD;
            const float dt = tok[t * 2], eA = tok[t * 2 + 1];
            const float xdt = ar[pp] * dt;
            float y = 0.f;
#pragma unroll
            for (int i = 0; i < 4; ++i) { const f32x4 bv = *(LAS f32x4*)(ar + 64 + i * 32 + nch * 4), cv = *(LAS f32x4*)(ar + 192 + i * 32 + nch * 4);
#pragma unroll
                for (int j = 0; j < 4; ++j) { hs[4 * i + j] = eA * hs[4 * i + j] + xdt * bv[j]; y += cv[j] * hs[4 * i + j]; } }
            y += __shfl_xor(y, 1); y += __shfl_xor(y, 2); y += __shfl_xor(y, 4);
            if (nch == 0) ybuf[t * SY_LD + pp] = y;
        }
        __syncthreads();
        for (int idx = tid; idx < T * 64; idx += 512) { const int t = idx >> 6, q = idx & 63; const size_t row = rowbase + t0 + t;
            const float z = bf2f(P[row * P_LD + C_ZS + h * 64 + q]);
            U[row * DM + h * 64 + q] = (ybuf[t * SY_LD + q] + act[t * SA_LD + q] * Dh) * silu_f(z); }
        __syncthreads();
    }
    float* Ho = p.out + (SAMPLE ? O_SSD_S : O_SSD_P) + ((size_t)(b * 64 + h) * 64 + pp) * 128;
#pragma unroll
    for (int i = 0; i < 4; ++i) { f32x4 v; v[0] = hs[4 * i]; v[1] = hs[4 * i + 1]; v[2] = hs[4 * i + 2]; v[3] = hs[4 * i + 3]; *(f32x4*)(Ho + i * 32 + nch * 4) = v; }
}

typedef __bf16 bf16x2_t __attribute__((ext_vector_type(2)));
typedef short bf16x4 __attribute__((ext_vector_type(4)));
__device__ __forceinline__ unsigned pk_bf16(float lo, float hi) { const f32x2v v = {lo, hi}; return __builtin_bit_cast(unsigned, __builtin_convertvector(v, bf16x2_t)); }
__device__ __forceinline__ bf16x8 pack2(const f32x4 lo, const f32x4 hi) { u32x4 r; r[0] = pk_bf16(lo[0], lo[1]); r[1] = pk_bf16(lo[2], lo[3]); r[2] = pk_bf16(hi[0], hi[1]); r[3] = pk_bf16(hi[2], hi[3]); return __builtin_bit_cast(bf16x8, r); }
__device__ __forceinline__ bf16x8 ld_perm(const LAS bf16_t* rowp, int q) { const u32x2 a = *(const LAS u32x2*)(rowp + 4 * q), b = *(const LAS u32x2*)(rowp + 16 + 4 * q); u32x4 r; r[0] = a[0]; r[1] = a[1]; r[2] = b[0]; r[3] = b[1]; return __builtin_bit_cast(bf16x8, r); }
__device__ __forceinline__ bf16x8 ld_nat(const LAS bf16_t* rowp, int q) { return *(const LAS bf16x8*)(rowp + 8 * q); }
#define MFMA16(a, b, c) __builtin_amdgcn_mfma_f32_16x16x32_bf16((a), (b), (c), 0, 0, 0)

#define BAR_LDS() do { asm volatile("s_waitcnt lgkmcnt(0)" ::: "memory"); __builtin_amdgcn_s_barrier(); asm volatile("" ::: "memory"); } while (0)
#define WAIT_VM0() asm volatile("s_waitcnt vmcnt(0)" ::: "memory")
#define LDP(base, off) __builtin_bit_cast(bf16x8, (u32x4){(*(const LAS u32x2*)((base) + (off)))[0], (*(const LAS u32x2*)((base) + (off)))[1], (*(const LAS u32x2*)((base) + (off) + 16))[0], (*(const LAS u32x2*)((base) + (off) + 16))[1]})
__device__ __forceinline__ float blo(unsigned v) { return __uint_as_float(v << 16); }
__device__ __forceinline__ float bhi(unsigned v) { return __uint_as_float(v & 0xffff0000u); }
__device__ __forceinline__ void dma_raw(LAS unsigned char* lds_raw, const bf16_t* P, const bf16_t* zsrc, const size_t rowbase, const int t0, const int c0, const int c1, const int c2, const int w, const int lane) {
#pragma unroll
    for (int kk = 0; kk < 7; ++kk) {
        int k = w + 8 * kk; k = k > 50 ? 50 : k;
        int seg = 4 * k + (lane >> 4); seg = seg > 200 ? 200 : seg;
        const int row = seg / 3, sec = seg - row * 3, tt = t0 - 3 + row;
        const bf16_t* src = tt >= 0 ? P + (rowbase + tt) * P_LD + (sec == 0 ? c0 : (sec == 1 ? c1 : c2)) : zsrc;
        __builtin_amdgcn_global_load_lds((const unsigned*)(src + (lane & 15) * 8), (LAS unsigned*)(lds_raw + k * 1024), 16, 0, 0);
    }
}
__device__ __forceinline__ float reduce16(float (&v)[16], const int lane) {
#pragma unroll
    for (int i = 0; i < 8; ++i) { const bool up = (lane & 32) != 0; const float send = up ? v[i] : v[i + 8], keep = up ? v[i + 8] : v[i]; v[i] = keep + __shfl_xor(send, 32); }
#pragma unroll
    for (int i = 0; i < 4; ++i) { const bool up = (lane & 16) != 0; const float send = up ? v[i] : v[i + 4], keep = up ? v[i + 4] : v[i]; v[i] = keep + __shfl_xor(send, 16); }
#pragma unroll
    for (int i = 0; i < 2; ++i) { const bool up = (lane & 8) != 0; const float send = up ? v[i] : v[i + 2], keep = up ? v[i + 2] : v[i]; v[i] = keep + __shfl_xor(send, 8); }
    { const bool up = (lane & 4) != 0; const float send = up ? v[0] : v[1], keep = up ? v[1] : v[0]; v[0] = keep + __shfl_xor(send, 4); }
    v[0] += __shfl_xor(v[0], 2); v[0] += __shfl_xor(v[0], 1);
    return v[0];
}

constexpr int GL_RAW = 0, GL_QA = 52224, GL_KA = 69632, GL_OB = GL_KA  , GL_KAT = 87040, GL_WL = 105472, GL_AB = 122880, GL_QK = 132096,
              GL_ADT = 141312, GL_TF = 145408, GL_TOK = 147456, GL_SSQ = 148480, GL_LAST = 148992, GL_WTS = 149056;
__device__ __forceinline__ void gdn_chunk_item(const Params& p, LAS unsigned char* lds, const int b, const int h) {
    const bf16_t* P = (const bf16_t*)(p.ws + OFF_P); const float* G = (const float*)(p.ws + OFF_G32); bf16_t* MIX = (bf16_t*)(p.ws + OFF_MIX);
    const bf16_t* zsrc = (const bf16_t*)(p.ws + OFF_XB) + (size_t)NTOK * DM;
    const size_t rowbase = (size_t)b * 2048;
    const float Aneg = -expf(p.gdn_a_log[h]), dtb = p.gdn_dt_bias[h];
    const int c0 = C_QKV + h * 128, c1 = C_QKV + 4096 + h * 128, c2 = C_QKV + 8192 + h * 128;
    f32x4 Sacc[8];
#pragma unroll
    for (int j = 0; j < 8; ++j) Sacc[j] = (f32x4){0.f, 0.f, 0.f, 0.f};
    float g_araw = 0.f, g_braw = 0.f;
    {
        const int tid = opaque_tid(), lane = tid & 63, w = __builtin_amdgcn_readfirstlane(tid >> 6);
        for (int i = tid; i < (9216 * 2) / 4; i += 512) ((LAS unsigned*)(lds + GL_AB))[i] = 0u;
        for (int i = tid; i < 1536; i += 512) { const int j = i / 384, cc = i - j * 384; ((LAS float*)(lds + GL_WTS))[i] = p.gdn_conv_w[j * 12288 + (cc >> 7) * 4096 + h * 128 + (cc & 127)]; }
        dma_raw(lds + GL_RAW, P, zsrc, rowbase, 0, c0, c1, c2, w, lane);
        if (w == 0) { g_araw = G[(rowbase + lane) * G_LD + 96 + h]; g_braw = G[(rowbase + lane) * G_LD + 64 + h]; }
    }
#pragma unroll 1
    for (int c = 0; c < 32; ++c) {
        const int t0 = c * 64;
        WAIT_VM0(); BAR_LDS();
        {
            const int tid = opaque_tid(), lane = tid & 63, w = tid >> 6;
            const LAS unsigned char* rawl = lds + GL_RAW + (8 * w) * 768 + lane * 4; const LAS float* wts = (const LAS float*)(lds + GL_WTS) + 2 * lane;
            float ssv[16];
#pragma unroll
            for (int sec = 0; sec < 2; ++sec) {
                f32x2v wj[4];
#pragma unroll
                for (int j = 0; j < 4; ++j) wj[j] = *(const LAS f32x2v*)(wts + j * 384 + sec * 128);
                float x0[11], x1[11];
#pragma unroll
                for (int rr = 0; rr < 11; ++rr) { const unsigned u = *(const LAS unsigned*)(rawl + rr * 768 + sec * 256); x0[rr] = blo(u); x1[rr] = bhi(u); }
                unsigned pk[8];
#pragma unroll
                for (int t = 0; t < 8; ++t) {
                    const float a0 = silu_f(wj[0][0] * x0[t] + wj[1][0] * x0[t + 1] + wj[2][0] * x0[t + 2] + wj[3][0] * x0[t + 3]);
                    const float a1 = silu_f(wj[0][1] * x1[t] + wj[1][1] * x1[t + 1] + wj[2][1] * x1[t + 2] + wj[3][1] * x1[t + 3]);
                    ssv[2 * t + sec] = a0 * a0 + a1 * a1; pk[t] = pk_bf16(a0, a1);
                    *(LAS unsigned*)(lds + (sec == 0 ? GL_QA : GL_KA) + ((8 * w + t) * 136 + 2 * lane) * 2) = pk[t];
                }
                if (sec == 1) {
                    u32x4 ke, ko;
#pragma unroll
                    for (int t2 = 0; t2 < 4; ++t2) { ke[t2] = (pk[2 * t2] & 0xffffu) | (pk[2 * t2 + 1] << 16); ko[t2] = (pk[2 * t2] >> 16) | (pk[2 * t2 + 1] & 0xffff0000u); }
                    *(LAS u32x4*)(lds + GL_KAT + ((2 * lane) * 72 + 8 * w) * 2) = ke; *(LAS u32x4*)(lds + GL_KAT + ((2 * lane + 1) * 72 + 8 * w) * 2) = ko;
                }
            }
            const float tot = reduce16(ssv, lane);
            if ((lane & 3) == 0) ((LAS float*)(lds + GL_SSQ))[16 * w + (lane >> 2)] = tot;
            if (c == 31 && w == 7) {
                float* convout = p.out + O_GDNC_P + (size_t)b * 3 * 12288 + h * 128 + 2 * lane;
#pragma unroll
                for (int j = 0; j < 3; ++j)
#pragma unroll
                    for (int sec = 0; sec < 3; ++sec) { const unsigned u = *(const LAS unsigned*)(lds + GL_RAW + ((64 + j) * 3 + sec) * 256 + lane * 4); *(f32x2v*)(convout + j * 12288 + sec * 4096) = (f32x2v){blo(u), bhi(u)}; }
            }
        }
        BAR_LDS();
        {
            const int tid = opaque_tid(), lane = tid & 63;
            if ((tid >> 6) == 0) {
                const LAS float* ssq = (const LAS float*)(lds + GL_SSQ);
                float cs = Aneg * softplus_f(g_araw + dtb); const float beta = sigmoid_f(g_braw);
                if (c < 31) { const size_t row = rowbase + t0 + 64 + lane; g_araw = G[row * G_LD + 96 + h]; g_braw = G[row * G_LD + 64 + h]; }
#pragma unroll
                for (int d = 1; d < 64; d <<= 1) { const float n = __shfl_up(cs, d); if (lane >= d) cs += n; }
                f32x4 tv; tv[0] = rsqrtf(ssq[lane * 2] + 1e-6f) * 0.08838834764831845f; tv[1] = rsqrtf(ssq[lane * 2 + 1] + 1e-6f); tv[2] = beta; tv[3] = cs;
                ((LAS f32x4*)(lds + GL_TOK))[lane] = tv; if (lane == 63) *(LAS float*)(lds + GL_LAST) = cs;
            }
        }
        BAR_LDS();
        {
            const int tid = opaque_tid(), w = tid >> 6, lane = tid & 63, r = lane & 15, q = lane >> 4;
#pragma unroll 1
            for (int job = w; job < 20; job += 8) {
                const int tj = job < 10 ? job : job - 10; const bool isQK = job >= 10;
                const int ti = tj >= 6 ? 3 : (tj >= 3 ? 2 : (tj >= 1 ? 1 : 0)), si = tj - (ti * (ti + 1)) / 2;
                const LAS bf16_t* Ab = (const LAS bf16_t*)(lds + (isQK ? GL_QA : GL_KA)) + (ti * 16 + r) * 136 + 8 * q; const LAS bf16_t* Bb = (const LAS bf16_t*)(lds + GL_KA) + (si * 16 + r) * 136 + 8 * q;
                f32x4 acc = (f32x4){0.f, 0.f, 0.f, 0.f};
#pragma unroll
                for (int kk = 0; kk < 4; ++kk) acc = MFMA16(*(const LAS bf16x8*)(Ab + kk * 32), *(const LAS bf16x8*)(Bb + kk * 32), acc);
                const int s = si * 16 + r; const f32x4 ts = ((const LAS f32x4*)(lds + GL_TOK))[s];
                const LAS f32x4* tq = (const LAS f32x4*)(lds + GL_TOK) + ti * 16 + 4 * q;
                float val[4];
#pragma unroll
                for (int reg = 0; reg < 4; ++reg) { const int t = ti * 16 + 4 * q + reg; const f32x4 tt = tq[reg]; const float dec = __expf(tt[3] - ts[3]);
                    val[reg] = isQK ? (s <= t ? acc[reg] * tt[0] * ts[1] * dec : 0.f) : (s < t ? -(acc[reg] * tt[1] * ts[1] * tt[2] * dec) : 0.f); }
                LAS bf16_t* dst = (LAS bf16_t*)(lds + (isQK ? GL_QK : GL_AB)) + (ti * 16 + 4 * q) * 72 + s;
                const bool diagKK = (!isQK) && (ti == si);
#pragma unroll
                for (int reg = 0; reg < 4; ++reg) dst[reg * 72] = diagKK ? (bf16_t)0 : (bf16_t)(pk_bf16(val[reg], 0.f) & 0xffffu);
                if (diagKK) *(LAS f32x4*)((LAS float*)(lds + GL_ADT) + (ti * 16 + r) * 16 + 4 * q) = (f32x4){val[0], val[1], val[2], val[3]};
            }
        }
        BAR_LDS();
        {
            const int tid = opaque_tid(), w = tid >> 6, lane = tid & 63, r = lane & 15, q = lane >> 4;
            if (w < 4) {
                const LAS float* A = (const LAS float*)(lds + GL_ADT) + w * 256;
                float tr[16];
#pragma unroll
                for (int j = 15; j >= 0; --j) { float v = (j == r) ? 1.f : 0.f;
#pragma unroll
                    for (int k = j + 1; k < 16; ++k) v += tr[k] * A[j * 16 + k];
                    tr[j] = v; }
                const float s0 = q == 0 ? tr[0] : (q == 1 ? tr[4] : (q == 2 ? tr[8] : tr[12])), s1 = q == 0 ? tr[1] : (q == 1 ? tr[5] : (q == 2 ? tr[9] : tr[13]));
                const float s2 = q == 0 ? tr[2] : (q == 1 ? tr[6] : (q == 2 ? tr[10] : tr[14])), s3 = q == 0 ? tr[3] : (q == 1 ? tr[7] : (q == 2 ? tr[11] : tr[15]));
                u32x2 tv; tv[0] = pk_bf16(s0, s1); tv[1] = pk_bf16(s2, s3); ((LAS u32x2*)(lds + GL_TF))[w * 64 + lane] = tv;
            }
        }
        BAR_LDS();
        f32x4 U[4];
        {
            const int tid = opaque_tid(), w = tid >> 6, lane = tid & 63, r = lane & 15, q = lane >> 4, E = w * 16 + r;
            const LAS f32x4* tq = (const LAS f32x4*)(lds + GL_TOK) + 4 * q;
            const LAS bf16_t* RvE = (const LAS bf16_t*)(lds + GL_RAW) + ((4 * q) * 3 + 2) * 128 + E; const LAS bf16_t* KaE = (const LAS bf16_t*)(lds + GL_KA) + (4 * q) * 136 + E;
            const LAS bf16_t* AbR = (const LAS bf16_t*)(lds + GL_AB) + r * 72 + 4 * q;
            const LAS u32x2* TfL = (const LAS u32x2*)(lds + GL_TF) + lane;
            LAS bf16_t* WlE = (LAS bf16_t*)(lds + GL_WL) + (4 * q) * 136 + E;
            const LAS float* wv = (const LAS float*)(lds + GL_WTS) + 256 + E;
            const float w0 = wv[0], w1 = wv[384], w2 = wv[768], w3 = wv[1152];
            u32x4 XU[2], XW[2];
            XU[0] = XU[1] = XW[0] = XW[1] = (u32x4){0u, 0u, 0u, 0u};
#pragma unroll
            for (int i = 0; i < 4; ++i) {
                f32x4 au, aw; float xr[7];
#pragma unroll
                for (int k = 0; k < 7; ++k) xr[k] = bf2f(RvE[(16 * i + k) * 384]);
#pragma unroll
                for (int reg = 0; reg < 4; ++reg) { const f32x4 tt = tq[16 * i + reg];
                    au[reg] = silu_f(w0 * xr[reg] + w1 * xr[reg + 1] + w2 * xr[reg + 2] + w3 * xr[reg + 3]) * tt[2]; aw[reg] = bf2f(KaE[(16 * i + reg) * 136]) * (tt[1] * tt[2] * __expf(tt[3])); }
                if (i >= 1) { const bf16x8 a = LDP(AbR, 16 * i * 72); au = MFMA16(a, __builtin_bit_cast(bf16x8, XU[0]), au); aw = MFMA16(a, __builtin_bit_cast(bf16x8, XW[0]), aw); }
                if (i == 3) { const bf16x8 a = LDP(AbR, 48 * 72 + 32); au = MFMA16(a, __builtin_bit_cast(bf16x8, XU[1]), au); aw = MFMA16(a, __builtin_bit_cast(bf16x8, XW[1]), aw); }
                const u32x2 tf = TfL[i * 64]; const u32x4 ta = (u32x4){tf[0], tf[1], 0u, 0u};
                const u32x4 yu = (u32x4){pk_bf16(au[0], au[1]), pk_bf16(au[2], au[3]), 0u, 0u}, yw = (u32x4){pk_bf16(aw[0], aw[1]), pk_bf16(aw[2], aw[3]), 0u, 0u};
                const f32x4 z4 = (f32x4){0.f, 0.f, 0.f, 0.f};
                const f32x4 xu = MFMA16(__builtin_bit_cast(bf16x8, ta), __builtin_bit_cast(bf16x8, yu), z4), xw = MFMA16(__builtin_bit_cast(bf16x8, ta), __builtin_bit_cast(bf16x8, yw), z4);
                U[i] = xu;
                XU[i >> 1][2 * (i & 1)] = pk_bf16(xu[0], xu[1]); XU[i >> 1][2 * (i & 1) + 1] = pk_bf16(xu[2], xu[3]);
                XW[i >> 1][2 * (i & 1)] = pk_bf16(xw[0], xw[1]); XW[i >> 1][2 * (i & 1) + 1] = pk_bf16(xw[2], xw[3]);
#pragma unroll
                for (int reg = 0; reg < 4; ++reg) WlE[(16 * i + reg) * 136] = (bf16_t)(pk_bf16(-xw[reg], 0.f) & 0xffffu);
            }
        }
        BAR_LDS();
        u32x4 zreg[2];
        {
            const int tid = opaque_tid(), lane = tid & 63, w = __builtin_amdgcn_readfirstlane(tid >> 6);
#pragma unroll
            for (int it = 0; it < 2; ++it) { const int idx = tid + it * 512; zreg[it] = *(const u32x4*)(P + (rowbase + t0 + (idx >> 4)) * P_LD + C_ZG + h * 128 + (idx & 15) * 8); }
            if (c < 31) dma_raw(lds + GL_RAW, P, zsrc, rowbase, t0 + 64, c0, c1, c2, w, lane);
        }
        {
            const int tid = opaque_tid(), w = tid >> 6, lane = tid & 63, r = lane & 15, q = lane >> 4, E = w * 16 + r;
            const LAS f32x4* tq = (const LAS f32x4*)(lds + GL_TOK) + 4 * q;
            const LAS bf16_t* WlR = (const LAS bf16_t*)(lds + GL_WL) + r * 136 + 4 * q; const LAS bf16_t* QaR = (const LAS bf16_t*)(lds + GL_QA) + r * 136 + 4 * q;
            const LAS bf16_t* QkR = (const LAS bf16_t*)(lds + GL_QK) + r * 72 + 4 * q; const LAS bf16_t* KtR = (const LAS bf16_t*)(lds + GL_KAT) + r * 72 + 4 * q;
            LAS bf16_t* obE = (LAS bf16_t*)(lds + GL_OB) + (4 * q) * 136 + E;
            bf16x8 Sb[4];
#pragma unroll
            for (int kp = 0; kp < 4; ++kp) Sb[kp] = pack2(Sacc[2 * kp], Sacc[2 * kp + 1]);
            const float last = *(const LAS float*)(lds + GL_LAST);
            f32x4 vn[4], oo[4], vs[4];
#pragma unroll
            for (int i = 0; i < 4; ++i) { f32x4 acc = U[i];
#pragma unroll
                for (int kp = 0; kp < 4; ++kp) acc = MFMA16(LDP(WlR, 16 * i * 136 + 32 * kp), Sb[kp], acc);
                vn[i] = acc; }
#pragma unroll
            for (int i = 0; i < 4; ++i) { f32x4 acc = (f32x4){0.f, 0.f, 0.f, 0.f};
#pragma unroll
                for (int kp = 0; kp < 4; ++kp) acc = MFMA16(LDP(QaR, 16 * i * 136 + 32 * kp), Sb[kp], acc);
#pragma unroll
                for (int reg = 0; reg < 4; ++reg) { const f32x4 tt = tq[16 * i + reg]; acc[reg] *= tt[0] * __expf(tt[3]); vs[i][reg] = vn[i][reg] * (tt[1] * __expf(last - tt[3])); }
                oo[i] = acc; }
            bf16x8 Vn[2], Vs[2];
            Vn[0] = pack2(vn[0], vn[1]); Vn[1] = pack2(vn[2], vn[3]); Vs[0] = pack2(vs[0], vs[1]); Vs[1] = pack2(vs[2], vs[3]);
#pragma unroll
            for (int i = 0; i < 4; ++i) {
                oo[i] = MFMA16(LDP(QkR, 16 * i * 72), Vn[0], oo[i]);
                if (i >= 2) oo[i] = MFMA16(LDP(QkR, 16 * i * 72 + 32), Vn[1], oo[i]);
            }
            const float el = __expf(last);
#pragma unroll
            for (int j = 0; j < 8; ++j) { f32x4 acc = Sacc[j] * el;
                acc = MFMA16(LDP(KtR, 16 * j * 72), Vs[0], acc); acc = MFMA16(LDP(KtR, 16 * j * 72 + 32), Vs[1], acc);
                Sacc[j] = acc; }
#pragma unroll
            for (int i = 0; i < 4; ++i)
#pragma unroll
                for (int reg = 0; reg < 4; ++reg) obE[(16 * i + reg) * 136] = (bf16_t)(pk_bf16(oo[i][reg], 0.f) & 0xffffu);
        }
        BAR_LDS();
        {
            const int tid = opaque_tid();
#pragma unroll
            for (int it = 0; it < 2; ++it) { const int idx = tid + it * 512, t = idx >> 4, e8 = (idx & 15) * 8;
                const u32x4 ov = *(const LAS u32x4*)(lds + GL_OB + (t * 136 + e8) * 2);
                float o[8];
#pragma unroll
                for (int k = 0; k < 4; ++k) { o[2 * k] = blo(ov[k]); o[2 * k + 1] = bhi(ov[k]); }
                float ss = 0.f;
#pragma unroll
                for (int k = 0; k < 8; ++k) ss += o[k] * o[k];
                ss += __shfl_xor(ss, 1); ss += __shfl_xor(ss, 2); ss += __shfl_xor(ss, 4); ss += __shfl_xor(ss, 8);
                const float rs = rsqrtf(ss * (1.f / 128.f) + 1e-6f);
                const f32x4 n0 = *(const f32x4*)(p.gdn_norm_w + e8), n1 = *(const f32x4*)(p.gdn_norm_w + e8 + 4);
                u32x4 res;
#pragma unroll
                for (int k = 0; k < 4; ++k) { const float za = blo(zreg[it][k]), zb = bhi(zreg[it][k]); const float na = k < 2 ? n0[2 * k] : n1[2 * k - 4], nb = k < 2 ? n0[2 * k + 1] : n1[2 * k - 3];
                    res[k] = pk_bf16(o[2 * k] * rs * na * silu_f(za), o[2 * k + 1] * rs * nb * silu_f(zb)); }
                *(u32x4*)(MIX + (rowbase + t0 + t) * MIXW + 4096 + h * 128 + e8) = res; }
        }
    }
    {
        const int tid = opaque_tid(), w = tid >> 6, lane = tid & 63, r = lane & 15, q = lane >> 4, E = w * 16 + r;
        float* So = p.out + O_GDN_P + (size_t)(b * 32 + h) * 16384 + (4 * q) * 128 + E;
#pragma unroll
        for (int j = 0; j < 8; ++j)
#pragma unroll
            for (int reg = 0; reg < 4; ++reg) So[(16 * j + reg) * 128] = Sacc[j][reg];
    }
}

constexpr int SL_RAW = 0, SL_CA = 52224, SL_BA = 69632, SL_BAT = 87040, SL_XST = 105472, SL_CB = 123904, SL_TOK = 133120, SL_LAST = 135168, SL_YB = 135232, SL_WTS = 152640, SL_BIAS = 158784;
__device__ __forceinline__ void ssd_chunk_item(const Params& p, LAS unsigned char* lds, const int b, const int g, const int hp) {
    const bf16_t* P = (const bf16_t*)(p.ws + OFF_P); const float* G = (const float*)(p.ws + OFF_G32); float* Uo = (float*)(p.ws + OFF_U32);
    const bf16_t* zsrc = (const bf16_t*)(p.ws + OFF_XB) + (size_t)NTOK * DM;
    const int h0 = g * 8 + hp * 2;
    const size_t rowbase = (size_t)b * 2048;
    const int c0 = C_XBC + h0 * 64, c1 = C_XBC + 4096 + g * 128, c2 = C_XBC + 5120 + g * 128;
    f32x4 Hacc[8];
#pragma unroll
    for (int j = 0; j < 8; ++j) Hacc[j] = (f32x4){0.f, 0.f, 0.f, 0.f};
    float g_dtraw = 0.f, g_A = 0.f, g_dtb = 0.f;
    {
        const int tid = opaque_tid(), lane = tid & 63, w = __builtin_amdgcn_readfirstlane(tid >> 6);
        for (int i = tid; i < 1536 + 384; i += 512) {
            const int j = i / 384, cc = i - j * 384, sec = cc >> 7, col = cc & 127, ch = sec == 0 ? h0 * 64 + col : (sec == 1 ? 4096 + g * 128 + col : 5120 + g * 128 + col);
            if (j < 4) ((LAS float*)(lds + SL_WTS))[i] = p.ssd_conv_w[j * 6144 + ch]; else ((LAS float*)(lds + SL_BIAS))[cc] = p.ssd_conv_b[ch]; }
        dma_raw(lds + SL_RAW, P, zsrc, rowbase, 0, c0, c1, c2, w, lane);
        if (w < 2) { const int hh = h0 + w; g_dtraw = G[(rowbase + lane) * G_LD + hh]; g_A = -expf(p.ssd_a_log[hh]); g_dtb = p.ssd_dt_bias[hh]; }
    }
#pragma unroll 1
    for (int c = 0; c < 32; ++c) {
        const int t0 = c * 64;
        WAIT_VM0(); BAR_LDS();
        {
            const int tid = opaque_tid(), lane = tid & 63, w = tid >> 6;
            const LAS unsigned char* rawl = lds + SL_RAW + (8 * w) * 768 + lane * 4; const LAS float* wts = (const LAS float*)(lds + SL_WTS) + 2 * lane; const LAS float* bia = (const LAS float*)(lds + SL_BIAS) + 2 * lane;
#pragma unroll
            for (int sec = 0; sec < 3; ++sec) {
                f32x2v wj[4];
#pragma unroll
                for (int j = 0; j < 4; ++j) wj[j] = *(const LAS f32x2v*)(wts + j * 384 + sec * 128);
                const f32x2v bj = *(const LAS f32x2v*)(bia + sec * 128);
                float x0[11], x1[11];
#pragma unroll
                for (int rr = 0; rr < 11; ++rr) { const unsigned u = *(const LAS unsigned*)(rawl + rr * 768 + sec * 256); x0[rr] = blo(u); x1[rr] = bhi(u); }
                unsigned pk[8];
#pragma unroll
                for (int t = 0; t < 8; ++t) {
                    const float a0 = silu_f(bj[0] + wj[0][0] * x0[t] + wj[1][0] * x0[t + 1] + wj[2][0] * x0[t + 2] + wj[3][0] * x0[t + 3]);
                    const float a1 = silu_f(bj[1] + wj[0][1] * x1[t] + wj[1][1] * x1[t + 1] + wj[2][1] * x1[t + 2] + wj[3][1] * x1[t + 3]);
                    pk[t] = pk_bf16(a0, a1);
                    if (sec >= 1) *(LAS unsigned*)(lds + (sec == 1 ? SL_BA : SL_CA) + ((8 * w + t) * 136 + 2 * lane) * 2) = pk[t];
                }
                if (sec <= 1) {
                    u32x4 ke, ko;
#pragma unroll
                    for (int t2 = 0; t2 < 4; ++t2) { ke[t2] = (pk[2 * t2] & 0xffffu) | (pk[2 * t2 + 1] << 16); ko[t2] = (pk[2 * t2] >> 16) | (pk[2 * t2 + 1] & 0xffff0000u); }
                    *(LAS u32x4*)(lds + (sec == 0 ? SL_XST : SL_BAT) + ((2 * lane) * 72 + 8 * w) * 2) = ke; *(LAS u32x4*)(lds + (sec == 0 ? SL_XST : SL_BAT) + ((2 * lane + 1) * 72 + 8 * w) * 2) = ko;
                }
            }
            if (c == 31 && w == 7) {
                float* convout = p.out + O_SSDC_P + (size_t)b * 3 * 6144 + 2 * lane;
#pragma unroll
                for (int j = 0; j < 3; ++j)
#pragma unroll
                    for (int sec = 0; sec < 3; ++sec) { if (sec == 0 || hp == 0) { const unsigned u = *(const LAS unsigned*)(lds + SL_RAW + ((64 + j) * 3 + sec) * 256 + lane * 4);
                        *(f32x2v*)(convout + j * 6144 + (sec == 0 ? h0 * 64 : (sec == 1 ? 4096 + g * 128 : 5120 + g * 128))) = (f32x2v){blo(u), bhi(u)}; } }
            }
        }
        BAR_LDS();
        {
            const int tid = opaque_tid(), lane = tid & 63, r = lane & 15, q = lane >> 4, w = __builtin_amdgcn_readfirstlane(tid >> 6);
            if (c < 31) dma_raw(lds + SL_RAW, P, zsrc, rowbase, t0 + 64, c0, c1, c2, w, lane);
            if (w < 2) {
                const float dt = softplus_f(g_dtraw + g_dtb);
                if (c < 31) g_dtraw = G[(rowbase + t0 + 64 + lane) * G_LD + h0 + w];
                float cs = g_A * dt;
#pragma unroll
                for (int d = 1; d < 64; d <<= 1) { const float n = __shfl_up(cs, d); if (lane >= d) cs += n; }
                ((LAS f32x2v*)(lds + SL_TOK))[w * 64 + lane] = (f32x2v){dt, cs}; if (lane == 63) ((LAS float*)(lds + SL_LAST))[w] = cs;
            } else {
#pragma unroll 1
                for (int job = w - 2; job < 10; job += 6) {
                    const int ti = job >= 6 ? 3 : (job >= 3 ? 2 : (job >= 1 ? 1 : 0)), si = job - (ti * (ti + 1)) / 2;
                    const LAS bf16_t* Ab = (const LAS bf16_t*)(lds + SL_CA) + (ti * 16 + r) * 136 + 8 * q; const LAS bf16_t* Bb = (const LAS bf16_t*)(lds + SL_BA) + (si * 16 + r) * 136 + 8 * q;
                    f32x4 acc = (f32x4){0.f, 0.f, 0.f, 0.f};
#pragma unroll
                    for (int kk = 0; kk < 4; ++kk) acc = MFMA16(*(const LAS bf16x8*)(Ab + kk * 32), *(const LAS bf16x8*)(Bb + kk * 32), acc);
                    LAS bf16_t* dst = (LAS bf16_t*)(lds + SL_CB) + (ti * 16 + 4 * q) * 72 + si * 16 + r;
#pragma unroll
                    for (int reg = 0; reg < 4; ++reg) dst[reg * 72] = (bf16_t)(pk_bf16(acc[reg], 0.f) & 0xffffu);
                }
            }
        }
        BAR_LDS();
        u32x4 zreg[2];
        {
            const int tid = opaque_tid();
#pragma unroll
            for (int it = 0; it < 2; ++it) { const int idx = tid + it * 512; zreg[it] = *(const u32x4*)(P + (rowbase + t0 + (idx >> 4)) * P_LD + C_ZS + h0 * 64 + (idx & 15) * 8); }
        }
        {
            const int tid = opaque_tid(), w = tid >> 6, lane = tid & 63, r = lane & 15, q = lane >> 4, hl = w >> 2, Pc = (w & 3) * 16 + r;
            const float Dh = p.ssd_d[h0 + hl];
            const LAS f32x2v* tk = (const LAS f32x2v*)(lds + SL_TOK) + hl * 64; const float last = ((const LAS float*)(lds + SL_LAST))[hl];
            const LAS bf16_t* XsP = (const LAS bf16_t*)(lds + SL_XST) + (hl * 64 + Pc) * 72;
            const LAS bf16_t* CaR = (const LAS bf16_t*)(lds + SL_CA) + r * 136 + 4 * q; const LAS bf16_t* CbR = (const LAS bf16_t*)(lds + SL_CB) + r * 72 + 8 * q;
            const LAS bf16_t* BtR = (const LAS bf16_t*)(lds + SL_BAT) + r * 72 + 8 * q;
            LAS bf16_t* ybE = (LAS bf16_t*)(lds + SL_YB) + (4 * q) * 136 + hl * 64 + Pc;
            bf16x8 Hb[4];
#pragma unroll
            for (int kp = 0; kp < 4; ++kp) Hb[kp] = pack2(Hacc[2 * kp], Hacc[2 * kp + 1]);
            bf16x8 xf[2], xw[2];
#pragma unroll
            for (int kp = 0; kp < 2; ++kp) { const u32x4 xv = *(const LAS u32x4*)(XsP + 32 * kp + 8 * q); xf[kp] = __builtin_bit_cast(bf16x8, xv);
                u32x4 xs;
#pragma unroll
                for (int e2 = 0; e2 < 4; ++e2) { const f32x2v ta = tk[32 * kp + 8 * q + 2 * e2], tb = tk[32 * kp + 8 * q + 2 * e2 + 1];
                    xs[e2] = pk_bf16(blo(xv[e2]) * (ta[0] * __expf(last - ta[1])), bhi(xv[e2]) * (tb[0] * __expf(last - tb[1]))); }
                xw[kp] = __builtin_bit_cast(bf16x8, xs); }
#pragma unroll
            for (int i = 0; i < 4; ++i) {
                f32x4 acc = (f32x4){0.f, 0.f, 0.f, 0.f};
#pragma unroll
                for (int kp = 0; kp < 4; ++kp) acc = MFMA16(LDP(CaR, 16 * i * 136 + 32 * kp), Hb[kp], acc);
#pragma unroll
                for (int reg = 0; reg < 4; ++reg) acc[reg] *= __expf(tk[16 * i + 4 * q + reg][1]);
                const int t = 16 * i + r; const float cum_t = tk[t][1];
#pragma unroll
                for (int kp = 0; kp < 2; ++kp) { if (kp <= (i >> 1)) {
                    const u32x4 cbv = *(const LAS u32x4*)(CbR + 16 * i * 72 + 32 * kp);
                    float lv[8];
#pragma unroll
                    for (int jj = 0; jj < 8; ++jj) { const int s = 32 * kp + 8 * q + jj; const f32x2v ts = tk[s]; const float cb = (jj & 1) ? bhi(cbv[jj >> 1]) : blo(cbv[jj >> 1]);
                        lv[jj] = s <= t ? cb * __expf(cum_t - ts[1]) * ts[0] : 0.f; }
                    const u32x4 lw = (u32x4){pk_bf16(lv[0], lv[1]), pk_bf16(lv[2], lv[3]), pk_bf16(lv[4], lv[5]), pk_bf16(lv[6], lv[7])};
                    acc = MFMA16(__builtin_bit_cast(bf16x8, lw), xf[kp], acc); } }
                const u32x2 xd = *(const LAS u32x2*)(XsP + 16 * i + 4 * q);
                acc[0] += blo(xd[0]) * Dh; acc[1] += bhi(xd[0]) * Dh; acc[2] += blo(xd[1]) * Dh; acc[3] += bhi(xd[1]) * Dh;
#pragma unroll
                for (int reg = 0; reg < 4; ++reg) ybE[(16 * i + reg) * 136] = (bf16_t)(pk_bf16(acc[reg], 0.f) & 0xffffu);
            }
            const float el = __expf(last);
#pragma unroll
            for (int j = 0; j < 8; ++j) { f32x4 acc = Hacc[j] * el;
                acc = MFMA16(*(const LAS bf16x8*)(BtR + 16 * j * 72), xw[0], acc); acc = MFMA16(*(const LAS bf16x8*)(BtR + 16 * j * 72 + 32), xw[1], acc);
                Hacc[j] = acc; }
        }
        BAR_LDS();
        {
            const int tid = opaque_tid();
#pragma unroll
            for (int it = 0; it < 2; ++it) { const int idx = tid + it * 512, t = idx >> 4, e8 = (idx & 15) * 8;
                const u32x4 yv = *(const LAS u32x4*)(lds + SL_YB + (t * 136 + e8) * 2);
                f32x4 o0, o1;
                o0[0] = blo(yv[0]) * silu_f(blo(zreg[it][0])); o0[1] = bhi(yv[0]) * silu_f(bhi(zreg[it][0])); o0[2] = blo(yv[1]) * silu_f(blo(zreg[it][1])); o0[3] = bhi(yv[1]) * silu_f(bhi(zreg[it][1]));
                o1[0] = blo(yv[2]) * silu_f(blo(zreg[it][2])); o1[1] = bhi(yv[2]) * silu_f(bhi(zreg[it][2])); o1[2] = blo(yv[3]) * silu_f(blo(zreg[it][3])); o1[3] = bhi(yv[3]) * silu_f(bhi(zreg[it][3]));
                float* up = Uo + (rowbase + t0 + t) * DM + h0 * 64 + e8; *(f32x4*)up = o0; *(f32x4*)(up + 4) = o1; }
        }
    }
    {
        const int tid = opaque_tid(), w = tid >> 6, lane = tid & 63, r = lane & 15, q = lane >> 4, hl = w >> 2, Pc = (w & 3) * 16 + r;
        float* Ho = p.out + O_SSD_P + ((size_t)(b * 64 + h0 + hl) * 64 + Pc) * 128 + 4 * q;
#pragma unroll
        for (int j = 0; j < 8; ++j) *(f32x4*)(Ho + 16 * j) = Hacc[j];
    }
}

__device__ __forceinline__ void phase_scan(const Params& p, LAS unsigned char* lds, const int qword = QCTR_WORD, const int item0 = 0) {
    LAS int* qslot = (LAS int*)(lds + LDS_MISC + 16);
    unsigned* qctr = (unsigned*)(p.ws + OFF_BAR) + qword;
    for (;;) {
        __syncthreads();
        if (threadIdx.x == 0) *qslot = item0 + (int)__hip_atomic_fetch_add(qctr, 1u, __ATOMIC_RELAXED, __HIP_MEMORY_SCOPE_AGENT);
        __syncthreads();
        const int item = __builtin_amdgcn_readfirstlane(*qslot);
        if (item >= N_ITEMS) break;
        if (item < N_GDN_P) gdn_chunk_item(p, lds, item >> 5, item & 31);
        else if (item < N_GDN_P + N_SSD_P) { const int i = item - N_GDN_P; ssd_chunk_item(p, lds, i >> 5, (i >> 2) & 7, i & 3); }
        else if (item < N_GDN_P + N_SSD_P + N_GDN_S) { const int i = item - N_GDN_P - N_SSD_P; gdn_item<true>(p, lds, i >> 5, i & 31); }
        else { const int i = item - N_GDN_P - N_SSD_P - N_GDN_S; ssd_item<true>(p, lds, i >> 6, i & 63); }
    }
}

__device__ __forceinline__ void phase_ssdnorm(const Params& p) {
    const float* U = (const float*)(p.ws + OFF_U32); bf16_t* MIX = (bf16_t*)(p.ws + OFF_MIX);
    const int lane = threadIdx.x & 63, gw = blockIdx.x * 8 + (threadIdx.x >> 6), nw = gridDim.x * 8;
    for (int it = gw; it < NTOK * 8; it += nw) {
        const int row = it >> 3, g = it & 7; const size_t off = (size_t)row * DM + g * 512 + lane * 8;
        const f32x4 a = *(const f32x4*)(U + off), b = *(const f32x4*)(U + off + 4);
        const float ss = wave_sum(a[0] * a[0] + a[1] * a[1] + a[2] * a[2] + a[3] * a[3] + b[0] * b[0] + b[1] * b[1] + b[2] * b[2] + b[3] * b[3]);
        const float rs = rsqrtf(ss * (1.f / 512.f) + 1e-6f);
        const f32x4 wa = *(const f32x4*)(p.ssd_norm_w + g * 512 + lane * 8), wb = *(const f32x4*)(p.ssd_norm_w + g * 512 + lane * 8 + 4);
        u32x4 o; o[0] = cvt_pk_bf16(a[0] * rs * wa[0], a[1] * rs * wa[1]); o[1] = cvt_pk_bf16(a[2] * rs * wa[2], a[3] * rs * wa[3]);
        o[2] = cvt_pk_bf16(b[0] * rs * wb[0], b[1] * rs * wb[1]); o[3] = cvt_pk_bf16(b[2] * rs * wb[2], b[3] * rs * wb[3]);
        *(u32x4*)(MIX + (size_t)row * MIXW + g * 512 + lane * 8) = o;
    }
}

__device__ __forceinline__ void phase_ln(const Params& p) {
    const float* R = (const float*)(p.ws + OFF_R);
    const int lane = threadIdx.x & 63, gw = blockIdx.x * 8 + (threadIdx.x >> 6), nw = gridDim.x * 8;
    for (int row = gw; row < NTOK; row += nw) {
        const float* rr = R + (size_t)row * DM;
        f32x4 v[16]; float sum = 0.f;
#pragma unroll
        for (int i = 0; i < 16; ++i) { v[i] = *(const f32x4*)(rr + (i * 64 + lane) * 4); sum += v[i][0] + v[i][1] + v[i][2] + v[i][3]; }
        const float mu = wave_sum(sum) * (1.f / 4096.f);
        float sq = 0.f;
#pragma unroll
        for (int i = 0; i < 16; ++i) { v[i] = v[i] - mu; sq += v[i][0] * v[i][0] + v[i][1] * v[i][1] + v[i][2] * v[i][2] + v[i][3] * v[i][3]; }
        const float rs = rsqrtf(wave_sum(sq) * (1.f / 4096.f) + 1e-5f);
        float* o = p.out + (row < NTP ? O_YP + (size_t)row * DM : O_YS + (size_t)(row - NTP) * DM);
#pragma unroll
        for (int i = 0; i < 16; ++i) { const int c = (i * 64 + lane) * 4; const f32x4 gg = *(const f32x4*)(p.ln_g + c), bb = *(const f32x4*)(p.ln_b + c);
            *(f32x4*)(o + c) = v[i] * rs * gg + bb; }
    }
}

template <int PH>
__global__ __launch_bounds__(512, 2) void mk_fwd(Params p) {
    extern __shared__ __attribute__((aligned(16))) unsigned char smem[];
    LAS unsigned char* lds = (LAS unsigned char*)smem;
    XcdBarrier bar;
    if (PH < 0) {
        if (threadIdx.x == 0) *(LAS u32x4*)(lds + LDS_MISC) = (u32x4){0u, 0u, 0u, 0u};
        __syncthreads();
        bar = xcd_barrier_post((unsigned*)(p.ws + OFF_BAR), (volatile LAS unsigned*)(lds + LDS_MISC));
    }
    if (PH < 0 || PH == 0) { phase_convert(p, lds); if (PROBE_REP == 1) { __syncthreads(); phase_convert(p, lds); } }
    if (PH < 0) xcd_barrier(bar);
    if (PH < 0 || PH == 1) {
        pg8::Gemm g{(const bf16_t*)(p.ws + OFF_XB), (const bf16_t*)(p.ws + OFF_WB), MPAD, NPAD, DM};
        pg8::StaticOrder S; S.init(MPAD, NPAD, (int)gridDim.x, (int)blockIdx.x);
        pg8::EpiProj E{(bf16_t*)(p.ws + OFF_P), (float*)(p.ws + OFF_G32)};
        pg8::gemm_phase<pg8::EpiProj, pg8::StaticOrder, true, true>(lds, g, S, E);
        if (PROBE_REP == 2) { __syncthreads(); pg8::gemm_phase<pg8::EpiProj, pg8::StaticOrder, true, true>(lds, g, S, E); }
    }
    if (PH < 0) xcd_barrier(bar);
    if (PH < 0 || PH == 2) { phase_scan(p, lds); if (PROBE_REP == 3) phase_scan(p, lds, QCTR_WORD + 64, 0); if (PROBE_REP == 4) phase_scan(p, lds, QCTR_WORD + 64, N_GDN_P + N_SSD_P); }
    if (PH < 0) xcd_barrier(bar);
    if (PH < 0 || PH == 3) phase_ssdnorm(p);
    if (PH < 0) xcd_barrier(bar);
    if (PH < 0 || PH == 4) {
        pg8::Gemm g{(const bf16_t*)(p.ws + OFF_MIX), (const bf16_t*)(p.ws + OFF_WOB), MPAD, DM, MIXW};
        pg8::StaticOrder S; S.init(MPAD, DM, (int)gridDim.x, (int)blockIdx.x);
        pg8::EpiOut E{(float*)(p.ws + OFF_R), p.x_prompt, p.x_sample};
        pg8::gemm_phase<pg8::EpiOut, pg8::StaticOrder, true, true>(lds, g, S, E);
        if (PROBE_REP == 5) { __syncthreads(); pg8::gemm_phase<pg8::EpiOut, pg8::StaticOrder, true, true>(lds, g, S, E); }
    }
    if (PH < 0) xcd_barrier(bar);
    if (PH < 0 || PH == 5) phase_ln(p);
}

template <int PH> static void launch_phase(const Params& p, int grid, hipStream_t stream) {
    static bool attr = false;
    if (!attr) { (void)hipFuncSetAttribute((const void*)mk_fwd<PH>, hipFuncAttributeMaxDynamicSharedMemorySize, LDS_BYTES); attr = true; }
    hipLaunchKernelGGL((mk_fwd<PH>), dim3(grid), dim3(512), LDS_BYTES, stream, p);
}

extern "C" void kernel_launch(void* const* d_in, const int* in_sizes, int n_in, void* d_out, int out_size, void* d_ws, size_t ws_size, hipStream_t stream) {
    (void)in_sizes; (void)n_in; (void)out_size;
    if (ws_size < WS_END) { fprintf(stderr, "workspace too small: %zu < %zu\n", ws_size, (size_t)WS_END); return; }
    Params p{};
    p.x_prompt = (const float*)d_in[0]; p.x_sample = (const float*)d_in[1]; p.state_ssd = (const float*)d_in[2]; p.state_ssd_conv = (const float*)d_in[3];
    p.state_gdn = (const float*)d_in[4]; p.state_gdn_conv = (const float*)d_in[5]; p.w_in = (const float*)d_in[6]; p.ssd_conv_w = (const float*)d_in[7];
    p.ssd_conv_b = (const float*)d_in[8]; p.ssd_dt_bias = (const float*)d_in[9]; p.ssd_a_log = (const float*)d_in[10]; p.ssd_d = (const float*)d_in[11];
    p.ssd_norm_w = (const float*)d_in[12]; p.gdn_conv_w = (const float*)d_in[13]; p.gdn_dt_bias = (const float*)d_in[14]; p.gdn_a_log = (const float*)d_in[15];
    p.gdn_norm_w = (const float*)d_in[16]; p.w_out = (const float*)d_in[17]; p.ln_g = (const float*)d_in[18]; p.ln_b = (const float*)d_in[19];
    p.out = (float*)d_out; p.ws = (unsigned char*)d_ws;
    static int grid = 0;
    if (!grid) { int dev = 0, cus = 0; (void)hipGetDevice(&dev); (void)hipDeviceGetAttribute(&cus, hipDeviceAttributeMultiprocessorCount, dev); grid = cus > 0 ? cus : 256; }
    (void)hipMemsetAsync(d_ws, 0, 16384, stream);
#if MK_FUSED
    launch_phase<-1>(p, grid, stream);
#else
    launch_phase<0>(p, grid, stream); launch_phase<1>(p, grid, stream); launch_phase<2>(p, grid, stream);
    launch_phase<3>(p, grid, stream); launch_phase<4>(p, grid, stream); launch_phase<5>(p, grid, stream);
#endif
}
```

```cpp
#include <hip/hip_runtime.h>
#include <cstdio>
#include <cstdint>

#ifndef PROBE_REP
#define PROBE_REP 0
#endif
#ifndef MK_FUSED
#define MK_FUSED 1
#endif

#define LAS __attribute__((address_space(3)))
typedef unsigned short bf16_t;
typedef short bf16x8 __attribute__((ext_vector_type(8)));
typedef float f32x4 __attribute__((ext_vector_type(4)));
typedef float f32x2v __attribute__((ext_vector_type(2)));
typedef unsigned u32x4 __attribute__((ext_vector_type(4)));
typedef unsigned u32x2 __attribute__((ext_vector_type(2)));

constexpr int DM = 4096, NTP = 8192, NTS = 128, NTOK = 8320, MPAD = 8448;
constexpr int NPROJ = 26752, P_LD = 26624, NPAD = 26880, MIXW = 8192, G_LD = 256;
constexpr int C_ZS = 0, C_XBC = 4096, C_QKV = 10240, C_ZG = 22528;
constexpr float ALPHA = 1.189207115002721f;
constexpr int LDS_BYTES = 163840;
constexpr int LDS_MISC = LDS_BYTES - 64;

constexpr size_t OFF_BAR = 0;
constexpr size_t OFF_XB  = 16384;
constexpr size_t OFF_WB  = OFF_XB  + (size_t)MPAD * DM * 2;
constexpr size_t OFF_WOB = OFF_WB  + (size_t)NPAD * DM * 2;
constexpr size_t OFF_P   = OFF_WOB + (size_t)DM * MIXW * 2;
constexpr size_t OFF_G32 = OFF_P   + (size_t)MPAD * P_LD * 2;
constexpr size_t OFF_MIX = OFF_G32 + (size_t)MPAD * G_LD * 4;
constexpr size_t OFF_U32 = OFF_MIX + (size_t)MPAD * MIXW * 2;
constexpr size_t OFF_R   = OFF_U32 + (size_t)MPAD * DM * 4;
constexpr size_t OFF_RPART = OFF_R + (size_t)MPAD * DM * 4;
constexpr size_t WS_END  = OFF_RPART + (size_t)16 * NTS * DM * 4;
constexpr int QCTR_WORD = 3584;

constexpr size_t O_YP = 0;
constexpr size_t O_YS = O_YP + (size_t)NTP * DM;
constexpr size_t O_SSD_P = O_YS + (size_t)NTS * DM;
constexpr size_t O_SSDC_P = O_SSD_P + (size_t)4 * 64 * 64 * 128;
constexpr size_t O_GDN_P = O_SSDC_P + (size_t)4 * 3 * 6144;
constexpr size_t O_GDNC_P = O_GDN_P + (size_t)4 * 32 * 128 * 128;
constexpr size_t O_SSD_S = O_GDNC_P + (size_t)4 * 3 * 12288;
constexpr size_t O_SSDC_S = O_SSD_S + (size_t)128 * 64 * 64 * 128;
constexpr size_t O_GDN_S = O_SSDC_S + (size_t)128 * 3 * 6144;
constexpr size_t O_GDNC_S = O_GDN_S + (size_t)128 * 32 * 128 * 128;

struct Params {
    const float* x_prompt; const float* x_sample; const float* state_ssd; const float* state_ssd_conv; const float* state_gdn; const float* state_gdn_conv;
    const float* w_in; const float* ssd_conv_w; const float* ssd_conv_b; const float* ssd_dt_bias; const float* ssd_a_log; const float* ssd_d; const float* ssd_norm_w;
    const float* gdn_conv_w; const float* gdn_dt_bias; const float* gdn_a_log; const float* gdn_norm_w; const float* w_out; const float* ln_g; const float* ln_b;
    float* out; unsigned char* ws;
};

__device__ __forceinline__ unsigned cvt_pk_bf16(float lo, float hi) { unsigned r; asm volatile("v_cvt_pk_bf16_f32 %0, %1, %2" : "=v"(r) : "v"(lo), "v"(hi)); return r; }
__device__ __forceinline__ float bf2f(bf16_t v) { return __uint_as_float(((unsigned)v) << 16); }
__device__ __forceinline__ bf16_t f2bf(float f) { unsigned u = __float_as_uint(f); u += 0x7FFFu + ((u >> 16) & 1u); return (bf16_t)(u >> 16); }
__device__ __forceinline__ float silu_f(float x) { return x / (1.f + __expf(-x)); }
__device__ __forceinline__ float sigmoid_f(float x) { return 1.f / (1.f + __expf(-x)); }
__device__ __forceinline__ float softplus_f(float x) { return x > 20.f ? x : log1pf(expf(x)); }
__device__ __forceinline__ f32x4 ldbf4(const bf16_t* p) { const u32x2 v = *(const u32x2*)p; f32x4 r; r[0] = __uint_as_float(v[0] << 16); r[1] = __uint_as_float(v[0] & 0xffff0000u); r[2] = __uint_as_float(v[1] << 16); r[3] = __uint_as_float(v[1] & 0xffff0000u); return r; }
__device__ __forceinline__ int opaque_tid() { int t = threadIdx.x; asm volatile("" : "+v"(t)); return t; }
__device__ __forceinline__ size_t tiled_off(int row, int col, int K) {
    const int r = row & 127, c = col & 63, st = (r >> 4) * 2 + (c >> 5), ob = (r & 15) * 64 + (c & 31) * 2;
    return ((size_t)(row >> 7) * (K >> 6) + (col >> 6)) * 8192 + ((st * 1024 + (ob ^ (((ob >> 9) & 1) << 5))) >> 1);
}
__device__ __forceinline__ float wave_sum(float v) {
#pragma unroll
    for (int m = 32; m >= 1; m >>= 1) v += __shfl_xor(v, m);
    return v;
}

#define XB_TMO      128
#define XB_XCNT(j)  (256  + 64 * (j))
#define XB_XSUB(j)  (1280 + 64 * (j))
#define XB_XGEN(j)  (2304 + 64 * (j))
#define XB_TOP      3328
#define XB_TOPGEN   3392
#define XCD_BAR_WORDS 3456
#define XB_SPIN_CAP (1u << 18)
__device__ __forceinline__ unsigned xb_ld(unsigned* p)              { return __hip_atomic_load(p, __ATOMIC_RELAXED, __HIP_MEMORY_SCOPE_AGENT); }
__device__ __forceinline__ unsigned xb_add(unsigned* p, unsigned v) { return __hip_atomic_fetch_add(p, v, __ATOMIC_RELAXED, __HIP_MEMORY_SCOPE_AGENT); }
__device__ __forceinline__ unsigned xb_xcc_id() { return (unsigned)__builtin_amdgcn_s_getreg((3 << 11) | 20) & 0xFu; }
#define XB_SPIN(cond, bar) do { unsigned _sp = 0; while (cond) { __builtin_amdgcn_s_sleep(1); \
    if ((++_sp & 255u) == 0u) { if (xb_ld(&(bar)[XB_TMO])) break; if (_sp > XB_SPIN_CAP) { atomicAdd(&(bar)[XB_TMO], 1u); break; } } } } while (0)
struct XcdBarrier { unsigned* bar; unsigned x; volatile LAS unsigned* st; };
__device__ __forceinline__ XcdBarrier xcd_barrier_post(unsigned* bar, volatile LAS unsigned* st) {
    XcdBarrier b; b.bar = bar; b.x = xb_xcc_id(); b.st = st;
    if (threadIdx.x == 0) (void)xb_add(&bar[XB_XCNT(b.x)], 1u);
    return b;
}
__device__ __forceinline__ void xcd_barrier_complete(unsigned* bar, unsigned x, unsigned& nloc, unsigned& nx) {
    const unsigned G = gridDim.x * gridDim.y * gridDim.z;
    unsigned sum, cnt, mine, sp = 0u;
    for (;;) {
        sum = 0u; cnt = 0u; mine = 0u;
#pragma unroll
        for (unsigned j = 0; j < 16; ++j) { const unsigned c = xb_ld(&bar[XB_XCNT(j)]); sum += c; cnt += (c > 0u) ? 1u : 0u; mine = (j == x) ? c : mine; }
        if (sum == G) break;
        __builtin_amdgcn_s_sleep(1);
        if ((++sp & 255u) == 0u) { if (xb_ld(&bar[XB_TMO])) break; if (sp > XB_SPIN_CAP) { atomicAdd(&bar[XB_TMO], 1u); break; } }
    }
    nloc = mine > 0u ? mine : 1u; nx = cnt > 0u ? cnt : 1u;
}
__device__ __forceinline__ void xcd_barrier(const XcdBarrier& b) {
    asm volatile("s_waitcnt vmcnt(0)" ::: "memory");
    __syncthreads();
    if (threadIdx.x == 0) {
        unsigned* bar = b.bar;
        __builtin_amdgcn_s_waitcnt(0);
        unsigned nloc = b.st[0], nx = b.st[1];
        if (nloc == 0u) { xcd_barrier_complete(bar, b.x, nloc, nx); b.st[0] = nloc; b.st[1] = nx; }
        const unsigned old = xb_add(&bar[XB_XSUB(b.x)], 1u);
        const unsigned gen = old / nloc;
        if (old + 1u == (gen + 1u) * nloc) {
            __builtin_amdgcn_fence(__ATOMIC_RELEASE, "agent");
            asm volatile("s_waitcnt vmcnt(0)" ::: "memory");
            const unsigned og = xb_add(&bar[XB_TOP], 1u);
            const unsigned tg = og / nx;
            if (og + 1u == (tg + 1u) * nx) xb_add(&bar[XB_TOPGEN], 1u);
            else XB_SPIN(xb_ld(&bar[XB_TOPGEN]) == tg, bar);
            __builtin_amdgcn_fence(__ATOMIC_ACQUIRE, "agent");
            xb_add(&bar[XB_XGEN(b.x)], 1u);
            asm volatile("s_waitcnt vmcnt(0)" ::: "memory");
        } else {
            XB_SPIN(xb_ld(&bar[XB_XGEN(b.x)]) == gen, bar);
            __builtin_amdgcn_fence(__ATOMIC_ACQUIRE, "agent");
            asm volatile("s_waitcnt vmcnt(0)" ::: "memory");
        }
    }
    __syncthreads();
}

namespace pg8 {
constexpr int BM = 256, BK = 64, HALF = 128, HTB = HALF * BK * 2, STAGE_BYTES = 8 * HTB, NXCD = 8, WGM = 8;
__host__ __device__ __forceinline__ int lds_byte(int r, int c) { const int st = (r >> 4) * 2 + (c >> 5), rr = r & 15, cc = c & 31, ob = rr * 64 + cc * 2; return st * 1024 + (ob ^ (((ob >> 9) & 1) << 5)); }
__host__ __device__ __forceinline__ void stage_rc(int b, int& R, int& C) { const int st = b / 1024, sb = b % 1024, swz = sb ^ (((sb >> 9) & 1) << 5); R = (st >> 1) * 16 + swz / 64; C = (st & 1) * 32 + (swz % 64) / 2; }
__host__ __device__ __forceinline__ int perm32(int rho) { const int n = rho >> 4, i = rho & 15; return 8 * (i >> 2) + 4 * n + (i & 3); }
struct Unit { int pm, pn; };
struct Gemm { const bf16_t* A; const bf16_t* Bt; int M, N, K; };
struct StaticOrder {
    int nM, nN, nwg, G, c; bool swapmn;
    __host__ __device__ void init(int M, int N, int G_, int c_, bool sw = false) { swapmn = sw; nM = (sw ? N : M) / BM; nN = (sw ? M : N) / BM; nwg = nM * nN; G = G_; c = c_; }
    __host__ __device__ bool next(int i, Unit& u) const {
        const long L = (long)i * G + c; if (L >= nwg) return false;
        int wgid = (int)L; { const int q = nwg / NXCD, r = nwg % NXCD, xcd = wgid % NXCD, off = wgid / NXCD; wgid = (xcd < r ? xcd * (q + 1) : r * (q + 1) + (xcd - r) * q) + off; }
        const int nig = WGM * nN, gid = wgid / nig, fm = gid * WGM, gsz = (nM - fm) < WGM ? (nM - fm) : WGM;
        const int a = fm + ((wgid % nig) % gsz), b = (wgid % nig) / gsz;
        u.pm = swapmn ? b : a; u.pn = swapmn ? a : b; return true;
    }
    __device__ __forceinline__ void a_ready(const Unit&) const {}
    __device__ __forceinline__ void done(const Unit&) const {}
};

struct EpiProj {
    static constexpr bool PERM = true, AFTER_DRAIN = false;
    bf16_t* P; float* G;
    __device__ __forceinline__ void operator()(const f32x4 (&acc)[2][2][4][2], const Unit& u, int wr, int wc, int fr, int fq) const {
        const int row0 = u.pm * BM + wr * 64 + fr;
        if (u.pn < 104) {
            const int col0 = u.pn * BM + wc * 32 + 8 * fq;
#pragma unroll
            for (int ai = 0; ai < 2; ++ai)
#pragma unroll
                for (int m = 0; m < 4; ++m) { bf16_t* rowp = P + (size_t)(row0 + ai * HALF + m * 16) * P_LD + col0;
#pragma unroll
                    for (int bj = 0; bj < 2; ++bj) { const f32x4 v0 = acc[ai][bj][m][0], v1 = acc[ai][bj][m][1];
                        u32x4 w; w[0] = cvt_pk_bf16(v0[0], v0[1]); w[1] = cvt_pk_bf16(v0[2], v0[3]); w[2] = cvt_pk_bf16(v1[0], v1[1]); w[3] = cvt_pk_bf16(v1[2], v1[3]);
                        *(u32x4*)(rowp + bj * HALF) = w; } }
        } else {
#pragma unroll
            for (int ai = 0; ai < 2; ++ai)
#pragma unroll
                for (int m = 0; m < 4; ++m) { float* rowp = G + (size_t)(row0 + ai * HALF + m * 16) * G_LD + wc * 32 + 8 * fq;
                    *(f32x4*)(rowp) = acc[ai][0][m][0]; *(f32x4*)(rowp + 4) = acc[ai][0][m][1]; }
        }
    }
};
struct EpiOut {
    static constexpr bool PERM = false, AFTER_DRAIN = false;
    float* R; const float* xp; const float* xs;
    __device__ __forceinline__ void operator()(const f32x4 (&acc)[2][2][4][2], const Unit& u, int wr, int wc, int fr, int fq) const {
        const int row0 = u.pm * BM + wr * 64 + fr, col0 = u.pn * BM + wc * 32 + 4 * fq;
#pragma unroll
        for (int ai = 0; ai < 2; ++ai)
#pragma unroll
            for (int m = 0; m < 4; ++m) { const int r = row0 + ai * HALF + m * 16;
                { const float* xr = xp + (size_t)r * DM; float* rr = R + (size_t)r * DM;
#pragma unroll
                    for (int bj = 0; bj < 2; ++bj)
#pragma unroll
                        for (int n = 0; n < 2; ++n) { const int c = col0 + bj * HALF + n * 16; const f32x4 xv = *(const f32x4*)(xr + c); *(f32x4*)(rr + c) = acc[ai][bj][m][n] + ALPHA * xv; } } }
    }
};

template <class Epi, class Sched, bool ALIGN_EPI = false, bool SP2 = false>
__device__ __forceinline__ void gemm_phase(LAS unsigned char* lds, const Gemm g, const Sched& S, const Epi& E) {
    const int tid = threadIdx.x, wid = __builtin_amdgcn_readfirstlane(tid >> 6), lane = tid & 63, wr = wid >> 2, wc = wid & 3, fr = lane & 15, fq = lane >> 4;
    const int K = g.K, nt = K / BK;
    unsigned voffA[2], voffB[2];
#pragma unroll
    for (int i = 0; i < 2; ++i) { voffA[i] = (unsigned)(tid * 16 + i * 8192); voffB[i] = voffA[i]; }
    const size_t kstep = (size_t)(HTB);
    const size_t hstep = (size_t)HALF * K * 2;
    const size_t tstep = 2 * hstep;
    const unsigned ldsw = (unsigned)wid * 1024u;
    const int aoff = lds_byte(wr * 64 + fr, fq * 8), boff = lds_byte(wc * 32 + fr, fq * 8);
#define PG8_SA(b, h) (((b) * 2 + (h)) * HTB)
#define PG8_SB(b, h) ((4 + (b) * 2 + (h)) * HTB)
#define PG8_STAGE(bufoff, gbase, voff) do { _Pragma("unroll") for (int _i = 0; _i < 2; ++_i) \
        __builtin_amdgcn_global_load_lds((const unsigned*)((const char*)(gbase) + (voff)[_i]), (LAS unsigned*)(lds + (bufoff) + ldsw + _i * 8192), 16, 0, 0); } while (0)
#define PG8_LDA(dst, b, h) do { _Pragma("unroll") for (int m = 0; m < 4; ++m) _Pragma("unroll") for (int k = 0; k < 2; ++k) dst[m][k] = *(const LAS bf16x8*)(lds + PG8_SA(b, h) + aoff + m * 2048 + k * 1024); } while (0)
#define PG8_LDB(dst, b, h) do { _Pragma("unroll") for (int n = 0; n < 2; ++n) _Pragma("unroll") for (int k = 0; k < 2; ++k) dst[n][k] = *(const LAS bf16x8*)(lds + PG8_SB(b, h) + boff + n * 2048 + k * 1024); } while (0)
#define PG8_MMA(ai, bj, At, Bt) do { __builtin_amdgcn_s_setprio(1); _Pragma("unroll") for (int m = 0; m < 4; ++m) _Pragma("unroll") for (int n = 0; n < 2; ++n) _Pragma("unroll") for (int k = 0; k < 2; ++k) \
        acc[ai][bj][m][n] = __builtin_amdgcn_mfma_f32_16x16x32_bf16(Bt[n][k], At[m][k], acc[ai][bj][m][n], 0, 0, 0); __builtin_amdgcn_s_setprio(0); } while (0)
#define PG8_WAIT_V(n) asm volatile("s_waitcnt vmcnt(" #n ")" ::: "memory")
#define PG8_WAIT_L(n) asm volatile("s_waitcnt lgkmcnt(" #n ")" ::: "memory")
#define PG8_BAR __builtin_amdgcn_s_barrier()
#define PG8_SCHED __builtin_amdgcn_sched_barrier(0)
    Unit cur, nxt; int ui = 0;
    if (!S.next(0, cur)) return;
    f32x4 acc[2][2][4][2];
#pragma unroll
    for (int a = 0; a < 2; ++a)
#pragma unroll
        for (int b = 0; b < 2; ++b)
#pragma unroll
            for (int m = 0; m < 4; ++m)
#pragma unroll
                for (int n = 0; n < 2; ++n) acc[a][b][m][n] = (f32x4){0.f, 0.f, 0.f, 0.f};
    bf16x8 At[4][2], B0[2][2], B1[2][2];
    const char* cA = (const char*)g.A + (size_t)cur.pm * tstep; const char* cB = (const char*)g.Bt + (size_t)cur.pn * tstep;
    S.a_ready(cur);
    if constexpr (SP2) {
        PG8_STAGE(PG8_SB(0, 0), cB, voffB); PG8_STAGE(PG8_SB(0, 1), cB + hstep, voffB); PG8_STAGE(PG8_SA(0, 0), cA, voffA); PG8_STAGE(PG8_SA(0, 1), cA + hstep, voffA);
        if (wr == 1) PG8_BAR;
        PG8_WAIT_V(2); PG8_BAR;
        PG8_STAGE(PG8_SB(1, 0), cB + kstep, voffB); PG8_STAGE(PG8_SA(1, 0), cA + kstep, voffA); PG8_STAGE(PG8_SB(1, 1), cB + hstep + kstep, voffB);
        PG8_WAIT_V(6); PG8_BAR;
    } else {
        PG8_STAGE(PG8_SB(0, 0), cB, voffB); PG8_STAGE(PG8_SA(0, 0), cA, voffA); PG8_STAGE(PG8_SB(0, 1), cB + hstep, voffB); PG8_STAGE(PG8_SA(0, 1), cA + hstep, voffA);
        if (wr == 1) PG8_BAR;
        PG8_WAIT_V(4); PG8_BAR;
        PG8_STAGE(PG8_SB(1, 0), cB + kstep, voffB); PG8_STAGE(PG8_SA(1, 0), cA + kstep, voffA); PG8_STAGE(PG8_SB(1, 1), cB + hstep + kstep, voffB);
        PG8_WAIT_V(6); PG8_BAR;
    }
    for (;;) {
        const bool has_next = S.next(ui + 1, nxt);
        const char* nA = has_next ? (const char*)g.A + (size_t)nxt.pm * tstep : cA; const char* nB = has_next ? (const char*)g.Bt + (size_t)nxt.pn * tstep : cB;
        for (int t = 0; t < nt; t += 2) {
            const bool last = (t == nt - 2);
            const char* a1 = cA + (size_t)(t + 1) * kstep;
            const char* a2 = last ? nA : cA + (size_t)(t + 2) * kstep; const char* b2 = last ? nB : cB + (size_t)(t + 2) * kstep;
            const char* a3 = a2 + kstep; const char* b3 = b2 + kstep;
            if (last && has_next) S.a_ready(nxt);
            if constexpr (SP2) {
            PG8_LDB(B0, 0, 0); PG8_LDB(B1, 0, 1); PG8_SCHED; PG8_LDA(At, 0, 0); PG8_STAGE(PG8_SA(1, 1), a1 + hstep, voffA);
            PG8_WAIT_V(8); PG8_WAIT_L(0); PG8_BAR; PG8_MMA(0, 0, At, B0); PG8_MMA(0, 1, At, B1); PG8_BAR; PG8_SCHED;
            PG8_LDA(At, 0, 1); PG8_STAGE(PG8_SB(0, 0), b2, voffB); PG8_STAGE(PG8_SB(0, 1), b2 + hstep, voffB); PG8_STAGE(PG8_SA(0, 0), a2, voffA);
            PG8_WAIT_V(8); PG8_WAIT_L(0); PG8_BAR; PG8_MMA(1, 0, At, B0); PG8_MMA(1, 1, At, B1); PG8_BAR; PG8_SCHED;
            PG8_LDB(B0, 1, 0); PG8_LDB(B1, 1, 1); PG8_SCHED; PG8_LDA(At, 1, 0); PG8_STAGE(PG8_SA(0, 1), a2 + hstep, voffA);
            PG8_WAIT_V(8); PG8_WAIT_L(0); PG8_BAR; PG8_MMA(0, 0, At, B0); PG8_MMA(0, 1, At, B1); PG8_BAR; PG8_SCHED;
            PG8_LDA(At, 1, 1); PG8_STAGE(PG8_SB(1, 0), b3, voffB); PG8_STAGE(PG8_SB(1, 1), b3 + hstep, voffB); PG8_STAGE(PG8_SA(1, 0), a3, voffA);
            PG8_WAIT_V(8); PG8_WAIT_L(0); PG8_BAR; PG8_MMA(1, 0, At, B0); PG8_MMA(1, 1, At, B1); PG8_BAR; PG8_SCHED;
            } else {
            PG8_LDB(B0, 0, 0); PG8_SCHED; PG8_LDA(At, 0, 0); PG8_STAGE(PG8_SA(1, 1), a1 + hstep, voffA);
            PG8_WAIT_L(8); PG8_BAR; PG8_WAIT_L(0); PG8_MMA(0, 0, At, B0); PG8_BAR; PG8_SCHED;
            PG8_LDB(B1, 0, 1); PG8_STAGE(PG8_SB(0, 0), b2, voffB);
            PG8_BAR; PG8_WAIT_L(0); PG8_MMA(0, 1, At, B1); PG8_BAR;
            PG8_LDA(At, 0, 1); PG8_STAGE(PG8_SA(0, 0), a2, voffA);
            PG8_BAR; PG8_WAIT_L(0); PG8_MMA(1, 0, At, B0); PG8_BAR; PG8_SCHED;
            PG8_STAGE(PG8_SB(0, 1), b2 + hstep, voffB);
            PG8_WAIT_V(6); PG8_BAR; PG8_MMA(1, 1, At, B1); PG8_BAR;
            PG8_LDB(B0, 1, 0); PG8_SCHED; PG8_LDA(At, 1, 0); PG8_STAGE(PG8_SA(0, 1), a2 + hstep, voffA);
            PG8_WAIT_L(8); PG8_BAR; PG8_WAIT_L(0); PG8_MMA(0, 0, At, B0); PG8_BAR; PG8_SCHED;
            PG8_LDB(B1, 1, 1); PG8_STAGE(PG8_SB(1, 0), b3, voffB);
            PG8_BAR; PG8_WAIT_L(0); PG8_MMA(0, 1, At, B1); PG8_BAR;
            PG8_LDA(At, 1, 1); PG8_STAGE(PG8_SA(1, 0), a3, voffA);
            PG8_BAR; PG8_WAIT_L(0); PG8_MMA(1, 0, At, B0); PG8_BAR; PG8_SCHED;
            PG8_STAGE(PG8_SB(1, 1), b3 + hstep, voffB);
            PG8_WAIT_V(6); PG8_BAR; PG8_MMA(1, 1, At, B1); PG8_BAR;
            }
        }
        if constexpr (ALIGN_EPI) { if (wr == 0) PG8_BAR; }
        if constexpr (!Epi::AFTER_DRAIN) { E(acc, cur, wr, wc, fr, fq); S.done(cur); }
        if (!has_next) break;
#pragma unroll
        for (int a = 0; a < 2; ++a)
#pragma unroll
            for (int b = 0; b < 2; ++b)
#pragma unroll
                for (int m = 0; m < 4; ++m)
#pragma unroll
                    for (int n = 0; n < 2; ++n) acc[a][b][m][n] = (f32x4){0.f, 0.f, 0.f, 0.f};
        cur = nxt; cA = nA; cB = nB; ++ui;
        if constexpr (ALIGN_EPI) { if (wr == 1) PG8_BAR; }
    }
    PG8_WAIT_V(0);
    if constexpr (!ALIGN_EPI) { if (wr == 0) PG8_BAR; }
    PG8_BAR;
#undef PG8_SA
#undef PG8_SB
#undef PG8_STAGE
#undef PG8_LDA
#undef PG8_LDB
#undef PG8_MMA
#undef PG8_WAIT_V
#undef PG8_WAIT_L
#undef PG8_BAR
#undef PG8_SCHED
}
}

template <bool REMAP, bool PERM>
__device__ __forceinline__ void tconv(const float* __restrict__ src, int ldsrc, bf16_t* __restrict__ dst, int K, int ntn, LAS unsigned char* lds) {
    LAS unsigned* T = (LAS unsigned*)lds;
    const int tid = threadIdx.x, nkt = K / 128, total = nkt * ntn;
    for (int tile = blockIdx.x; tile < total; tile += gridDim.x) {
        const int nt = tile / nkt, kt = tile - nt * nkt, n0 = nt * 64, k0 = kt * 128;
        int on0 = n0; bool zero = false;
        if (REMAP) { if (n0 < 10240) on0 = n0; else if (n0 < 26624) on0 = n0 + 64; else if (n0 < 26688) on0 = n0 - 26624 + 10240; else if (n0 < 26752) on0 = n0; else zero = true; }
#pragma unroll
        for (int i = 0; i < 2; ++i) {
            const int rp = (tid >> 4) + 32 * i, c4 = tid & 15;
            f32x4 v0 = (f32x4){0.f, 0.f, 0.f, 0.f}, v1 = v0;
            if (!zero) { const float* s = src + (size_t)(k0 + 2 * rp) * ldsrc + on0 + c4 * 4; v0 = *(const f32x4*)s; v1 = *(const f32x4*)(s + ldsrc); }
#pragma unroll
            for (int j = 0; j < 4; ++j) T[(c4 * 4 + j) * 65 + rp] = cvt_pk_bf16(v0[j], v1[j]);
        }
        __syncthreads();
#pragma unroll
        for (int i = 0; i < 2; ++i) {
            const int n = (tid >> 4) + 32 * i, kc = tid & 15;
            u32x4 v; v[0] = T[n * 65 + kc * 4]; v[1] = T[n * 65 + kc * 4 + 1]; v[2] = T[n * 65 + kc * 4 + 2]; v[3] = T[n * 65 + kc * 4 + 3];
            int nn = n0 + n;
            if (PERM) { const int x = nn & 31; nn = (nn & ~31) + 16 * ((x >> 2) & 1) + 4 * (x >> 3) + (x & 3); }
            *(u32x4*)(dst + tiled_off(nn, k0 + kc * 8, K)) = v;
        }
        __syncthreads();
    }
}
__device__ __forceinline__ void phase_convert(const Params& p, LAS unsigned char* lds) {
    bf16_t* Xb = (bf16_t*)(p.ws + OFF_XB);
    const size_t n8 = (size_t)MPAD * DM / 8;
    for (size_t i = (size_t)blockIdx.x * 512 + threadIdx.x; i < n8; i += (size_t)gridDim.x * 512) {
        const size_t e = i * 8; const int row = (int)(e / DM);
        f32x4 a = (f32x4){0.f, 0.f, 0.f, 0.f}, b = a;
        if (row < NTP) { a = *(const f32x4*)(p.x_prompt + e); b = *(const f32x4*)(p.x_prompt + e + 4); }
        else if (row < NTOK) { const size_t e2 = e - (size_t)NTP * DM; a = *(const f32x4*)(p.x_sample + e2); b = *(const f32x4*)(p.x_sample + e2 + 4); }
        u32x4 o; o[0] = cvt_pk_bf16(a[0], a[1]); o[1] = cvt_pk_bf16(a[2], a[3]); o[2] = cvt_pk_bf16(b[0], b[1]); o[3] = cvt_pk_bf16(b[2], b[3]);
        *(u32x4*)(Xb + tiled_off(row, (int)(e - (size_t)row * DM), DM)) = o;
    }
    { u32x4* mz = (u32x4*)((bf16_t*)(p.ws + OFF_MIX) + (size_t)NTOK * MIXW); const size_t nz = (size_t)(MPAD - NTOK) * MIXW / 8;
      for (size_t i = (size_t)blockIdx.x * 512 + threadIdx.x; i < nz; i += (size_t)gridDim.x * 512) mz[i] = (u32x4){0u, 0u, 0u, 0u}; }
    tconv<true, true>(p.w_in, NPROJ, (bf16_t*)(p.ws + OFF_WB), DM, NPAD / 64, lds);
    tconv<false, false>(p.w_out, DM, (bf16_t*)(p.ws + OFF_WOB), MIXW, DM / 64, lds);
}

constexpr int N_GDN_P = 128, N_SSD_P = 128, N_GDN_S = 4096, N_SSD_S = 8192, N_ITEMS = N_GDN_P + N_SSD_P + N_GDN_S + N_SSD_S;
constexpr int GA_LD = 388, GO_LD = 132, SA_LD = 324, SY_LD = 68;

template <bool SAMPLE>
__device__ __forceinline__ void gdn_item(const Params& p, LAS unsigned char* lds, const int b, const int h) {
    LAS float* act = (LAS float*)lds;
    LAS float* tok = (LAS float*)(lds + 64 * GA_LD * 4);
    LAS float* obuf = (LAS float*)(lds + 64 * GA_LD * 4 + 1024);
    const bf16_t* P = (const bf16_t*)(p.ws + OFF_P); const float* G = (const float*)(p.ws + OFF_G32); bf16_t* MIX = (bf16_t*)(p.ws + OFF_MIX);
    const int tid = opaque_tid(), w = tid >> 6, lane = tid & 63, dgrp = lane >> 4, ecol = w * 16 + (lane & 15);
    float s[32];
    if (SAMPLE) { const float* S0 = p.state_gdn + (size_t)(b * 32 + h) * 16384;
#pragma unroll
        for (int i = 0; i < 32; ++i) s[i] = S0[(dgrp * 32 + i) * 128 + ecol]; }
    else {
#pragma unroll
        for (int i = 0; i < 32; ++i) s[i] = 0.f; }
    const int T = SAMPLE ? 1 : 64, NC = SAMPLE ? 1 : 32;
    const size_t rowbase = SAMPLE ? (size_t)(NTP + b) : (size_t)b * 2048;
    const float Aneg = -expf(p.gdn_a_log[h]), dtb = p.gdn_dt_bias[h];
    float* convout = p.out + (SAMPLE ? O_GDNC_S : O_GDNC_P);
    for (int c = 0; c < NC; ++c) {
        const int t0 = c * 64;
        for (int idx = tid; idx < T * 96; idx += 512) {
            const int t = idx / 96, cq = idx - t * 96, col = cq * 4, ch = (col >> 7) * 4096 + h * 128 + (col & 127);
            f32x4 a = (f32x4){0.f, 0.f, 0.f, 0.f};
#pragma unroll
            for (int j = 0; j < 4; ++j) {
                const f32x4 wv = *(const f32x4*)(p.gdn_conv_w + j * 12288 + ch);
                f32x4 rv = (f32x4){0.f, 0.f, 0.f, 0.f};
                if (SAMPLE) { if (j < 3) rv = *(const f32x4*)(p.state_gdn_conv + ((size_t)b * 3 + j) * 12288 + ch); else rv = ldbf4(P + rowbase * P_LD + C_QKV + ch);
                    if (j >= 1) *(f32x4*)(convout + ((size_t)b * 3 + (j - 1)) * 12288 + ch) = rv; }
                else { const int tt = t0 + t - 3 + j; if (tt >= 0) rv = ldbf4(P + (rowbase + tt) * P_LD + C_QKV + ch);
                    if (j == 3 && c == 31 && t >= 61) *(f32x4*)(convout + ((size_t)b * 3 + (t - 61)) * 12288 + ch) = rv; }
                a += wv * rv;
            }
            f32x4 o; o[0] = silu_f(a[0]); o[1] = silu_f(a[1]); o[2] = silu_f(a[2]); o[3] = silu_f(a[3]);
            *(LAS f32x4*)(act + t * GA_LD + col) = o;
        }
        __syncthreads();
#pragma unroll 1
        for (int r = 0; r < 8; ++r) { const int t = w * 8 + r; if (t < T) {
            LAS float* ar = act + t * GA_LD;
            const float q0 = ar[lane], q1 = ar[64 + lane], k0 = ar[128 + lane], k1 = ar[192 + lane];
            const float sq = wave_sum(q0 * q0 + q1 * q1), sk = wave_sum(k0 * k0 + k1 * k1);
            const float rq = rsqrtf(sq + 1e-6f) * 0.08838834764831845f, rk = rsqrtf(sk + 1e-6f);
            ar[lane] = q0 * rq; ar[64 + lane] = q1 * rq; ar[128 + lane] = k0 * rk; ar[192 + lane] = k1 * rk; } }
        if (tid < T) { const size_t row = rowbase + t0 + tid; const float araw = G[row * G_LD + 96 + h], braw = G[row * G_LD + 64 + h];
            tok[tid * 2] = sigmoid_f(braw); tok[tid * 2 + 1] = expf(Aneg * softplus_f(araw + dtb)); }
        __syncthreads();
#pragma unroll 1
        for (int t = 0; t < T; ++t) {
            LAS float* ar = act + t * GA_LD;
            const float beta = tok[t * 2], eg = tok[t * 2 + 1];
            float kk[32], qq[32];
#pragma unroll
            for (int i = 0; i < 8; ++i) { const f32x4 kv = *(LAS f32x4*)(ar + 128 + dgrp * 32 + i * 4); kk[4 * i] = kv[0]; kk[4 * i + 1] = kv[1]; kk[4 * i + 2] = kv[2]; kk[4 * i + 3] = kv[3]; }
            float ks = 0.f;
#pragma unroll
            for (int i = 0; i < 32; ++i) ks += kk[i] * s[i];
            ks += __shfl_xor(ks, 16); ks += __shfl_xor(ks, 32);
            const float vnew = beta * (ar[256 + ecol] - eg * ks);
#pragma unroll
            for (int i = 0; i < 8; ++i) { const f32x4 qv = *(LAS f32x4*)(ar + dgrp * 32 + i * 4); qq[4 * i] = qv[0]; qq[4 * i + 1] = qv[1]; qq[4 * i + 2] = qv[2]; qq[4 * i + 3] = qv[3]; }
            float o = 0.f;
#pragma unroll
            for (int i = 0; i < 32; ++i) { s[i] = eg * s[i] + kk[i] * vnew; o += qq[i] * s[i]; }
            o += __shfl_xor(o, 16); o += __shfl_xor(o, 32);
            if (dgrp == 0) obuf[t * GO_LD + ecol] = o;
        }
        __syncthreads();
#pragma unroll 1
        for (int r = 0; r < 8; ++r) { const int t = w * 8 + r; if (t < T) {
            const float o0 = obuf[t * GO_LD + lane], o1 = obuf[t * GO_LD + 64 + lane];
            const float rs = rsqrtf(wave_sum(o0 * o0 + o1 * o1) * (1.f / 128.f) + 1e-6f);
            const size_t row = rowbase + t0 + t;
            const float z0 = bf2f(P[row * P_LD + C_ZG + h * 128 + lane]), z1 = bf2f(P[row * P_LD + C_ZG + h * 128 + 64 + lane]);
            MIX[tiled_off((int)row, 4096 + h * 128 + lane, MIXW)] = f2bf(o0 * rs * p.gdn_norm_w[lane] * silu_f(z0));
            MIX[tiled_off((int)row, 4096 + h * 128 + 64 + lane, MIXW)] = f2bf(o1 * rs * p.gdn_norm_w[64 + lane] * silu_f(z1)); } }
        __syncthreads();
    }
    float* So = p.out + (SAMPLE ? O_GDN_S : O_GDN_P) + (size_t)(b * 32 + h) * 16384;
#pragma unroll
    for (int i = 0; i < 32; ++i) So[(dgrp * 32 + i) * 128 + ecol] = s[i];
}

template <bool SAMPLE>
__device__ __forceinline__ void ssd_item(const Params& p, LAS unsigned char* lds, const int b, const int h) {
    LAS float* act = (LAS float*)lds;
    LAS float* tok = (LAS float*)(lds + 64 * SA_LD * 4);
    LAS float* ybuf = (LAS float*)(lds + 64 * SA_LD * 4 + 1024);
    const bf16_t* P = (const bf16_t*)(p.ws + OFF_P); const float* G = (const float*)(p.ws + OFF_G32); float* U = (float*)(p.ws + OFF_U32);
    const int tid = opaque_tid(), w = tid >> 6, lane = tid & 63, pp = w * 8 + (lane >> 3), nch = lane & 7, g = h >> 3;
    float hs[16];
    if (SAMPLE) { const float* H0 = p.state_ssd + ((size_t)(b * 64 + h) * 64 + pp) * 128;
#pragma unroll
        for (int i = 0; i < 4; ++i) { const f32x4 v = *(const f32x4*)(H0 + i * 32 + nch * 4); hs[4 * i] = v[0]; hs[4 * i + 1] = v[1]; hs[4 * i + 2] = v[2]; hs[4 * i + 3] = v[3]; } }
    else {
#pragma unroll
        for (int i = 0; i < 16; ++i) hs[i] = 0.f; }
    const int T = SAMPLE ? 1 : 64, NC = SAMPLE ? 1 : 32;
    const size_t rowbase = SAMPLE ? (size_t)(NTP + b) : (size_t)b * 2048;
    const float Aneg = -expf(p.ssd_a_log[h]), dtb = p.ssd_dt_bias[h], Dh = p.ssd_d[h];
    float* convout = p.out + (SAMPLE ? O_SSDC_S : O_SSDC_P);
    for (int c = 0; c < NC; ++c) {
        const int t0 = c * 64;
        for (int idx = tid; idx < T * 80; idx += 512) {
            const int t = idx / 80, cq = idx - t * 80, col = cq * 4;
            const int ch = col < 64 ? h * 64 + col : (col < 192 ? 4096 + g * 128 + (col - 64) : 5120 + g * 128 + (col - 192));
            const bool wr_state = (col < 64) || ((h & 7) == 0);
            f32x4 a = *(const f32x4*)(p.ssd_conv_b + ch);
#pragma unroll
            for (int j = 0; j < 4; ++j) {
                const f32x4 wv = *(const f32x4*)(p.ssd_conv_w + j * 6144 + ch);
                f32x4 rv = (f32x4){0.f, 0.f, 0.f, 0.f};
                if (SAMPLE) { if (j < 3) rv = *(const f32x4*)(p.state_ssd_conv + ((size_t)b * 3 + j) * 6144 + ch); else rv = ldbf4(P + rowbase * P_LD + C_XBC + ch);
                    if (j >= 1 && wr_state) *(f32x4*)(convout + ((size_t)b * 3 + (j - 1)) * 6144 + ch) = rv; }
                else { const int tt = t0 + t - 3 + j; if (tt >= 0) rv = ldbf4(P + (rowbase + tt) * P_LD + C_XBC + ch);
                    if (j == 3 && c == 31 && t >= 61 && wr_state) *(f32x4*)(convout + ((size_t)b * 3 + (t - 61)) * 6144 + ch) = rv; }
                a += wv * rv;
            }
            f32x4 o; o[0] = silu_f(a[0]); o[1] = silu_f(a[1]); o[2] = silu_f(a[2]); o[3] = silu_f(a[3]);
            *(LAS f32x4*)(act + t * SA_LD + col) = o;
        }
        if (tid < T) { const size_t row = rowbase + t0 + tid; const float dt = softplus_f(G[row * G_LD + h] + dtb);
            tok[tid * 2] = dt; tok[tid * 2 + 1] = expf(dt * Aneg); }
        __syncthreads();
#pragma unroll 1
        for (int t = 0; t < T; ++t) {
            LAS float* ar = act + t * SA_LD;
            const float dt = tok[t * 2], eA = tok[t * 2 + 1];
            const float xdt = ar[pp] * dt;
            float y = 0.f;
#pragma unroll
            for (int i = 0; i < 4; ++i) { const f32x4 bv = *(LAS f32x4*)(ar + 64 + i * 32 + nch * 4), cv = *(LAS f32x4*)(ar + 192 + i * 32 + nch * 4);
#pragma unroll
                for (int j = 0; j < 4; ++j) { hs[4 * i + j] = eA * hs[4 * i + j] + xdt * bv[j]; y += cv[j] * hs[4 * i + j]; } }
            y += __shfl_xor(y, 1); y += __shfl_xor(y, 2); y += __shfl_xor(y, 4);
            if (nch == 0) ybuf[t * SY_LD + pp] = y;
        }
        __syncthreads();
        for (int idx = tid; idx < T * 64; idx += 512) { const int t = idx >> 6, q = idx & 63; const size_t row = rowbase + t0 + t;
            const float z = bf2f(P[row * P_LD + C_ZS + h * 64 + q]);
            U[row * DM + h * 64 + q] = (ybuf[t * SY_LD + q] + act[t * SA_LD + q] * Dh) * silu_f(z); }
        __syncthreads();
    }
    float* Ho = p.out + (SAMPLE ? O_SSD_S : O_SSD_P) + ((size_t)(b * 64 + h) * 64 + pp) * 128;
#pragma unroll
    for (int i = 0; i < 4; ++i) { f32x4 v; v[0] = hs[4 * i]; v[1] = hs[4 * i + 1]; v[2] = hs[4 * i + 2]; v[3] = hs[4 * i + 3]; *(f32x4*)(Ho + i * 32 + nch * 4) = v; }
}

typedef __bf16 bf16x2_t __attribute__((ext_vector_type(2)));
typedef short bf16x4 __attribute__((ext_vector_type(4)));
__device__ __forceinline__ unsigned pk_bf16(float lo, float hi) { const f32x2v v = {lo, hi}; return __builtin_bit_cast(unsigned, __builtin_convertvector(v, bf16x2_t)); }
__device__ __forceinline__ bf16x8 pack2(const f32x4 lo, const f32x4 hi) { u32x4 r; r[0] = pk_bf16(lo[0], lo[1]); r[1] = pk_bf16(lo[2], lo[3]); r[2] = pk_bf16(hi[0], hi[1]); r[3] = pk_bf16(hi[2], hi[3]); return __builtin_bit_cast(bf16x8, r); }
__device__ __forceinline__ bf16x8 ld_perm(const LAS bf16_t* rowp, int q) { const u32x2 a = *(const LAS u32x2*)(rowp + 4 * q), b = *(const LAS u32x2*)(rowp + 16 + 4 * q); u32x4 r; r[0] = a[0]; r[1] = a[1]; r[2] = b[0]; r[3] = b[1]; return __builtin_bit_cast(bf16x8, r); }
__device__ __forceinline__ bf16x8 ld_nat(const LAS bf16_t* rowp, int q) { return *(const LAS bf16x8*)(rowp + 8 * q); }
#define MFMA16(a, b, c) __builtin_amdgcn_mfma_f32_16x16x32_bf16((a), (b), (c), 0, 0, 0)

#define BAR_LDS() do { asm volatile("s_waitcnt lgkmcnt(0)" ::: "memory"); __builtin_amdgcn_s_barrier(); asm volatile("" ::: "memory"); } while (0)
#define WAIT_VM0() asm volatile("s_waitcnt vmcnt(0)" ::: "memory")
#define LDP(base, off) __builtin_bit_cast(bf16x8, (u32x4){(*(const LAS u32x2*)((base) + (off)))[0], (*(const LAS u32x2*)((base) + (off)))[1], (*(const LAS u32x2*)((base) + (off) + 16))[0], (*(const LAS u32x2*)((base) + (off) + 16))[1]})
__device__ __forceinline__ float blo(unsigned v) { return __uint_as_float(v << 16); }
__device__ __forceinline__ float bhi(unsigned v) { return __uint_as_float(v & 0xffff0000u); }
__device__ __forceinline__ void dma_raw(LAS unsigned char* lds_raw, const bf16_t* P, const bf16_t* zsrc, const size_t rowbase, const int t0, const int c0, const int c1, const int c2, const int w, const int lane) {
#pragma unroll
    for (int kk = 0; kk < 7; ++kk) {
        int k = w + 8 * kk; k = k > 50 ? 50 : k;
        int seg = 4 * k + (lane >> 4); seg = seg > 200 ? 200 : seg;
        const int row = seg / 3, sec = seg - row * 3, tt = t0 - 3 + row;
        const bf16_t* src = tt >= 0 ? P + (rowbase + tt) * P_LD + (sec == 0 ? c0 : (sec == 1 ? c1 : c2)) : zsrc;
        __builtin_amdgcn_global_load_lds((const unsigned*)(src + (lane & 15) * 8), (LAS unsigned*)(lds_raw + k * 1024), 16, 0, 0);
    }
}
__device__ __forceinline__ float reduce16(float (&v)[16], const int lane) {
#pragma unroll
    for (int i = 0; i < 8; ++i) { const bool up = (lane & 32) != 0; const float send = up ? v[i] : v[i + 8], keep = up ? v[i + 8] : v[i]; v[i] = keep + __shfl_xor(send, 32); }
#pragma unroll
    for (int i = 0; i < 4; ++i) { const bool up = (lane & 16) != 0; const float send = up ? v[i] : v[i + 4], keep = up ? v[i + 4] : v[i]; v[i] = keep + __shfl_xor(send, 16); }
#pragma unroll
    for (int i = 0; i < 2; ++i) { const bool up = (lane & 8) != 0; const float send = up ? v[i] : v[i + 2], keep = up ? v[i + 2] : v[i]; v[i] = keep + __shfl_xor(send, 8); }
    { const bool up = (lane & 4) != 0; const float send = up ? v[0] : v[1], keep = up ? v[1] : v[0]; v[0] = keep + __shfl_xor(send, 4); }
    v[0] += __shfl_xor(v[0], 2); v[0] += __shfl_xor(v[0], 1);
    return v[0];
}

constexpr int GL_RAW = 0, GL_QA = 52224, GL_KA = 69632, GL_OB = GL_KA  , GL_KAT = 87040, GL_WL = 105472, GL_AB = 122880, GL_QK = 132096,
              GL_ADT = 141312, GL_TF = 145408, GL_TOK = 147456, GL_SSQ = 148480, GL_LAST = 148992, GL_WTS = 149056;
__device__ __forceinline__ void gdn_chunk_item(const Params& p, LAS unsigned char* lds, const int b, const int h) {
    const bf16_t* P = (const bf16_t*)(p.ws + OFF_P); const float* G = (const float*)(p.ws + OFF_G32); bf16_t* MIX = (bf16_t*)(p.ws + OFF_MIX);
    const bf16_t* zsrc = (const bf16_t*)(p.ws + OFF_XB) + (size_t)NTOK * DM;
    const size_t rowbase = (size_t)b * 2048;
    const float Aneg = -expf(p.gdn_a_log[h]), dtb = p.gdn_dt_bias[h];
    const int c0 = C_QKV + h * 128, c1 = C_QKV + 4096 + h * 128, c2 = C_QKV + 8192 + h * 128;
    f32x4 Sacc[8];
#pragma unroll
    for (int j = 0; j < 8; ++j) Sacc[j] = (f32x4){0.f, 0.f, 0.f, 0.f};
    float g_araw = 0.f, g_braw = 0.f;
    {
        const int tid = opaque_tid(), lane = tid & 63, w = __builtin_amdgcn_readfirstlane(tid >> 6);
        for (int i = tid; i < (9216 * 2) / 4; i += 512) ((LAS unsigned*)(lds + GL_AB))[i] = 0u;
        for (int i = tid; i < 1536; i += 512) { const int j = i / 384, cc = i - j * 384; ((LAS float*)(lds + GL_WTS))[i] = p.gdn_conv_w[j * 12288 + (cc >> 7) * 4096 + h * 128 + (cc & 127)]; }
        dma_raw(lds + GL_RAW, P, zsrc, rowbase, 0, c0, c1, c2, w, lane);
        if (w == 0) { g_araw = G[(rowbase + lane) * G_LD + 96 + h]; g_braw = G[(rowbase + lane) * G_LD + 64 + h]; }
    }
#pragma unroll 1
    for (int c = 0; c < 32; ++c) {
        const int t0 = c * 64;
        WAIT_VM0(); BAR_LDS();
        {
            const int tid = opaque_tid(), lane = tid & 63, w = tid >> 6;
            const LAS unsigned char* rawl = lds + GL_RAW + (8 * w) * 768 + lane * 4; const LAS float* wts = (const LAS float*)(lds + GL_WTS) + 2 * lane;
            float ssv[16];
#pragma unroll
            for (int sec = 0; sec < 2; ++sec) {
                f32x2v wj[4];
#pragma unroll
                for (int j = 0; j < 4; ++j) wj[j] = *(const LAS f32x2v*)(wts + j * 384 + sec * 128);
                float x0[11], x1[11];
#pragma unroll
                for (int rr = 0; rr < 11; ++rr) { const unsigned u = *(const LAS unsigned*)(rawl + rr * 768 + sec * 256); x0[rr] = blo(u); x1[rr] = bhi(u); }
                unsigned pk[8];
#pragma unroll
                for (int t = 0; t < 8; ++t) {
                    const float a0 = silu_f(wj[0][0] * x0[t] + wj[1][0] * x0[t + 1] + wj[2][0] * x0[t + 2] + wj[3][0] * x0[t + 3]);
                    const float a1 = silu_f(wj[0][1] * x1[t] + wj[1][1] * x1[t + 1] + wj[2][1] * x1[t + 2] + wj[3][1] * x1[t + 3]);
                    ssv[2 * t + sec] = a0 * a0 + a1 * a1; pk[t] = pk_bf16(a0, a1);
                    *(LAS unsigned*)(lds + (sec == 0 ? GL_QA : GL_KA) + ((8 * w + t) * 136 + 2 * lane) * 2) = pk[t];
                }
                if (sec == 1) {
                    u32x4 ke, ko;
#pragma unroll
                    for (int t2 = 0; t2 < 4; ++t2) { ke[t2] = (pk[2 * t2] & 0xffffu) | (pk[2 * t2 + 1] << 16); ko[t2] = (pk[2 * t2] >> 16) | (pk[2 * t2 + 1] & 0xffff0000u); }
                    *(LAS u32x4*)(lds + GL_KAT + ((2 * lane) * 72 + 8 * w) * 2) = ke; *(LAS u32x4*)(lds + GL_KAT + ((2 * lane + 1) * 72 + 8 * w) * 2) = ko;
                }
            }
            const float tot = reduce16(ssv, lane);
            if ((lane & 3) == 0) ((LAS float*)(lds + GL_SSQ))[16 * w + (lane >> 2)] = tot;
            if (c == 31 && w == 7) {
                float* convout = p.out + O_GDNC_P + (size_t)b * 3 * 12288 + h * 128 + 2 * lane;
#pragma unroll
                for (int j = 0; j < 3; ++j)
#pragma unroll
                    for (int sec = 0; sec < 3; ++sec) { const unsigned u = *(const LAS unsigned*)(lds + GL_RAW + ((64 + j) * 3 + sec) * 256 + lane * 4); *(f32x2v*)(convout + j * 12288 + sec * 4096) = (f32x2v){blo(u), bhi(u)}; }
            }
        }
        BAR_LDS();
        {
            const int tid = opaque_tid(), lane = tid & 63;
            if ((tid >> 6) == 0) {
                const LAS float* ssq = (const LAS float*)(lds + GL_SSQ);
                float cs = Aneg * softplus_f(g_araw + dtb); const float beta = sigmoid_f(g_braw);
                if (c < 31) { const size_t row = rowbase + t0 + 64 + lane; g_araw = G[row * G_LD + 96 + h]; g_braw = G[row * G_LD + 64 + h]; }
#pragma unroll
                for (int d = 1; d < 64; d <<= 1) { const float n = __shfl_up(cs, d); if (lane >= d) cs += n; }
                f32x4 tv; tv[0] = rsqrtf(ssq[lane * 2] + 1e-6f) * 0.08838834764831845f; tv[1] = rsqrtf(ssq[lane * 2 + 1] + 1e-6f); tv[2] = beta; tv[3] = cs;
                ((LAS f32x4*)(lds + GL_TOK))[lane] = tv; if (lane == 63) *(LAS float*)(lds + GL_LAST) = cs;
            }
        }
        BAR_LDS();
        {
            const int tid = opaque_tid(), w = tid >> 6, lane = tid & 63, r = lane & 15, q = lane >> 4;
#pragma unroll 1
            for (int job = w; job < 20; job += 8) {
                const int tj = job < 10 ? job : job - 10; const bool isQK = job >= 10;
                const int ti = tj >= 6 ? 3 : (tj >= 3 ? 2 : (tj >= 1 ? 1 : 0)), si = tj - (ti * (ti + 1)) / 2;
                const LAS bf16_t* Ab = (const LAS bf16_t*)(lds + (isQK ? GL_QA : GL_KA)) + (ti * 16 + r) * 136 + 8 * q; const LAS bf16_t* Bb = (const LAS bf16_t*)(lds + GL_KA) + (si * 16 + r) * 136 + 8 * q;
                f32x4 acc = (f32x4){0.f, 0.f, 0.f, 0.f};
#pragma unroll
                for (int kk = 0; kk < 4; ++kk) acc = MFMA16(*(const LAS bf16x8*)(Ab + kk * 32), *(const LAS bf16x8*)(Bb + kk * 32), acc);
                const int s = si * 16 + r; const f32x4 ts = ((const LAS f32x4*)(lds + GL_TOK))[s];
                const LAS f32x4* tq = (const LAS f32x4*)(lds + GL_TOK) + ti * 16 + 4 * q;
                float val[4];
#pragma unroll
                for (int reg = 0; reg < 4; ++reg) { const int t = ti * 16 + 4 * q + reg; const f32x4 tt = tq[reg]; const float dec = __expf(tt[3] - ts[3]);
                    val[reg] = isQK ? (s <= t ? acc[reg] * tt[0] * ts[1] * dec : 0.f) : (s < t ? -(acc[reg] * tt[1] * ts[1] * tt[2] * dec) : 0.f); }
                LAS bf16_t* dst = (LAS bf16_t*)(lds + (isQK ? GL_QK : GL_AB)) + (ti * 16 + 4 * q) * 72 + s;
                const bool diagKK = (!isQK) && (ti == si);
#pragma unroll
                for (int reg = 0; reg < 4; ++reg) dst[reg * 72] = diagKK ? (bf16_t)0 : (bf16_t)(pk_bf16(val[reg], 0.f) & 0xffffu);
                if (diagKK) *(LAS f32x4*)((LAS float*)(lds + GL_ADT) + (ti * 16 + r) * 16 + 4 * q) = (f32x4){val[0], val[1], val[2], val[3]};
            }
        }
        BAR_LDS();
        {
            const int tid = opaque_tid(), w = tid >> 6, lane = tid & 63, r = lane & 15, q = lane >> 4;
            if (w < 4) {
                const LAS float* A = (const LAS float*)(lds + GL_ADT) + w * 256;
                float tr[16];
#pragma unroll
                for (int j = 15; j >= 0; --j) { float v = (j == r) ? 1.f : 0.f;
#pragma unroll
                    for (int k = j + 1; k < 16; ++k) v += tr[k] * A[j * 16 + k];
                    tr[j] = v; }
                const float s0 = q == 0 ? tr[0] : (q == 1 ? tr[4] : (q == 2 ? tr[8] : tr[12])), s1 = q == 0 ? tr[1] : (q == 1 ? tr[5] : (q == 2 ? tr[9] : tr[13]));
                const float s2 = q == 0 ? tr[2] : (q == 1 ? tr[6] : (q == 2 ? tr[10] : tr[14])), s3 = q == 0 ? tr[3] : (q == 1 ? tr[7] : (q == 2 ? tr[11] : tr[15]));
                u32x2 tv; tv[0] = pk_bf16(s0, s1); tv[1] = pk_bf16(s2, s3); ((LAS u32x2*)(lds + GL_TF))[w * 64 + lane] = tv;
            }
        }
        BAR_LDS();
        f32x4 U[4];
        {
            const int tid = opaque_tid(), w = tid >> 6, lane = tid & 63, r = lane & 15, q = lane >> 4, E = w * 16 + r;
            const LAS f32x4* tq = (const LAS f32x4*)(lds + GL_TOK) + 4 * q;
            const LAS bf16_t* RvE = (const LAS bf16_t*)(lds + GL_RAW) + ((4 * q) * 3 + 2) * 128 + E; const LAS bf16_t* KaE = (const LAS bf16_t*)(lds + GL_KA) + (4 * q) * 136 + E;
            const LAS bf16_t* AbR = (const LAS bf16_t*)(lds + GL_AB) + r * 72 + 4 * q;
            const LAS u32x2* TfL = (const LAS u32x2*)(lds + GL_TF) + lane;
            LAS bf16_t* WlE = (LAS bf16_t*)(lds + GL_WL) + (4 * q) * 136 + E;
            const LAS float* wv = (const LAS float*)(lds + GL_WTS) + 256 + E;
            const float w0 = wv[0], w1 = wv[384], w2 = wv[768], w3 = wv[1152];
            u32x4 XU[2], XW[2];
            XU[0] = XU[1] = XW[0] = XW[1] = (u32x4){0u, 0u, 0u, 0u};
#pragma unroll
            for (int i = 0; i < 4; ++i) {
                f32x4 au, aw; float xr[7];
#pragma unroll
                for (int k = 0; k < 7; ++k) xr[k] = bf2f(RvE[(16 * i + k) * 384]);
#pragma unroll
                for (int reg = 0; reg < 4; ++reg) { const f32x4 tt = tq[16 * i + reg];
                    au[reg] = silu_f(w0 * xr[reg] + w1 * xr[reg + 1] + w2 * xr[reg + 2] + w3 * xr[reg + 3]) * tt[2]; aw[reg] = bf2f(KaE[(16 * i + reg) * 136]) * (tt[1] * tt[2] * __expf(tt[3])); }
                if (i >= 1) { const bf16x8 a = LDP(AbR, 16 * i * 72); au = MFMA16(a, __builtin_bit_cast(bf16x8, XU[0]), au); aw = MFMA16(a, __builtin_bit_cast(bf16x8, XW[0]), aw); }
                if (i == 3) { const bf16x8 a = LDP(AbR, 48 * 72 + 32); au = MFMA16(a, __builtin_bit_cast(bf16x8, XU[1]), au); aw = MFMA16(a, __builtin_bit_cast(bf16x8, XW[1]), aw); }
                const u32x2 tf = TfL[i * 64]; const u32x4 ta = (u32x4){tf[0], tf[1], 0u, 0u};
                const u32x4 yu = (u32x4){pk_bf16(au[0], au[1]), pk_bf16(au[2], au[3]), 0u, 0u}, yw = (u32x4){pk_bf16(aw[0], aw[1]), pk_bf16(aw[2], aw[3]), 0u, 0u};
                const f32x4 z4 = (f32x4){0.f, 0.f, 0.f, 0.f};
                const f32x4 xu = MFMA16(__builtin_bit_cast(bf16x8, ta), __builtin_bit_cast(bf16x8, yu), z4), xw = MFMA16(__builtin_bit_cast(bf16x8, ta), __builtin_bit_cast(bf16x8, yw), z4);
                U[i] = xu;
                XU[i >> 1][2 * (i & 1)] = pk_bf16(xu[0], xu[1]); XU[i >> 1][2 * (i & 1) + 1] = pk_bf16(xu[2], xu[3]);
                XW[i >> 1][2 * (i & 1)] = pk_bf16(xw[0], xw[1]); XW[i >> 1][2 * (i & 1) + 1] = pk_bf16(xw[2], xw[3]);
#pragma unroll
                for (int reg = 0; reg < 4; ++reg) WlE[(16 * i + reg) * 136] = (bf16_t)(pk_bf16(-xw[reg], 0.f) & 0xffffu);
            }
        }
        BAR_LDS();
        u32x4 zreg[2];
        {
            const int tid = opaque_tid(), lane = tid & 63, w = __builtin_amdgcn_readfirstlane(tid >> 6);
#pragma unroll
            for (int it = 0; it < 2; ++it) { const int idx = tid + it * 512; zreg[it] = *(const u32x4*)(P + (rowbase + t0 + (idx >> 4)) * P_LD + C_ZG + h * 128 + (idx & 15) * 8); }
            if (c < 31) dma_raw(lds + GL_RAW, P, zsrc, rowbase, t0 + 64, c0, c1, c2, w, lane);
        }
        {
            const int tid = opaque_tid(), w = tid >> 6, lane = tid & 63, r = lane & 15, q = lane >> 4, E = w * 16 + r;
            const LAS f32x4* tq = (const LAS f32x4*)(lds + GL_TOK) + 4 * q;
            const LAS bf16_t* WlR = (const LAS bf16_t*)(lds + GL_WL) + r * 136 + 4 * q; const LAS bf16_t* QaR = (const LAS bf16_t*)(lds + GL_QA) + r * 136 + 4 * q;
            const LAS bf16_t* QkR = (const LAS bf16_t*)(lds + GL_QK) + r * 72 + 4 * q; const LAS bf16_t* KtR = (const LAS bf16_t*)(lds + GL_KAT) + r * 72 + 4 * q;
            LAS bf16_t* obE = (LAS bf16_t*)(lds + GL_OB) + (4 * q) * 136 + E;
            bf16x8 Sb[4];
#pragma unroll
            for (int kp = 0; kp < 4; ++kp) Sb[kp] = pack2(Sacc[2 * kp], Sacc[2 * kp + 1]);
            const float last = *(const LAS float*)(lds + GL_LAST);
            f32x4 vn[4], oo[4], vs[4];
#pragma unroll
            for (int i = 0; i < 4; ++i) { f32x4 acc = U[i];
#pragma unroll
                for (int kp = 0; kp < 4; ++kp) acc = MFMA16(LDP(WlR, 16 * i * 136 + 32 * kp), Sb[kp], acc);
                vn[i] = acc; }
#pragma unroll
            for (int i = 0; i < 4; ++i) { f32x4 acc = (f32x4){0.f, 0.f, 0.f, 0.f};
#pragma unroll
                for (int kp = 0; kp < 4; ++kp) acc = MFMA16(LDP(QaR, 16 * i * 136 + 32 * kp), Sb[kp], acc);
#pragma unroll
                for (int reg = 0; reg < 4; ++reg) { const f32x4 tt = tq[16 * i + reg]; acc[reg] *= tt[0] * __expf(tt[3]); vs[i][reg] = vn[i][reg] * (tt[1] * __expf(last - tt[3])); }
                oo[i] = acc; }
            bf16x8 Vn[2], Vs[2];
            Vn[0] = pack2(vn[0], vn[1]); Vn[1] = pack2(vn[2], vn[3]); Vs[0] = pack2(vs[0], vs[1]); Vs[1] = pack2(vs[2], vs[3]);
#pragma unroll
            for (int i = 0; i < 4; ++i) {
                oo[i] = MFMA16(LDP(QkR, 16 * i * 72), Vn[0], oo[i]);
                if (i >= 2) oo[i] = MFMA16(LDP(QkR, 16 * i * 72 + 32), Vn[1], oo[i]);
            }
            const float el = __expf(last);
#pragma unroll
            for (int j = 0; j < 8; ++j) { f32x4 acc = Sacc[j] * el;
                acc = MFMA16(LDP(KtR, 16 * j * 72), Vs[0], acc); acc = MFMA16(LDP(KtR, 16 * j * 72 + 32), Vs[1], acc);
                Sacc[j] = acc; }
#pragma unroll
            for (int i = 0; i < 4; ++i)
#pragma unroll
                for (int reg = 0; reg < 4; ++reg) obE[(16 * i + reg) * 136] = (bf16_t)(pk_bf16(oo[i][reg], 0.f) & 0xffffu);
        }
        BAR_LDS();
        {
            const int tid = opaque_tid();
#pragma unroll
            for (int it = 0; it < 2; ++it) { const int idx = tid + it * 512, t = idx >> 4, e8 = (idx & 15) * 8;
                const u32x4 ov = *(const LAS u32x4*)(lds + GL_OB + (t * 136 + e8) * 2);
                float o[8];
#pragma unroll
                for (int k = 0; k < 4; ++k) { o[2 * k] = blo(ov[k]); o[2 * k + 1] = bhi(ov[k]); }
                float ss = 0.f;
#pragma unroll
                for (int k = 0; k < 8; ++k) ss += o[k] * o[k];
                ss += __shfl_xor(ss, 1); ss += __shfl_xor(ss, 2); ss += __shfl_xor(ss, 4); ss += __shfl_xor(ss, 8);
                const float rs = rsqrtf(ss * (1.f / 128.f) + 1e-6f);
                const f32x4 n0 = *(const f32x4*)(p.gdn_norm_w + e8), n1 = *(const f32x4*)(p.gdn_norm_w + e8 + 4);
                u32x4 res;
#pragma unroll
                for (int k = 0; k < 4; ++k) { const float za = blo(zreg[it][k]), zb = bhi(zreg[it][k]); const float na = k < 2 ? n0[2 * k] : n1[2 * k - 4], nb = k < 2 ? n0[2 * k + 1] : n1[2 * k - 3];
                    res[k] = pk_bf16(o[2 * k] * rs * na * silu_f(za), o[2 * k + 1] * rs * nb * silu_f(zb)); }
                *(u32x4*)(MIX + tiled_off((int)(rowbase + t0 + t), 4096 + h * 128 + e8, MIXW)) = res; }
        }
    }
    {
        const int tid = opaque_tid(), w = tid >> 6, lane = tid & 63, r = lane & 15, q = lane >> 4, E = w * 16 + r;
        float* So = p.out + O_GDN_P + (size_t)(b * 32 + h) * 16384 + (4 * q) * 128 + E;
#pragma unroll
        for (int j = 0; j < 8; ++j)
#pragma unroll
            for (int reg = 0; reg < 4; ++reg) So[(16 * j + reg) * 128] = Sacc[j][reg];
    }
}

constexpr int SL_RAW = 0, SL_CA = 52224, SL_BA = 69632, SL_BAT = 87040, SL_XST = 105472, SL_CB = 123904, SL_TOK = 133120, SL_LAST = 135168, SL_YB = 135232, SL_WTS = 152640, SL_BIAS = 158784;
__device__ __forceinline__ void ssd_chunk_item(const Params& p, LAS unsigned char* lds, const int b, const int g, const int hp) {
    const bf16_t* P = (const bf16_t*)(p.ws + OFF_P); const float* G = (const float*)(p.ws + OFF_G32); float* Uo = (float*)(p.ws + OFF_U32);
    const bf16_t* zsrc = (const bf16_t*)(p.ws + OFF_XB) + (size_t)NTOK * DM;
    const int h0 = g * 8 + hp * 2;
    const size_t rowbase = (size_t)b * 2048;
    const int c0 = C_XBC + h0 * 64, c1 = C_XBC + 4096 + g * 128, c2 = C_XBC + 5120 + g * 128;
    f32x4 Hacc[8];
#pragma unroll
    for (int j = 0; j < 8; ++j) Hacc[j] = (f32x4){0.f, 0.f, 0.f, 0.f};
    float g_dtraw = 0.f, g_A = 0.f, g_dtb = 0.f;
    {
        const int tid = opaque_tid(), lane = tid & 63, w = __builtin_amdgcn_readfirstlane(tid >> 6);
        for (int i = tid; i < 1536 + 384; i += 512) {
            const int j = i / 384, cc = i - j * 384, sec = cc >> 7, col = cc & 127, ch = sec == 0 ? h0 * 64 + col : (sec == 1 ? 4096 + g * 128 + col : 5120 + g * 128 + col);
            if (j < 4) ((LAS float*)(lds + SL_WTS))[i] = p.ssd_conv_w[j * 6144 + ch]; else ((LAS float*)(lds + SL_BIAS))[cc] = p.ssd_conv_b[ch]; }
        dma_raw(lds + SL_RAW, P, zsrc, rowbase, 0, c0, c1, c2, w, lane);
        if (w < 2) { const int hh = h0 + w; g_dtraw = G[(rowbase + lane) * G_LD + hh]; g_A = -expf(p.ssd_a_log[hh]); g_dtb = p.ssd_dt_bias[hh]; }
    }
#pragma unroll 1
    for (int c = 0; c < 32; ++c) {
        const int t0 = c * 64;
        WAIT_VM0(); BAR_LDS();
        {
            const int tid = opaque_tid(), lane = tid & 63, w = tid >> 6;
            const LAS unsigned char* rawl = lds + SL_RAW + (8 * w) * 768 + lane * 4; const LAS float* wts = (const LAS float*)(lds + SL_WTS) + 2 * lane; const LAS float* bia = (const LAS float*)(lds + SL_BIAS) + 2 * lane;
#pragma unroll
            for (int sec = 0; sec < 3; ++sec) {
                f32x2v wj[4];
#pragma unroll
                for (int j = 0; j < 4; ++j) wj[j] = *(const LAS f32x2v*)(wts + j * 384 + sec * 128);
                const f32x2v bj = *(const LAS f32x2v*)(bia + sec * 128);
                float x0[11], x1[11];
#pragma unroll
                for (int rr = 0; rr < 11; ++rr) { const unsigned u = *(const LAS unsigned*)(rawl + rr * 768 + sec * 256); x0[rr] = blo(u); x1[rr] = bhi(u); }
                unsigned pk[8];
#pragma unroll
                for (int t = 0; t < 8; ++t) {
                    const float a0 = silu_f(bj[0] + wj[0][0] * x0[t] + wj[1][0] * x0[t + 1] + wj[2][0] * x0[t + 2] + wj[3][0] * x0[t + 3]);
                    const float a1 = silu_f(bj[1] + wj[0][1] * x1[t] + wj[1][1] * x1[t + 1] + wj[2][1] * x1[t + 2] + wj[3][1] * x1[t + 3]);
                    pk[t] = pk_bf16(a0, a1);
                    if (sec >= 1) *(LAS unsigned*)(lds + (sec == 1 ? SL_BA : SL_CA) + ((8 * w + t) * 136 + 2 * lane) * 2) = pk[t];
                }
                if (sec <= 1) {
                    u32x4 ke, ko;
#pragma unroll
                    for (int t2 = 0; t2 < 4; ++t2) { ke[t2] = (pk[2 * t2] & 0xffffu) | (pk[2 * t2 + 1] << 16); ko[t2] = (pk[2 * t2] >> 16) | (pk[2 * t2 + 1] & 0xffff0000u); }
                    *(LAS u32x4*)(lds + (sec == 0 ? SL_XST : SL_BAT) + ((2 * lane) * 72 + 8 * w) * 2) = ke; *(LAS u32x4*)(lds + (sec == 0 ? SL_XST : SL_BAT) + ((2 * lane + 1) * 72 + 8 * w) * 2) = ko;
                }
            }
            if (c == 31 && w == 7) {
                float* convout = p.out + O_SSDC_P + (size_t)b * 3 * 6144 + 2 * lane;
#pragma unroll
                for (int j = 0; j < 3; ++j)
#pragma unroll
                    for (int sec = 0; sec < 3; ++sec) { if (sec == 0 || hp == 0) { const unsigned u = *(const LAS unsigned*)(lds + SL_RAW + ((64 + j) * 3 + sec) * 256 + lane * 4);
                        *(f32x2v*)(convout + j * 6144 + (sec == 0 ? h0 * 64 : (sec == 1 ? 4096 + g * 128 : 5120 + g * 128))) = (f32x2v){blo(u), bhi(u)}; } }
            }
        }
        BAR_LDS();
        {
            const int tid = opaque_tid(), lane = tid & 63, r = lane & 15, q = lane >> 4, w = __builtin_amdgcn_readfirstlane(tid >> 6);
            if (c < 31) dma_raw(lds + SL_RAW, P, zsrc, rowbase, t0 + 64, c0, c1, c2, w, lane);
            if (w < 2) {
                const float dt = softplus_f(g_dtraw + g_dtb);
                if (c < 31) g_dtraw = G[(rowbase + t0 + 64 + lane) * G_LD + h0 + w];
                float cs = g_A * dt;
#pragma unroll
                for (int d = 1; d < 64; d <<= 1) { const float n = __shfl_up(cs, d); if (lane >= d) cs += n; }
                ((LAS f32x2v*)(lds + SL_TOK))[w * 64 + lane] = (f32x2v){dt, cs}; if (lane == 63) ((LAS float*)(lds + SL_LAST))[w] = cs;
            } else {
#pragma unroll 1
                for (int job = w - 2; job < 10; job += 6) {
                    const int ti = job >= 6 ? 3 : (job >= 3 ? 2 : (job >= 1 ? 1 : 0)), si = job - (ti * (ti + 1)) / 2;
                    const LAS bf16_t* Ab = (const LAS bf16_t*)(lds + SL_CA) + (ti * 16 + r) * 136 + 8 * q; const LAS bf16_t* Bb = (const LAS bf16_t*)(lds + SL_BA) + (si * 16 + r) * 136 + 8 * q;
                    f32x4 acc = (f32x4){0.f, 0.f, 0.f, 0.f};
#pragma unroll
                    for (int kk = 0; kk < 4; ++kk) acc = MFMA16(*(const LAS bf16x8*)(Ab + kk * 32), *(const LAS bf16x8*)(Bb + kk * 32), acc);
                    LAS bf16_t* dst = (LAS bf16_t*)(lds + SL_CB) + (ti * 16 + 4 * q) * 72 + si * 16 + r;
#pragma unroll
                    for (int reg = 0; reg < 4; ++reg) dst[reg * 72] = (bf16_t)(pk_bf16(acc[reg], 0.f) & 0xffffu);
                }
            }
        }
        BAR_LDS();
        u32x4 zreg[2];
        {
            const int tid = opaque_tid();
#pragma unroll
            for (int it = 0; it < 2; ++it) { const int idx = tid + it * 512; zreg[it] = *(const u32x4*)(P + (rowbase + t0 + (idx >> 4)) * P_LD + C_ZS + h0 * 64 + (idx & 15) * 8); }
        }
        {
            const int tid = opaque_tid(), w = tid >> 6, lane = tid & 63, r = lane & 15, q = lane >> 4, hl = w >> 2, Pc = (w & 3) * 16 + r;
            const float Dh = p.ssd_d[h0 + hl];
            const LAS f32x2v* tk = (const LAS f32x2v*)(lds + SL_TOK) + hl * 64; const float last = ((const LAS float*)(lds + SL_LAST))[hl];
            const LAS bf16_t* XsP = (const LAS bf16_t*)(lds + SL_XST) + (hl * 64 + Pc) * 72;
            const LAS bf16_t* CaR = (const LAS bf16_t*)(lds + SL_CA) + r * 136 + 4 * q; const LAS bf16_t* CbR = (const LAS bf16_t*)(lds + SL_CB) + r * 72 + 8 * q;
            const LAS bf16_t* BtR = (const LAS bf16_t*)(lds + SL_BAT) + r * 72 + 8 * q;
            LAS bf16_t* ybE = (LAS bf16_t*)(lds + SL_YB) + (4 * q) * 136 + hl * 64 + Pc;
            bf16x8 Hb[4];
#pragma unroll
            for (int kp = 0; kp < 4; ++kp) Hb[kp] = pack2(Hacc[2 * kp], Hacc[2 * kp + 1]);
            bf16x8 xf[2], xw[2];
#pragma unroll
            for (int kp = 0; kp < 2; ++kp) { const u32x4 xv = *(const LAS u32x4*)(XsP + 32 * kp + 8 * q); xf[kp] = __builtin_bit_cast(bf16x8, xv);
                u32x4 xs;
#pragma unroll
                for (int e2 = 0; e2 < 4; ++e2) { const f32x2v ta = tk[32 * kp + 8 * q + 2 * e2], tb = tk[32 * kp + 8 * q + 2 * e2 + 1];
                    xs[e2] = pk_bf16(blo(xv[e2]) * (ta[0] * __expf(last - ta[1])), bhi(xv[e2]) * (tb[0] * __expf(last - tb[1]))); }
                xw[kp] = __builtin_bit_cast(bf16x8, xs); }
#pragma unroll
            for (int i = 0; i < 4; ++i) {
                f32x4 acc = (f32x4){0.f, 0.f, 0.f, 0.f};
#pragma unroll
                for (int kp = 0; kp < 4; ++kp) acc = MFMA16(LDP(CaR, 16 * i * 136 + 32 * kp), Hb[kp], acc);
#pragma unroll
                for (int reg = 0; reg < 4; ++reg) acc[reg] *= __expf(tk[16 * i + 4 * q + reg][1]);
                const int t = 16 * i + r; const float cum_t = tk[t][1];
#pragma unroll
                for (int kp = 0; kp < 2; ++kp) { if (kp <= (i >> 1)) {
                    const u32x4 cbv = *(const LAS u32x4*)(CbR + 16 * i * 72 + 32 * kp);
                    float lv[8];
#pragma unroll
                    for (int jj = 0; jj < 8; ++jj) { const int s = 32 * kp + 8 * q + jj; const f32x2v ts = tk[s]; const float cb = (jj & 1) ? bhi(cbv[jj >> 1]) : blo(cbv[jj >> 1]);
                        lv[jj] = s <= t ? cb * __expf(cum_t - ts[1]) * ts[0] : 0.f; }
                    const u32x4 lw = (u32x4){pk_bf16(lv[0], lv[1]), pk_bf16(lv[2], lv[3]), pk_bf16(lv[4], lv[5]), pk_bf16(lv[6], lv[7])};
                    acc = MFMA16(__builtin_bit_cast(bf16x8, lw), xf[kp], acc); } }
                const u32x2 xd = *(const LAS u32x2*)(XsP + 16 * i + 4 * q);
                acc[0] += blo(xd[0]) * Dh; acc[1] += bhi(xd[0]) * Dh; acc[2] += blo(xd[1]) * Dh; acc[3] += bhi(xd[1]) * Dh;
#pragma unroll
                for (int reg = 0; reg < 4; ++reg) ybE[(16 * i + reg) * 136] = (bf16_t)(pk_bf16(acc[reg], 0.f) & 0xffffu);
            }
            const float el = __expf(last);
#pragma unroll
            for (int j = 0; j < 8; ++j) { f32x4 acc = Hacc[j] * el;
                acc = MFMA16(*(const LAS bf16x8*)(BtR + 16 * j * 72), xw[0], acc); acc = MFMA16(*(const LAS bf16x8*)(BtR + 16 * j * 72 + 32), xw[1], acc);
                Hacc[j] = acc; }
        }
        BAR_LDS();
        {
            const int tid = opaque_tid();
#pragma unroll
            for (int it = 0; it < 2; ++it) { const int idx = tid + it * 512, t = idx >> 4, e8 = (idx & 15) * 8;
                const u32x4 yv = *(const LAS u32x4*)(lds + SL_YB + (t * 136 + e8) * 2);
                f32x4 o0, o1;
                o0[0] = blo(yv[0]) * silu_f(blo(zreg[it][0])); o0[1] = bhi(yv[0]) * silu_f(bhi(zreg[it][0])); o0[2] = blo(yv[1]) * silu_f(blo(zreg[it][1])); o0[3] = bhi(yv[1]) * silu_f(bhi(zreg[it][1]));
                o1[0] = blo(yv[2]) * silu_f(blo(zreg[it][2])); o1[1] = bhi(yv[2]) * silu_f(bhi(zreg[it][2])); o1[2] = blo(yv[3]) * silu_f(blo(zreg[it][3])); o1[3] = bhi(yv[3]) * silu_f(bhi(zreg[it][3]));
                float* up = Uo + (rowbase + t0 + t) * DM + h0 * 64 + e8; *(f32x4*)up = o0; *(f32x4*)(up + 4) = o1; }
        }
    }
    {
        const int tid = opaque_tid(), w = tid >> 6, lane = tid & 63, r = lane & 15, q = lane >> 4, hl = w >> 2, Pc = (w & 3) * 16 + r;
        float* Ho = p.out + O_SSD_P + ((size_t)(b * 64 + h0 + hl) * 64 + Pc) * 128 + 4 * q;
#pragma unroll
        for (int j = 0; j < 8; ++j) *(f32x4*)(Ho + 16 * j) = Hacc[j];
    }
}

__device__ __forceinline__ void phase_scan(const Params& p, LAS unsigned char* lds, const int qword = QCTR_WORD, const int item0 = 0, const int item_end = N_ITEMS) {
    LAS int* qslot = (LAS int*)(lds + LDS_MISC + 16);
    unsigned* qctr = (unsigned*)(p.ws + OFF_BAR) + qword;
    for (;;) {
        __syncthreads();
        if (threadIdx.x == 0) *qslot = item0 + (int)__hip_atomic_fetch_add(qctr, 1u, __ATOMIC_RELAXED, __HIP_MEMORY_SCOPE_AGENT);
        __syncthreads();
        const int item = __builtin_amdgcn_readfirstlane(*qslot);
        if (item >= item_end) break;
        if (item < N_GDN_P) gdn_chunk_item(p, lds, item >> 5, item & 31);
        else if (item < N_GDN_P + N_SSD_P) { const int i = item - N_GDN_P; ssd_chunk_item(p, lds, i >> 5, (i >> 2) & 7, i & 3); }
        else if (item < N_GDN_P + N_SSD_P + N_GDN_S) { const int i = item - N_GDN_P - N_SSD_P; gdn_item<true>(p, lds, i >> 5, i & 31); }
        else { const int i = item - N_GDN_P - N_SSD_P - N_GDN_S; ssd_item<true>(p, lds, i >> 6, i & 63); }
    }
}

__device__ __forceinline__ void phase_outproj_sample(const Params& p, LAS unsigned char* lds) {
    const int tid = threadIdx.x, wid = __builtin_amdgcn_readfirstlane(tid >> 6), lane = tid & 63, wr = wid >> 2, wc = wid & 3, fr = lane & 15, fq = lane >> 4;
    const int aoff = pg8::lds_byte(wr * 64 + fr, fq * 8), boff = pg8::lds_byte((wc & 1) * 64 + fr, fq * 8) + 16384 + (wc >> 1) * 16384;
    for (int u = blockIdx.x; u < 256; u += gridDim.x) {
        const int pn = u & 15, ks = u >> 4;
        const char* gA = (const char*)(p.ws + OFF_MIX) + ((size_t)64 * 128 + ks * 8) * 16384;
        const char* gB0 = (const char*)(p.ws + OFF_WOB) + ((size_t)(2 * pn) * 128 + ks * 8) * 16384; const char* gB1 = gB0 + (size_t)128 * 16384;
#define OS_ISSUE(kt, st) do { _Pragma("unroll") for (int pc = 0; pc < 6; ++pc) { const char* s_ = (pc < 2 ? gA : (pc < 4 ? gB0 : gB1)) + (size_t)(kt) * 16384 + (pc & 1) * 8192 + tid * 16; \
            __builtin_amdgcn_global_load_lds((const unsigned*)s_, (LAS unsigned*)(lds + (st) * 49152 + pc * 8192 + wid * 1024), 16, 0, 0); } } while (0)
        f32x4 acc[4][4];
#pragma unroll
        for (int m = 0; m < 4; ++m)
#pragma unroll
            for (int n = 0; n < 4; ++n) acc[m][n] = (f32x4){0.f, 0.f, 0.f, 0.f};
        OS_ISSUE(0, 0); OS_ISSUE(1, 1); OS_ISSUE(2, 2);
#pragma unroll
        for (int kt = 0; kt < 8; ++kt) {
            if (kt <= 5) asm volatile("s_waitcnt vmcnt(12)" ::: "memory"); else if (kt == 6) asm volatile("s_waitcnt vmcnt(6)" ::: "memory"); else asm volatile("s_waitcnt vmcnt(0)" ::: "memory");
            __builtin_amdgcn_s_barrier(); asm volatile("" ::: "memory");
            const LAS unsigned char* sb = lds + (kt % 3) * 49152;
            bf16x8 af[4][2], bfr[4][2];
#pragma unroll
            for (int m = 0; m < 4; ++m)
#pragma unroll
                for (int k = 0; k < 2; ++k) { af[m][k] = *(const LAS bf16x8*)(sb + aoff + m * 2048 + k * 1024); bfr[m][k] = *(const LAS bf16x8*)(sb + boff + m * 2048 + k * 1024); }
#pragma unroll
            for (int m = 0; m < 4; ++m)
#pragma unroll
                for (int n = 0; n < 4; ++n)
#pragma unroll
                    for (int k = 0; k < 2; ++k) acc[m][n] = __builtin_amdgcn_mfma_f32_16x16x32_bf16(bfr[n][k], af[m][k], acc[m][n], 0, 0, 0);
            asm volatile("s_waitcnt lgkmcnt(0)" ::: "memory"); __builtin_amdgcn_s_barrier(); asm volatile("" ::: "memory");
            if (kt + 3 < 8) OS_ISSUE(kt + 3, kt % 3);
        }
#undef OS_ISSUE
        float* Rp = (float*)(p.ws + OFF_RPART) + ((size_t)ks * NTS + wr * 64 + fr) * DM + pn * 256 + wc * 64 + 4 * fq;
#pragma unroll
        for (int m = 0; m < 4; ++m)
#pragma unroll
            for (int n = 0; n < 4; ++n) *(f32x4*)(Rp + (size_t)(m * 16) * DM + n * 16) = acc[m][n];
    }
    __syncthreads();
}

__device__ __forceinline__ void phase_ssdnorm(const Params& p) {
    const float* U = (const float*)(p.ws + OFF_U32); bf16_t* MIX = (bf16_t*)(p.ws + OFF_MIX);
    const int lane = threadIdx.x & 63, gw = blockIdx.x * 8 + (threadIdx.x >> 6), nw = gridDim.x * 8;
    for (int it = gw; it < NTOK * 8; it += nw) {
        const int row = it >> 3, g = it & 7; const size_t off = (size_t)row * DM + g * 512 + lane * 8;
        const f32x4 a = *(const f32x4*)(U + off), b = *(const f32x4*)(U + off + 4);
        const float ss = wave_sum(a[0] * a[0] + a[1] * a[1] + a[2] * a[2] + a[3] * a[3] + b[0] * b[0] + b[1] * b[1] + b[2] * b[2] + b[3] * b[3]);
        const float rs = rsqrtf(ss * (1.f / 512.f) + 1e-6f);
        const f32x4 wa = *(const f32x4*)(p.ssd_norm_w + g * 512 + lane * 8), wb = *(const f32x4*)(p.ssd_norm_w + g * 512 + lane * 8 + 4);
        u32x4 o; o[0] = cvt_pk_bf16(a[0] * rs * wa[0], a[1] * rs * wa[1]); o[1] = cvt_pk_bf16(a[2] * rs * wa[2], a[3] * rs * wa[3]);
        o[2] = cvt_pk_bf16(b[0] * rs * wb[0], b[1] * rs * wb[1]); o[3] = cvt_pk_bf16(b[2] * rs * wb[2], b[3] * rs * wb[3]);
        *(u32x4*)(MIX + tiled_off(row, g * 512 + lane * 8, MIXW)) = o;
    }
}

__device__ __forceinline__ void phase_ln(const Params& p) {
    const float* R = (const float*)(p.ws + OFF_R);
    const int lane = threadIdx.x & 63, gw = blockIdx.x * 8 + (threadIdx.x >> 6), nw = gridDim.x * 8;
    for (int row = gw; row < NTOK; row += nw) {
        const float* rr = R + (size_t)row * DM;
        f32x4 v[16]; float sum = 0.f;
        if (row < NTP) {
#pragma unroll
            for (int i = 0; i < 16; ++i) v[i] = *(const f32x4*)(rr + (i * 64 + lane) * 4);
        } else {
            const float* xr = p.x_sample + (size_t)(row - NTP) * DM; const float* pr = (const float*)(p.ws + OFF_RPART) + (size_t)(row - NTP) * DM;
#pragma unroll
            for (int i = 0; i < 16; ++i) v[i] = ALPHA * *(const f32x4*)(xr + (i * 64 + lane) * 4);
#pragma unroll 1
            for (int ks = 0; ks < 16; ++ks) {
#pragma unroll
                for (int i = 0; i < 16; ++i) v[i] += *(const f32x4*)(pr + (size_t)ks * NTS * DM + (i * 64 + lane) * 4); }
        }
#pragma unroll
        for (int i = 0; i < 16; ++i) sum += v[i][0] + v[i][1] + v[i][2] + v[i][3];
        const float mu = wave_sum(sum) * (1.f / 4096.f);
        float sq = 0.f;
#pragma unroll
        for (int i = 0; i < 16; ++i) { v[i] = v[i] - mu; sq += v[i][0] * v[i][0] + v[i][1] * v[i][1] + v[i][2] * v[i][2] + v[i][3] * v[i][3]; }
        const float rs = rsqrtf(wave_sum(sq) * (1.f / 4096.f) + 1e-5f);
        float* o = p.out + (row < NTP ? O_YP + (size_t)row * DM : O_YS + (size_t)(row - NTP) * DM);
#pragma unroll
        for (int i = 0; i < 16; ++i) { const int c = (i * 64 + lane) * 4; const f32x4 gg = *(const f32x4*)(p.ln_g + c), bb = *(const f32x4*)(p.ln_b + c);
            *(f32x4*)(o + c) = v[i] * rs * gg + bb; }
    }
}

template <int PH>
__global__ __launch_bounds__(512, 2) void mk_fwd(Params p) {
    extern __shared__ __attribute__((aligned(16))) unsigned char smem[];
    LAS unsigned char* lds = (LAS unsigned char*)smem;
    XcdBarrier bar;
    if (PH < 0) {
        if (threadIdx.x == 0) *(LAS u32x4*)(lds + LDS_MISC) = (u32x4){0u, 0u, 0u, 0u};
        __syncthreads();
        bar = xcd_barrier_post((unsigned*)(p.ws + OFF_BAR), (volatile LAS unsigned*)(lds + LDS_MISC));
    }
    if (PH < 0 || PH == 0) { phase_convert(p, lds); if (PROBE_REP == 1) { __syncthreads(); phase_convert(p, lds); } }
    if (PH < 0) xcd_barrier(bar);
    if (PH < 0 || PH == 1) {
        pg8::Gemm g{(const bf16_t*)(p.ws + OFF_XB), (const bf16_t*)(p.ws + OFF_WB), MPAD, NPAD, DM};
        pg8::StaticOrder S; S.init(MPAD, NPAD, (int)gridDim.x, (int)blockIdx.x, true);
        pg8::EpiProj E{(bf16_t*)(p.ws + OFF_P), (float*)(p.ws + OFF_G32)};
        pg8::gemm_phase<pg8::EpiProj, pg8::StaticOrder, true, true>(lds, g, S, E);
        if (PROBE_REP == 2) { __syncthreads(); pg8::gemm_phase<pg8::EpiProj, pg8::StaticOrder, true, true>(lds, g, S, E); }
    }
    if (PH < 0) xcd_barrier(bar);
    if (PH < 0 || PH == 2) { phase_scan(p, lds); if (PROBE_REP == 3) phase_scan(p, lds, QCTR_WORD + 64, 0); if (PROBE_REP == 4) phase_scan(p, lds, QCTR_WORD + 64, N_GDN_P + N_SSD_P); if (PROBE_REP == 6) phase_scan(p, lds, QCTR_WORD + 64, 0, N_GDN_P); if (PROBE_REP == 7) phase_scan(p, lds, QCTR_WORD + 64, N_GDN_P, N_GDN_P + N_SSD_P); }
    if (PH < 0) xcd_barrier(bar);
    if (PH < 0 || PH == 3) phase_ssdnorm(p);
    if (PH < 0) xcd_barrier(bar);
    if (PH < 0 || PH == 4) {
        phase_outproj_sample(p, lds);
        pg8::Gemm g{(const bf16_t*)(p.ws + OFF_MIX), (const bf16_t*)(p.ws + OFF_WOB), NTP, DM, MIXW};
        pg8::StaticOrder S; S.init(NTP, DM, (int)gridDim.x, (int)blockIdx.x);
        pg8::EpiOut E{(float*)(p.ws + OFF_R), p.x_prompt, p.x_sample};
        pg8::gemm_phase<pg8::EpiOut, pg8::StaticOrder, true, true>(lds, g, S, E);
        if (PROBE_REP == 5) { __syncthreads(); pg8::gemm_phase<pg8::EpiOut, pg8::StaticOrder, true, true>(lds, g, S, E); }
    }
    if (PH < 0) xcd_barrier(bar);
    if (PH < 0 || PH == 5) phase_ln(p);
}

template <int PH> static void launch_phase(const Params& p, int grid, hipStream_t stream) {
    static bool attr = false;
    if (!attr) { (void)hipFuncSetAttribute((const void*)mk_fwd<PH>, hipFuncAttributeMaxDynamicSharedMemorySize, LDS_BYTES); attr = true; }
    hipLaunchKernelGGL((mk_fwd<PH>), dim3(grid), dim3(512), LDS_BYTES, stream, p);
}

extern "C" void kernel_launch(void* const* d_in, const int* in_sizes, int n_in, void* d_out, int out_size, void* d_ws, size_t ws_size, hipStream_t stream) {
    (void)in_sizes; (void)n_in; (void)out_size;
    if (ws_size < WS_END) { fprintf(stderr, "workspace too small: %zu < %zu\n", ws_size, (size_t)WS_END); return; }
    Params p{};
    p.x_prompt = (const float*)d_in[0]; p.x_sample = (const float*)d_in[1]; p.state_ssd = (const float*)d_in[2]; p.state_ssd_conv = (const float*)d_in[3];
    p.state_gdn = (const float*)d_in[4]; p.state_gdn_conv = (const float*)d_in[5]; p.w_in = (const float*)d_in[6]; p.ssd_conv_w = (const float*)d_in[7];
    p.ssd_conv_b = (const float*)d_in[8]; p.ssd_dt_bias = (const float*)d_in[9]; p.ssd_a_log = (const float*)d_in[10]; p.ssd_d = (const float*)d_in[11];
    p.ssd_norm_w = (const float*)d_in[12]; p.gdn_conv_w = (const float*)d_in[13]; p.gdn_dt_bias = (const float*)d_in[14]; p.gdn_a_log = (const float*)d_in[15];
    p.gdn_norm_w = (const float*)d_in[16]; p.w_out = (const float*)d_in[17]; p.ln_g = (const float*)d_in[18]; p.ln_b = (const float*)d_in[19];
    p.out = (float*)d_out; p.ws = (unsigned char*)d_ws;
    static int grid = 0;
    if (!grid) { int dev = 0, cus = 0; (void)hipGetDevice(&dev); (void)hipDeviceGetAttribute(&cus, hipDeviceAttributeMultiprocessorCount, dev); grid = cus > 0 ? cus : 256; }
    (void)hipMemsetAsync(d_ws, 0, 16384, stream);
#if MK_FUSED
    launch_phase<-1>(p, grid, stream);
#else
    launch_phase<0>(p, grid, stream); launch_phase<1>(p, grid, stream); launch_phase<2>(p, grid, stream);
    launch_phase<3>(p, grid, stream); launch_phase<4>(p, grid, stream); launch_phase<5>(p, grid, stream);
#endif
}
```

```cpp
#include <hip/hip_runtime.h>
#include <cstdio>
#include <cstdint>

#ifndef PROBE_REP
#define PROBE_REP 0
#endif
#ifndef MK_FUSED
#define MK_FUSED 1
#endif

#define LAS __attribute__((address_space(3)))
typedef unsigned short bf16_t;
typedef short bf16x8 __attribute__((ext_vector_type(8)));
typedef float f32x4 __attribute__((ext_vector_type(4)));
typedef float f32x2v __attribute__((ext_vector_type(2)));
typedef unsigned u32x4 __attribute__((ext_vector_type(4)));
typedef unsigned u32x2 __attribute__((ext_vector_type(2)));

constexpr int DM = 4096, NTP = 8192, NTS = 128, NTOK = 8320, MPAD = 8448;
constexpr int NPROJ = 26752, P_LD = 26624, NPAD = 26880, MIXW = 8192, G_LD = 256;
constexpr int C_ZS = 0, C_XBC = 4096, C_QKV = 10240, C_ZG = 22528;
constexpr float ALPHA = 1.189207115002721f;
constexpr int LDS_BYTES = 163840;
constexpr int LDS_MISC = LDS_BYTES - 64;

constexpr size_t OFF_BAR = 0;
constexpr size_t OFF_XB  = 16384;
constexpr size_t OFF_WB  = OFF_XB  + (size_t)MPAD * DM * 2;
constexpr size_t OFF_WOB = OFF_WB  + (size_t)NPAD * DM * 2;
constexpr size_t OFF_P   = OFF_WOB + (size_t)DM * MIXW * 2;
constexpr size_t OFF_G32 = OFF_P   + (size_t)MPAD * P_LD * 2;
constexpr size_t OFF_MIX = OFF_G32 + (size_t)MPAD * G_LD * 4;
constexpr size_t OFF_U32 = OFF_MIX + (size_t)MPAD * MIXW * 2;
constexpr size_t OFF_R   = OFF_U32 + (size_t)MPAD * DM * 4;
constexpr size_t OFF_RPART = OFF_R + (size_t)MPAD * DM * 4;
constexpr size_t OFF_SF  = OFF_RPART + (size_t)16 * NTS * DM * 4;
constexpr size_t WS_END  = OFF_SF + (size_t)16 * 1024 * 1024;
constexpr int QCTR_WORD = 3584;

constexpr size_t O_YP = 0;
constexpr size_t O_YS = O_YP + (size_t)NTP * DM;
constexpr size_t O_SSD_P = O_YS + (size_t)NTS * DM;
constexpr size_t O_SSDC_P = O_SSD_P + (size_t)4 * 64 * 64 * 128;
constexpr size_t O_GDN_P = O_SSDC_P + (size_t)4 * 3 * 6144;
constexpr size_t O_GDNC_P = O_GDN_P + (size_t)4 * 32 * 128 * 128;
constexpr size_t O_SSD_S = O_GDNC_P + (size_t)4 * 3 * 12288;
constexpr size_t O_SSDC_S = O_SSD_S + (size_t)128 * 64 * 64 * 128;
constexpr size_t O_GDN_S = O_SSDC_S + (size_t)128 * 3 * 6144;
constexpr size_t O_GDNC_S = O_GDN_S + (size_t)128 * 32 * 128 * 128;

struct Params {
    const float* x_prompt; const float* x_sample; const float* state_ssd; const float* state_ssd_conv; const float* state_gdn; const float* state_gdn_conv;
    const float* w_in; const float* ssd_conv_w; const float* ssd_conv_b; const float* ssd_dt_bias; const float* ssd_a_log; const float* ssd_d; const float* ssd_norm_w;
    const float* gdn_conv_w; const float* gdn_dt_bias; const float* gdn_a_log; const float* gdn_norm_w; const float* w_out; const float* ln_g; const float* ln_b;
    float* out; unsigned char* ws;
};

__device__ __forceinline__ unsigned cvt_pk_bf16(float lo, float hi) { unsigned r; asm volatile("v_cvt_pk_bf16_f32 %0, %1, %2" : "=v"(r) : "v"(lo), "v"(hi)); return r; }
__device__ __forceinline__ float bf2f(bf16_t v) { return __uint_as_float(((unsigned)v) << 16); }
__device__ __forceinline__ bf16_t f2bf(float f) { unsigned u = __float_as_uint(f); u += 0x7FFFu + ((u >> 16) & 1u); return (bf16_t)(u >> 16); }
__device__ __forceinline__ float silu_f(float x) { return x / (1.f + __expf(-x)); }
__device__ __forceinline__ float sigmoid_f(float x) { return 1.f / (1.f + __expf(-x)); }
__device__ __forceinline__ float softplus_f(float x) { return x > 20.f ? x : log1pf(expf(x)); }
__device__ __forceinline__ f32x4 ldbf4(const bf16_t* p) { const u32x2 v = *(const u32x2*)p; f32x4 r; r[0] = __uint_as_float(v[0] << 16); r[1] = __uint_as_float(v[0] & 0xffff0000u); r[2] = __uint_as_float(v[1] << 16); r[3] = __uint_as_float(v[1] & 0xffff0000u); return r; }
__device__ __forceinline__ int opaque_tid() { int t = threadIdx.x; asm volatile("" : "+v"(t)); return t; }
__device__ __forceinline__ size_t tiled_off(int row, int col, int K) {
    const int r = row & 127, c = col & 63, st = (r >> 4) * 2 + (c >> 5), ob = (r & 15) * 64 + (c & 31) * 2;
    return ((size_t)(row >> 7) * (K >> 6) + (col >> 6)) * 8192 + ((st * 1024 + (ob ^ (((ob >> 9) & 1) << 5))) >> 1);
}
__device__ __forceinline__ float wave_sum(float v) {
#pragma unroll
    for (int m = 32; m >= 1; m >>= 1) v += __shfl_xor(v, m);
    return v;
}

#define XB_TMO      128
#define XB_XCNT(j)  (256  + 64 * (j))
#define XB_XSUB(j)  (1280 + 64 * (j))
#define XB_XGEN(j)  (2304 + 64 * (j))
#define XB_TOP      3328
#define XB_TOPGEN   3392
#define XCD_BAR_WORDS 3456
#define XB_SPIN_CAP (1u << 18)
__device__ __forceinline__ unsigned xb_ld(unsigned* p)              { return __hip_atomic_load(p, __ATOMIC_RELAXED, __HIP_MEMORY_SCOPE_AGENT); }
__device__ __forceinline__ unsigned xb_add(unsigned* p, unsigned v) { return __hip_atomic_fetch_add(p, v, __ATOMIC_RELAXED, __HIP_MEMORY_SCOPE_AGENT); }
__device__ __forceinline__ unsigned xb_xcc_id() { return (unsigned)__builtin_amdgcn_s_getreg((3 << 11) | 20) & 0xFu; }
#define XB_SPIN(cond, bar) do { unsigned _sp = 0; while (cond) { __builtin_amdgcn_s_sleep(1); \
    if ((++_sp & 255u) == 0u) { if (xb_ld(&(bar)[XB_TMO])) break; if (_sp > XB_SPIN_CAP) { atomicAdd(&(bar)[XB_TMO], 1u); break; } } } } while (0)
struct XcdBarrier { unsigned* bar; unsigned x; volatile LAS unsigned* st; };
__device__ __forceinline__ XcdBarrier xcd_barrier_post(unsigned* bar, volatile LAS unsigned* st) {
    XcdBarrier b; b.bar = bar; b.x = xb_xcc_id(); b.st = st;
    if (threadIdx.x == 0) (void)xb_add(&bar[XB_XCNT(b.x)], 1u);
    return b;
}
__device__ __forceinline__ void xcd_barrier_complete(unsigned* bar, unsigned x, unsigned& nloc, unsigned& nx) {
    const unsigned G = gridDim.x * gridDim.y * gridDim.z;
    unsigned sum, cnt, mine, sp = 0u;
    for (;;) {
        sum = 0u; cnt = 0u; mine = 0u;
#pragma unroll
        for (unsigned j = 0; j < 16; ++j) { const unsigned c = xb_ld(&bar[XB_XCNT(j)]); sum += c; cnt += (c > 0u) ? 1u : 0u; mine = (j == x) ? c : mine; }
        if (sum == G) break;
        __builtin_amdgcn_s_sleep(1);
        if ((++sp & 255u) == 0u) { if (xb_ld(&bar[XB_TMO])) break; if (sp > XB_SPIN_CAP) { atomicAdd(&bar[XB_TMO], 1u); break; } }
    }
    nloc = mine > 0u ? mine : 1u; nx = cnt > 0u ? cnt : 1u;
}
__device__ __forceinline__ void xcd_barrier(const XcdBarrier& b) {
    asm volatile("s_waitcnt vmcnt(0)" ::: "memory");
    __syncthreads();
    if (threadIdx.x == 0) {
        unsigned* bar = b.bar;
        __builtin_amdgcn_s_waitcnt(0);
        unsigned nloc = b.st[0], nx = b.st[1];
        if (nloc == 0u) { xcd_barrier_complete(bar, b.x, nloc, nx); b.st[0] = nloc; b.st[1] = nx; }
        const unsigned old = xb_add(&bar[XB_XSUB(b.x)], 1u);
        const unsigned gen = old / nloc;
        if (old + 1u == (gen + 1u) * nloc) {
            __builtin_amdgcn_fence(__ATOMIC_RELEASE, "agent");
            asm volatile("s_waitcnt vmcnt(0)" ::: "memory");
            const unsigned og = xb_add(&bar[XB_TOP], 1u);
            const unsigned tg = og / nx;
            if (og + 1u == (tg + 1u) * nx) xb_add(&bar[XB_TOPGEN], 1u);
            else XB_SPIN(xb_ld(&bar[XB_TOPGEN]) == tg, bar);
            __builtin_amdgcn_fence(__ATOMIC_ACQUIRE, "agent");
            xb_add(&bar[XB_XGEN(b.x)], 1u);
            asm volatile("s_waitcnt vmcnt(0)" ::: "memory");
        } else {
            XB_SPIN(xb_ld(&bar[XB_XGEN(b.x)]) == gen, bar);
            __builtin_amdgcn_fence(__ATOMIC_ACQUIRE, "agent");
            asm volatile("s_waitcnt vmcnt(0)" ::: "memory");
        }
    }
    __syncthreads();
}

namespace pg8 {
constexpr int BM = 256, BK = 64, HALF = 128, HTB = HALF * BK * 2, STAGE_BYTES = 8 * HTB, NXCD = 8, WGM = 8;
__host__ __device__ __forceinline__ int lds_byte(int r, int c) { const int st = (r >> 4) * 2 + (c >> 5), rr = r & 15, cc = c & 31, ob = rr * 64 + cc * 2; return st * 1024 + (ob ^ (((ob >> 9) & 1) << 5)); }
__host__ __device__ __forceinline__ void stage_rc(int b, int& R, int& C) { const int st = b / 1024, sb = b % 1024, swz = sb ^ (((sb >> 9) & 1) << 5); R = (st >> 1) * 16 + swz / 64; C = (st & 1) * 32 + (swz % 64) / 2; }
__host__ __device__ __forceinline__ int perm32(int rho) { const int n = rho >> 4, i = rho & 15; return 8 * (i >> 2) + 4 * n + (i & 3); }
struct Unit { int pm, pn; };
struct Gemm { const bf16_t* A; const bf16_t* Bt; int M, N, K; };
struct StaticOrder {
    int nM, nN, nwg, G, c; bool swapmn;
    __host__ __device__ void init(int M, int N, int G_, int c_, bool sw = false) { swapmn = sw; nM = (sw ? N : M) / BM; nN = (sw ? M : N) / BM; nwg = nM * nN; G = G_; c = c_; }
    __host__ __device__ bool next(int i, Unit& u) const {
        const long L = (long)i * G + c; if (L >= nwg) return false;
        int wgid = (int)L; { const int q = nwg / NXCD, r = nwg % NXCD, xcd = wgid % NXCD, off = wgid / NXCD; wgid = (xcd < r ? xcd * (q + 1) : r * (q + 1) + (xcd - r) * q) + off; }
        const int nig = WGM * nN, gid = wgid / nig, fm = gid * WGM, gsz = (nM - fm) < WGM ? (nM - fm) : WGM;
        const int a = fm + ((wgid % nig) % gsz), b = (wgid % nig) / gsz;
        u.pm = swapmn ? b : a; u.pn = swapmn ? a : b; return true;
    }
    __device__ __forceinline__ void a_ready(const Unit&) const {}
    __device__ __forceinline__ void done(const Unit&) const {}
};

struct EpiProj {
    static constexpr bool PERM = true, AFTER_DRAIN = false;
    bf16_t* P; float* G;
    __device__ __forceinline__ void operator()(const f32x4 (&acc)[2][2][4][2], const Unit& u, int wr, int wc, int fr, int fq) const {
        const int row0 = u.pm * BM + wr * 64 + fr;
        if (u.pn < 104) {
            const int col0 = u.pn * BM + wc * 32 + 8 * fq;
#pragma unroll
            for (int ai = 0; ai < 2; ++ai)
#pragma unroll
                for (int m = 0; m < 4; ++m) { bf16_t* rowp = P + (size_t)(row0 + ai * HALF + m * 16) * P_LD + col0;
#pragma unroll
                    for (int bj = 0; bj < 2; ++bj) { const f32x4 v0 = acc[ai][bj][m][0], v1 = acc[ai][bj][m][1];
                        u32x4 w; w[0] = cvt_pk_bf16(v0[0], v0[1]); w[1] = cvt_pk_bf16(v0[2], v0[3]); w[2] = cvt_pk_bf16(v1[0], v1[1]); w[3] = cvt_pk_bf16(v1[2], v1[3]);
                        *(u32x4*)(rowp + bj * HALF) = w; } }
        } else {
#pragma unroll
            for (int ai = 0; ai < 2; ++ai)
#pragma unroll
                for (int m = 0; m < 4; ++m) { float* rowp = G + (size_t)(row0 + ai * HALF + m * 16) * G_LD + wc * 32 + 8 * fq;
                    *(f32x4*)(rowp) = acc[ai][0][m][0]; *(f32x4*)(rowp + 4) = acc[ai][0][m][1]; }
        }
    }
};
struct EpiOut {
    static constexpr bool PERM = false, AFTER_DRAIN = false;
    float* R; const float* xp; const float* xs;
    __device__ __forceinline__ void operator()(const f32x4 (&acc)[2][2][4][2], const Unit& u, int wr, int wc, int fr, int fq) const {
        const int row0 = u.pm * BM + wr * 64 + fr, col0 = u.pn * BM + wc * 32 + 4 * fq;
#pragma unroll
        for (int ai = 0; ai < 2; ++ai)
#pragma unroll
            for (int m = 0; m < 4; ++m) { const int r = row0 + ai * HALF + m * 16;
                { const float* xr = xp + (size_t)r * DM; float* rr = R + (size_t)r * DM;
#pragma unroll
                    for (int bj = 0; bj < 2; ++bj)
#pragma unroll
                        for (int n = 0; n < 2; ++n) { const int c = col0 + bj * HALF + n * 16; const f32x4 xv = *(const f32x4*)(xr + c); *(f32x4*)(rr + c) = acc[ai][bj][m][n] + ALPHA * xv; } } }
    }
};

template <class Epi, class Sched, bool ALIGN_EPI = false, bool SP2 = false>
__device__ __forceinline__ void gemm_phase(LAS unsigned char* lds, const Gemm g, const Sched& S, const Epi& E) {
    const int tid = threadIdx.x, wid = __builtin_amdgcn_readfirstlane(tid >> 6), lane = tid & 63, wr = wid >> 2, wc = wid & 3, fr = lane & 15, fq = lane >> 4;
    const int K = g.K, nt = K / BK;
    unsigned voffA[2], voffB[2];
#pragma unroll
    for (int i = 0; i < 2; ++i) { voffA[i] = (unsigned)(tid * 16 + i * 8192); voffB[i] = voffA[i]; }
    const size_t kstep = (size_t)(HTB);
    const size_t hstep = (size_t)HALF * K * 2;
    const size_t tstep = 2 * hstep;
    const unsigned ldsw = (unsigned)wid * 1024u;
    const int aoff = lds_byte(wr * 64 + fr, fq * 8), boff = lds_byte(wc * 32 + fr, fq * 8);
#define PG8_SA(b, h) (((b) * 2 + (h)) * HTB)
#define PG8_SB(b, h) ((4 + (b) * 2 + (h)) * HTB)
#define PG8_STAGE(bufoff, gbase, voff) do { _Pragma("unroll") for (int _i = 0; _i < 2; ++_i) \
        __builtin_amdgcn_global_load_lds((const unsigned*)((const char*)(gbase) + (voff)[_i]), (LAS unsigned*)(lds + (bufoff) + ldsw + _i * 8192), 16, 0, 0); } while (0)
#define PG8_LDA(dst, b, h) do { _Pragma("unroll") for (int m = 0; m < 4; ++m) _Pragma("unroll") for (int k = 0; k < 2; ++k) dst[m][k] = *(const LAS bf16x8*)(lds + PG8_SA(b, h) + aoff + m * 2048 + k * 1024); } while (0)
#define PG8_LDB(dst, b, h) do { _Pragma("unroll") for (int n = 0; n < 2; ++n) _Pragma("unroll") for (int k = 0; k < 2; ++k) dst[n][k] = *(const LAS bf16x8*)(lds + PG8_SB(b, h) + boff + n * 2048 + k * 1024); } while (0)
#define PG8_MMA(ai, bj, At, Bt) do { __builtin_amdgcn_s_setprio(1); _Pragma("unroll") for (int m = 0; m < 4; ++m) _Pragma("unroll") for (int n = 0; n < 2; ++n) _Pragma("unroll") for (int k = 0; k < 2; ++k) \
        acc[ai][bj][m][n] = __builtin_amdgcn_mfma_f32_16x16x32_bf16(Bt[n][k], At[m][k], acc[ai][bj][m][n], 0, 0, 0); __builtin_amdgcn_s_setprio(0); } while (0)
#define PG8_WAIT_V(n) asm volatile("s_waitcnt vmcnt(" #n ")" ::: "memory")
#define PG8_WAIT_L(n) asm volatile("s_waitcnt lgkmcnt(" #n ")" ::: "memory")
#define PG8_BAR __builtin_amdgcn_s_barrier()
#define PG8_SCHED __builtin_amdgcn_sched_barrier(0)
    Unit cur, nxt; int ui = 0;
    if (!S.next(0, cur)) return;
    f32x4 acc[2][2][4][2];
#pragma unroll
    for (int a = 0; a < 2; ++a)
#pragma unroll
        for (int b = 0; b < 2; ++b)
#pragma unroll
            for (int m = 0; m < 4; ++m)
#pragma unroll
                for (int n = 0; n < 2; ++n) acc[a][b][m][n] = (f32x4){0.f, 0.f, 0.f, 0.f};
    bf16x8 At[4][2], B0[2][2], B1[2][2];
    const char* cA = (const char*)g.A + (size_t)cur.pm * tstep; const char* cB = (const char*)g.Bt + (size_t)cur.pn * tstep;
    S.a_ready(cur);
    if constexpr (SP2) {
        PG8_STAGE(PG8_SB(0, 0), cB, voffB); PG8_STAGE(PG8_SB(0, 1), cB + hstep, voffB); PG8_STAGE(PG8_SA(0, 0), cA, voffA); PG8_STAGE(PG8_SA(0, 1), cA + hstep, voffA);
        if (wr == 1) PG8_BAR;
        PG8_WAIT_V(2); PG8_BAR;
        PG8_STAGE(PG8_SB(1, 0), cB + kstep, voffB); PG8_STAGE(PG8_SA(1, 0), cA + kstep, voffA); PG8_STAGE(PG8_SB(1, 1), cB + hstep + kstep, voffB);
        PG8_WAIT_V(6); PG8_BAR;
    } else {
        PG8_STAGE(PG8_SB(0, 0), cB, voffB); PG8_STAGE(PG8_SA(0, 0), cA, voffA); PG8_STAGE(PG8_SB(0, 1), cB + hstep, voffB); PG8_STAGE(PG8_SA(0, 1), cA + hstep, voffA);
        if (wr == 1) PG8_BAR;
        PG8_WAIT_V(4); PG8_BAR;
        PG8_STAGE(PG8_SB(1, 0), cB + kstep, voffB); PG8_STAGE(PG8_SA(1, 0), cA + kstep, voffA); PG8_STAGE(PG8_SB(1, 1), cB + hstep + kstep, voffB);
        PG8_WAIT_V(6); PG8_BAR;
    }
    for (;;) {
        const bool has_next = S.next(ui + 1, nxt);
        const char* nA = has_next ? (const char*)g.A + (size_t)nxt.pm * tstep : cA; const char* nB = has_next ? (const char*)g.Bt + (size_t)nxt.pn * tstep : cB;
        for (int t = 0; t < nt; t += 2) {
            const bool last = (t == nt - 2);
            const char* a1 = cA + (size_t)(t + 1) * kstep;
            const char* a2 = last ? nA : cA + (size_t)(t + 2) * kstep; const char* b2 = last ? nB : cB + (size_t)(t + 2) * kstep;
            const char* a3 = a2 + kstep; const char* b3 = b2 + kstep;
            if (last && has_next) S.a_ready(nxt);
            if constexpr (SP2) {
            PG8_LDB(B0, 0, 0); PG8_LDB(B1, 0, 1); PG8_SCHED; PG8_LDA(At, 0, 0); PG8_STAGE(PG8_SA(1, 1), a1 + hstep, voffA);
            PG8_WAIT_V(8); PG8_WAIT_L(0); PG8_BAR; PG8_MMA(0, 0, At, B0); PG8_MMA(0, 1, At, B1); PG8_BAR; PG8_SCHED;
            PG8_LDA(At, 0, 1); PG8_STAGE(PG8_SB(0, 0), b2, voffB); PG8_STAGE(PG8_SB(0, 1), b2 + hstep, voffB); PG8_STAGE(PG8_SA(0, 0), a2, voffA);
            PG8_WAIT_V(8); PG8_WAIT_L(0); PG8_BAR; PG8_MMA(1, 0, At, B0); PG8_MMA(1, 1, At, B1); PG8_BAR; PG8_SCHED;
            PG8_LDB(B0, 1, 0); PG8_LDB(B1, 1, 1); PG8_SCHED; PG8_LDA(At, 1, 0); PG8_STAGE(PG8_SA(0, 1), a2 + hstep, voffA);
            PG8_WAIT_V(8); PG8_WAIT_L(0); PG8_BAR; PG8_MMA(0, 0, At, B0); PG8_MMA(0, 1, At, B1); PG8_BAR; PG8_SCHED;
            PG8_LDA(At, 1, 1); PG8_STAGE(PG8_SB(1, 0), b3, voffB); PG8_STAGE(PG8_SB(1, 1), b3 + hstep, voffB); PG8_STAGE(PG8_SA(1, 0), a3, voffA);
            PG8_WAIT_V(8); PG8_WAIT_L(0); PG8_BAR; PG8_MMA(1, 0, At, B0); PG8_MMA(1, 1, At, B1); PG8_BAR; PG8_SCHED;
            } else {
            PG8_LDB(B0, 0, 0); PG8_SCHED; PG8_LDA(At, 0, 0); PG8_STAGE(PG8_SA(1, 1), a1 + hstep, voffA);
            PG8_WAIT_L(8); PG8_BAR; PG8_WAIT_L(0); PG8_MMA(0, 0, At, B0); PG8_BAR; PG8_SCHED;
            PG8_LDB(B1, 0, 1); PG8_STAGE(PG8_SB(0, 0), b2, voffB);
            PG8_BAR; PG8_WAIT_L(0); PG8_MMA(0, 1, At, B1); PG8_BAR;
            PG8_LDA(At, 0, 1); PG8_STAGE(PG8_SA(0, 0), a2, voffA);
            PG8_BAR; PG8_WAIT_L(0); PG8_MMA(1, 0, At, B0); PG8_BAR; PG8_SCHED;
            PG8_STAGE(PG8_SB(0, 1), b2 + hstep, voffB);
            PG8_WAIT_V(6); PG8_BAR; PG8_MMA(1, 1, At, B1); PG8_BAR;
            PG8_LDB(B0, 1, 0); PG8_SCHED; PG8_LDA(At, 1, 0); PG8_STAGE(PG8_SA(0, 1), a2 + hstep, voffA);
            PG8_WAIT_L(8); PG8_BAR; PG8_WAIT_L(0); PG8_MMA(0, 0, At, B0); PG8_BAR; PG8_SCHED;
            PG8_LDB(B1, 1, 1); PG8_STAGE(PG8_SB(1, 0), b3, voffB);
            PG8_BAR; PG8_WAIT_L(0); PG8_MMA(0, 1, At, B1); PG8_BAR;
            PG8_LDA(At, 1, 1); PG8_STAGE(PG8_SA(1, 0), a3, voffA);
            PG8_BAR; PG8_WAIT_L(0); PG8_MMA(1, 0, At, B0); PG8_BAR; PG8_SCHED;
            PG8_STAGE(PG8_SB(1, 1), b3 + hstep, voffB);
            PG8_WAIT_V(6); PG8_BAR; PG8_MMA(1, 1, At, B1); PG8_BAR;
            }
        }
        if constexpr (ALIGN_EPI) { if (wr == 0) PG8_BAR; }
        if constexpr (!Epi::AFTER_DRAIN) { E(acc, cur, wr, wc, fr, fq); S.done(cur); }
        if (!has_next) break;
#pragma unroll
        for (int a = 0; a < 2; ++a)
#pragma unroll
            for (int b = 0; b < 2; ++b)
#pragma unroll
                for (int m = 0; m < 4; ++m)
#pragma unroll
                    for (int n = 0; n < 2; ++n) acc[a][b][m][n] = (f32x4){0.f, 0.f, 0.f, 0.f};
        cur = nxt; cA = nA; cB = nB; ++ui;
        if constexpr (ALIGN_EPI) { if (wr == 1) PG8_BAR; }
    }
    PG8_WAIT_V(0);
    if constexpr (!ALIGN_EPI) { if (wr == 0) PG8_BAR; }
    PG8_BAR;
#undef PG8_SA
#undef PG8_SB
#undef PG8_STAGE
#undef PG8_LDA
#undef PG8_LDB
#undef PG8_MMA
#undef PG8_WAIT_V
#undef PG8_WAIT_L
#undef PG8_BAR
#undef PG8_SCHED
}
}

template <bool REMAP, bool PERM>
__device__ __forceinline__ void tconv(const float* __restrict__ src, int ldsrc, bf16_t* __restrict__ dst, int K, int ntn, LAS unsigned char* lds) {
    LAS unsigned* T = (LAS unsigned*)lds;
    const int tid = threadIdx.x, nkt = K / 128, total = nkt * ntn;
    for (int tile = blockIdx.x; tile < total; tile += gridDim.x) {
        const int nt = tile / nkt, kt = tile - nt * nkt, n0 = nt * 64, k0 = kt * 128;
        int on0 = n0; bool zero = false;
        if (REMAP) { if (n0 < 10240) on0 = n0; else if (n0 < 26624) on0 = n0 + 64; else if (n0 < 26688) on0 = n0 - 26624 + 10240; else if (n0 < 26752) on0 = n0; else zero = true; }
#pragma unroll
        for (int i = 0; i < 2; ++i) {
            const int rp = (tid >> 4) + 32 * i, c4 = tid & 15;
            f32x4 v0 = (f32x4){0.f, 0.f, 0.f, 0.f}, v1 = v0;
            if (!zero) { const float* s = src + (size_t)(k0 + 2 * rp) * ldsrc + on0 + c4 * 4; v0 = *(const f32x4*)s; v1 = *(const f32x4*)(s + ldsrc); }
#pragma unroll
            for (int j = 0; j < 4; ++j) T[(c4 * 4 + j) * 65 + rp] = cvt_pk_bf16(v0[j], v1[j]);
        }
        __syncthreads();
#pragma unroll
        for (int i = 0; i < 2; ++i) {
            const int n = (tid >> 4) + 32 * i, kc = tid & 15;
            u32x4 v; v[0] = T[n * 65 + kc * 4]; v[1] = T[n * 65 + kc * 4 + 1]; v[2] = T[n * 65 + kc * 4 + 2]; v[3] = T[n * 65 + kc * 4 + 3];
            int nn = n0 + n;
            if (PERM) { const int x = nn & 31; nn = (nn & ~31) + 16 * ((x >> 2) & 1) + 4 * (x >> 3) + (x & 3); }
            *(u32x4*)(dst + tiled_off(nn, k0 + kc * 8, K)) = v;
        }
        __syncthreads();
    }
}
__device__ __forceinline__ void phase_convert(const Params& p, LAS unsigned char* lds) {
    bf16_t* Xb = (bf16_t*)(p.ws + OFF_XB);
    const size_t n8 = (size_t)MPAD * DM / 8;
    for (size_t i = (size_t)blockIdx.x * 512 + threadIdx.x; i < n8; i += (size_t)gridDim.x * 512) {
        const size_t e = i * 8; const int row = (int)(e / DM);
        f32x4 a = (f32x4){0.f, 0.f, 0.f, 0.f}, b = a;
        if (row < NTP) { a = *(const f32x4*)(p.x_prompt + e); b = *(const f32x4*)(p.x_prompt + e + 4); }
        else if (row < NTOK) { const size_t e2 = e - (size_t)NTP * DM; a = *(const f32x4*)(p.x_sample + e2); b = *(const f32x4*)(p.x_sample + e2 + 4); }
        u32x4 o; o[0] = cvt_pk_bf16(a[0], a[1]); o[1] = cvt_pk_bf16(a[2], a[3]); o[2] = cvt_pk_bf16(b[0], b[1]); o[3] = cvt_pk_bf16(b[2], b[3]);
        *(u32x4*)(Xb + tiled_off(row, (int)(e - (size_t)row * DM), DM)) = o;
    }
    { u32x4* mz = (u32x4*)((bf16_t*)(p.ws + OFF_MIX) + (size_t)NTOK * MIXW); const size_t nz = (size_t)(MPAD - NTOK) * MIXW / 8;
      for (size_t i = (size_t)blockIdx.x * 512 + threadIdx.x; i < nz; i += (size_t)gridDim.x * 512) mz[i] = (u32x4){0u, 0u, 0u, 0u}; }
    tconv<true, true>(p.w_in, NPROJ, (bf16_t*)(p.ws + OFF_WB), DM, NPAD / 64, lds);
    tconv<false, false>(p.w_out, DM, (bf16_t*)(p.ws + OFF_WOB), MIXW, DM / 64, lds);
}

constexpr int N_GDN_P = 128, N_SSD_P = 128, N_GDN_S = 2048, N_SSD_S = 1024, N_ITEMS = N_GDN_P + N_SSD_P + N_GDN_S + N_SSD_S;
constexpr int GO_LD = 132;
constexpr size_t SF_SXA = 0;
constexpr size_t SF_GQ  = SF_SXA + (size_t)NTS * 6144;
constexpr size_t SF_SDT = SF_GQ + (size_t)NTS * 12288;
constexpr size_t SF_SEA = SF_SDT + (size_t)NTS * 64;
constexpr size_t SF_GB  = SF_SEA + (size_t)NTS * 64;
constexpr size_t SF_GEG = SF_GB + (size_t)NTS * 32;
constexpr size_t SF_GO  = SF_GEG + (size_t)NTS * 32;
constexpr size_t SF_END = SF_GO + (size_t)NTS * 4096;

__device__ __forceinline__ void phase_sample_front(const Params& p) {
    const bf16_t* P = (const bf16_t*)(p.ws + OFF_P); const float* G = (const float*)(p.ws + OFF_G32); float* SF = (float*)(p.ws + OFF_SF);
    const int tid = threadIdx.x, lane = tid & 63;
    for (int item = blockIdx.x; item < NTS * 4; item += gridDim.x) {
        const int tok = item >> 2, sec = item & 3; const size_t row = (size_t)(NTP + tok);
        if (sec == 0) {
#pragma unroll 1
            for (int i = 0; i < 3; ++i) { const int ch = (tid + i * 512) * 4;
                f32x4 a = *(const f32x4*)(p.ssd_conv_b + ch);
#pragma unroll
                for (int j = 0; j < 4; ++j) { const f32x4 wv = *(const f32x4*)(p.ssd_conv_w + j * 6144 + ch);
                    const f32x4 rv = j < 3 ? *(const f32x4*)(p.state_ssd_conv + ((size_t)tok * 3 + j) * 6144 + ch) : ldbf4(P + row * P_LD + C_XBC + ch);
                    if (j >= 1) *(f32x4*)(p.out + O_SSDC_S + ((size_t)tok * 3 + (j - 1)) * 6144 + ch) = rv;
                    a += wv * rv; }
                *(f32x4*)(SF + SF_SXA + (size_t)tok * 6144 + ch) = (f32x4){silu_f(a[0]), silu_f(a[1]), silu_f(a[2]), silu_f(a[3])}; }
            if (tid < 64) { const float dt = softplus_f(G[row * G_LD + tid] + p.ssd_dt_bias[tid]); SF[SF_SDT + tok * 64 + tid] = dt; SF[SF_SEA + tok * 64 + tid] = expf(-expf(p.ssd_a_log[tid]) * dt); }
        } else {
            const int gs = sec - 1;
#pragma unroll 1
            for (int i = 0; i < 2; ++i) { const int cl = (tid + i * 512) * 4, ch = gs * 4096 + cl;
                f32x4 a = (f32x4){0.f, 0.f, 0.f, 0.f};
#pragma unroll
                for (int j = 0; j < 4; ++j) { const f32x4 wv = *(const f32x4*)(p.gdn_conv_w + j * 12288 + ch);
                    const f32x4 rv = j < 3 ? *(const f32x4*)(p.state_gdn_conv + ((size_t)tok * 3 + j) * 12288 + ch) : ldbf4(P + row * P_LD + C_QKV + ch);
                    if (j >= 1) *(f32x4*)(p.out + O_GDNC_S + ((size_t)tok * 3 + (j - 1)) * 12288 + ch) = rv;
                    a += wv * rv; }
                f32x4 o = (f32x4){silu_f(a[0]), silu_f(a[1]), silu_f(a[2]), silu_f(a[3])};
                if (gs < 2) {
                    float ss = o[0] * o[0] + o[1] * o[1] + o[2] * o[2] + o[3] * o[3];
                    ss += __shfl_xor(ss, 1); ss += __shfl_xor(ss, 2); ss += __shfl_xor(ss, 4); ss += __shfl_xor(ss, 8); ss += __shfl_xor(ss, 16);
                    const float rn = rsqrtf(ss + 1e-6f) * (gs == 0 ? 0.08838834764831845f : 1.f); o = o * rn; }
                *(f32x4*)(SF + SF_GQ + (size_t)tok * 12288 + ch) = o; }
            if (gs == 0 && tid < 32) { const float araw = G[row * G_LD + 96 + tid], braw = G[row * G_LD + 64 + tid];
                SF[SF_GB + tok * 32 + tid] = sigmoid_f(braw); SF[SF_GEG + tok * 32 + tid] = expf(-expf(p.gdn_a_log[tid]) * softplus_f(araw + p.gdn_dt_bias[tid])); }
        }
    }
    (void)lane;
}

__device__ __forceinline__ void ssd_sample_item(const Params& p, const int tok, const int g) {
    const float* SF = (const float*)(p.ws + OFF_SF); const bf16_t* P = (const bf16_t*)(p.ws + OFF_P);
    const int tid = opaque_tid(), w = tid >> 6, lane = tid & 63, half = lane >> 5, nq = lane & 31, h = g * 8 + w;
    const f32x4 B4 = *(const f32x4*)(SF + SF_SXA + (size_t)tok * 6144 + 4096 + g * 128 + nq * 4), C4 = *(const f32x4*)(SF + SF_SXA + (size_t)tok * 6144 + 5120 + g * 128 + nq * 4);
    const float xs_mine = SF[SF_SXA + (size_t)tok * 6144 + h * 64 + lane], dt = SF[SF_SDT + tok * 64 + h], eA = SF[SF_SEA + tok * 64 + h];
    const float z = bf2f(P[(size_t)(NTP + tok) * P_LD + C_ZS + h * 64 + lane]);
    const float xdt_mine = xs_mine * dt;
    const float* Hin = p.state_ssd + ((size_t)(tok * 64 + h) * 64 + 32 * half) * 128 + nq * 4; float* Hout = p.out + O_SSD_S + ((size_t)(tok * 64 + h) * 64 + 32 * half) * 128 + nq * 4;
    float y_mine = 0.f;
    f32x4 buf[2][8];
#pragma unroll
    for (int i = 0; i < 8; ++i) buf[0][i] = *(const f32x4*)(Hin + (size_t)i * 128);
#pragma unroll
    for (int bb = 0; bb < 4; ++bb) {
        if (bb < 3) {
#pragma unroll
            for (int i = 0; i < 8; ++i) buf[(bb + 1) & 1][i] = *(const f32x4*)(Hin + (size_t)((bb + 1) * 8 + i) * 128); }
#pragma unroll
        for (int i = 0; i < 8; ++i) { const int it = bb * 8 + i;
            const float xdt = __shfl(xdt_mine, it + 32 * half);
            const f32x4 hn = eA * buf[bb & 1][i] + xdt * B4;
            *(f32x4*)(Hout + (size_t)it * 128) = hn;
            float y = hn[0] * C4[0] + hn[1] * C4[1] + hn[2] * C4[2] + hn[3] * C4[3];
            y += __shfl_xor(y, 1); y += __shfl_xor(y, 2); y += __shfl_xor(y, 4); y += __shfl_xor(y, 8); y += __shfl_xor(y, 16);
            y_mine = (nq == it) ? y : y_mine; }
    }
    ((float*)(p.ws + OFF_U32))[(size_t)(NTP + tok) * DM + h * 64 + lane] = (y_mine + xs_mine * p.ssd_d[h]) * silu_f(z);
}
__device__ __forceinline__ void gdn_sample_item(const Params& p, const int tok, const int hp) {
    const float* SF = (const float*)(p.ws + OFF_SF); float* SFo = (float*)(p.ws + OFF_SF);
    const int tid = opaque_tid(), w = tid >> 6, lane = tid & 63, dg = lane >> 3, e4 = lane & 7, h = hp * 2 + (w >> 2), es = w & 3;
    const float* Sin = p.state_gdn + ((size_t)(tok * 32 + h) * 128 + dg * 16) * 128 + es * 32 + e4 * 4; float* Sout = p.out + O_GDN_S + ((size_t)(tok * 32 + h) * 128 + dg * 16) * 128 + es * 32 + e4 * 4;
    f32x4 S[16];
#pragma unroll
    for (int i = 0; i < 16; ++i) S[i] = *(const f32x4*)(Sin + (size_t)i * 128);
    const float* qp = SF + SF_GQ + (size_t)tok * 12288 + h * 128 + dg * 16; const float* kp = qp + 4096;
    f32x4 q4[4], k4[4];
#pragma unroll
    for (int i = 0; i < 4; ++i) { q4[i] = *(const f32x4*)(qp + 4 * i); k4[i] = *(const f32x4*)(kp + 4 * i); }
    const f32x4 v4 = *(const f32x4*)(SF + SF_GQ + (size_t)tok * 12288 + 8192 + h * 128 + es * 32 + e4 * 4);
    const float beta = SF[SF_GB + tok * 32 + h], eg = SF[SF_GEG + tok * 32 + h];
    f32x4 ks = (f32x4){0.f, 0.f, 0.f, 0.f};
#pragma unroll
    for (int i = 0; i < 16; ++i) ks += k4[i >> 2][i & 3] * S[i];
#pragma unroll
    for (int c = 0; c < 4; ++c) { ks[c] += __shfl_xor(ks[c], 8); ks[c] += __shfl_xor(ks[c], 16); ks[c] += __shfl_xor(ks[c], 32); }
    const f32x4 vn = beta * (v4 - eg * ks);
    f32x4 o = (f32x4){0.f, 0.f, 0.f, 0.f};
#pragma unroll
    for (int i = 0; i < 16; ++i) { S[i] = eg * S[i] + k4[i >> 2][i & 3] * vn; *(f32x4*)(Sout + (size_t)i * 128) = S[i]; o += q4[i >> 2][i & 3] * S[i]; }
#pragma unroll
    for (int c = 0; c < 4; ++c) { o[c] += __shfl_xor(o[c], 8); o[c] += __shfl_xor(o[c], 16); o[c] += __shfl_xor(o[c], 32); }
    if (dg == 0) *(f32x4*)(SFo + SF_GO + (size_t)tok * 4096 + h * 128 + es * 32 + e4 * 4) = o;
}

typedef __bf16 bf16x2_t __attribute__((ext_vector_type(2)));
typedef short bf16x4 __attribute__((ext_vector_type(4)));
__device__ __forceinline__ unsigned pk_bf16(float lo, float hi) { const f32x2v v = {lo, hi}; return __builtin_bit_cast(unsigned, __builtin_convertvector(v, bf16x2_t)); }
__device__ __forceinline__ bf16x8 pack2(const f32x4 lo, const f32x4 hi) { u32x4 r; r[0] = pk_bf16(lo[0], lo[1]); r[1] = pk_bf16(lo[2], lo[3]); r[2] = pk_bf16(hi[0], hi[1]); r[3] = pk_bf16(hi[2], hi[3]); return __builtin_bit_cast(bf16x8, r); }
__device__ __forceinline__ bf16x8 ld_perm(const LAS bf16_t* rowp, int q) { const u32x2 a = *(const LAS u32x2*)(rowp + 4 * q), b = *(const LAS u32x2*)(rowp + 16 + 4 * q); u32x4 r; r[0] = a[0]; r[1] = a[1]; r[2] = b[0]; r[3] = b[1]; return __builtin_bit_cast(bf16x8, r); }
__device__ __forceinline__ bf16x8 ld_nat(const LAS bf16_t* rowp, int q) { return *(const LAS bf16x8*)(rowp + 8 * q); }
#define MFMA16(a, b, c) __builtin_amdgcn_mfma_f32_16x16x32_bf16((a), (b), (c), 0, 0, 0)

#define BAR_LDS() do { asm volatile("s_waitcnt lgkmcnt(0)" ::: "memory"); __builtin_amdgcn_s_barrier(); asm volatile("" ::: "memory"); } while (0)
#define WAIT_VM0() asm volatile("s_waitcnt vmcnt(0)" ::: "memory")
#define LDP(base, off) __builtin_bit_cast(bf16x8, (u32x4){(*(const LAS u32x2*)((base) + (off)))[0], (*(const LAS u32x2*)((base) + (off)))[1], (*(const LAS u32x2*)((base) + (off) + 16))[0], (*(const LAS u32x2*)((base) + (off) + 16))[1]})
__device__ __forceinline__ float blo(unsigned v) { return __uint_as_float(v << 16); }
__device__ __forceinline__ float bhi(unsigned v) { return __uint_as_float(v & 0xffff0000u); }
__device__ __forceinline__ void dma_raw(LAS unsigned char* lds_raw, const bf16_t* P, const bf16_t* zsrc, const size_t rowbase, const int t0, const int c0, const int c1, const int c2, const int w, const int lane) {
#pragma unroll
    for (int kk = 0; kk < 7; ++kk) {
        int k = w + 8 * kk; k = k > 50 ? 50 : k;
        int seg = 4 * k + (lane >> 4); seg = seg > 200 ? 200 : seg;
        const int row = seg / 3, sec = seg - row * 3, tt = t0 - 3 + row;
        const bf16_t* src = tt >= 0 ? P + (rowbase + tt) * P_LD + (sec == 0 ? c0 : (sec == 1 ? c1 : c2)) : zsrc;
        __builtin_amdgcn_global_load_lds((const unsigned*)(src + (lane & 15) * 8), (LAS unsigned*)(lds_raw + k * 1024), 16, 0, 0);
    }
}
__device__ __forceinline__ float reduce16(float (&v)[16], const int lane) {
#pragma unroll
    for (int i = 0; i < 8; ++i) { const bool up = (lane & 32) != 0; const float send = up ? v[i] : v[i + 8], keep = up ? v[i + 8] : v[i]; v[i] = keep + __shfl_xor(send, 32); }
#pragma unroll
    for (int i = 0; i < 4; ++i) { const bool up = (lane & 16) != 0; const float send = up ? v[i] : v[i + 4], keep = up ? v[i + 4] : v[i]; v[i] = keep + __shfl_xor(send, 16); }
#pragma unroll
    for (int i = 0; i < 2; ++i) { const bool up = (lane & 8) != 0; const float send = up ? v[i] : v[i + 2], keep = up ? v[i + 2] : v[i]; v[i] = keep + __shfl_xor(send, 8); }
    { const bool up = (lane & 4) != 0; const float send = up ? v[0] : v[1], keep = up ? v[1] : v[0]; v[0] = keep + __shfl_xor(send, 4); }
    v[0] += __shfl_xor(v[0], 2); v[0] += __shfl_xor(v[0], 1);
    return v[0];
}

constexpr int GL_RAW = 0, GL_QA = 52224, GL_KA = 69632, GL_OB = GL_KA  , GL_KAT = 87040, GL_WL = 105472, GL_AB = 122880, GL_QK = 132096,
              GL_ADT = 141312, GL_TF = 145408, GL_TOK = 147456, GL_SSQ = 148480, GL_LAST = 148992, GL_WTS = 149056, GL_TOK2 = 155200;
__device__ __forceinline__ void gdn_chunk_item(const Params& p, LAS unsigned char* lds, const int b, const int h) {
    const bf16_t* P = (const bf16_t*)(p.ws + OFF_P); const float* G = (const float*)(p.ws + OFF_G32); bf16_t* MIX = (bf16_t*)(p.ws + OFF_MIX);
    const bf16_t* zsrc = (const bf16_t*)(p.ws + OFF_XB) + (size_t)NTOK * DM;
    const size_t rowbase = (size_t)b * 2048;
    const float Aneg = -expf(p.gdn_a_log[h]), dtb = p.gdn_dt_bias[h];
    const int c0 = C_QKV + h * 128, c1 = C_QKV + 4096 + h * 128, c2 = C_QKV + 8192 + h * 128;
    f32x4 Sacc[8];
#pragma unroll
    for (int j = 0; j < 8; ++j) Sacc[j] = (f32x4){0.f, 0.f, 0.f, 0.f};
    float g_araw = 0.f, g_braw = 0.f;
    {
        const int tid = opaque_tid(), lane = tid & 63, w = __builtin_amdgcn_readfirstlane(tid >> 6);
        for (int i = tid; i < (9216 * 2) / 4; i += 512) ((LAS unsigned*)(lds + GL_AB))[i] = 0u;
        for (int i = tid; i < 1536; i += 512) { const int j = i / 384, cc = i - j * 384; ((LAS float*)(lds + GL_WTS))[i] = p.gdn_conv_w[j * 12288 + (cc >> 7) * 4096 + h * 128 + (cc & 127)]; }
        dma_raw(lds + GL_RAW, P, zsrc, rowbase, 0, c0, c1, c2, w, lane);
        if (w == 0) { g_araw = G[(rowbase + lane) * G_LD + 96 + h]; g_braw = G[(rowbase + lane) * G_LD + 64 + h]; }
    }
#pragma unroll 1
    for (int c = 0; c < 32; ++c) {
        const int t0 = c * 64;
        if (c == 0) WAIT_VM0(); else asm volatile("s_waitcnt vmcnt(2)" ::: "memory");
        BAR_LDS();
        {
            const int tid = opaque_tid(), lane = tid & 63, w = tid >> 6;
            const LAS unsigned char* rawl = lds + GL_RAW + (8 * w) * 768 + lane * 4; const LAS float* wts = (const LAS float*)(lds + GL_WTS) + 2 * lane;
            float ssv[16];
#pragma unroll
            for (int sec = 0; sec < 2; ++sec) {
                f32x2v wj[4];
#pragma unroll
                for (int j = 0; j < 4; ++j) wj[j] = *(const LAS f32x2v*)(wts + j * 384 + sec * 128);
                float x0[11], x1[11];
#pragma unroll
                for (int rr = 0; rr < 11; ++rr) { const unsigned u = *(const LAS unsigned*)(rawl + rr * 768 + sec * 256); x0[rr] = blo(u); x1[rr] = bhi(u); }
                unsigned pk[8];
#pragma unroll
                for (int t = 0; t < 8; ++t) {
                    const float a0 = silu_f(wj[0][0] * x0[t] + wj[1][0] * x0[t + 1] + wj[2][0] * x0[t + 2] + wj[3][0] * x0[t + 3]);
                    const float a1 = silu_f(wj[0][1] * x1[t] + wj[1][1] * x1[t + 1] + wj[2][1] * x1[t + 2] + wj[3][1] * x1[t + 3]);
                    ssv[2 * t + sec] = a0 * a0 + a1 * a1; pk[t] = pk_bf16(a0, a1);
                    *(LAS unsigned*)(lds + (sec == 0 ? GL_QA : GL_KA) + ((8 * w + t) * 136 + 2 * lane) * 2) = pk[t];
                }
                if (sec == 1) {
                    u32x4 ke, ko;
#pragma unroll
                    for (int t2 = 0; t2 < 4; ++t2) { ke[t2] = (pk[2 * t2] & 0xffffu) | (pk[2 * t2 + 1] << 16); ko[t2] = (pk[2 * t2] >> 16) | (pk[2 * t2 + 1] & 0xffff0000u); }
                    *(LAS u32x4*)(lds + GL_KAT + ((2 * lane) * 72 + 8 * w) * 2) = ke; *(LAS u32x4*)(lds + GL_KAT + ((2 * lane + 1) * 72 + 8 * w) * 2) = ko;
                }
            }
            const float tot = reduce16(ssv, lane);
            if ((lane & 3) == 0) ((LAS float*)(lds + GL_SSQ))[16 * w + (lane >> 2)] = tot;
            if (c == 31 && w == 7) {
                float* convout = p.out + O_GDNC_P + (size_t)b * 3 * 12288 + h * 128 + 2 * lane;
#pragma unroll
                for (int j = 0; j < 3; ++j)
#pragma unroll
                    for (int sec = 0; sec < 3; ++sec) { const unsigned u = *(const LAS unsigned*)(lds + GL_RAW + ((64 + j) * 3 + sec) * 256 + lane * 4); *(f32x2v*)(convout + j * 12288 + sec * 4096) = (f32x2v){blo(u), bhi(u)}; }
            }
        }
        BAR_LDS();
        {
            const int tid = opaque_tid(), lane = tid & 63;
            if ((tid >> 6) == 0) {
                const LAS float* ssq = (const LAS float*)(lds + GL_SSQ);
                float cs = Aneg * softplus_f(g_araw + dtb); const float beta = sigmoid_f(g_braw);
                if (c < 31) { const size_t row = rowbase + t0 + 64 + lane; g_araw = G[row * G_LD + 96 + h]; g_braw = G[row * G_LD + 64 + h]; }
#pragma unroll
                for (int d = 1; d < 64; d <<= 1) { const float n = __shfl_up(cs, d); if (lane >= d) cs += n; }
                f32x4 tv; tv[0] = rsqrtf(ssq[lane * 2] + 1e-6f) * 0.08838834764831845f; tv[1] = rsqrtf(ssq[lane * 2 + 1] + 1e-6f); tv[2] = beta; tv[3] = cs;
                ((LAS f32x4*)(lds + GL_TOK))[lane] = tv; if (lane == 63) *(LAS float*)(lds + GL_LAST) = cs;
                const float lastv = __shfl(cs, 63), ec = __expf(cs);
                ((LAS f32x4*)(lds + GL_TOK2))[lane] = (f32x4){tv[0] * ec, tv[1] * __expf(lastv - cs), beta, tv[1] * beta * ec};
            }
        }
        BAR_LDS();
        {
            const int tid = opaque_tid(), w = tid >> 6, lane = tid & 63, r = lane & 15, q = lane >> 4;
#pragma unroll 1
            for (int job = w; job < 20; job += 8) {
                const int tj = job < 10 ? job : job - 10; const bool isQK = job >= 10;
                const int ti = tj >= 6 ? 3 : (tj >= 3 ? 2 : (tj >= 1 ? 1 : 0)), si = tj - (ti * (ti + 1)) / 2;
                const LAS bf16_t* Ab = (const LAS bf16_t*)(lds + (isQK ? GL_QA : GL_KA)) + (ti * 16 + r) * 136 + 8 * q; const LAS bf16_t* Bb = (const LAS bf16_t*)(lds + GL_KA) + (si * 16 + r) * 136 + 8 * q;
                f32x4 acc = (f32x4){0.f, 0.f, 0.f, 0.f};
#pragma unroll
                for (int kk = 0; kk < 4; ++kk) acc = MFMA16(*(const LAS bf16x8*)(Ab + kk * 32), *(const LAS bf16x8*)(Bb + kk * 32), acc);
                const int s = si * 16 + r; const f32x4 ts = ((const LAS f32x4*)(lds + GL_TOK))[s];
                const LAS f32x4* tq = (const LAS f32x4*)(lds + GL_TOK) + ti * 16 + 4 * q;
                float val[4];
#pragma unroll
                for (int reg = 0; reg < 4; ++reg) { const int t = ti * 16 + 4 * q + reg; const f32x4 tt = tq[reg]; const float dec = __expf(tt[3] - ts[3]);
                    val[reg] = isQK ? (s <= t ? acc[reg] * tt[0] * ts[1] * dec : 0.f) : (s < t ? -(acc[reg] * tt[1] * ts[1] * tt[2] * dec) : 0.f); }
                LAS bf16_t* dst = (LAS bf16_t*)(lds + (isQK ? GL_QK : GL_AB)) + (ti * 16 + 4 * q) * 72 + s;
                const bool diagKK = (!isQK) && (ti == si);
#pragma unroll
                for (int reg = 0; reg < 4; ++reg) dst[reg * 72] = diagKK ? (bf16_t)0 : (bf16_t)(pk_bf16(val[reg], 0.f) & 0xffffu);
                if (diagKK) *(LAS f32x4*)((LAS float*)(lds + GL_ADT) + (ti * 16 + r) * 16 + 4 * q) = (f32x4){val[0], val[1], val[2], val[3]};
            }
        }
        BAR_LDS();
        {
            const int tid = opaque_tid(), w = tid >> 6, lane = tid & 63, r = lane & 15, q = lane >> 4;
            if (w < 4) {
                const LAS float* A = (const LAS float*)(lds + GL_ADT) + w * 256;
                float tr[16];
#pragma unroll
                for (int j = 15; j >= 0; --j) { float v = (j == r) ? 1.f : 0.f;
#pragma unroll
                    for (int k = j + 1; k < 16; ++k) v += tr[k] * A[j * 16 + k];
                    tr[j] = v; }
                const float s0 = q == 0 ? tr[0] : (q == 1 ? tr[4] : (q == 2 ? tr[8] : tr[12])), s1 = q == 0 ? tr[1] : (q == 1 ? tr[5] : (q == 2 ? tr[9] : tr[13]));
                const float s2 = q == 0 ? tr[2] : (q == 1 ? tr[6] : (q == 2 ? tr[10] : tr[14])), s3 = q == 0 ? tr[3] : (q == 1 ? tr[7] : (q == 2 ? tr[11] : tr[15]));
                u32x2 tv; tv[0] = pk_bf16(s0, s1); tv[1] = pk_bf16(s2, s3); ((LAS u32x2*)(lds + GL_TF))[w * 64 + lane] = tv;
            }
        }
        BAR_LDS();
        f32x4 U[4];
        {
            const int tid = opaque_tid(), w = tid >> 6, lane = tid & 63, r = lane & 15, q = lane >> 4, E = w * 16 + r;
            const LAS f32x4* tq = (const LAS f32x4*)(lds + GL_TOK2) + 4 * q;
            const LAS bf16_t* RvE = (const LAS bf16_t*)(lds + GL_RAW) + ((4 * q) * 3 + 2) * 128 + E; const LAS bf16_t* KaE = (const LAS bf16_t*)(lds + GL_KA) + (4 * q) * 136 + E;
            const LAS bf16_t* AbR = (const LAS bf16_t*)(lds + GL_AB) + r * 72 + 4 * q;
            const LAS u32x2* TfL = (const LAS u32x2*)(lds + GL_TF) + lane;
            LAS bf16_t* WlE = (LAS bf16_t*)(lds + GL_WL) + (4 * q) * 136 + E;
            const LAS float* wv = (const LAS float*)(lds + GL_WTS) + 256 + E;
            const float w0 = wv[0], w1 = wv[384], w2 = wv[768], w3 = wv[1152];
            u32x4 XU[2], XW[2];
            XU[0] = XU[1] = XW[0] = XW[1] = (u32x4){0u, 0u, 0u, 0u};
#pragma unroll
            for (int i = 0; i < 4; ++i) {
                f32x4 au, aw; float xr[7];
#pragma unroll
                for (int k = 0; k < 7; ++k) xr[k] = bf2f(RvE[(16 * i + k) * 384]);
#pragma unroll
                for (int reg = 0; reg < 4; ++reg) { const f32x4 tt = tq[16 * i + reg];
                    au[reg] = silu_f(w0 * xr[reg] + w1 * xr[reg + 1] + w2 * xr[reg + 2] + w3 * xr[reg + 3]) * tt[2]; aw[reg] = bf2f(KaE[(16 * i + reg) * 136]) * tt[3]; }
                if (i >= 1) { const bf16x8 a = LDP(AbR, 16 * i * 72); au = MFMA16(a, __builtin_bit_cast(bf16x8, XU[0]), au); aw = MFMA16(a, __builtin_bit_cast(bf16x8, XW[0]), aw); }
                if (i == 3) { const bf16x8 a = LDP(AbR, 48 * 72 + 32); au = MFMA16(a, __builtin_bit_cast(bf16x8, XU[1]), au); aw = MFMA16(a, __builtin_bit_cast(bf16x8, XW[1]), aw); }
                const u32x2 tf = TfL[i * 64]; const u32x4 ta = (u32x4){tf[0], tf[1], 0u, 0u};
                const u32x4 yu = (u32x4){pk_bf16(au[0], au[1]), pk_bf16(au[2], au[3]), 0u, 0u}, yw = (u32x4){pk_bf16(aw[0], aw[1]), pk_bf16(aw[2], aw[3]), 0u, 0u};
                const f32x4 z4 = (f32x4){0.f, 0.f, 0.f, 0.f};
                const f32x4 xu = MFMA16(__builtin_bit_cast(bf16x8, ta), __builtin_bit_cast(bf16x8, yu), z4), xw = MFMA16(__builtin_bit_cast(bf16x8, ta), __builtin_bit_cast(bf16x8, yw), z4);
                U[i] = xu;
                XU[i >> 1][2 * (i & 1)] = pk_bf16(xu[0], xu[1]); XU[i >> 1][2 * (i & 1) + 1] = pk_bf16(xu[2], xu[3]);
                XW[i >> 1][2 * (i & 1)] = pk_bf16(xw[0], xw[1]); XW[i >> 1][2 * (i & 1) + 1] = pk_bf16(xw[2], xw[3]);
#pragma unroll
                for (int reg = 0; reg < 4; ++reg) WlE[(16 * i + reg) * 136] = (bf16_t)(pk_bf16(-xw[reg], 0.f) & 0xffffu);
            }
        }
        BAR_LDS();
        u32x4 zreg[2];
        {
            const int tid = opaque_tid(), lane = tid & 63, w = __builtin_amdgcn_readfirstlane(tid >> 6);
#pragma unroll
            for (int it = 0; it < 2; ++it) { const int idx = tid + it * 512; zreg[it] = *(const u32x4*)(P + (rowbase + t0 + (idx >> 4)) * P_LD + C_ZG + h * 128 + (idx & 15) * 8); }
            if (c < 31) dma_raw(lds + GL_RAW, P, zsrc, rowbase, t0 + 64, c0, c1, c2, w, lane);
        }
        {
            const int tid = opaque_tid(), w = tid >> 6, lane = tid & 63, r = lane & 15, q = lane >> 4, E = w * 16 + r;
            const LAS f32x4* tq = (const LAS f32x4*)(lds + GL_TOK2) + 4 * q;
            const LAS bf16_t* WlR = (const LAS bf16_t*)(lds + GL_WL) + r * 136 + 4 * q; const LAS bf16_t* QaR = (const LAS bf16_t*)(lds + GL_QA) + r * 136 + 4 * q;
            const LAS bf16_t* QkR = (const LAS bf16_t*)(lds + GL_QK) + r * 72 + 4 * q; const LAS bf16_t* KtR = (const LAS bf16_t*)(lds + GL_KAT) + r * 72 + 4 * q;
            LAS bf16_t* obE = (LAS bf16_t*)(lds + GL_OB) + (4 * q) * 136 + E;
            bf16x8 Sb[4];
#pragma unroll
            for (int kp = 0; kp < 4; ++kp) Sb[kp] = pack2(Sacc[2 * kp], Sacc[2 * kp + 1]);
            const float last = *(const LAS float*)(lds + GL_LAST);
            f32x4 vn[4], oo[4], vs[4];
#pragma unroll
            for (int i = 0; i < 4; ++i) { f32x4 acc = U[i];
#pragma unroll
                for (int kp = 0; kp < 4; ++kp) acc = MFMA16(LDP(WlR, 16 * i * 136 + 32 * kp), Sb[kp], acc);
                vn[i] = acc; }
#pragma unroll
            for (int i = 0; i < 4; ++i) { f32x4 acc = (f32x4){0.f, 0.f, 0.f, 0.f};
#pragma unroll
                for (int kp = 0; kp < 4; ++kp) acc = MFMA16(LDP(QaR, 16 * i * 136 + 32 * kp), Sb[kp], acc);
#pragma unroll
                for (int reg = 0; reg < 4; ++reg) { const f32x4 tt = tq[16 * i + reg]; acc[reg] *= tt[0]; vs[i][reg] = vn[i][reg] * tt[1]; }
                oo[i] = acc; }
            bf16x8 Vn[2], Vs[2];
            Vn[0] = pack2(vn[0], vn[1]); Vn[1] = pack2(vn[2], vn[3]); Vs[0] = pack2(vs[0], vs[1]); Vs[1] = pack2(vs[2], vs[3]);
#pragma unroll
            for (int i = 0; i < 4; ++i) {
                oo[i] = MFMA16(LDP(QkR, 16 * i * 72), Vn[0], oo[i]);
                if (i >= 2) oo[i] = MFMA16(LDP(QkR, 16 * i * 72 + 32), Vn[1], oo[i]);
            }
            const float el = __expf(last);
#pragma unroll
            for (int j = 0; j < 8; ++j) { f32x4 acc = Sacc[j] * el;
                acc = MFMA16(LDP(KtR, 16 * j * 72), Vs[0], acc); acc = MFMA16(LDP(KtR, 16 * j * 72 + 32), Vs[1], acc);
                Sacc[j] = acc; }
#pragma unroll
            for (int i = 0; i < 4; ++i)
#pragma unroll
                for (int reg = 0; reg < 4; ++reg) obE[(16 * i + reg) * 136] = (bf16_t)(pk_bf16(oo[i][reg], 0.f) & 0xffffu);
        }
        BAR_LDS();
        {
            const int tid = opaque_tid();
#pragma unroll
            for (int it = 0; it < 2; ++it) { const int idx = tid + it * 512, t = idx >> 4, e8 = (idx & 15) * 8;
                const u32x4 ov = *(const LAS u32x4*)(lds + GL_OB + (t * 136 + e8) * 2);
                float o[8];
#pragma unroll
                for (int k = 0; k < 4; ++k) { o[2 * k] = blo(ov[k]); o[2 * k + 1] = bhi(ov[k]); }
                float ss = 0.f;
#pragma unroll
                for (int k = 0; k < 8; ++k) ss += o[k] * o[k];
                ss += __shfl_xor(ss, 1); ss += __shfl_xor(ss, 2); ss += __shfl_xor(ss, 4); ss += __shfl_xor(ss, 8);
                const float rs = rsqrtf(ss * (1.f / 128.f) + 1e-6f);
                const f32x4 n0 = *(const f32x4*)(p.gdn_norm_w + e8), n1 = *(const f32x4*)(p.gdn_norm_w + e8 + 4);
                u32x4 res;
#pragma unroll
                for (int k = 0; k < 4; ++k) { const float za = blo(zreg[it][k]), zb = bhi(zreg[it][k]); const float na = k < 2 ? n0[2 * k] : n1[2 * k - 4], nb = k < 2 ? n0[2 * k + 1] : n1[2 * k - 3];
                    res[k] = pk_bf16(o[2 * k] * rs * na * silu_f(za), o[2 * k + 1] * rs * nb * silu_f(zb)); }
                *(u32x4*)(MIX + tiled_off((int)(rowbase + t0 + t), 4096 + h * 128 + e8, MIXW)) = res; }
        }
    }
    {
        const int tid = opaque_tid(), w = tid >> 6, lane = tid & 63, r = lane & 15, q = lane >> 4, E = w * 16 + r;
        float* So = p.out + O_GDN_P + (size_t)(b * 32 + h) * 16384 + (4 * q) * 128 + E;
#pragma unroll
        for (int j = 0; j < 8; ++j)
#pragma unroll
            for (int reg = 0; reg < 4; ++reg) So[(16 * j + reg) * 128] = Sacc[j][reg];
    }
}

constexpr int SL_RAW = 0, SL_CA = 52224, SL_BA = 69632, SL_BAT = 87040, SL_XST = 105472, SL_CB = 123904, SL_TOK = 133120, SL_LAST = 135168, SL_YB = 135232, SL_WTS = 152640, SL_BIAS = 158784;
__device__ __forceinline__ void ssd_chunk_item(const Params& p, LAS unsigned char* lds, const int b, const int g, const int hp) {
    const bf16_t* P = (const bf16_t*)(p.ws + OFF_P); const float* G = (const float*)(p.ws + OFF_G32); float* Uo = (float*)(p.ws + OFF_U32);
    const bf16_t* zsrc = (const bf16_t*)(p.ws + OFF_XB) + (size_t)NTOK * DM;
    const int h0 = g * 8 + hp * 2;
    const size_t rowbase = (size_t)b * 2048;
    const int c0 = C_XBC + h0 * 64, c1 = C_XBC + 4096 + g * 128, c2 = C_XBC + 5120 + g * 128;
    f32x4 Hacc[8];
#pragma unroll
    for (int j = 0; j < 8; ++j) Hacc[j] = (f32x4){0.f, 0.f, 0.f, 0.f};
    float g_dtraw = 0.f, g_A = 0.f, g_dtb = 0.f;
    {
        const int tid = opaque_tid(), lane = tid & 63, w = __builtin_amdgcn_readfirstlane(tid >> 6);
        for (int i = tid; i < 1536 + 384; i += 512) {
            const int j = i / 384, cc = i - j * 384, sec = cc >> 7, col = cc & 127, ch = sec == 0 ? h0 * 64 + col : (sec == 1 ? 4096 + g * 128 + col : 5120 + g * 128 + col);
            if (j < 4) ((LAS float*)(lds + SL_WTS))[i] = p.ssd_conv_w[j * 6144 + ch]; else ((LAS float*)(lds + SL_BIAS))[cc] = p.ssd_conv_b[ch]; }
        dma_raw(lds + SL_RAW, P, zsrc, rowbase, 0, c0, c1, c2, w, lane);
        if (w < 2) { const int hh = h0 + w; g_dtraw = G[(rowbase + lane) * G_LD + hh]; g_A = -expf(p.ssd_a_log[hh]); g_dtb = p.ssd_dt_bias[hh]; }
    }
#pragma unroll 1
    for (int c = 0; c < 32; ++c) {
        const int t0 = c * 64;
        if (c == 0) WAIT_VM0(); else asm volatile("s_waitcnt vmcnt(6)" ::: "memory");
        BAR_LDS();
        {
            const int tid = opaque_tid(), lane = tid & 63, w = tid >> 6;
            const LAS unsigned char* rawl = lds + SL_RAW + (8 * w) * 768 + lane * 4; const LAS float* wts = (const LAS float*)(lds + SL_WTS) + 2 * lane; const LAS float* bia = (const LAS float*)(lds + SL_BIAS) + 2 * lane;
#pragma unroll
            for (int sec = 0; sec < 3; ++sec) {
                f32x2v wj[4];
#pragma unroll
                for (int j = 0; j < 4; ++j) wj[j] = *(const LAS f32x2v*)(wts + j * 384 + sec * 128);
                const f32x2v bj = *(const LAS f32x2v*)(bia + sec * 128);
                float x0[11], x1[11];
#pragma unroll
                for (int rr = 0; rr < 11; ++rr) { const unsigned u = *(const LAS unsigned*)(rawl + rr * 768 + sec * 256); x0[rr] = blo(u); x1[rr] = bhi(u); }
                unsigned pk[8];
#pragma unroll
                for (int t = 0; t < 8; ++t) {
                    const float a0 = silu_f(bj[0] + wj[0][0] * x0[t] + wj[1][0] * x0[t + 1] + wj[2][0] * x0[t + 2] + wj[3][0] * x0[t + 3]);
                    const float a1 = silu_f(bj[1] + wj[0][1] * x1[t] + wj[1][1] * x1[t + 1] + wj[2][1] * x1[t + 2] + wj[3][1] * x1[t + 3]);
                    pk[t] = pk_bf16(a0, a1);
                    if (sec >= 1) *(LAS unsigned*)(lds + (sec == 1 ? SL_BA : SL_CA) + ((8 * w + t) * 136 + 2 * lane) * 2) = pk[t];
                }
                if (sec <= 1) {
                    u32x4 ke, ko;
#pragma unroll
                    for (int t2 = 0; t2 < 4; ++t2) { ke[t2] = (pk[2 * t2] & 0xffffu) | (pk[2 * t2 + 1] << 16); ko[t2] = (pk[2 * t2] >> 16) | (pk[2 * t2 + 1] & 0xffff0000u); }
                    *(LAS u32x4*)(lds + (sec == 0 ? SL_XST : SL_BAT) + ((2 * lane) * 72 + 8 * w) * 2) = ke; *(LAS u32x4*)(lds + (sec == 0 ? SL_XST : SL_BAT) + ((2 * lane + 1) * 72 + 8 * w) * 2) = ko;
                }
            }
            if (c == 31 && w == 7) {
                float* convout = p.out + O_SSDC_P + (size_t)b * 3 * 6144 + 2 * lane;
#pragma unroll
                for (int j = 0; j < 3; ++j)
#pragma unroll
                    for (int sec = 0; sec < 3; ++sec) { if (sec == 0 || hp == 0) { const unsigned u = *(const LAS unsigned*)(lds + SL_RAW + ((64 + j) * 3 + sec) * 256 + lane * 4);
                        *(f32x2v*)(convout + j * 6144 + (sec == 0 ? h0 * 64 : (sec == 1 ? 4096 + g * 128 : 5120 + g * 128))) = (f32x2v){blo(u), bhi(u)}; } }
            }
        }
        BAR_LDS();
        {
            const int tid = opaque_tid(), lane = tid & 63, r = lane & 15, q = lane >> 4, w = __builtin_amdgcn_readfirstlane(tid >> 6);
            if (c < 31) dma_raw(lds + SL_RAW, P, zsrc, rowbase, t0 + 64, c0, c1, c2, w, lane);
            if (w < 2) {
                const float dt = softplus_f(g_dtraw + g_dtb);
                if (c < 31) g_dtraw = G[(rowbase + t0 + 64 + lane) * G_LD + h0 + w];
                float cs = g_A * dt;
#pragma unroll
                for (int d = 1; d < 64; d <<= 1) { const float n = __shfl_up(cs, d); if (lane >= d) cs += n; }
                const float lastv = __shfl(cs, 63);
                ((LAS f32x4*)(lds + SL_TOK))[w * 64 + lane] = (f32x4){dt, cs, __expf(cs), dt * __expf(lastv - cs)}; if (lane == 63) ((LAS float*)(lds + SL_LAST))[w] = cs;
            } else {
#pragma unroll 1
                for (int job = w - 2; job < 10; job += 6) {
                    const int ti = job >= 6 ? 3 : (job >= 3 ? 2 : (job >= 1 ? 1 : 0)), si = job - (ti * (ti + 1)) / 2;
                    const LAS bf16_t* Ab = (const LAS bf16_t*)(lds + SL_CA) + (ti * 16 + r) * 136 + 8 * q; const LAS bf16_t* Bb = (const LAS bf16_t*)(lds + SL_BA) + (si * 16 + r) * 136 + 8 * q;
                    f32x4 acc = (f32x4){0.f, 0.f, 0.f, 0.f};
#pragma unroll
                    for (int kk = 0; kk < 4; ++kk) acc = MFMA16(*(const LAS bf16x8*)(Ab + kk * 32), *(const LAS bf16x8*)(Bb + kk * 32), acc);
                    LAS bf16_t* dst = (LAS bf16_t*)(lds + SL_CB) + (ti * 16 + 4 * q) * 72 + si * 16 + r;
#pragma unroll
                    for (int reg = 0; reg < 4; ++reg) dst[reg * 72] = (bf16_t)(pk_bf16(acc[reg], 0.f) & 0xffffu);
                }
            }
        }
        BAR_LDS();
        u32x4 zreg[2];
        {
            const int tid = opaque_tid();
#pragma unroll
            for (int it = 0; it < 2; ++it) { const int idx = tid + it * 512; zreg[it] = *(const u32x4*)(P + (rowbase + t0 + (idx >> 4)) * P_LD + C_ZS + h0 * 64 + (idx & 15) * 8); }
        }
        {
            const int tid = opaque_tid(), w = tid >> 6, lane = tid & 63, r = lane & 15, q = lane >> 4, hl = w >> 2, Pc = (w & 3) * 16 + r;
            const float Dh = p.ssd_d[h0 + hl];
            const LAS f32x4* tk = (const LAS f32x4*)(lds + SL_TOK) + hl * 64; const float last = ((const LAS float*)(lds + SL_LAST))[hl];
            const LAS bf16_t* XsP = (const LAS bf16_t*)(lds + SL_XST) + (hl * 64 + Pc) * 72;
            const LAS bf16_t* CaR = (const LAS bf16_t*)(lds + SL_CA) + r * 136 + 4 * q; const LAS bf16_t* CbR = (const LAS bf16_t*)(lds + SL_CB) + r * 72 + 8 * q;
            const LAS bf16_t* BtR = (const LAS bf16_t*)(lds + SL_BAT) + r * 72 + 8 * q;
            LAS bf16_t* ybE = (LAS bf16_t*)(lds + SL_YB) + (4 * q) * 136 + hl * 64 + Pc;
            bf16x8 Hb[4];
#pragma unroll
            for (int kp = 0; kp < 4; ++kp) Hb[kp] = pack2(Hacc[2 * kp], Hacc[2 * kp + 1]);
            bf16x8 xf[2], xw[2];
#pragma unroll
            for (int kp = 0; kp < 2; ++kp) { const u32x4 xv = *(const LAS u32x4*)(XsP + 32 * kp + 8 * q); xf[kp] = __builtin_bit_cast(bf16x8, xv);
                u32x4 xs;
#pragma unroll
                for (int e2 = 0; e2 < 4; ++e2) { const float wa = tk[32 * kp + 8 * q + 2 * e2][3], wb = tk[32 * kp + 8 * q + 2 * e2 + 1][3];
                    xs[e2] = pk_bf16(blo(xv[e2]) * wa, bhi(xv[e2]) * wb); }
                xw[kp] = __builtin_bit_cast(bf16x8, xs); }
#pragma unroll
            for (int i = 0; i < 4; ++i) {
                f32x4 acc = (f32x4){0.f, 0.f, 0.f, 0.f};
#pragma unroll
                for (int kp = 0; kp < 4; ++kp) acc = MFMA16(LDP(CaR, 16 * i * 136 + 32 * kp), Hb[kp], acc);
#pragma unroll
                for (int reg = 0; reg < 4; ++reg) acc[reg] *= tk[16 * i + 4 * q + reg][2];
                const int t = 16 * i + r; const float cum_t = tk[t][1];
#pragma unroll
                for (int kp = 0; kp < 2; ++kp) { if (kp <= (i >> 1)) {
                    const u32x4 cbv = *(const LAS u32x4*)(CbR + 16 * i * 72 + 32 * kp);
                    float lv[8];
#pragma unroll
                    for (int jj = 0; jj < 8; ++jj) { const int s = 32 * kp + 8 * q + jj; const f32x4 ts = tk[s]; const float cb = (jj & 1) ? bhi(cbv[jj >> 1]) : blo(cbv[jj >> 1]);
                        lv[jj] = s <= t ? cb * __expf(cum_t - ts[1]) * ts[0] : 0.f; }
                    const u32x4 lw = (u32x4){pk_bf16(lv[0], lv[1]), pk_bf16(lv[2], lv[3]), pk_bf16(lv[4], lv[5]), pk_bf16(lv[6], lv[7])};
                    acc = MFMA16(__builtin_bit_cast(bf16x8, lw), xf[kp], acc); } }
                const u32x2 xd = *(const LAS u32x2*)(XsP + 16 * i + 4 * q);
                acc[0] += blo(xd[0]) * Dh; acc[1] += bhi(xd[0]) * Dh; acc[2] += blo(xd[1]) * Dh; acc[3] += bhi(xd[1]) * Dh;
#pragma unroll
                for (int reg = 0; reg < 4; ++reg) ybE[(16 * i + reg) * 136] = (bf16_t)(pk_bf16(acc[reg], 0.f) & 0xffffu);
            }
            const float el = __expf(last);
#pragma unroll
            for (int j = 0; j < 8; ++j) { f32x4 acc = Hacc[j] * el;
                acc = MFMA16(*(const LAS bf16x8*)(BtR + 16 * j * 72), xw[0], acc); acc = MFMA16(*(const LAS bf16x8*)(BtR + 16 * j * 72 + 32), xw[1], acc);
                Hacc[j] = acc; }
        }
        BAR_LDS();
        {
            const int tid = opaque_tid();
#pragma unroll
            for (int it = 0; it < 2; ++it) { const int idx = tid + it * 512, t = idx >> 4, e8 = (idx & 15) * 8;
                const u32x4 yv = *(const LAS u32x4*)(lds + SL_YB + (t * 136 + e8) * 2);
                f32x4 o0, o1;
                o0[0] = blo(yv[0]) * silu_f(blo(zreg[it][0])); o0[1] = bhi(yv[0]) * silu_f(bhi(zreg[it][0])); o0[2] = blo(yv[1]) * silu_f(blo(zreg[it][1])); o0[3] = bhi(yv[1]) * silu_f(bhi(zreg[it][1]));
                o1[0] = blo(yv[2]) * silu_f(blo(zreg[it][2])); o1[1] = bhi(yv[2]) * silu_f(bhi(zreg[it][2])); o1[2] = blo(yv[3]) * silu_f(blo(zreg[it][3])); o1[3] = bhi(yv[3]) * silu_f(bhi(zreg[it][3]));
                float* up = Uo + (rowbase + t0 + t) * DM + h0 * 64 + e8; *(f32x4*)up = o0; *(f32x4*)(up + 4) = o1; }
        }
    }
    {
        const int tid = opaque_tid(), w = tid >> 6, lane = tid & 63, r = lane & 15, q = lane >> 4, hl = w >> 2, Pc = (w & 3) * 16 + r;
        float* Ho = p.out + O_SSD_P + ((size_t)(b * 64 + h0 + hl) * 64 + Pc) * 128 + 4 * q;
#pragma unroll
        for (int j = 0; j < 8; ++j) *(f32x4*)(Ho + 16 * j) = Hacc[j];
    }
}

__device__ __forceinline__ void phase_scan(const Params& p, LAS unsigned char* lds, const int qword = QCTR_WORD, const int item0 = 0, const int item_end = N_ITEMS) {
    LAS int* qslot = (LAS int*)(lds + LDS_MISC + 16);
    unsigned* qctr = (unsigned*)(p.ws + OFF_BAR) + qword;
    for (;;) {
        __syncthreads();
        if (threadIdx.x == 0) *qslot = item0 + (int)__hip_atomic_fetch_add(qctr, 1u, __ATOMIC_RELAXED, __HIP_MEMORY_SCOPE_AGENT);
        __syncthreads();
        const int item = __builtin_amdgcn_readfirstlane(*qslot);
        if (item >= item_end) break;
        if (item < N_GDN_P) gdn_chunk_item(p, lds, item >> 5, item & 31);
        else if (item < N_GDN_P + N_SSD_P) { const int i = item - N_GDN_P; ssd_chunk_item(p, lds, i >> 5, (i >> 2) & 7, i & 3); }
        else if (item < N_GDN_P + N_SSD_P + N_GDN_S) { const int i = item - N_GDN_P - N_SSD_P; gdn_sample_item(p, i >> 4, i & 15); }
        else { const int i = item - N_GDN_P - N_SSD_P - N_GDN_S; ssd_sample_item(p, i >> 3, i & 7); }
    }
}

__device__ __forceinline__ void phase_outproj_sample(const Params& p, LAS unsigned char* lds) {
    const int tid = threadIdx.x, wid = __builtin_amdgcn_readfirstlane(tid >> 6), lane = tid & 63, wr = wid >> 2, wc = wid & 3, fr = lane & 15, fq = lane >> 4;
    const int aoff = pg8::lds_byte(wr * 64 + fr, fq * 8), boff = pg8::lds_byte((wc & 1) * 64 + fr, fq * 8) + 16384 + (wc >> 1) * 16384;
    for (int u = blockIdx.x; u < 256; u += gridDim.x) {
        const int pn = u & 15, ks = u >> 4;
        const char* gA = (const char*)(p.ws + OFF_MIX) + ((size_t)64 * 128 + ks * 8) * 16384;
        const char* gB0 = (const char*)(p.ws + OFF_WOB) + ((size_t)(2 * pn) * 128 + ks * 8) * 16384; const char* gB1 = gB0 + (size_t)128 * 16384;
#define OS_ISSUE(kt, st) do { _Pragma("unroll") for (int pc = 0; pc < 6; ++pc) { const char* s_ = (pc < 2 ? gA : (pc < 4 ? gB0 : gB1)) + (size_t)(kt) * 16384 + (pc & 1) * 8192 + tid * 16; \
            __builtin_amdgcn_global_load_lds((const unsigned*)s_, (LAS unsigned*)(lds + (st) * 49152 + pc * 8192 + wid * 1024), 16, 0, 0); } } while (0)
        f32x4 acc[4][4];
#pragma unroll
        for (int m = 0; m < 4; ++m)
#pragma unroll
            for (int n = 0; n < 4; ++n) acc[m][n] = (f32x4){0.f, 0.f, 0.f, 0.f};
        OS_ISSUE(0, 0); OS_ISSUE(1, 1); OS_ISSUE(2, 2);
#pragma unroll
        for (int kt = 0; kt < 8; ++kt) {
            if (kt <= 5) asm volatile("s_waitcnt vmcnt(12)" ::: "memory"); else if (kt == 6) asm volatile("s_waitcnt vmcnt(6)" ::: "memory"); else asm volatile("s_waitcnt vmcnt(0)" ::: "memory");
            __builtin_amdgcn_s_barrier(); asm volatile("" ::: "memory");
            const LAS unsigned char* sb = lds + (kt % 3) * 49152;
            bf16x8 af[4][2], bfr[4][2];
#pragma unroll
            for (int m = 0; m < 4; ++m)
#pragma unroll
                for (int k = 0; k < 2; ++k) { af[m][k] = *(const LAS bf16x8*)(sb + aoff + m * 2048 + k * 1024); bfr[m][k] = *(const LAS bf16x8*)(sb + boff + m * 2048 + k * 1024); }
#pragma unroll
            for (int m = 0; m < 4; ++m)
#pragma unroll
                for (int n = 0; n < 4; ++n)
#pragma unroll
                    for (int k = 0; k < 2; ++k) acc[m][n] = __builtin_amdgcn_mfma_f32_16x16x32_bf16(bfr[n][k], af[m][k], acc[m][n], 0, 0, 0);
            asm volatile("s_waitcnt lgkmcnt(0)" ::: "memory"); __builtin_amdgcn_s_barrier(); asm volatile("" ::: "memory");
            if (kt + 3 < 8) OS_ISSUE(kt + 3, kt % 3);
        }
#undef OS_ISSUE
        float* Rp = (float*)(p.ws + OFF_RPART) + ((size_t)ks * NTS + wr * 64 + fr) * DM + pn * 256 + wc * 64 + 4 * fq;
#pragma unroll
        for (int m = 0; m < 4; ++m)
#pragma unroll
            for (int n = 0; n < 4; ++n) *(f32x4*)(Rp + (size_t)(m * 16) * DM + n * 16) = acc[m][n];
    }
    __syncthreads();
}

__device__ __forceinline__ void phase_ssdnorm(const Params& p) {
    const float* U = (const float*)(p.ws + OFF_U32); bf16_t* MIX = (bf16_t*)(p.ws + OFF_MIX);
    const int lane = threadIdx.x & 63, gw = blockIdx.x * 8 + (threadIdx.x >> 6), nw = gridDim.x * 8;
    for (int it = gw; it < NTOK * 8; it += nw) {
        const int row = it >> 3, g = it & 7; const size_t off = (size_t)row * DM + g * 512 + lane * 8;
        const f32x4 a = *(const f32x4*)(U + off), b = *(const f32x4*)(U + off + 4);
        const float ss = wave_sum(a[0] * a[0] + a[1] * a[1] + a[2] * a[2] + a[3] * a[3] + b[0] * b[0] + b[1] * b[1] + b[2] * b[2] + b[3] * b[3]);
        const float rs = rsqrtf(ss * (1.f / 512.f) + 1e-6f);
        const f32x4 wa = *(const f32x4*)(p.ssd_norm_w + g * 512 + lane * 8), wb = *(const f32x4*)(p.ssd_norm_w + g * 512 + lane * 8 + 4);
        u32x4 o; o[0] = cvt_pk_bf16(a[0] * rs * wa[0], a[1] * rs * wa[1]); o[1] = cvt_pk_bf16(a[2] * rs * wa[2], a[3] * rs * wa[3]);
        o[2] = cvt_pk_bf16(b[0] * rs * wb[0], b[1] * rs * wb[1]); o[3] = cvt_pk_bf16(b[2] * rs * wb[2], b[3] * rs * wb[3]);
        *(u32x4*)(MIX + tiled_off(row, g * 512 + lane * 8, MIXW)) = o;
    }
    const float* GO = (const float*)(p.ws + OFF_SF) + SF_GO; const bf16_t* P = (const bf16_t*)(p.ws + OFF_P);
    for (int it = gw; it < NTS * 32; it += nw) {
        const int tok = it >> 5, h = it & 31;
        const float o0 = GO[(size_t)tok * 4096 + h * 128 + lane], o1 = GO[(size_t)tok * 4096 + h * 128 + 64 + lane];
        const float rs = rsqrtf(wave_sum(o0 * o0 + o1 * o1) * (1.f / 128.f) + 1e-6f);
        const size_t prow = (size_t)(NTP + tok) * P_LD + C_ZG + h * 128;
        MIX[tiled_off(NTP + tok, 4096 + h * 128 + lane, MIXW)] = f2bf(o0 * rs * p.gdn_norm_w[lane] * silu_f(bf2f(P[prow + lane])));
        MIX[tiled_off(NTP + tok, 4096 + h * 128 + 64 + lane, MIXW)] = f2bf(o1 * rs * p.gdn_norm_w[64 + lane] * silu_f(bf2f(P[prow + 64 + lane])));
    }
}

__device__ __forceinline__ void phase_ln(const Params& p) {
    const float* R = (const float*)(p.ws + OFF_R);
    const int lane = threadIdx.x & 63, gw = blockIdx.x * 8 + (threadIdx.x >> 6), nw = gridDim.x * 8;
    for (int row = gw; row < NTOK; row += nw) {
        const float* rr = R + (size_t)row * DM;
        f32x4 v[16]; float sum = 0.f;
        if (row < NTP) {
#pragma unroll
            for (int i = 0; i < 16; ++i) v[i] = *(const f32x4*)(rr + (i * 64 + lane) * 4);
        } else {
            const float* xr = p.x_sample + (size_t)(row - NTP) * DM; const float* pr = (const float*)(p.ws + OFF_RPART) + (size_t)(row - NTP) * DM;
#pragma unroll
            for (int i = 0; i < 16; ++i) v[i] = ALPHA * *(const f32x4*)(xr + (i * 64 + lane) * 4);
#pragma unroll 1
            for (int ks = 0; ks < 16; ++ks) {
#pragma unroll
                for (int i = 0; i < 16; ++i) v[i] += *(const f32x4*)(pr + (size_t)ks * NTS * DM + (i * 64 + lane) * 4); }
        }
#pragma unroll
        for (int i = 0; i < 16; ++i) sum += v[i][0] + v[i][1] + v[i][2] + v[i][3];
        const float mu = wave_sum(sum) * (1.f / 4096.f);
        float sq = 0.f;
#pragma unroll
        for (int i = 0; i < 16; ++i) { v[i] = v[i] - mu; sq += v[i][0] * v[i][0] + v[i][1] * v[i][1] + v[i][2] * v[i][2] + v[i][3] * v[i][3]; }
        const float rs = rsqrtf(wave_sum(sq) * (1.f / 4096.f) + 1e-5f);
        float* o = p.out + (row < NTP ? O_YP + (size_t)row * DM : O_YS + (size_t)(row - NTP) * DM);
#pragma unroll
        for (int i = 0; i < 16; ++i) { const int c = (i * 64 + lane) * 4; const f32x4 gg = *(const f32x4*)(p.ln_g + c), bb = *(const f32x4*)(p.ln_b + c);
            *(f32x4*)(o + c) = v[i] * rs * gg + bb; }
    }
}

template <int PH>
__global__ __launch_bounds__(512, 2) void mk_fwd(Params p) {
    extern __shared__ __attribute__((aligned(16))) unsigned char smem[];
    LAS unsigned char* lds = (LAS unsigned char*)smem;
    XcdBarrier bar;
    if (PH < 0) {
        if (threadIdx.x == 0) *(LAS u32x4*)(lds + LDS_MISC) = (u32x4){0u, 0u, 0u, 0u};
        __syncthreads();
        bar = xcd_barrier_post((unsigned*)(p.ws + OFF_BAR), (volatile LAS unsigned*)(lds + LDS_MISC));
    }
    if (PH < 0 || PH == 0) { phase_convert(p, lds); if (PROBE_REP == 1) { __syncthreads(); phase_convert(p, lds); } }
    if (PH < 0) xcd_barrier(bar);
    if (PH < 0 || PH == 1) {
        pg8::Gemm g{(const bf16_t*)(p.ws + OFF_XB), (const bf16_t*)(p.ws + OFF_WB), MPAD, NPAD, DM};
        pg8::StaticOrder S; S.init(MPAD, NPAD, (int)gridDim.x, (int)blockIdx.x, true);
        pg8::EpiProj E{(bf16_t*)(p.ws + OFF_P), (float*)(p.ws + OFF_G32)};
        pg8::gemm_phase<pg8::EpiProj, pg8::StaticOrder, true, true>(lds, g, S, E);
        if (PROBE_REP == 2) { __syncthreads(); pg8::gemm_phase<pg8::EpiProj, pg8::StaticOrder, true, true>(lds, g, S, E); }
    }
    if (PH < 0) xcd_barrier(bar);
    if (PH < 0 || PH == 2) { phase_sample_front(p); if (PH < 0) xcd_barrier(bar); else __syncthreads(); phase_scan(p, lds); if (PROBE_REP == 3) phase_scan(p, lds, QCTR_WORD + 64, 0); if (PROBE_REP == 4) phase_scan(p, lds, QCTR_WORD + 64, N_GDN_P + N_SSD_P); if (PROBE_REP == 6) phase_scan(p, lds, QCTR_WORD + 64, 0, N_GDN_P); if (PROBE_REP == 7) phase_scan(p, lds, QCTR_WORD + 64, N_GDN_P, N_GDN_P + N_SSD_P); }
    if (PH < 0) xcd_barrier(bar);
    if (PH < 0 || PH == 3) phase_ssdnorm(p);
    if (PH < 0) xcd_barrier(bar);
    if (PH < 0 || PH == 4) {
        phase_outproj_sample(p, lds);
        pg8::Gemm g{(const bf16_t*)(p.ws + OFF_MIX), (const bf16_t*)(p.ws + OFF_WOB), NTP, DM, MIXW};
        pg8::StaticOrder S; S.init(NTP, DM, (int)gridDim.x, (int)blockIdx.x);
        pg8::EpiOut E{(float*)(p.ws + OFF_R), p.x_prompt, p.x_sample};
        pg8::gemm_phase<pg8::EpiOut, pg8::StaticOrder, true, true>(lds, g, S, E);
        if (PROBE_REP == 5) { __syncthreads(); pg8::gemm_phase<pg8::EpiOut, pg8::StaticOrder, true, true>(lds, g, S, E); }
    }
    if (PH < 0) xcd_barrier(bar);
    if (PH < 0 || PH == 5) phase_ln(p);
}

template <int PH> static void launch_phase(const Params& p, int grid, hipStream_t stream) {
    static bool attr = false;
    if (!attr) { (void)hipFuncSetAttribute((const void*)mk_fwd<PH>, hipFuncAttributeMaxDynamicSharedMemorySize, LDS_BYTES); attr = true; }
    hipLaunchKernelGGL((mk_fwd<PH>), dim3(grid), dim3(512), LDS_BYTES, stream, p);
}

extern "C" void kernel_launch(void* const* d_in, const int* in_sizes, int n_in, void* d_out, int out_size, void* d_ws, size_t ws_size, hipStream_t stream) {
    (void)in_sizes; (void)n_in; (void)out_size;
    if (ws_size < WS_END) { fprintf(stderr, "workspace too small: %zu < %zu\n", ws_size, (size_t)WS_END); return; }
    Params p{};
    p.x_prompt = (const float*)d_in[0]; p.x_sample = (const float*)d_in[1]; p.state_ssd = (const float*)d_in[2]; p.state_ssd_conv = (const float*)d_in[3];
    p.state_gdn = (const float*)d_in[4]; p.state_gdn_conv = (const float*)d_in[5]; p.w_in = (const float*)d_in[6]; p.ssd_conv_w = (const float*)d_in[7];
    p.ssd_conv_b = (const float*)d_in[8]; p.ssd_dt_bias = (const float*)d_in[9]; p.ssd_a_log = (const float*)d_in[10]; p.ssd_d = (const float*)d_in[11];
    p.ssd_norm_w = (const float*)d_in[12]; p.gdn_conv_w = (const float*)d_in[13]; p.gdn_dt_bias = (const float*)d_in[14]; p.gdn_a_log = (const float*)d_in[15];
    p.gdn_norm_w = (const float*)d_in[16]; p.w_out = (const float*)d_in[17]; p.ln_g = (const float*)d_in[18]; p.ln_b = (const float*)d_in[19];
    p.out = (float*)d_out; p.ws = (unsigned char*)d_ws;
    static int grid = 0;
    if (!grid) { int dev = 0, cus = 0; (void)hipGetDevice(&dev); (void)hipDeviceGetAttribute(&cus, hipDeviceAttributeMultiprocessorCount, dev); grid = cus > 0 ? cus : 256; }
    (void)hipMemsetAsync(d_ws, 0, 16384, stream);
#if MK_FUSED
    launch_phase<-1>(p, grid, stream);
#else
    launch_phase<0>(p, grid, stream); launch_phase<1>(p, grid, stream); launch_phase<2>(p, grid, stream);
    launch_phase<3>(p, grid, stream); launch_phase<4>(p, grid, stream); launch_phase<5>(p, grid, stream);
#endif
}
```

```cpp
#include <hip/hip_runtime.h>
#include <cstdio>
#include <cstdint>

#ifndef PROBE_REP
#define PROBE_REP 0
#endif
#ifndef MK_FUSED
#define MK_FUSED 1
#endif

#define LAS __attribute__((address_space(3)))
typedef unsigned short bf16_t;
typedef short bf16x8 __attribute__((ext_vector_type(8)));
typedef float f32x4 __attribute__((ext_vector_type(4)));
typedef float f32x2v __attribute__((ext_vector_type(2)));
typedef unsigned u32x4 __attribute__((ext_vector_type(4)));
typedef unsigned u32x2 __attribute__((ext_vector_type(2)));

constexpr int DM = 4096, NTP = 8192, NTS = 128, NTOK = 8320, MPAD = 8448;
constexpr int NPROJ = 26752, P_LD = 26624, NPAD = 26880, MIXW = 8192, G_LD = 256;
constexpr int C_ZS = 0, C_XBC = 4096, C_QKV = 10240, C_ZG = 22528;
constexpr float ALPHA = 1.189207115002721f;
constexpr int LDS_BYTES = 163840;
constexpr int LDS_MISC = LDS_BYTES - 64;

constexpr size_t OFF_BAR = 0;
constexpr size_t OFF_XB  = 16384;
constexpr size_t OFF_WB  = OFF_XB  + (size_t)MPAD * DM * 2;
constexpr size_t OFF_WOB = OFF_WB  + (size_t)NPAD * DM * 2;
constexpr size_t OFF_P   = OFF_WOB + (size_t)DM * MIXW * 2;
constexpr size_t OFF_G32 = OFF_P   + (size_t)MPAD * P_LD * 2;
constexpr size_t OFF_MIX = OFF_G32 + (size_t)MPAD * G_LD * 4;
constexpr size_t OFF_U32 = OFF_MIX + (size_t)MPAD * MIXW * 2;
constexpr size_t OFF_R   = OFF_U32 + (size_t)MPAD * DM * 4;
constexpr size_t OFF_RPART = OFF_R + (size_t)MPAD * DM * 4;
constexpr size_t OFF_SF  = OFF_RPART + (size_t)16 * NTS * DM * 4;
constexpr size_t WS_END  = OFF_SF + (size_t)16 * 1024 * 1024;
constexpr int QCTR_WORD = 3584;

constexpr size_t O_YP = 0;
constexpr size_t O_YS = O_YP + (size_t)NTP * DM;
constexpr size_t O_SSD_P = O_YS + (size_t)NTS * DM;
constexpr size_t O_SSDC_P = O_SSD_P + (size_t)4 * 64 * 64 * 128;
constexpr size_t O_GDN_P = O_SSDC_P + (size_t)4 * 3 * 6144;
constexpr size_t O_GDNC_P = O_GDN_P + (size_t)4 * 32 * 128 * 128;
constexpr size_t O_SSD_S = O_GDNC_P + (size_t)4 * 3 * 12288;
constexpr size_t O_SSDC_S = O_SSD_S + (size_t)128 * 64 * 64 * 128;
constexpr size_t O_GDN_S = O_SSDC_S + (size_t)128 * 3 * 6144;
constexpr size_t O_GDNC_S = O_GDN_S + (size_t)128 * 32 * 128 * 128;

struct Params {
    const float* x_prompt; const float* x_sample; const float* state_ssd; const float* state_ssd_conv; const float* state_gdn; const float* state_gdn_conv;
    const float* w_in; const float* ssd_conv_w; const float* ssd_conv_b; const float* ssd_dt_bias; const float* ssd_a_log; const float* ssd_d; const float* ssd_norm_w;
    const float* gdn_conv_w; const float* gdn_dt_bias; const float* gdn_a_log; const float* gdn_norm_w; const float* w_out; const float* ln_g; const float* ln_b;
    float* out; unsigned char* ws;
};

__device__ __forceinline__ unsigned cvt_pk_bf16(float lo, float hi) { unsigned r; asm volatile("v_cvt_pk_bf16_f32 %0, %1, %2" : "=v"(r) : "v"(lo), "v"(hi)); return r; }
__device__ __forceinline__ float bf2f(bf16_t v) { return __uint_as_float(((unsigned)v) << 16); }
__device__ __forceinline__ bf16_t f2bf(float f) { unsigned u = __float_as_uint(f); u += 0x7FFFu + ((u >> 16) & 1u); return (bf16_t)(u >> 16); }
__device__ __forceinline__ float silu_f(float x) { return x / (1.f + __expf(-x)); }
__device__ __forceinline__ float sigmoid_f(float x) { return 1.f / (1.f + __expf(-x)); }
__device__ __forceinline__ float softplus_f(float x) { return x > 20.f ? x : log1pf(expf(x)); }
__device__ __forceinline__ f32x4 ldbf4(const bf16_t* p) { const u32x2 v = *(const u32x2*)p; f32x4 r; r[0] = __uint_as_float(v[0] << 16); r[1] = __uint_as_float(v[0] & 0xffff0000u); r[2] = __uint_as_float(v[1] << 16); r[3] = __uint_as_float(v[1] & 0xffff0000u); return r; }
__device__ __forceinline__ int opaque_tid() { int t = threadIdx.x; asm volatile("" : "+v"(t)); return t; }
__device__ __forceinline__ size_t tiled_off(int row, int col, int K) {
    const int r = row & 127, c = col & 63, st = (r >> 4) * 2 + (c >> 5), ob = (r & 15) * 64 + (c & 31) * 2;
    return ((size_t)(row >> 7) * (K >> 6) + (col >> 6)) * 8192 + ((st * 1024 + (ob ^ (((ob >> 9) & 1) << 5))) >> 1);
}
__device__ __forceinline__ float wave_sum(float v) {
#pragma unroll
    for (int m = 32; m >= 1; m >>= 1) v += __shfl_xor(v, m);
    return v;
}

#define XB_TMO      128
#define XB_XCNT(j)  (256  + 64 * (j))
#define XB_XSUB(j)  (1280 + 64 * (j))
#define XB_XGEN(j)  (2304 + 64 * (j))
#define XB_TOP      3328
#define XB_TOPGEN   3392
#define XCD_BAR_WORDS 3456
#define XB_SPIN_CAP (1u << 18)
__device__ __forceinline__ unsigned xb_ld(unsigned* p)              { return __hip_atomic_load(p, __ATOMIC_RELAXED, __HIP_MEMORY_SCOPE_AGENT); }
__device__ __forceinline__ unsigned xb_add(unsigned* p, unsigned v) { return __hip_atomic_fetch_add(p, v, __ATOMIC_RELAXED, __HIP_MEMORY_SCOPE_AGENT); }
__device__ __forceinline__ unsigned xb_xcc_id() { return (unsigned)__builtin_amdgcn_s_getreg((3 << 11) | 20) & 0xFu; }
#define XB_SPIN(cond, bar) do { unsigned _sp = 0; while (cond) { __builtin_amdgcn_s_sleep(1); \
    if ((++_sp & 255u) == 0u) { if (xb_ld(&(bar)[XB_TMO])) break; if (_sp > XB_SPIN_CAP) { atomicAdd(&(bar)[XB_TMO], 1u); break; } } } } while (0)
struct XcdBarrier { unsigned* bar; unsigned x; volatile LAS unsigned* st; };
__device__ __forceinline__ XcdBarrier xcd_barrier_post(unsigned* bar, volatile LAS unsigned* st) {
    XcdBarrier b; b.bar = bar; b.x = xb_xcc_id(); b.st = st;
    if (threadIdx.x == 0) (void)xb_add(&bar[XB_XCNT(b.x)], 1u);
    return b;
}
__device__ __forceinline__ void xcd_barrier_complete(unsigned* bar, unsigned x, unsigned& nloc, unsigned& nx) {
    const unsigned G = gridDim.x * gridDim.y * gridDim.z;
    unsigned sum, cnt, mine, sp = 0u;
    for (;;) {
        sum = 0u; cnt = 0u; mine = 0u;
#pragma unroll
        for (unsigned j = 0; j < 16; ++j) { const unsigned c = xb_ld(&bar[XB_XCNT(j)]); sum += c; cnt += (c > 0u) ? 1u : 0u; mine = (j == x) ? c : mine; }
        if (sum == G) break;
        __builtin_amdgcn_s_sleep(1);
        if ((++sp & 255u) == 0u) { if (xb_ld(&bar[XB_TMO])) break; if (sp > XB_SPIN_CAP) { atomicAdd(&bar[XB_TMO], 1u); break; } }
    }
    nloc = mine > 0u ? mine : 1u; nx = cnt > 0u ? cnt : 1u;
}
__device__ __forceinline__ void xcd_barrier(const XcdBarrier& b) {
    asm volatile("s_waitcnt vmcnt(0)" ::: "memory");
    __syncthreads();
    if (threadIdx.x == 0) {
        unsigned* bar = b.bar;
        __builtin_amdgcn_s_waitcnt(0);
        unsigned nloc = b.st[0], nx = b.st[1];
        if (nloc == 0u) { xcd_barrier_complete(bar, b.x, nloc, nx); b.st[0] = nloc; b.st[1] = nx; }
        const unsigned old = xb_add(&bar[XB_XSUB(b.x)], 1u);
        const unsigned gen = old / nloc;
        if (old + 1u == (gen + 1u) * nloc) {
            __builtin_amdgcn_fence(__ATOMIC_RELEASE, "agent");
            asm volatile("s_waitcnt vmcnt(0)" ::: "memory");
            const unsigned og = xb_add(&bar[XB_TOP], 1u);
            const unsigned tg = og / nx;
            if (og + 1u == (tg + 1u) * nx) xb_add(&bar[XB_TOPGEN], 1u);
            else XB_SPIN(xb_ld(&bar[XB_TOPGEN]) == tg, bar);
            __builtin_amdgcn_fence(__ATOMIC_ACQUIRE, "agent");
            xb_add(&bar[XB_XGEN(b.x)], 1u);
            asm volatile("s_waitcnt vmcnt(0)" ::: "memory");
        } else {
            XB_SPIN(xb_ld(&bar[XB_XGEN(b.x)]) == gen, bar);
            __builtin_amdgcn_fence(__ATOMIC_ACQUIRE, "agent");
            asm volatile("s_waitcnt vmcnt(0)" ::: "memory");
        }
    }
    __syncthreads();
}

namespace pg8 {
constexpr int BM = 256, BK = 64, HALF = 128, HTB = HALF * BK * 2, STAGE_BYTES = 8 * HTB, NXCD = 8, WGM = 8;
__host__ __device__ __forceinline__ int lds_byte(int r, int c) { const int st = (r >> 4) * 2 + (c >> 5), rr = r & 15, cc = c & 31, ob = rr * 64 + cc * 2; return st * 1024 + (ob ^ (((ob >> 9) & 1) << 5)); }
__host__ __device__ __forceinline__ void stage_rc(int b, int& R, int& C) { const int st = b / 1024, sb = b % 1024, swz = sb ^ (((sb >> 9) & 1) << 5); R = (st >> 1) * 16 + swz / 64; C = (st & 1) * 32 + (swz % 64) / 2; }
__host__ __device__ __forceinline__ int perm32(int rho) { const int n = rho >> 4, i = rho & 15; return 8 * (i >> 2) + 4 * n + (i & 3); }
struct Unit { int pm, pn; };
struct Gemm { const bf16_t* A; const bf16_t* Bt; int M, N, K; };
struct StaticOrder {
    int nM, nN, nwg, G, c; bool swapmn;
    __host__ __device__ void init(int M, int N, int G_, int c_, bool sw = false) { swapmn = sw; nM = (sw ? N : M) / BM; nN = (sw ? M : N) / BM; nwg = nM * nN; G = G_; c = c_; }
    __host__ __device__ bool next(int i, Unit& u) const {
        const long L = (long)i * G + c; if (L >= nwg) return false;
        int wgid = (int)L; { const int q = nwg / NXCD, r = nwg % NXCD, xcd = wgid % NXCD, off = wgid / NXCD; wgid = (xcd < r ? xcd * (q + 1) : r * (q + 1) + (xcd - r) * q) + off; }
        const int nig = WGM * nN, gid = wgid / nig, fm = gid * WGM, gsz = (nM - fm) < WGM ? (nM - fm) : WGM;
        const int a = fm + ((wgid % nig) % gsz), b = (wgid % nig) / gsz;
        u.pm = swapmn ? b : a; u.pn = swapmn ? a : b; return true;
    }
    __device__ __forceinline__ void a_ready(const Unit&) const {}
    __device__ __forceinline__ void done(const Unit&) const {}
};

struct EpiProj {
    static constexpr bool PERM = true, AFTER_DRAIN = false;
    bf16_t* P; float* G;
    __device__ __forceinline__ void operator()(const f32x4 (&acc)[2][2][4][2], const Unit& u, int wr, int wc, int fr, int fq) const {
        const int row0 = u.pm * BM + wr * 64 + fr;
        if (u.pn < 104) {
            const int col0 = u.pn * BM + wc * 32 + 8 * fq;
#pragma unroll
            for (int ai = 0; ai < 2; ++ai)
#pragma unroll
                for (int m = 0; m < 4; ++m) { bf16_t* rowp = P + (size_t)(row0 + ai * HALF + m * 16) * P_LD + col0;
#pragma unroll
                    for (int bj = 0; bj < 2; ++bj) { const f32x4 v0 = acc[ai][bj][m][0], v1 = acc[ai][bj][m][1];
                        u32x4 w; w[0] = cvt_pk_bf16(v0[0], v0[1]); w[1] = cvt_pk_bf16(v0[2], v0[3]); w[2] = cvt_pk_bf16(v1[0], v1[1]); w[3] = cvt_pk_bf16(v1[2], v1[3]);
                        *(u32x4*)(rowp + bj * HALF) = w; } }
        } else {
#pragma unroll
            for (int ai = 0; ai < 2; ++ai)
#pragma unroll
                for (int m = 0; m < 4; ++m) { float* rowp = G + (size_t)(row0 + ai * HALF + m * 16) * G_LD + wc * 32 + 8 * fq;
                    *(f32x4*)(rowp) = acc[ai][0][m][0]; *(f32x4*)(rowp + 4) = acc[ai][0][m][1]; }
        }
    }
};
struct EpiOut {
    static constexpr bool PERM = false, AFTER_DRAIN = false;
    float* R; const float* xp; const float* xs;
    __device__ __forceinline__ void operator()(const f32x4 (&acc)[2][2][4][2], const Unit& u, int wr, int wc, int fr, int fq) const {
        const int row0 = u.pm * BM + wr * 64 + fr, col0 = u.pn * BM + wc * 32 + 4 * fq;
#pragma unroll
        for (int ai = 0; ai < 2; ++ai)
#pragma unroll
            for (int m = 0; m < 4; ++m) { const int r = row0 + ai * HALF + m * 16;
                { const float* xr = xp + (size_t)r * DM; float* rr = R + (size_t)r * DM;
#pragma unroll
                    for (int bj = 0; bj < 2; ++bj)
#pragma unroll
                        for (int n = 0; n < 2; ++n) { const int c = col0 + bj * HALF + n * 16; const f32x4 xv = *(const f32x4*)(xr + c); *(f32x4*)(rr + c) = acc[ai][bj][m][n] + ALPHA * xv; } } }
    }
};

template <class Epi, class Sched, bool ALIGN_EPI = false, bool SP2 = false>
__device__ __forceinline__ void gemm_phase(LAS unsigned char* lds, const Gemm g, const Sched& S, const Epi& E) {
    const int tid = threadIdx.x, wid = __builtin_amdgcn_readfirstlane(tid >> 6), lane = tid & 63, wr = wid >> 2, wc = wid & 3, fr = lane & 15, fq = lane >> 4;
    const int K = g.K, nt = K / BK;
    unsigned voffA[2], voffB[2];
#pragma unroll
    for (int i = 0; i < 2; ++i) { voffA[i] = (unsigned)(tid * 16 + i * 8192); voffB[i] = voffA[i]; }
    const size_t kstep = (size_t)(HTB);
    const size_t hstep = (size_t)HALF * K * 2;
    const size_t tstep = 2 * hstep;
    const unsigned ldsw = (unsigned)wid * 1024u;
    const int aoff = lds_byte(wr * 64 + fr, fq * 8), boff = lds_byte(wc * 32 + fr, fq * 8);
#define PG8_SA(b, h) (((b) * 2 + (h)) * HTB)
#define PG8_SB(b, h) ((4 + (b) * 2 + (h)) * HTB)
#define PG8_STAGE(bufoff, gbase, voff) do { _Pragma("unroll") for (int _i = 0; _i < 2; ++_i) \
        __builtin_amdgcn_global_load_lds((const unsigned*)((const char*)(gbase) + (voff)[_i]), (LAS unsigned*)(lds + (bufoff) + ldsw + _i * 8192), 16, 0, 0); } while (0)
#define PG8_LDA(dst, b, h) do { _Pragma("unroll") for (int m = 0; m < 4; ++m) _Pragma("unroll") for (int k = 0; k < 2; ++k) dst[m][k] = *(const LAS bf16x8*)(lds + PG8_SA(b, h) + aoff + m * 2048 + k * 1024); } while (0)
#define PG8_LDB(dst, b, h) do { _Pragma("unroll") for (int n = 0; n < 2; ++n) _Pragma("unroll") for (int k = 0; k < 2; ++k) dst[n][k] = *(const LAS bf16x8*)(lds + PG8_SB(b, h) + boff + n * 2048 + k * 1024); } while (0)
#define PG8_MMA(ai, bj, At, Bt) do { __builtin_amdgcn_s_setprio(1); _Pragma("unroll") for (int m = 0; m < 4; ++m) _Pragma("unroll") for (int n = 0; n < 2; ++n) _Pragma("unroll") for (int k = 0; k < 2; ++k) \
        acc[ai][bj][m][n] = __builtin_amdgcn_mfma_f32_16x16x32_bf16(Bt[n][k], At[m][k], acc[ai][bj][m][n], 0, 0, 0); __builtin_amdgcn_s_setprio(0); } while (0)
#define PG8_WAIT_V(n) asm volatile("s_waitcnt vmcnt(" #n ")" ::: "memory")
#define PG8_WAIT_L(n) asm volatile("s_waitcnt lgkmcnt(" #n ")" ::: "memory")
#define PG8_BAR __builtin_amdgcn_s_barrier()
#define PG8_SCHED __builtin_amdgcn_sched_barrier(0)
    Unit cur, nxt; int ui = 0;
    if (!S.next(0, cur)) return;
    f32x4 acc[2][2][4][2];
#pragma unroll
    for (int a = 0; a < 2; ++a)
#pragma unroll
        for (int b = 0; b < 2; ++b)
#pragma unroll
            for (int m = 0; m < 4; ++m)
#pragma unroll
                for (int n = 0; n < 2; ++n) acc[a][b][m][n] = (f32x4){0.f, 0.f, 0.f, 0.f};
    bf16x8 At[4][2], B0[2][2], B1[2][2];
    const char* cA = (const char*)g.A + (size_t)cur.pm * tstep; const char* cB = (const char*)g.Bt + (size_t)cur.pn * tstep;
    S.a_ready(cur);
    if constexpr (SP2) {
        PG8_STAGE(PG8_SB(0, 0), cB, voffB); PG8_STAGE(PG8_SB(0, 1), cB + hstep, voffB); PG8_STAGE(PG8_SA(0, 0), cA, voffA); PG8_STAGE(PG8_SA(0, 1), cA + hstep, voffA);
        if (wr == 1) PG8_BAR;
        PG8_WAIT_V(2); PG8_BAR;
        PG8_STAGE(PG8_SB(1, 0), cB + kstep, voffB); PG8_STAGE(PG8_SA(1, 0), cA + kstep, voffA); PG8_STAGE(PG8_SB(1, 1), cB + hstep + kstep, voffB);
        PG8_WAIT_V(6); PG8_BAR;
    } else {
        PG8_STAGE(PG8_SB(0, 0), cB, voffB); PG8_STAGE(PG8_SA(0, 0), cA, voffA); PG8_STAGE(PG8_SB(0, 1), cB + hstep, voffB); PG8_STAGE(PG8_SA(0, 1), cA + hstep, voffA);
        if (wr == 1) PG8_BAR;
        PG8_WAIT_V(4); PG8_BAR;
        PG8_STAGE(PG8_SB(1, 0), cB + kstep, voffB); PG8_STAGE(PG8_SA(1, 0), cA + kstep, voffA); PG8_STAGE(PG8_SB(1, 1), cB + hstep + kstep, voffB);
        PG8_WAIT_V(6); PG8_BAR;
    }
    for (;;) {
        const bool has_next = S.next(ui + 1, nxt);
        const char* nA = has_next ? (const char*)g.A + (size_t)nxt.pm * tstep : cA; const char* nB = has_next ? (const char*)g.Bt + (size_t)nxt.pn * tstep : cB;
        for (int t = 0; t < nt; t += 2) {
            const bool last = (t == nt - 2);
            const char* a1 = cA + (size_t)(t + 1) * kstep;
            const char* a2 = last ? nA : cA + (size_t)(t + 2) * kstep; const char* b2 = last ? nB : cB + (size_t)(t + 2) * kstep;
            const char* a3 = a2 + kstep; const char* b3 = b2 + kstep;
            if (last && has_next) S.a_ready(nxt);
            if constexpr (SP2) {
            PG8_LDB(B0, 0, 0); PG8_LDB(B1, 0, 1); PG8_SCHED; PG8_LDA(At, 0, 0); PG8_STAGE(PG8_SA(1, 1), a1 + hstep, voffA);
            PG8_WAIT_V(8); PG8_WAIT_L(0); PG8_BAR; PG8_MMA(0, 0, At, B0); PG8_MMA(0, 1, At, B1); PG8_BAR; PG8_SCHED;
            PG8_LDA(At, 0, 1); PG8_STAGE(PG8_SB(0, 0), b2, voffB); PG8_STAGE(PG8_SB(0, 1), b2 + hstep, voffB); PG8_STAGE(PG8_SA(0, 0), a2, voffA);
            PG8_WAIT_V(8); PG8_WAIT_L(0); PG8_BAR; PG8_MMA(1, 0, At, B0); PG8_MMA(1, 1, At, B1); PG8_BAR; PG8_SCHED;
            PG8_LDB(B0, 1, 0); PG8_LDB(B1, 1, 1); PG8_SCHED; PG8_LDA(At, 1, 0); PG8_STAGE(PG8_SA(0, 1), a2 + hstep, voffA);
            PG8_WAIT_V(8); PG8_WAIT_L(0); PG8_BAR; PG8_MMA(0, 0, At, B0); PG8_MMA(0, 1, At, B1); PG8_BAR; PG8_SCHED;
            PG8_LDA(At, 1, 1); PG8_STAGE(PG8_SB(1, 0), b3, voffB); PG8_STAGE(PG8_SB(1, 1), b3 + hstep, voffB); PG8_STAGE(PG8_SA(1, 0), a3, voffA);
            PG8_WAIT_V(8); PG8_WAIT_L(0); PG8_BAR; PG8_MMA(1, 0, At, B0); PG8_MMA(1, 1, At, B1); PG8_BAR; PG8_SCHED;
            } else {
            PG8_LDB(B0, 0, 0); PG8_SCHED; PG8_LDA(At, 0, 0); PG8_STAGE(PG8_SA(1, 1), a1 + hstep, voffA);
            PG8_WAIT_L(8); PG8_BAR; PG8_WAIT_L(0); PG8_MMA(0, 0, At, B0); PG8_BAR; PG8_SCHED;
            PG8_LDB(B1, 0, 1); PG8_STAGE(PG8_SB(0, 0), b2, voffB);
            PG8_BAR; PG8_WAIT_L(0); PG8_MMA(0, 1, At, B1); PG8_BAR;
            PG8_LDA(At, 0, 1); PG8_STAGE(PG8_SA(0, 0), a2, voffA);
            PG8_BAR; PG8_WAIT_L(0); PG8_MMA(1, 0, At, B0); PG8_BAR; PG8_SCHED;
            PG8_STAGE(PG8_SB(0, 1), b2 + hstep, voffB);
            PG8_WAIT_V(6); PG8_BAR; PG8_MMA(1, 1, At, B1); PG8_BAR;
            PG8_LDB(B0, 1, 0); PG8_SCHED; PG8_LDA(At, 1, 0); PG8_STAGE(PG8_SA(0, 1), a2 + hstep, voffA);
            PG8_WAIT_L(8); PG8_BAR; PG8_WAIT_L(0); PG8_MMA(0, 0, At, B0); PG8_BAR; PG8_SCHED;
            PG8_LDB(B1, 1, 1); PG8_STAGE(PG8_SB(1, 0), b3, voffB);
            PG8_BAR; PG8_WAIT_L(0); PG8_MMA(0, 1, At, B1); PG8_BAR;
            PG8_LDA(At, 1, 1); PG8_STAGE(PG8_SA(1, 0), a3, voffA);
            PG8_BAR; PG8_WAIT_L(0); PG8_MMA(1, 0, At, B0); PG8_BAR; PG8_SCHED;
            PG8_STAGE(PG8_SB(1, 1), b3 + hstep, voffB);
            PG8_WAIT_V(6); PG8_BAR; PG8_MMA(1, 1, At, B1); PG8_BAR;
            }
        }
        if constexpr (ALIGN_EPI) { if (wr == 0) PG8_BAR; }
        if constexpr (!Epi::AFTER_DRAIN) { E(acc, cur, wr, wc, fr, fq); S.done(cur); }
        if (!has_next) break;
#pragma unroll
        for (int a = 0; a < 2; ++a)
#pragma unroll
            for (int b = 0; b < 2; ++b)
#pragma unroll
                for (int m = 0; m < 4; ++m)
#pragma unroll
                    for (int n = 0; n < 2; ++n) acc[a][b][m][n] = (f32x4){0.f, 0.f, 0.f, 0.f};
        cur = nxt; cA = nA; cB = nB; ++ui;
        if constexpr (ALIGN_EPI) { if (wr == 1) PG8_BAR; }
    }
    PG8_WAIT_V(0);
    if constexpr (!ALIGN_EPI) { if (wr == 0) PG8_BAR; }
    PG8_BAR;
#undef PG8_SA
#undef PG8_SB
#undef PG8_STAGE
#undef PG8_LDA
#undef PG8_LDB
#undef PG8_MMA
#undef PG8_WAIT_V
#undef PG8_WAIT_L
#undef PG8_BAR
#undef PG8_SCHED
}
}

template <bool REMAP, bool PERM>
__device__ __forceinline__ void tconv(const float* __restrict__ src, int ldsrc, bf16_t* __restrict__ dst, int K, int ntn, LAS unsigned char* lds) {
    LAS unsigned* T = (LAS unsigned*)lds;
    const int tid = threadIdx.x, nkt = K / 128, total = nkt * ntn;
    for (int tile = blockIdx.x; tile < total; tile += gridDim.x) {
        const int nt = tile / nkt, kt = tile - nt * nkt, n0 = nt * 64, k0 = kt * 128;
        int on0 = n0; bool zero = false;
        if (REMAP) { if (n0 < 10240) on0 = n0; else if (n0 < 26624) on0 = n0 + 64; else if (n0 < 26688) on0 = n0 - 26624 + 10240; else if (n0 < 26752) on0 = n0; else zero = true; }
#pragma unroll
        for (int i = 0; i < 2; ++i) {
            const int rp = (tid >> 4) + 32 * i, c4 = tid & 15;
            f32x4 v0 = (f32x4){0.f, 0.f, 0.f, 0.f}, v1 = v0;
            if (!zero) { const float* s = src + (size_t)(k0 + 2 * rp) * ldsrc + on0 + c4 * 4; v0 = *(const f32x4*)s; v1 = *(const f32x4*)(s + ldsrc); }
#pragma unroll
            for (int j = 0; j < 4; ++j) T[(c4 * 4 + j) * 65 + rp] = cvt_pk_bf16(v0[j], v1[j]);
        }
        __syncthreads();
#pragma unroll
        for (int i = 0; i < 2; ++i) {
            const int n = (tid >> 4) + 32 * i, kc = tid & 15;
            u32x4 v; v[0] = T[n * 65 + kc * 4]; v[1] = T[n * 65 + kc * 4 + 1]; v[2] = T[n * 65 + kc * 4 + 2]; v[3] = T[n * 65 + kc * 4 + 3];
            int nn = n0 + n;
            if (PERM) { const int x = nn & 31; nn = (nn & ~31) + 16 * ((x >> 2) & 1) + 4 * (x >> 3) + (x & 3); }
            *(u32x4*)(dst + tiled_off(nn, k0 + kc * 8, K)) = v;
        }
        __syncthreads();
    }
}
__device__ __forceinline__ void phase_convert(const Params& p, LAS unsigned char* lds) {
    bf16_t* Xb = (bf16_t*)(p.ws + OFF_XB);
    const size_t n8 = (size_t)MPAD * DM / 8;
    for (size_t i = (size_t)blockIdx.x * 512 + threadIdx.x; i < n8; i += (size_t)gridDim.x * 512) {
        const size_t e = i * 8; const int row = (int)(e / DM);
        f32x4 a = (f32x4){0.f, 0.f, 0.f, 0.f}, b = a;
        if (row < NTP) { a = *(const f32x4*)(p.x_prompt + e); b = *(const f32x4*)(p.x_prompt + e + 4); }
        else if (row < NTOK) { const size_t e2 = e - (size_t)NTP * DM; a = *(const f32x4*)(p.x_sample + e2); b = *(const f32x4*)(p.x_sample + e2 + 4); }
        u32x4 o; o[0] = cvt_pk_bf16(a[0], a[1]); o[1] = cvt_pk_bf16(a[2], a[3]); o[2] = cvt_pk_bf16(b[0], b[1]); o[3] = cvt_pk_bf16(b[2], b[3]);
        *(u32x4*)(Xb + tiled_off(row, (int)(e - (size_t)row * DM), DM)) = o;
    }
    { u32x4* mz = (u32x4*)((bf16_t*)(p.ws + OFF_MIX) + (size_t)NTOK * MIXW); const size_t nz = (size_t)(MPAD - NTOK) * MIXW / 8;
      for (size_t i = (size_t)blockIdx.x * 512 + threadIdx.x; i < nz; i += (size_t)gridDim.x * 512) mz[i] = (u32x4){0u, 0u, 0u, 0u}; }
    tconv<true, true>(p.w_in, NPROJ, (bf16_t*)(p.ws + OFF_WB), DM, NPAD / 64, lds);
    tconv<false, false>(p.w_out, DM, (bf16_t*)(p.ws + OFF_WOB), MIXW, DM / 64, lds);
}

constexpr int N_GDN_P = 128, N_SSD_P = 128, N_GDN_S = 2048, N_SSD_S = 1024, N_ITEMS = N_GDN_P + N_SSD_P + N_GDN_S + N_SSD_S;
constexpr int GO_LD = 132;
constexpr size_t SF_SXA = 0;
constexpr size_t SF_GQ  = SF_SXA + (size_t)NTS * 6144;
constexpr size_t SF_SDT = SF_GQ + (size_t)NTS * 12288;
constexpr size_t SF_SEA = SF_SDT + (size_t)NTS * 64;
constexpr size_t SF_GB  = SF_SEA + (size_t)NTS * 64;
constexpr size_t SF_GEG = SF_GB + (size_t)NTS * 32;
constexpr size_t SF_GO  = SF_GEG + (size_t)NTS * 32;
constexpr size_t SF_END = SF_GO + (size_t)NTS * 4096;

__device__ __forceinline__ void phase_sample_front(const Params& p) {
    const bf16_t* P = (const bf16_t*)(p.ws + OFF_P); const float* G = (const float*)(p.ws + OFF_G32); float* SF = (float*)(p.ws + OFF_SF);
    const int tid = threadIdx.x, lane = tid & 63;
    for (int item = blockIdx.x; item < NTS * 4; item += gridDim.x) {
        const int tok = item >> 2, sec = item & 3; const size_t row = (size_t)(NTP + tok);
        if (sec == 0) {
#pragma unroll 1
            for (int i = 0; i < 3; ++i) { const int ch = (tid + i * 512) * 4;
                f32x4 a = *(const f32x4*)(p.ssd_conv_b + ch);
#pragma unroll
                for (int j = 0; j < 4; ++j) { const f32x4 wv = *(const f32x4*)(p.ssd_conv_w + j * 6144 + ch);
                    const f32x4 rv = j < 3 ? *(const f32x4*)(p.state_ssd_conv + ((size_t)tok * 3 + j) * 6144 + ch) : ldbf4(P + row * P_LD + C_XBC + ch);
                    if (j >= 1) *(f32x4*)(p.out + O_SSDC_S + ((size_t)tok * 3 + (j - 1)) * 6144 + ch) = rv;
                    a += wv * rv; }
                *(f32x4*)(SF + SF_SXA + (size_t)tok * 6144 + ch) = (f32x4){silu_f(a[0]), silu_f(a[1]), silu_f(a[2]), silu_f(a[3])}; }
            if (tid < 64) { const float dt = softplus_f(G[row * G_LD + tid] + p.ssd_dt_bias[tid]); SF[SF_SDT + tok * 64 + tid] = dt; SF[SF_SEA + tok * 64 + tid] = expf(-expf(p.ssd_a_log[tid]) * dt); }
        } else {
            const int gs = sec - 1;
#pragma unroll 1
            for (int i = 0; i < 2; ++i) { const int cl = (tid + i * 512) * 4, ch = gs * 4096 + cl;
                f32x4 a = (f32x4){0.f, 0.f, 0.f, 0.f};
#pragma unroll
                for (int j = 0; j < 4; ++j) { const f32x4 wv = *(const f32x4*)(p.gdn_conv_w + j * 12288 + ch);
                    const f32x4 rv = j < 3 ? *(const f32x4*)(p.state_gdn_conv + ((size_t)tok * 3 + j) * 12288 + ch) : ldbf4(P + row * P_LD + C_QKV + ch);
                    if (j >= 1) *(f32x4*)(p.out + O_GDNC_S + ((size_t)tok * 3 + (j - 1)) * 12288 + ch) = rv;
                    a += wv * rv; }
                f32x4 o = (f32x4){silu_f(a[0]), silu_f(a[1]), silu_f(a[2]), silu_f(a[3])};
                if (gs < 2) {
                    float ss = o[0] * o[0] + o[1] * o[1] + o[2] * o[2] + o[3] * o[3];
                    ss += __shfl_xor(ss, 1); ss += __shfl_xor(ss, 2); ss += __shfl_xor(ss, 4); ss += __shfl_xor(ss, 8); ss += __shfl_xor(ss, 16);
                    const float rn = rsqrtf(ss + 1e-6f) * (gs == 0 ? 0.08838834764831845f : 1.f); o = o * rn; }
                *(f32x4*)(SF + SF_GQ + (size_t)tok * 12288 + ch) = o; }
            if (gs == 0 && tid < 32) { const float araw = G[row * G_LD + 96 + tid], braw = G[row * G_LD + 64 + tid];
                SF[SF_GB + tok * 32 + tid] = sigmoid_f(braw); SF[SF_GEG + tok * 32 + tid] = expf(-expf(p.gdn_a_log[tid]) * softplus_f(araw + p.gdn_dt_bias[tid])); }
        }
    }
    (void)lane;
}

__device__ __forceinline__ void ssd_sample_item(const Params& p, const int tok, const int g) {
    const float* SF = (const float*)(p.ws + OFF_SF); const bf16_t* P = (const bf16_t*)(p.ws + OFF_P);
    const int tid = opaque_tid(), w = tid >> 6, lane = tid & 63, half = lane >> 5, nq = lane & 31, h = g * 8 + w;
    const f32x4 B4 = *(const f32x4*)(SF + SF_SXA + (size_t)tok * 6144 + 4096 + g * 128 + nq * 4), C4 = *(const f32x4*)(SF + SF_SXA + (size_t)tok * 6144 + 5120 + g * 128 + nq * 4);
    const float xs_mine = SF[SF_SXA + (size_t)tok * 6144 + h * 64 + lane], dt = SF[SF_SDT + tok * 64 + h], eA = SF[SF_SEA + tok * 64 + h];
    const float z = bf2f(P[(size_t)(NTP + tok) * P_LD + C_ZS + h * 64 + lane]);
    const float xdt_mine = xs_mine * dt;
    const float* Hin = p.state_ssd + ((size_t)(tok * 64 + h) * 64 + 32 * half) * 128 + nq * 4; float* Hout = p.out + O_SSD_S + ((size_t)(tok * 64 + h) * 64 + 32 * half) * 128 + nq * 4;
    float y_mine = 0.f;
    f32x4 buf[2][8];
#pragma unroll
    for (int i = 0; i < 8; ++i) buf[0][i] = *(const f32x4*)(Hin + (size_t)i * 128);
#pragma unroll
    for (int bb = 0; bb < 4; ++bb) {
        if (bb < 3) {
#pragma unroll
            for (int i = 0; i < 8; ++i) buf[(bb + 1) & 1][i] = *(const f32x4*)(Hin + (size_t)((bb + 1) * 8 + i) * 128); }
#pragma unroll
        for (int i = 0; i < 8; ++i) { const int it = bb * 8 + i;
            const float xdt = __shfl(xdt_mine, it + 32 * half);
            const f32x4 hn = eA * buf[bb & 1][i] + xdt * B4;
            *(f32x4*)(Hout + (size_t)it * 128) = hn;
            float y = hn[0] * C4[0] + hn[1] * C4[1] + hn[2] * C4[2] + hn[3] * C4[3];
            y += __shfl_xor(y, 1); y += __shfl_xor(y, 2); y += __shfl_xor(y, 4); y += __shfl_xor(y, 8); y += __shfl_xor(y, 16);
            y_mine = (nq == it) ? y : y_mine; }
    }
    ((float*)(p.ws + OFF_U32))[(size_t)(NTP + tok) * DM + h * 64 + lane] = (y_mine + xs_mine * p.ssd_d[h]) * silu_f(z);
}
__device__ __forceinline__ void gdn_sample_item(const Params& p, const int tok, const int hp) {
    const float* SF = (const float*)(p.ws + OFF_SF); float* SFo = (float*)(p.ws + OFF_SF);
    const int tid = opaque_tid(), w = tid >> 6, lane = tid & 63, dg = lane >> 3, e4 = lane & 7, h = hp * 2 + (w >> 2), es = w & 3;
    const float* Sin = p.state_gdn + ((size_t)(tok * 32 + h) * 128 + dg * 16) * 128 + es * 32 + e4 * 4; float* Sout = p.out + O_GDN_S + ((size_t)(tok * 32 + h) * 128 + dg * 16) * 128 + es * 32 + e4 * 4;
    f32x4 S[16];
#pragma unroll
    for (int i = 0; i < 16; ++i) S[i] = *(const f32x4*)(Sin + (size_t)i * 128);
    const float* qp = SF + SF_GQ + (size_t)tok * 12288 + h * 128 + dg * 16; const float* kp = qp + 4096;
    f32x4 q4[4], k4[4];
#pragma unroll
    for (int i = 0; i < 4; ++i) { q4[i] = *(const f32x4*)(qp + 4 * i); k4[i] = *(const f32x4*)(kp + 4 * i); }
    const f32x4 v4 = *(const f32x4*)(SF + SF_GQ + (size_t)tok * 12288 + 8192 + h * 128 + es * 32 + e4 * 4);
    const float beta = SF[SF_GB + tok * 32 + h], eg = SF[SF_GEG + tok * 32 + h];
    f32x4 ks = (f32x4){0.f, 0.f, 0.f, 0.f};
#pragma unroll
    for (int i = 0; i < 16; ++i) ks += k4[i >> 2][i & 3] * S[i];
#pragma unroll
    for (int c = 0; c < 4; ++c) { ks[c] += __shfl_xor(ks[c], 8); ks[c] += __shfl_xor(ks[c], 16); ks[c] += __shfl_xor(ks[c], 32); }
    const f32x4 vn = beta * (v4 - eg * ks);
    f32x4 o = (f32x4){0.f, 0.f, 0.f, 0.f};
#pragma unroll
    for (int i = 0; i < 16; ++i) { S[i] = eg * S[i] + k4[i >> 2][i & 3] * vn; *(f32x4*)(Sout + (size_t)i * 128) = S[i]; o += q4[i >> 2][i & 3] * S[i]; }
#pragma unroll
    for (int c = 0; c < 4; ++c) { o[c] += __shfl_xor(o[c], 8); o[c] += __shfl_xor(o[c], 16); o[c] += __shfl_xor(o[c], 32); }
    if (dg == 0) *(f32x4*)(SFo + SF_GO + (size_t)tok * 4096 + h * 128 + es * 32 + e4 * 4) = o;
}

typedef __bf16 bf16x2_t __attribute__((ext_vector_type(2)));
typedef short bf16x4 __attribute__((ext_vector_type(4)));
__device__ __forceinline__ unsigned pk_bf16(float lo, float hi) { const f32x2v v = {lo, hi}; return __builtin_bit_cast(unsigned, __builtin_convertvector(v, bf16x2_t)); }
__device__ __forceinline__ bf16x8 pack2(const f32x4 lo, const f32x4 hi) { u32x4 r; r[0] = pk_bf16(lo[0], lo[1]); r[1] = pk_bf16(lo[2], lo[3]); r[2] = pk_bf16(hi[0], hi[1]); r[3] = pk_bf16(hi[2], hi[3]); return __builtin_bit_cast(bf16x8, r); }
__device__ __forceinline__ bf16x8 ld_perm(const LAS bf16_t* rowp, int q) { const u32x2 a = *(const LAS u32x2*)(rowp + 4 * q), b = *(const LAS u32x2*)(rowp + 16 + 4 * q); u32x4 r; r[0] = a[0]; r[1] = a[1]; r[2] = b[0]; r[3] = b[1]; return __builtin_bit_cast(bf16x8, r); }
__device__ __forceinline__ bf16x8 ld_nat(const LAS bf16_t* rowp, int q) { return *(const LAS bf16x8*)(rowp + 8 * q); }
#define MFMA16(a, b, c) __builtin_amdgcn_mfma_f32_16x16x32_bf16((a), (b), (c), 0, 0, 0)

#define BAR_LDS() do { asm volatile("s_waitcnt lgkmcnt(0)" ::: "memory"); __builtin_amdgcn_s_barrier(); asm volatile("" ::: "memory"); } while (0)
#define WAIT_VM0() asm volatile("s_waitcnt vmcnt(0)" ::: "memory")
#define LDP(base, off) __builtin_bit_cast(bf16x8, (u32x4){(*(const LAS u32x2*)((base) + (off)))[0], (*(const LAS u32x2*)((base) + (off)))[1], (*(const LAS u32x2*)((base) + (off) + 16))[0], (*(const LAS u32x2*)((base) + (off) + 16))[1]})
__device__ __forceinline__ float blo(unsigned v) { return __uint_as_float(v << 16); }
__device__ __forceinline__ float bhi(unsigned v) { return __uint_as_float(v & 0xffff0000u); }
__device__ __forceinline__ int kperm(int c) { return (c & ~31) | (((c >> 2) & 3) << 3) | (((c >> 4) & 1) << 2) | (c & 3); }
#define LDQ(base, off) (*(const LAS bf16x8*)((base) + (off)))
__device__ __forceinline__ void dma_raw(LAS unsigned char* lds_raw, const bf16_t* P, const bf16_t* zsrc, const size_t rowbase, const int t0, const int c0, const int c1, const int c2, const int w, const int lane) {
#pragma unroll
    for (int kk = 0; kk < 7; ++kk) {
        int k = w + 8 * kk; k = k > 50 ? 50 : k;
        int seg = 4 * k + (lane >> 4); seg = seg > 200 ? 200 : seg;
        const int row = seg / 3, sec = seg - row * 3, tt = t0 - 3 + row;
        const bf16_t* src = tt >= 0 ? P + (rowbase + tt) * P_LD + (sec == 0 ? c0 : (sec == 1 ? c1 : c2)) : zsrc;
        __builtin_amdgcn_global_load_lds((const unsigned*)(src + (lane & 15) * 8), (LAS unsigned*)(lds_raw + k * 1024), 16, 0, 0);
    }
}
__device__ __forceinline__ void dma_offsets(unsigned (&doff)[7], const int c0, const int c1, const int c2, const int w, const int lane) {
#pragma unroll
    for (int kk = 0; kk < 7; ++kk) { int k = w + 8 * kk; k = k > 50 ? 50 : k; int seg = 4 * k + (lane >> 4); seg = seg > 200 ? 200 : seg; const int row = seg / 3, sec = seg - row * 3;
        doff[kk] = (unsigned)((row * P_LD + (sec == 0 ? c0 : (sec == 1 ? c1 : c2)) + (lane & 15) * 8) * 2); }
}
__device__ __forceinline__ void dma_fast(LAS unsigned char* lds_raw, const char* base, const unsigned (&doff)[7], const int w) {
#pragma unroll
    for (int kk = 0; kk < 7; ++kk) { int k = w + 8 * kk; k = k > 50 ? 50 : k;
        __builtin_amdgcn_global_load_lds((const unsigned*)(base + doff[kk]), (LAS unsigned*)(lds_raw + k * 1024), 16, 0, 0); }
}
__device__ __forceinline__ float reduce16(float (&v)[16], const int lane) {
#pragma unroll
    for (int i = 0; i < 8; ++i) { const bool up = (lane & 32) != 0; const float send = up ? v[i] : v[i + 8], keep = up ? v[i + 8] : v[i]; v[i] = keep + __shfl_xor(send, 32); }
#pragma unroll
    for (int i = 0; i < 4; ++i) { const bool up = (lane & 16) != 0; const float send = up ? v[i] : v[i + 4], keep = up ? v[i + 4] : v[i]; v[i] = keep + __shfl_xor(send, 16); }
#pragma unroll
    for (int i = 0; i < 2; ++i) { const bool up = (lane & 8) != 0; const float send = up ? v[i] : v[i + 2], keep = up ? v[i + 2] : v[i]; v[i] = keep + __shfl_xor(send, 8); }
    { const bool up = (lane & 4) != 0; const float send = up ? v[0] : v[1], keep = up ? v[1] : v[0]; v[0] = keep + __shfl_xor(send, 4); }
    v[0] += __shfl_xor(v[0], 2); v[0] += __shfl_xor(v[0], 1);
    return v[0];
}

constexpr int GL_RAW = 0, GL_QA = 52224, GL_KA = 69632, GL_OB = GL_KA  , GL_KAT = 87040, GL_WL = 105472, GL_AB = 122880, GL_QK = 132096,
              GL_ADT = 141312, GL_TF = 145408, GL_TOK = 147456, GL_SSQ = 148480, GL_LAST = 148992, GL_WTS = 149056, GL_TOK2 = 155200, GL_NW = 156224;
__device__ __forceinline__ void gdn_chunk_item(const Params& p, LAS unsigned char* lds, const int b, const int h) {
    const bf16_t* P = (const bf16_t*)(p.ws + OFF_P); const float* G = (const float*)(p.ws + OFF_G32); bf16_t* MIX = (bf16_t*)(p.ws + OFF_MIX);
    const bf16_t* zsrc = (const bf16_t*)(p.ws + OFF_XB) + (size_t)NTOK * DM;
    const size_t rowbase = (size_t)b * 2048;
    const float Aneg = -expf(p.gdn_a_log[h]), dtb = p.gdn_dt_bias[h];
    const int c0 = C_QKV + h * 128, c1 = C_QKV + 4096 + h * 128, c2 = C_QKV + 8192 + h * 128;
    f32x4 Sacc[8];
#pragma unroll
    for (int j = 0; j < 8; ++j) Sacc[j] = (f32x4){0.f, 0.f, 0.f, 0.f};
    float g_araw = 0.f, g_braw = 0.f;
    unsigned doff[7];
    {
        const int tid = opaque_tid(), lane = tid & 63, w = __builtin_amdgcn_readfirstlane(tid >> 6);
        dma_offsets(doff, c0, c1, c2, w, lane);
        for (int i = tid; i < (9216 * 2) / 4; i += 512) ((LAS unsigned*)(lds + GL_AB))[i] = 0u;
        for (int i = tid; i < 1536; i += 512) { const int j = i / 384, cc = i - j * 384; ((LAS float*)(lds + GL_WTS))[i] = p.gdn_conv_w[j * 12288 + (cc >> 7) * 4096 + h * 128 + (cc & 127)]; }
        if (tid < 128) ((LAS float*)(lds + GL_NW))[tid] = p.gdn_norm_w[tid];
        if (w == 0) { g_araw = G[(rowbase + lane) * G_LD + 96 + h]; g_braw = G[(rowbase + lane) * G_LD + 64 + h]; }
        asm volatile("" : "+v"(g_araw), "+v"(g_braw));
        dma_raw(lds + GL_RAW, P, zsrc, rowbase, 0, c0, c1, c2, w, lane);
    }
#pragma unroll 1
    for (int c = 0; c < 32; ++c) {
        const int t0 = c * 64;
        if (c == 0) WAIT_VM0(); else asm volatile("s_waitcnt vmcnt(2)" ::: "memory");
        BAR_LDS();
        {
            const int tid = opaque_tid(), lane = tid & 63, w = tid >> 6;
            const LAS unsigned char* rawl = lds + GL_RAW + (8 * w) * 768 + lane * 4; const LAS float* wts = (const LAS float*)(lds + GL_WTS) + 2 * lane;
            float ssv[16];
#pragma unroll
            for (int sec = 0; sec < 2; ++sec) {
                f32x2v wj[4];
#pragma unroll
                for (int j = 0; j < 4; ++j) wj[j] = *(const LAS f32x2v*)(wts + j * 384 + sec * 128);
                float x0[11], x1[11];
#pragma unroll
                for (int rr = 0; rr < 11; ++rr) { const unsigned u = *(const LAS unsigned*)(rawl + rr * 768 + sec * 256); x0[rr] = blo(u); x1[rr] = bhi(u); }
                unsigned pk[8];
#pragma unroll
                for (int t = 0; t < 8; ++t) {
                    const float a0 = silu_f(wj[0][0] * x0[t] + wj[1][0] * x0[t + 1] + wj[2][0] * x0[t + 2] + wj[3][0] * x0[t + 3]);
                    const float a1 = silu_f(wj[0][1] * x1[t] + wj[1][1] * x1[t + 1] + wj[2][1] * x1[t + 2] + wj[3][1] * x1[t + 3]);
                    ssv[2 * t + sec] = a0 * a0 + a1 * a1; pk[t] = pk_bf16(a0, a1);
                    *(LAS unsigned*)(lds + (sec == 0 ? GL_QA : GL_KA) + ((8 * w + t) * 136 + kperm(2 * lane)) * 2) = pk[t];
                }
                if (sec == 1) {
                    u32x4 ke, ko;
#pragma unroll
                    for (int t2 = 0; t2 < 4; ++t2) { ke[t2] = (pk[2 * t2] & 0xffffu) | (pk[2 * t2 + 1] << 16); ko[t2] = (pk[2 * t2] >> 16) | (pk[2 * t2 + 1] & 0xffff0000u); }
                    const int tp = kperm(8 * w);
                    LAS unsigned char* k0 = lds + GL_KAT + ((2 * lane) * 72 + tp) * 2; LAS unsigned char* k1 = k0 + 144;
                    *(LAS u32x2*)k0 = (u32x2){ke[0], ke[1]}; *(LAS u32x2*)(k0 + 16) = (u32x2){ke[2], ke[3]}; *(LAS u32x2*)k1 = (u32x2){ko[0], ko[1]}; *(LAS u32x2*)(k1 + 16) = (u32x2){ko[2], ko[3]};
                }
            }
            const float tot = reduce16(ssv, lane);
            if ((lane & 3) == 0) ((LAS float*)(lds + GL_SSQ))[16 * w + (lane >> 2)] = tot;
            if (c == 31 && w == 7) {
                float* convout = p.out + O_GDNC_P + (size_t)b * 3 * 12288 + h * 128 + 2 * lane;
#pragma unroll
                for (int j = 0; j < 3; ++j)
#pragma unroll
                    for (int sec = 0; sec < 3; ++sec) { const unsigned u = *(const LAS unsigned*)(lds + GL_RAW + ((64 + j) * 3 + sec) * 256 + lane * 4); *(f32x2v*)(convout + j * 12288 + sec * 4096) = (f32x2v){blo(u), bhi(u)}; }
            }
        }
        BAR_LDS();
        {
            const int tid = opaque_tid(), lane = tid & 63;
            if ((tid >> 6) == 0) {
                const LAS float* ssq = (const LAS float*)(lds + GL_SSQ);
                float cs = Aneg * softplus_f(g_araw + dtb); const float beta = sigmoid_f(g_braw);
#pragma unroll
                for (int d = 1; d < 64; d <<= 1) { const float n = __shfl_up(cs, d); if (lane >= d) cs += n; }
                f32x4 tv; tv[0] = rsqrtf(ssq[lane * 2] + 1e-6f) * 0.08838834764831845f; tv[1] = rsqrtf(ssq[lane * 2 + 1] + 1e-6f); tv[2] = beta; tv[3] = cs;
                ((LAS f32x4*)(lds + GL_TOK))[lane] = tv; if (lane == 63) *(LAS float*)(lds + GL_LAST) = cs;
                const float lastv = __shfl(cs, 63), ec = __expf(cs);
                ((LAS f32x2v*)(lds + GL_TOK2))[lane] = (f32x2v){beta, tv[1] * beta * ec};
                ((LAS f32x2v*)(lds + GL_TOK2 + 512))[lane] = (f32x2v){tv[0] * ec, tv[1] * __expf(lastv - cs)};
            }
        }
        BAR_LDS();
        u32x4 zreg[2];
        {
            const int tid = opaque_tid(), lane = tid & 63;
#pragma unroll
            for (int it = 0; it < 2; ++it) { const int idx = tid + it * 512; zreg[it] = *(const u32x4*)(P + (rowbase + t0 + (idx >> 4)) * P_LD + C_ZG + h * 128 + (idx & 15) * 8); }
            if ((tid >> 6) == 0 && c < 31) { const size_t row = rowbase + t0 + 64 + lane; g_araw = G[row * G_LD + 96 + h]; g_braw = G[row * G_LD + 64 + h]; }
        }
        {
            const int tid = opaque_tid(), w = tid >> 6, lane = tid & 63, r = lane & 15, q = lane >> 4;
#pragma unroll 1
            for (int job = w; job < 20; job += 8) {
                const int tj = job < 10 ? job : job - 10; const bool isQK = job >= 10;
                const int ti = tj >= 6 ? 3 : (tj >= 3 ? 2 : (tj >= 1 ? 1 : 0)), si = tj - (ti * (ti + 1)) / 2;
                const LAS bf16_t* Ab = (const LAS bf16_t*)(lds + (isQK ? GL_QA : GL_KA)) + (ti * 16 + r) * 136 + 8 * q; const LAS bf16_t* Bb = (const LAS bf16_t*)(lds + GL_KA) + (si * 16 + r) * 136 + 8 * q;
                f32x4 acc = (f32x4){0.f, 0.f, 0.f, 0.f};
#pragma unroll
                for (int kk = 0; kk < 4; ++kk) acc = MFMA16(*(const LAS bf16x8*)(Ab + kk * 32), *(const LAS bf16x8*)(Bb + kk * 32), acc);
                const int s = si * 16 + r; const f32x4 ts = ((const LAS f32x4*)(lds + GL_TOK))[s];
                const LAS f32x4* tq = (const LAS f32x4*)(lds + GL_TOK) + ti * 16 + 4 * q;
                float val[4];
#pragma unroll
                for (int reg = 0; reg < 4; ++reg) { const int t = ti * 16 + 4 * q + reg; const f32x4 tt = tq[reg]; const float dec = __expf(tt[3] - ts[3]);
                    val[reg] = isQK ? (s <= t ? acc[reg] * tt[0] * ts[1] * dec : 0.f) : (s < t ? -(acc[reg] * tt[1] * ts[1] * tt[2] * dec) : 0.f); }
                LAS bf16_t* dst = (LAS bf16_t*)(lds + (isQK ? GL_QK : GL_AB)) + (ti * 16 + 4 * q) * 72 + kperm(s);
                const bool diagKK = (!isQK) && (ti == si);
#pragma unroll
                for (int reg = 0; reg < 4; ++reg) dst[reg * 72] = diagKK ? (bf16_t)0 : (bf16_t)(pk_bf16(val[reg], 0.f) & 0xffffu);
                if (diagKK) *(LAS f32x4*)((LAS float*)(lds + GL_ADT) + (ti * 16 + r) * 16 + 4 * q) = (f32x4){val[0], val[1], val[2], val[3]};
            }
        }
        BAR_LDS();
        {
            const int tid = opaque_tid(), w = tid >> 6, lane = tid & 63, r = lane & 15, q = lane >> 4;
            if (w < 4) {
                const LAS float* A = (const LAS float*)(lds + GL_ADT) + w * 256;
                float tr[16];
#pragma unroll
                for (int j = 15; j >= 0; --j) { float v = (j == r) ? 1.f : 0.f;
#pragma unroll
                    for (int k = j + 1; k < 16; ++k) v += tr[k] * A[j * 16 + k];
                    tr[j] = v; }
                const float s0 = q == 0 ? tr[0] : (q == 1 ? tr[4] : (q == 2 ? tr[8] : tr[12])), s1 = q == 0 ? tr[1] : (q == 1 ? tr[5] : (q == 2 ? tr[9] : tr[13]));
                const float s2 = q == 0 ? tr[2] : (q == 1 ? tr[6] : (q == 2 ? tr[10] : tr[14])), s3 = q == 0 ? tr[3] : (q == 1 ? tr[7] : (q == 2 ? tr[11] : tr[15]));
                u32x2 tv; tv[0] = pk_bf16(s0, s1); tv[1] = pk_bf16(s2, s3); ((LAS u32x2*)(lds + GL_TF))[w * 64 + lane] = tv;
            }
        }
        BAR_LDS();
        f32x4 U[4];
        {
            const int tid = opaque_tid(), w = tid >> 6, lane = tid & 63, r = lane & 15, q = lane >> 4, E = w * 16 + r;
            const LAS f32x2v* tq = (const LAS f32x2v*)(lds + GL_TOK2) + 4 * q;
            const LAS bf16_t* RvE = (const LAS bf16_t*)(lds + GL_RAW) + ((4 * q) * 3 + 2) * 128 + E; const LAS bf16_t* KaE = (const LAS bf16_t*)(lds + GL_KA) + (4 * q) * 136 + kperm(E);
            const LAS bf16_t* AbR = (const LAS bf16_t*)(lds + GL_AB) + r * 72 + 8 * q;
            const LAS u32x2* TfL = (const LAS u32x2*)(lds + GL_TF) + lane;
            LAS bf16_t* WlE = (LAS bf16_t*)(lds + GL_WL) + (4 * q) * 136 + kperm(E);
            const LAS float* wv = (const LAS float*)(lds + GL_WTS) + 256 + E;
            const float w0 = wv[0], w1 = wv[384], w2 = wv[768], w3 = wv[1152];
            float xr[4][7], ka[4][4]; f32x2v t3[4][4]; bf16x8 af[4]; u32x2 tf[4];
#pragma unroll
            for (int i = 0; i < 4; ++i) {
#pragma unroll
                for (int k = 0; k < 7; ++k) xr[i][k] = bf2f(RvE[(16 * i + k) * 384]);
#pragma unroll
                for (int reg = 0; reg < 4; ++reg) { ka[i][reg] = bf2f(KaE[(16 * i + reg) * 136]); t3[i][reg] = tq[16 * i + reg]; }
                tf[i] = TfL[i * 64];
            }
            af[0] = LDQ(AbR, 16 * 72); af[1] = LDQ(AbR, 32 * 72); af[2] = LDQ(AbR, 48 * 72); af[3] = LDQ(AbR, 48 * 72 + 32);
            __builtin_amdgcn_sched_barrier(0);
            f32x4 au[4], aw[4];
#pragma unroll
            for (int i = 0; i < 4; ++i)
#pragma unroll
                for (int reg = 0; reg < 4; ++reg) { au[i][reg] = silu_f(w0 * xr[i][reg] + w1 * xr[i][reg + 1] + w2 * xr[i][reg + 2] + w3 * xr[i][reg + 3]) * t3[i][reg][0]; aw[i][reg] = ka[i][reg] * t3[i][reg][1]; }
            u32x4 XU[2], XW[2];
            XU[0] = XU[1] = XW[0] = XW[1] = (u32x4){0u, 0u, 0u, 0u};
            const f32x4 z4 = (f32x4){0.f, 0.f, 0.f, 0.f};
#pragma unroll
            for (int i = 0; i < 4; ++i) {
                f32x4 cu = au[i], cw = aw[i];
                if (i >= 1) { cu = MFMA16(af[i - 1], __builtin_bit_cast(bf16x8, XU[0]), cu); cw = MFMA16(af[i - 1], __builtin_bit_cast(bf16x8, XW[0]), cw); }
                if (i == 3) { cu = MFMA16(af[3], __builtin_bit_cast(bf16x8, XU[1]), cu); cw = MFMA16(af[3], __builtin_bit_cast(bf16x8, XW[1]), cw); }
                const u32x4 ta = (u32x4){tf[i][0], tf[i][1], 0u, 0u};
                const u32x4 yu = (u32x4){pk_bf16(cu[0], cu[1]), pk_bf16(cu[2], cu[3]), 0u, 0u}, yw = (u32x4){pk_bf16(cw[0], cw[1]), pk_bf16(cw[2], cw[3]), 0u, 0u};
                const f32x4 xu = MFMA16(__builtin_bit_cast(bf16x8, ta), __builtin_bit_cast(bf16x8, yu), z4), xw = MFMA16(__builtin_bit_cast(bf16x8, ta), __builtin_bit_cast(bf16x8, yw), z4);
                U[i] = xu;
                XU[i >> 1][2 * (i & 1)] = pk_bf16(xu[0], xu[1]); XU[i >> 1][2 * (i & 1) + 1] = pk_bf16(xu[2], xu[3]);
                const unsigned n01 = pk_bf16(-xw[0], -xw[1]), n23 = pk_bf16(-xw[2], -xw[3]);
                XW[i >> 1][2 * (i & 1)] = n01 ^ 0x80008000u; XW[i >> 1][2 * (i & 1) + 1] = n23 ^ 0x80008000u;
                WlE[(16 * i + 0) * 136] = (bf16_t)(n01 & 0xffffu); WlE[(16 * i + 1) * 136] = (bf16_t)(n01 >> 16); WlE[(16 * i + 2) * 136] = (bf16_t)(n23 & 0xffffu); WlE[(16 * i + 3) * 136] = (bf16_t)(n23 >> 16);
            }
        }
        asm volatile("" : "+v"(zreg[0]), "+v"(zreg[1]), "+v"(g_araw), "+v"(g_braw));
        BAR_LDS();
        {
            const int tid = opaque_tid(), w = __builtin_amdgcn_readfirstlane(tid >> 6);
            dma_fast(lds + GL_RAW, (const char*)(P + (rowbase + (c < 31 ? t0 + 61 : t0 - 3)) * P_LD), doff, w);
        }
        {
            const int tid = opaque_tid(), w = tid >> 6, lane = tid & 63, r = lane & 15, q = lane >> 4, E = w * 16 + r;
            const LAS f32x2v* tq = (const LAS f32x2v*)(lds + GL_TOK2 + 512) + 4 * q;
            const LAS bf16_t* WlR = (const LAS bf16_t*)(lds + GL_WL) + r * 136 + 8 * q; const LAS bf16_t* QaR = (const LAS bf16_t*)(lds + GL_QA) + r * 136 + 8 * q;
            const LAS bf16_t* QkR = (const LAS bf16_t*)(lds + GL_QK) + r * 72 + 8 * q; const LAS bf16_t* KtR = (const LAS bf16_t*)(lds + GL_KAT) + r * 72 + 8 * q;
            LAS bf16_t* obE = (LAS bf16_t*)(lds + GL_OB) + (4 * q) * 136 + E;
#define SCHED_B() __builtin_amdgcn_sched_barrier(0)
            bf16x8 fa[8], fb[8];
#pragma unroll
            for (int x = 0; x < 8; ++x) fa[x] = LDQ(WlR, 16 * (x >> 2) * 136 + 32 * (x & 3));
            SCHED_B();
#pragma unroll
            for (int x = 0; x < 8; ++x) fb[x] = LDQ(WlR, 16 * (2 + (x >> 2)) * 136 + 32 * (x & 3));
            bf16x8 Sb[4];
#pragma unroll
            for (int kp = 0; kp < 4; ++kp) Sb[kp] = pack2(Sacc[2 * kp], Sacc[2 * kp + 1]);
            f32x2v t4[4][4];
#pragma unroll
            for (int i = 0; i < 4; ++i)
#pragma unroll
                for (int reg = 0; reg < 4; ++reg) t4[i][reg] = tq[16 * i + reg];
            const float el = __expf(*(const LAS float*)(lds + GL_LAST));
            SCHED_B();
            f32x4 vn[4], oo[4];
#pragma unroll
            for (int i = 0; i < 2; ++i) { f32x4 acc = U[i];
#pragma unroll
                for (int kp = 0; kp < 4; ++kp) acc = MFMA16(fa[4 * i + kp], Sb[kp], acc);
                vn[i] = acc; }
            SCHED_B();
#pragma unroll
            for (int x = 0; x < 8; ++x) fa[x] = LDQ(QaR, 16 * (x >> 2) * 136 + 32 * (x & 3));
            SCHED_B();
#pragma unroll
            for (int i = 0; i < 2; ++i) { f32x4 acc = U[2 + i];
#pragma unroll
                for (int kp = 0; kp < 4; ++kp) acc = MFMA16(fb[4 * i + kp], Sb[kp], acc);
                vn[2 + i] = acc; }
            SCHED_B();
#pragma unroll
            for (int x = 0; x < 8; ++x) fb[x] = LDQ(QaR, 16 * (2 + (x >> 2)) * 136 + 32 * (x & 3));
            SCHED_B();
#pragma unroll
            for (int i = 0; i < 2; ++i) { f32x4 acc = (f32x4){0.f, 0.f, 0.f, 0.f};
#pragma unroll
                for (int kp = 0; kp < 4; ++kp) acc = MFMA16(fa[4 * i + kp], Sb[kp], acc);
                oo[i] = acc; }
            SCHED_B();
            fa[0] = LDQ(QkR, 0); fa[1] = LDQ(QkR, 16 * 72); fa[2] = LDQ(QkR, 32 * 72); fa[3] = LDQ(QkR, 32 * 72 + 32); fa[4] = LDQ(QkR, 48 * 72); fa[5] = LDQ(QkR, 48 * 72 + 32);
            SCHED_B();
#pragma unroll
            for (int i = 0; i < 2; ++i) { f32x4 acc = (f32x4){0.f, 0.f, 0.f, 0.f};
#pragma unroll
                for (int kp = 0; kp < 4; ++kp) acc = MFMA16(fb[4 * i + kp], Sb[kp], acc);
                oo[2 + i] = acc; }
            f32x4 vs[4];
#pragma unroll
            for (int i = 0; i < 4; ++i)
#pragma unroll
                for (int reg = 0; reg < 4; ++reg) { oo[i][reg] *= t4[i][reg][0]; vs[i][reg] = vn[i][reg] * t4[i][reg][1]; }
            bf16x8 Vn[2], Vs[2];
            Vn[0] = pack2(vn[0], vn[1]); Vn[1] = pack2(vn[2], vn[3]); Vs[0] = pack2(vs[0], vs[1]); Vs[1] = pack2(vs[2], vs[3]);
            SCHED_B();
#pragma unroll
            for (int x = 0; x < 8; ++x) fb[x] = LDQ(KtR, 16 * (x >> 1) * 72 + 32 * (x & 1));
            SCHED_B();
            oo[0] = MFMA16(fa[0], Vn[0], oo[0]); oo[1] = MFMA16(fa[1], Vn[0], oo[1]);
            oo[2] = MFMA16(fa[2], Vn[0], oo[2]); oo[2] = MFMA16(fa[3], Vn[1], oo[2]);
            oo[3] = MFMA16(fa[4], Vn[0], oo[3]); oo[3] = MFMA16(fa[5], Vn[1], oo[3]);
            SCHED_B();
#pragma unroll
            for (int x = 0; x < 8; ++x) fa[x] = LDQ(KtR, 16 * (4 + (x >> 1)) * 72 + 32 * (x & 1));
            SCHED_B();
#pragma unroll
            for (int j = 0; j < 4; ++j) { f32x4 acc = Sacc[j] * el; acc = MFMA16(fb[2 * j], Vs[0], acc); acc = MFMA16(fb[2 * j + 1], Vs[1], acc); Sacc[j] = acc; }
#pragma unroll
            for (int i = 0; i < 4; ++i) { const unsigned o01 = pk_bf16(oo[i][0], oo[i][1]), o23 = pk_bf16(oo[i][2], oo[i][3]);
                obE[(16 * i + 0) * 136] = (bf16_t)(o01 & 0xffffu); obE[(16 * i + 1) * 136] = (bf16_t)(o01 >> 16); obE[(16 * i + 2) * 136] = (bf16_t)(o23 & 0xffffu); obE[(16 * i + 3) * 136] = (bf16_t)(o23 >> 16); }
            SCHED_B();
#pragma unroll
            for (int j = 0; j < 4; ++j) { f32x4 acc = Sacc[4 + j] * el; acc = MFMA16(fa[2 * j], Vs[0], acc); acc = MFMA16(fa[2 * j + 1], Vs[1], acc); Sacc[4 + j] = acc; }
        }
        BAR_LDS();
        {
            const int tid = opaque_tid();
#pragma unroll
            for (int it = 0; it < 2; ++it) { const int idx = tid + it * 512, t = idx >> 4, e8 = (idx & 15) * 8;
                const u32x4 ov = *(const LAS u32x4*)(lds + GL_OB + (t * 136 + e8) * 2);
                float o[8];
#pragma unroll
                for (int k = 0; k < 4; ++k) { o[2 * k] = blo(ov[k]); o[2 * k + 1] = bhi(ov[k]); }
                float ss = 0.f;
#pragma unroll
                for (int k = 0; k < 8; ++k) ss += o[k] * o[k];
                ss += __shfl_xor(ss, 1); ss += __shfl_xor(ss, 2); ss += __shfl_xor(ss, 4); ss += __shfl_xor(ss, 8);
                const float rs = rsqrtf(ss * (1.f / 128.f) + 1e-6f);
                const f32x4 n0 = *(const LAS f32x4*)(lds + GL_NW + e8 * 4), n1 = *(const LAS f32x4*)(lds + GL_NW + e8 * 4 + 16);
                u32x4 res;
#pragma unroll
                for (int k = 0; k < 4; ++k) { const float za = blo(zreg[it][k]), zb = bhi(zreg[it][k]); const float na = k < 2 ? n0[2 * k] : n1[2 * k - 4], nb = k < 2 ? n0[2 * k + 1] : n1[2 * k - 3];
                    res[k] = pk_bf16(o[2 * k] * rs * na * silu_f(za), o[2 * k + 1] * rs * nb * silu_f(zb)); }
                *(u32x4*)(MIX + tiled_off((int)(rowbase + t0 + t), 4096 + h * 128 + e8, MIXW)) = res; }
        }
    }
    WAIT_VM0();
    {
        const int tid = opaque_tid(), w = tid >> 6, lane = tid & 63, r = lane & 15, q = lane >> 4, E = w * 16 + r;
        float* So = p.out + O_GDN_P + (size_t)(b * 32 + h) * 16384 + (4 * q) * 128 + E;
#pragma unroll
        for (int j = 0; j < 8; ++j)
#pragma unroll
            for (int reg = 0; reg < 4; ++reg) So[(16 * j + reg) * 128] = Sacc[j][reg];
    }
}

constexpr int SL_RAW = 0, SL_CA = 52224, SL_BA = 69632, SL_BAT = 87040, SL_XST = 105472, SL_CB = 123904, SL_TOK = 133120, SL_LAST = 135168, SL_YB = 135232, SL_WTS = 152640, SL_BIAS = 158784;
__device__ __forceinline__ void ssd_chunk_item(const Params& p, LAS unsigned char* lds, const int b, const int g, const int hp) {
    const bf16_t* P = (const bf16_t*)(p.ws + OFF_P); const float* G = (const float*)(p.ws + OFF_G32); float* Uo = (float*)(p.ws + OFF_U32);
    const bf16_t* zsrc = (const bf16_t*)(p.ws + OFF_XB) + (size_t)NTOK * DM;
    const int h0 = g * 8 + hp * 2;
    const size_t rowbase = (size_t)b * 2048;
    const int c0 = C_XBC + h0 * 64, c1 = C_XBC + 4096 + g * 128, c2 = C_XBC + 5120 + g * 128;
    f32x4 Hacc[8];
#pragma unroll
    for (int j = 0; j < 8; ++j) Hacc[j] = (f32x4){0.f, 0.f, 0.f, 0.f};
    float g_dtraw = 0.f, g_A = 0.f, g_dtb = 0.f, g_D = 0.f, g_dtnext = 0.f;
    unsigned doff[7];
    {
        const int tid = opaque_tid(), lane = tid & 63, w = __builtin_amdgcn_readfirstlane(tid >> 6);
        dma_offsets(doff, c0, c1, c2, w, lane);
        for (int i = tid; i < 1536 + 384; i += 512) {
            const int j = i / 384, cc = i - j * 384, sec = cc >> 7, col = cc & 127, ch = sec == 0 ? h0 * 64 + col : (sec == 1 ? 4096 + g * 128 + col : 5120 + g * 128 + col);
            if (j < 4) ((LAS float*)(lds + SL_WTS))[i] = p.ssd_conv_w[j * 6144 + ch]; else ((LAS float*)(lds + SL_BIAS))[cc] = p.ssd_conv_b[ch]; }
        if (w < 2) { const int hh = h0 + w; g_dtraw = G[(rowbase + lane) * G_LD + hh]; g_A = -expf(p.ssd_a_log[hh]); g_dtb = p.ssd_dt_bias[hh]; }
        g_D = p.ssd_d[h0 + (w >> 2)];
        asm volatile("" : "+v"(g_dtraw), "+v"(g_A), "+v"(g_dtb), "+v"(g_D));
        dma_raw(lds + SL_RAW, P, zsrc, rowbase, 0, c0, c1, c2, w, lane);
    }
#pragma unroll 1
    for (int c = 0; c < 32; ++c) {
        const int t0 = c * 64;
        if (c == 0) WAIT_VM0(); else asm volatile("s_waitcnt vmcnt(4)" ::: "memory");
        BAR_LDS();
        u32x4 zreg[2];
        {
            const int tid = opaque_tid(), lane = tid & 63, w = tid >> 6;
#pragma unroll
            for (int it = 0; it < 2; ++it) { const int idx = tid + it * 512; zreg[it] = *(const u32x4*)(P + (rowbase + t0 + (idx >> 4)) * P_LD + C_ZS + h0 * 64 + (idx & 15) * 8); }
            if (w < 2 && c < 31) g_dtnext = G[(rowbase + t0 + 64 + lane) * G_LD + h0 + w];
        }
        {
            const int tid = opaque_tid(), lane = tid & 63, w = tid >> 6;
            const LAS unsigned char* rawl = lds + SL_RAW + (8 * w) * 768 + lane * 4; const LAS float* wts = (const LAS float*)(lds + SL_WTS) + 2 * lane; const LAS float* bia = (const LAS float*)(lds + SL_BIAS) + 2 * lane;
#pragma unroll
            for (int sec = 0; sec < 3; ++sec) {
                f32x2v wj[4];
#pragma unroll
                for (int j = 0; j < 4; ++j) wj[j] = *(const LAS f32x2v*)(wts + j * 384 + sec * 128);
                const f32x2v bj = *(const LAS f32x2v*)(bia + sec * 128);
                float x0[11], x1[11];
#pragma unroll
                for (int rr = 0; rr < 11; ++rr) { const unsigned u = *(const LAS unsigned*)(rawl + rr * 768 + sec * 256); x0[rr] = blo(u); x1[rr] = bhi(u); }
                unsigned pk[8];
#pragma unroll
                for (int t = 0; t < 8; ++t) {
                    const float a0 = silu_f(bj[0] + wj[0][0] * x0[t] + wj[1][0] * x0[t + 1] + wj[2][0] * x0[t + 2] + wj[3][0] * x0[t + 3]);
                    const float a1 = silu_f(bj[1] + wj[0][1] * x1[t] + wj[1][1] * x1[t + 1] + wj[2][1] * x1[t + 2] + wj[3][1] * x1[t + 3]);
                    pk[t] = pk_bf16(a0, a1);
                    if (sec >= 1) *(LAS unsigned*)(lds + (sec == 1 ? SL_BA : SL_CA) + ((8 * w + t) * 136 + kperm(2 * lane)) * 2) = pk[t];
                }
                if (sec <= 1) {
                    u32x4 ke, ko;
#pragma unroll
                    for (int t2 = 0; t2 < 4; ++t2) { ke[t2] = (pk[2 * t2] & 0xffffu) | (pk[2 * t2 + 1] << 16); ko[t2] = (pk[2 * t2] >> 16) | (pk[2 * t2 + 1] & 0xffff0000u); }
                    *(LAS u32x4*)(lds + (sec == 0 ? SL_XST : SL_BAT) + ((2 * lane) * 72 + 8 * w) * 2) = ke; *(LAS u32x4*)(lds + (sec == 0 ? SL_XST : SL_BAT) + ((2 * lane + 1) * 72 + 8 * w) * 2) = ko;
                }
            }
            if (c == 31 && w == 7) {
                float* convout = p.out + O_SSDC_P + (size_t)b * 3 * 6144 + 2 * lane;
#pragma unroll
                for (int j = 0; j < 3; ++j)
#pragma unroll
                    for (int sec = 0; sec < 3; ++sec) { if (sec == 0 || hp == 0) { const unsigned u = *(const LAS unsigned*)(lds + SL_RAW + ((64 + j) * 3 + sec) * 256 + lane * 4);
                        *(f32x2v*)(convout + j * 6144 + (sec == 0 ? h0 * 64 : (sec == 1 ? 4096 + g * 128 : 5120 + g * 128))) = (f32x2v){blo(u), bhi(u)}; } }
            }
        }
        asm volatile("" : "+v"(zreg[0]), "+v"(zreg[1]), "+v"(g_dtnext));
        BAR_LDS();
        {
            const int tid = opaque_tid(), lane = tid & 63, r = lane & 15, q = lane >> 4, w = __builtin_amdgcn_readfirstlane(tid >> 6);
            dma_fast(lds + SL_RAW, (const char*)(P + (rowbase + (c < 31 ? t0 + 61 : t0 - 3)) * P_LD), doff, w);
            if (w < 2) {
                const float dt = softplus_f(g_dtraw + g_dtb); g_dtraw = g_dtnext;
                float cs = g_A * dt;
#pragma unroll
                for (int d = 1; d < 64; d <<= 1) { const float n = __shfl_up(cs, d); if (lane >= d) cs += n; }
                const float lastv = __shfl(cs, 63);
                ((LAS f32x4*)(lds + SL_TOK))[w * 64 + lane] = (f32x4){dt, cs, __expf(cs), dt * __expf(lastv - cs)}; if (lane == 63) ((LAS float*)(lds + SL_LAST))[w] = cs;
            } else {
#pragma unroll 1
                for (int job = w - 2; job < 10; job += 6) {
                    const int ti = job >= 6 ? 3 : (job >= 3 ? 2 : (job >= 1 ? 1 : 0)), si = job - (ti * (ti + 1)) / 2;
                    const LAS bf16_t* Ab = (const LAS bf16_t*)(lds + SL_CA) + (ti * 16 + r) * 136 + 8 * q; const LAS bf16_t* Bb = (const LAS bf16_t*)(lds + SL_BA) + (si * 16 + r) * 136 + 8 * q;
                    f32x4 acc = (f32x4){0.f, 0.f, 0.f, 0.f};
#pragma unroll
                    for (int kk = 0; kk < 4; ++kk) acc = MFMA16(*(const LAS bf16x8*)(Ab + kk * 32), *(const LAS bf16x8*)(Bb + kk * 32), acc);
                    LAS bf16_t* dst = (LAS bf16_t*)(lds + SL_CB) + (ti * 16 + 4 * q) * 72 + si * 16 + r;
#pragma unroll
                    for (int reg = 0; reg < 4; ++reg) dst[reg * 72] = (bf16_t)(pk_bf16(acc[reg], 0.f) & 0xffffu);
                }
            }
        }
        BAR_LDS();
        {
            const int tid = opaque_tid(), w = tid >> 6, lane = tid & 63, r = lane & 15, q = lane >> 4, hl = w >> 2, Pc = (w & 3) * 16 + r;
            const float Dh = g_D;
            const LAS f32x4* tk = (const LAS f32x4*)(lds + SL_TOK) + hl * 64; const float last = ((const LAS float*)(lds + SL_LAST))[hl];
            const LAS bf16_t* XsP = (const LAS bf16_t*)(lds + SL_XST) + (hl * 64 + Pc) * 72;
            const LAS bf16_t* CaR = (const LAS bf16_t*)(lds + SL_CA) + r * 136 + 8 * q; const LAS bf16_t* CbR = (const LAS bf16_t*)(lds + SL_CB) + r * 72 + 8 * q;
            const LAS bf16_t* BtR = (const LAS bf16_t*)(lds + SL_BAT) + r * 72 + 8 * q;
            LAS bf16_t* ybE = (LAS bf16_t*)(lds + SL_YB) + (4 * q) * 136 + hl * 64 + Pc;
            bf16x8 Hb[4];
#pragma unroll
            for (int kp = 0; kp < 4; ++kp) Hb[kp] = pack2(Hacc[2 * kp], Hacc[2 * kp + 1]);
            bf16x8 xf[2], xw[2];
#pragma unroll
            for (int kp = 0; kp < 2; ++kp) { const u32x4 xv = *(const LAS u32x4*)(XsP + 32 * kp + 8 * q); xf[kp] = __builtin_bit_cast(bf16x8, xv);
                u32x4 xs;
#pragma unroll
                for (int e2 = 0; e2 < 4; ++e2) { const float wa = tk[32 * kp + 8 * q + 2 * e2][3], wb = tk[32 * kp + 8 * q + 2 * e2 + 1][3];
                    xs[e2] = pk_bf16(blo(xv[e2]) * wa, bhi(xv[e2]) * wb); }
                xw[kp] = __builtin_bit_cast(bf16x8, xs); }
#pragma unroll
            for (int i = 0; i < 4; ++i) {
                f32x4 acc = (f32x4){0.f, 0.f, 0.f, 0.f};
#pragma unroll
                for (int kp = 0; kp < 4; ++kp) acc = MFMA16(LDQ(CaR, 16 * i * 136 + 32 * kp), Hb[kp], acc);
#pragma unroll
                for (int reg = 0; reg < 4; ++reg) acc[reg] *= tk[16 * i + 4 * q + reg][2];
                const int t = 16 * i + r; const float cum_t = tk[t][1];
#pragma unroll
                for (int kp = 0; kp < 2; ++kp) { if (kp <= (i >> 1)) {
                    const u32x4 cbv = *(const LAS u32x4*)(CbR + 16 * i * 72 + 32 * kp);
                    float lv[8];
#pragma unroll
                    for (int jj = 0; jj < 8; ++jj) { const int s = 32 * kp + 8 * q + jj; const f32x4 ts = tk[s]; const float cb = (jj & 1) ? bhi(cbv[jj >> 1]) : blo(cbv[jj >> 1]);
                        lv[jj] = s <= t ? cb * __expf(cum_t - ts[1]) * ts[0] : 0.f; }
                    const u32x4 lw = (u32x4){pk_bf16(lv[0], lv[1]), pk_bf16(lv[2], lv[3]), pk_bf16(lv[4], lv[5]), pk_bf16(lv[6], lv[7])};
                    acc = MFMA16(__builtin_bit_cast(bf16x8, lw), xf[kp], acc); } }
                const u32x2 xd = *(const LAS u32x2*)(XsP + 16 * i + 4 * q);
                acc[0] += blo(xd[0]) * Dh; acc[1] += bhi(xd[0]) * Dh; acc[2] += blo(xd[1]) * Dh; acc[3] += bhi(xd[1]) * Dh;
#pragma unroll
                for (int reg = 0; reg < 4; ++reg) ybE[(16 * i + reg) * 136] = (bf16_t)(pk_bf16(acc[reg], 0.f) & 0xffffu);
            }
            const float el = __expf(last);
#pragma unroll
            for (int j = 0; j < 8; ++j) { f32x4 acc = Hacc[j] * el;
                acc = MFMA16(*(const LAS bf16x8*)(BtR + 16 * j * 72), xw[0], acc); acc = MFMA16(*(const LAS bf16x8*)(BtR + 16 * j * 72 + 32), xw[1], acc);
                Hacc[j] = acc; }
        }
        BAR_LDS();
        {
            const int tid = opaque_tid();
#pragma unroll
            for (int it = 0; it < 2; ++it) { const int idx = tid + it * 512, t = idx >> 4, e8 = (idx & 15) * 8;
                const u32x4 yv = *(const LAS u32x4*)(lds + SL_YB + (t * 136 + e8) * 2);
                f32x4 o0, o1;
                o0[0] = blo(yv[0]) * silu_f(blo(zreg[it][0])); o0[1] = bhi(yv[0]) * silu_f(bhi(zreg[it][0])); o0[2] = blo(yv[1]) * silu_f(blo(zreg[it][1])); o0[3] = bhi(yv[1]) * silu_f(bhi(zreg[it][1]));
                o1[0] = blo(yv[2]) * silu_f(blo(zreg[it][2])); o1[1] = bhi(yv[2]) * silu_f(bhi(zreg[it][2])); o1[2] = blo(yv[3]) * silu_f(blo(zreg[it][3])); o1[3] = bhi(yv[3]) * silu_f(bhi(zreg[it][3]));
                float* up = Uo + (rowbase + t0 + t) * DM + h0 * 64 + e8; *(f32x4*)up = o0; *(f32x4*)(up + 4) = o1; }
        }
    }
    WAIT_VM0();
    {
        const int tid = opaque_tid(), w = tid >> 6, lane = tid & 63, r = lane & 15, q = lane >> 4, hl = w >> 2, Pc = (w & 3) * 16 + r;
        float* Ho = p.out + O_SSD_P + ((size_t)(b * 64 + h0 + hl) * 64 + Pc) * 128 + 4 * q;
#pragma unroll
        for (int j = 0; j < 8; ++j) *(f32x4*)(Ho + 16 * j) = Hacc[j];
    }
}

__device__ __forceinline__ void phase_scan(const Params& p, LAS unsigned char* lds, const int qword = QCTR_WORD, const int item0 = 0, const int item_end = N_ITEMS) {
    LAS int* qslot = (LAS int*)(lds + LDS_MISC + 16);
    unsigned* qctr = (unsigned*)(p.ws + OFF_BAR) + qword;
    for (;;) {
        __syncthreads();
        if (threadIdx.x == 0) *qslot = item0 + (int)__hip_atomic_fetch_add(qctr, 1u, __ATOMIC_RELAXED, __HIP_MEMORY_SCOPE_AGENT);
        __syncthreads();
        const int item = __builtin_amdgcn_readfirstlane(*qslot);
        if (item >= item_end) break;
        if (item < N_GDN_P) gdn_chunk_item(p, lds, item >> 5, item & 31);
        else if (item < N_GDN_P + N_SSD_P) { const int i = item - N_GDN_P; ssd_chunk_item(p, lds, i >> 5, (i >> 2) & 7, i & 3); }
        else if (item < N_GDN_P + N_SSD_P + N_GDN_S) { const int i = item - N_GDN_P - N_SSD_P; gdn_sample_item(p, i >> 4, i & 15); }
        else { const int i = item - N_GDN_P - N_SSD_P - N_GDN_S; ssd_sample_item(p, i >> 3, i & 7); }
    }
}

__device__ __forceinline__ void phase_outproj_sample(const Params& p, LAS unsigned char* lds) {
    const int tid = threadIdx.x, wid = __builtin_amdgcn_readfirstlane(tid >> 6), lane = tid & 63, wr = wid >> 2, wc = wid & 3, fr = lane & 15, fq = lane >> 4;
    const int aoff = pg8::lds_byte(wr * 64 + fr, fq * 8), boff = pg8::lds_byte((wc & 1) * 64 + fr, fq * 8) + 16384 + (wc >> 1) * 16384;
    for (int u = blockIdx.x; u < 256; u += gridDim.x) {
        const int pn = u & 15, ks = u >> 4;
        const char* gA = (const char*)(p.ws + OFF_MIX) + ((size_t)64 * 128 + ks * 8) * 16384;
        const char* gB0 = (const char*)(p.ws + OFF_WOB) + ((size_t)(2 * pn) * 128 + ks * 8) * 16384; const char* gB1 = gB0 + (size_t)128 * 16384;
#define OS_ISSUE(kt, st) do { _Pragma("unroll") for (int pc = 0; pc < 6; ++pc) { const char* s_ = (pc < 2 ? gA : (pc < 4 ? gB0 : gB1)) + (size_t)(kt) * 16384 + (pc & 1) * 8192 + tid * 16; \
            __builtin_amdgcn_global_load_lds((const unsigned*)s_, (LAS unsigned*)(lds + (st) * 49152 + pc * 8192 + wid * 1024), 16, 0, 0); } } while (0)
        f32x4 acc[4][4];
#pragma unroll
        for (int m = 0; m < 4; ++m)
#pragma unroll
            for (int n = 0; n < 4; ++n) acc[m][n] = (f32x4){0.f, 0.f, 0.f, 0.f};
        OS_ISSUE(0, 0); OS_ISSUE(1, 1); OS_ISSUE(2, 2);
#pragma unroll
        for (int kt = 0; kt < 8; ++kt) {
            if (kt <= 5) asm volatile("s_waitcnt vmcnt(12)" ::: "memory"); else if (kt == 6) asm volatile("s_waitcnt vmcnt(6)" ::: "memory"); else asm volatile("s_waitcnt vmcnt(0)" ::: "memory");
            __builtin_amdgcn_s_barrier(); asm volatile("" ::: "memory");
            const LAS unsigned char* sb = lds + (kt % 3) * 49152;
            bf16x8 af[4][2], bfr[4][2];
#pragma unroll
            for (int m = 0; m < 4; ++m)
#pragma unroll
                for (int k = 0; k < 2; ++k) { af[m][k] = *(const LAS bf16x8*)(sb + aoff + m * 2048 + k * 1024); bfr[m][k] = *(const LAS bf16x8*)(sb + boff + m * 2048 + k * 1024); }
#pragma unroll
            for (int m = 0; m < 4; ++m)
#pragma unroll
                for (int n = 0; n < 4; ++n)
#pragma unroll
                    for (int k = 0; k < 2; ++k) acc[m][n] = __builtin_amdgcn_mfma_f32_16x16x32_bf16(bfr[n][k], af[m][k], acc[m][n], 0, 0, 0);
            asm volatile("s_waitcnt lgkmcnt(0)" ::: "memory"); __builtin_amdgcn_s_barrier(); asm volatile("" ::: "memory");
            if (kt + 3 < 8) OS_ISSUE(kt + 3, kt % 3);
        }
#undef OS_ISSUE
        float* Rp = (float*)(p.ws + OFF_RPART) + ((size_t)ks * NTS + wr * 64 + fr) * DM + pn * 256 + wc * 64 + 4 * fq;
#pragma unroll
        for (int m = 0; m < 4; ++m)
#pragma unroll
            for (int n = 0; n < 4; ++n) *(f32x4*)(Rp + (size_t)(m * 16) * DM + n * 16) = acc[m][n];
    }
    __syncthreads();
}

__device__ __forceinline__ void phase_ssdnorm(const Params& p) {
    const float* U = (const float*)(p.ws + OFF_U32); bf16_t* MIX = (bf16_t*)(p.ws + OFF_MIX);
    const int lane = threadIdx.x & 63, gw = blockIdx.x * 8 + (threadIdx.x >> 6), nw = gridDim.x * 8;
    for (int it = gw; it < NTOK * 8; it += nw) {
        const int row = it >> 3, g = it & 7; const size_t off = (size_t)row * DM + g * 512 + lane * 8;
        const f32x4 a = *(const f32x4*)(U + off), b = *(const f32x4*)(U + off + 4);
        const float ss = wave_sum(a[0] * a[0] + a[1] * a[1] + a[2] * a[2] + a[3] * a[3] + b[0] * b[0] + b[1] * b[1] + b[2] * b[2] + b[3] * b[3]);
        const float rs = rsqrtf(ss * (1.f / 512.f) + 1e-6f);
        const f32x4 wa = *(const f32x4*)(p.ssd_norm_w + g * 512 + lane * 8), wb = *(const f32x4*)(p.ssd_norm_w + g * 512 + lane * 8 + 4);
        u32x4 o; o[0] = cvt_pk_bf16(a[0] * rs * wa[0], a[1] * rs * wa[1]); o[1] = cvt_pk_bf16(a[2] * rs * wa[2], a[3] * rs * wa[3]);
        o[2] = cvt_pk_bf16(b[0] * rs * wb[0], b[1] * rs * wb[1]); o[3] = cvt_pk_bf16(b[2] * rs * wb[2], b[3] * rs * wb[3]);
        *(u32x4*)(MIX + tiled_off(row, g * 512 + lane * 8, MIXW)) = o;
    }
    const float* GO = (const float*)(p.ws + OFF_SF) + SF_GO; const bf16_t* P = (const bf16_t*)(p.ws + OFF_P);
    for (int it = gw; it < NTS * 32; it += nw) {
        const int tok = it >> 5, h = it & 31;
        const float o0 = GO[(size_t)tok * 4096 + h * 128 + lane], o1 = GO[(size_t)tok * 4096 + h * 128 + 64 + lane];
        const float rs = rsqrtf(wave_sum(o0 * o0 + o1 * o1) * (1.f / 128.f) + 1e-6f);
        const size_t prow = (size_t)(NTP + tok) * P_LD + C_ZG + h * 128;
        MIX[tiled_off(NTP + tok, 4096 + h * 128 + lane, MIXW)] = f2bf(o0 * rs * p.gdn_norm_w[lane] * silu_f(bf2f(P[prow + lane])));
        MIX[tiled_off(NTP + tok, 4096 + h * 128 + 64 + lane, MIXW)] = f2bf(o1 * rs * p.gdn_norm_w[64 + lane] * silu_f(bf2f(P[prow + 64 + lane])));
    }
}

__device__ __forceinline__ void phase_ln(const Params& p) {
    const float* R = (const float*)(p.ws + OFF_R);
    const int lane = threadIdx.x & 63, gw = blockIdx.x * 8 + (threadIdx.x >> 6), nw = gridDim.x * 8;
    for (int row = gw; row < NTOK; row += nw) {
        const float* rr = R + (size_t)row * DM;
        f32x4 v[16]; float sum = 0.f;
        if (row < NTP) {
#pragma unroll
            for (int i = 0; i < 16; ++i) v[i] = *(const f32x4*)(rr + (i * 64 + lane) * 4);
        } else {
            const float* xr = p.x_sample + (size_t)(row - NTP) * DM; const float* pr = (const float*)(p.ws + OFF_RPART) + (size_t)(row - NTP) * DM;
#pragma unroll
            for (int i = 0; i < 16; ++i) v[i] = ALPHA * *(const f32x4*)(xr + (i * 64 + lane) * 4);
#pragma unroll 1
            for (int ks = 0; ks < 16; ++ks) {
#pragma unroll
                for (int i = 0; i < 16; ++i) v[i] += *(const f32x4*)(pr + (size_t)ks * NTS * DM + (i * 64 + lane) * 4); }
        }
#pragma unroll
        for (int i = 0; i < 16; ++i) sum += v[i][0] + v[i][1] + v[i][2] + v[i][3];
        const float mu = wave_sum(sum) * (1.f / 4096.f);
        float sq = 0.f;
#pragma unroll
        for (int i = 0; i < 16; ++i) { v[i] = v[i] - mu; sq += v[i][0] * v[i][0] + v[i][1] * v[i][1] + v[i][2] * v[i][2] + v[i][3] * v[i][3]; }
        const float rs = rsqrtf(wave_sum(sq) * (1.f / 4096.f) + 1e-5f);
        float* o = p.out + (row < NTP ? O_YP + (size_t)row * DM : O_YS + (size_t)(row - NTP) * DM);
#pragma unroll
        for (int i = 0; i < 16; ++i) { const int c = (i * 64 + lane) * 4; const f32x4 gg = *(const f32x4*)(p.ln_g + c), bb = *(const f32x4*)(p.ln_b + c);
            *(f32x4*)(o + c) = v[i] * rs * gg + bb; }
    }
}

template <int PH>
__global__ __launch_bounds__(512, 2) void mk_fwd(Params p) {
    extern __shared__ __attribute__((aligned(16))) unsigned char smem[];
    LAS unsigned char* lds = (LAS unsigned char*)smem;
    XcdBarrier bar;
    if (PH < 0) {
        if (threadIdx.x == 0) *(LAS u32x4*)(lds + LDS_MISC) = (u32x4){0u, 0u, 0u, 0u};
        __syncthreads();
        bar = xcd_barrier_post((unsigned*)(p.ws + OFF_BAR), (volatile LAS unsigned*)(lds + LDS_MISC));
    }
    if (PH < 0 || PH == 0) { phase_convert(p, lds); if (PROBE_REP == 1) { __syncthreads(); phase_convert(p, lds); } }
    if (PH < 0) xcd_barrier(bar);
    if (PH < 0 || PH == 1) {
        pg8::Gemm g{(const bf16_t*)(p.ws + OFF_XB), (const bf16_t*)(p.ws + OFF_WB), MPAD, NPAD, DM};
        pg8::StaticOrder S; S.init(MPAD, NPAD, (int)gridDim.x, (int)blockIdx.x, true);
        pg8::EpiProj E{(bf16_t*)(p.ws + OFF_P), (float*)(p.ws + OFF_G32)};
        pg8::gemm_phase<pg8::EpiProj, pg8::StaticOrder, true, true>(lds, g, S, E);
        if (PROBE_REP == 2) { __syncthreads(); pg8::gemm_phase<pg8::EpiProj, pg8::StaticOrder, true, true>(lds, g, S, E); }
    }
    if (PH < 0) xcd_barrier(bar);
    if (PH < 0 || PH == 2) { phase_sample_front(p); if (PH < 0) xcd_barrier(bar); else __syncthreads(); phase_scan(p, lds); if (PROBE_REP == 3) phase_scan(p, lds, QCTR_WORD + 64, 0); if (PROBE_REP == 4) phase_scan(p, lds, QCTR_WORD + 64, N_GDN_P + N_SSD_P); if (PROBE_REP == 6) phase_scan(p, lds, QCTR_WORD + 64, 0, N_GDN_P); if (PROBE_REP == 7) phase_scan(p, lds, QCTR_WORD + 64, N_GDN_P, N_GDN_P + N_SSD_P); }
    if (PH < 0) xcd_barrier(bar);
    if (PH < 0 || PH == 3) phase_ssdnorm(p);
    if (PH < 0) xcd_barrier(bar);
    if (PH < 0 || PH == 4) {
        phase_outproj_sample(p, lds);
        pg8::Gemm g{(const bf16_t*)(p.ws + OFF_MIX), (const bf16_t*)(p.ws + OFF_WOB), NTP, DM, MIXW};
        pg8::StaticOrder S; S.init(NTP, DM, (int)gridDim.x, (int)blockIdx.x);
        pg8::EpiOut E{(float*)(p.ws + OFF_R), p.x_prompt, p.x_sample};
        pg8::gemm_phase<pg8::EpiOut, pg8::StaticOrder, true, true>(lds, g, S, E);
        if (PROBE_REP == 5) { __syncthreads(); pg8::gemm_phase<pg8::EpiOut, pg8::StaticOrder, true, true>(lds, g, S, E); }
    }
    if (PH < 0) xcd_barrier(bar);
    if (PH < 0 || PH == 5) phase_ln(p);
}

template <int PH> static void launch_phase(const Params& p, int grid, hipStream_t stream) {
    static bool attr = false;
    if (!attr) { (void)hipFuncSetAttribute((const void*)mk_fwd<PH>, hipFuncAttributeMaxDynamicSharedMemorySize, LDS_BYTES); attr = true; }
    hipLaunchKernelGGL((mk_fwd<PH>), dim3(grid), dim3(512), LDS_BYTES, stream, p);
}

extern "C" void kernel_launch(void* const* d_in, const int* in_sizes, int n_in, void* d_out, int out_size, void* d_ws, size_t ws_size, hipStream_t stream) {
    (void)in_sizes; (void)n_in; (void)out_size;
    if (ws_size < WS_END) { fprintf(stderr, "workspace too small: %zu < %zu\n", ws_size, (size_t)WS_END); return; }
    Params p{};
    p.x_prompt = (const float*)d_in[0]; p.x_sample = (const float*)d_in[1]; p.state_ssd = (const float*)d_in[2]; p.state_ssd_conv = (const float*)d_in[3];
    p.state_gdn = (const float*)d_in[4]; p.state_gdn_conv = (const float*)d_in[5]; p.w_in = (const float*)d_in[6]; p.ssd_conv_w = (const float*)d_in[7];
    p.ssd_conv_b = (const float*)d_in[8]; p.ssd_dt_bias = (const float*)d_in[9]; p.ssd_a_log = (const float*)d_in[10]; p.ssd_d = (const float*)d_in[11];
    p.ssd_norm_w = (const float*)d_in[12]; p.gdn_conv_w = (const float*)d_in[13]; p.gdn_dt_bias = (const float*)d_in[14]; p.gdn_a_log = (const float*)d_in[15];
    p.gdn_norm_w = (const float*)d_in[16]; p.w_out = (const float*)d_in[17]; p.ln_g = (const float*)d_in[18]; p.ln_b = (const float*)d_in[19];
    p.out = (float*)d_out; p.ws = (unsigned char*)d_ws;
    static int grid = 0;
    if (!grid) { int dev = 0, cus = 0; (void)hipGetDevice(&dev); (void)hipDeviceGetAttribute(&cus, hipDeviceAttributeMultiprocessorCount, dev); grid = cus > 0 ? cus : 256; }
    (void)hipMemsetAsync(d_ws, 0, 16384, stream);
#if MK_FUSED
    launch_phase<-1>(p, grid, stream);
#else
    launch_phase<0>(p, grid, stream); launch_phase<1>(p, grid, stream); launch_phase<2>(p, grid, stream);
    launch_phase<3>(p, grid, stream); launch_phase<4>(p, grid, stream); launch_phase<5>(p, grid, stream);
#endif
}
```

```cpp
#include <hip/hip_runtime.h>
#include <cstdio>
#include <cstdint>

#ifndef PROBE_REP
#define PROBE_REP 0
#endif
#ifndef MK_FUSED
#define MK_FUSED 1
#endif

#define LAS __attribute__((address_space(3)))
typedef unsigned short bf16_t;
typedef short bf16x8 __attribute__((ext_vector_type(8)));
typedef float f32x4 __attribute__((ext_vector_type(4)));
typedef float f32x2v __attribute__((ext_vector_type(2)));
typedef unsigned u32x4 __attribute__((ext_vector_type(4)));
typedef unsigned u32x2 __attribute__((ext_vector_type(2)));

constexpr int DM = 4096, NTP = 8192, NTS = 128, NTOK = 8320, MPAD = 8448;
constexpr int NPROJ = 26752, P_LD = 26624, NPAD = 26880, MIXW = 8192, G_LD = 256;
constexpr int C_ZS = 0, C_XBC = 4096, C_QKV = 10240, C_ZG = 22528;
constexpr float ALPHA = 1.189207115002721f;
constexpr int LDS_BYTES = 163840;
constexpr int LDS_MISC = LDS_BYTES - 64;

constexpr size_t OFF_BAR = 0;
constexpr size_t OFF_XB  = 32768;
constexpr size_t OFF_WB  = OFF_XB  + (size_t)MPAD * DM * 2;
constexpr size_t OFF_WOB = OFF_WB  + (size_t)NPAD * DM * 2;
constexpr size_t OFF_P   = OFF_WOB + (size_t)DM * MIXW * 2;
constexpr size_t OFF_G32 = OFF_P   + (size_t)MPAD * P_LD * 2;
constexpr size_t OFF_MIX = OFF_G32 + (size_t)MPAD * G_LD * 4;
constexpr size_t OFF_U32 = OFF_MIX + (size_t)MPAD * MIXW * 2;
constexpr size_t OFF_R   = OFF_U32 + (size_t)MPAD * DM * 4;
constexpr size_t OFF_RPART = OFF_R + (size_t)MPAD * DM * 4;
constexpr size_t OFF_SF  = OFF_RPART + (size_t)16 * NTS * DM * 4;
constexpr size_t WS_END  = OFF_SF + (size_t)16 * 1024 * 1024;
constexpr int QCTR_WORD = 3584;
constexpr int READY_WORD = 4096;
constexpr int HOOK_TMO_WORD = 5120;
constexpr int NCONV = 8;
constexpr int PRE_SLABS = 8;
constexpr int N_SLABS = 14, SLAB_TILES = 1024, WIN_TILES = 13440, WOUT_TILES = 4096;

constexpr size_t O_YP = 0;
constexpr size_t O_YS = O_YP + (size_t)NTP * DM;
constexpr size_t O_SSD_P = O_YS + (size_t)NTS * DM;
constexpr size_t O_SSDC_P = O_SSD_P + (size_t)4 * 64 * 64 * 128;
constexpr size_t O_GDN_P = O_SSDC_P + (size_t)4 * 3 * 6144;
constexpr size_t O_GDNC_P = O_GDN_P + (size_t)4 * 32 * 128 * 128;
constexpr size_t O_SSD_S = O_GDNC_P + (size_t)4 * 3 * 12288;
constexpr size_t O_SSDC_S = O_SSD_S + (size_t)128 * 64 * 64 * 128;
constexpr size_t O_GDN_S = O_SSDC_S + (size_t)128 * 3 * 6144;
constexpr size_t O_GDNC_S = O_GDN_S + (size_t)128 * 32 * 128 * 128;

struct Params {
    const float* x_prompt; const float* x_sample; const float* state_ssd; const float* state_ssd_conv; const float* state_gdn; const float* state_gdn_conv;
    const float* w_in; const float* ssd_conv_w; const float* ssd_conv_b; const float* ssd_dt_bias; const float* ssd_a_log; const float* ssd_d; const float* ssd_norm_w;
    const float* gdn_conv_w; const float* gdn_dt_bias; const float* gdn_a_log; const float* gdn_norm_w; const float* w_out; const float* ln_g; const float* ln_b;
    float* out; unsigned char* ws;
};

__device__ __forceinline__ unsigned cvt_pk_bf16(float lo, float hi) { unsigned r; asm volatile("v_cvt_pk_bf16_f32 %0, %1, %2" : "=v"(r) : "v"(lo), "v"(hi)); return r; }
__device__ __forceinline__ float bf2f(bf16_t v) { return __uint_as_float(((unsigned)v) << 16); }
__device__ __forceinline__ bf16_t f2bf(float f) { unsigned u = __float_as_uint(f); u += 0x7FFFu + ((u >> 16) & 1u); return (bf16_t)(u >> 16); }
__device__ __forceinline__ float silu_f(float x) { return x / (1.f + __expf(-x)); }
__device__ __forceinline__ float sigmoid_f(float x) { return 1.f / (1.f + __expf(-x)); }
__device__ __forceinline__ float softplus_f(float x) { return x > 20.f ? x : log1pf(expf(x)); }
__device__ __forceinline__ f32x4 ldbf4(const bf16_t* p) { const u32x2 v = *(const u32x2*)p; f32x4 r; r[0] = __uint_as_float(v[0] << 16); r[1] = __uint_as_float(v[0] & 0xffff0000u); r[2] = __uint_as_float(v[1] << 16); r[3] = __uint_as_float(v[1] & 0xffff0000u); return r; }
__device__ __forceinline__ int opaque_tid() { int t = threadIdx.x; asm volatile("" : "+v"(t)); return t; }
__device__ __forceinline__ size_t tiled_off(int row, int col, int K) {
    const int r = row & 127, c = col & 63, st = (r >> 4) * 2 + (c >> 5), ob = (r & 15) * 64 + (c & 31) * 2;
    return ((size_t)(row >> 7) * (K >> 6) + (col >> 6)) * 8192 + ((st * 1024 + (ob ^ (((ob >> 9) & 1) << 5))) >> 1);
}
__device__ __forceinline__ float wave_sum(float v) {
#pragma unroll
    for (int m = 32; m >= 1; m >>= 1) v += __shfl_xor(v, m);
    return v;
}

#define XB_TMO      128
#define XB_XCNT(j)  (256  + 64 * (j))
#define XB_XSUB(j)  (1280 + 64 * (j))
#define XB_XGEN(j)  (2304 + 64 * (j))
#define XB_TOP      3328
#define XB_TOPGEN   3392
#define XCD_BAR_WORDS 3456
#define XB_SPIN_CAP (1u << 18)
__device__ __forceinline__ unsigned xb_ld(unsigned* p)              { return __hip_atomic_load(p, __ATOMIC_RELAXED, __HIP_MEMORY_SCOPE_AGENT); }
__device__ __forceinline__ unsigned xb_add(unsigned* p, unsigned v) { return __hip_atomic_fetch_add(p, v, __ATOMIC_RELAXED, __HIP_MEMORY_SCOPE_AGENT); }
__device__ __forceinline__ unsigned xb_xcc_id() { return (unsigned)__builtin_amdgcn_s_getreg((3 << 11) | 20) & 0xFu; }
#define XB_SPIN(cond, bar) do { unsigned _sp = 0; while (cond) { __builtin_amdgcn_s_sleep(1); \
    if ((++_sp & 255u) == 0u) { if (xb_ld(&(bar)[XB_TMO])) break; if (_sp > XB_SPIN_CAP) { atomicAdd(&(bar)[XB_TMO], 1u); break; } } } } while (0)
struct XcdBarrier { unsigned* bar; unsigned x; volatile LAS unsigned* st; };
__device__ __forceinline__ XcdBarrier xcd_barrier_post(unsigned* bar, volatile LAS unsigned* st) {
    XcdBarrier b; b.bar = bar; b.x = xb_xcc_id(); b.st = st;
    if (threadIdx.x == 0) (void)xb_add(&bar[XB_XCNT(b.x)], 1u);
    return b;
}
__device__ __forceinline__ void xcd_barrier_complete(unsigned* bar, unsigned x, unsigned& nloc, unsigned& nx) {
    const unsigned G = gridDim.x * gridDim.y * gridDim.z;
    unsigned sum, cnt, mine, sp = 0u;
    for (;;) {
        sum = 0u; cnt = 0u; mine = 0u;
#pragma unroll
        for (unsigned j = 0; j < 16; ++j) { const unsigned c = xb_ld(&bar[XB_XCNT(j)]); sum += c; cnt += (c > 0u) ? 1u : 0u; mine = (j == x) ? c : mine; }
        if (sum == G) break;
        __builtin_amdgcn_s_sleep(1);
        if ((++sp & 255u) == 0u) { if (xb_ld(&bar[XB_TMO])) break; if (sp > XB_SPIN_CAP) { atomicAdd(&bar[XB_TMO], 1u); break; } }
    }
    nloc = mine > 0u ? mine : 1u; nx = cnt > 0u ? cnt : 1u;
}
__device__ __forceinline__ void xcd_barrier(const XcdBarrier& b) {
    asm volatile("s_waitcnt vmcnt(0)" ::: "memory");
    __syncthreads();
    if (threadIdx.x == 0) {
        unsigned* bar = b.bar;
        __builtin_amdgcn_s_waitcnt(0);
        unsigned nloc = b.st[0], nx = b.st[1];
        if (nloc == 0u) { xcd_barrier_complete(bar, b.x, nloc, nx); b.st[0] = nloc; b.st[1] = nx; }
        const unsigned old = xb_add(&bar[XB_XSUB(b.x)], 1u);
        const unsigned gen = old / nloc;
        if (old + 1u == (gen + 1u) * nloc) {
            __builtin_amdgcn_fence(__ATOMIC_RELEASE, "agent");
            asm volatile("s_waitcnt vmcnt(0)" ::: "memory");
            const unsigned og = xb_add(&bar[XB_TOP], 1u);
            const unsigned tg = og / nx;
            if (og + 1u == (tg + 1u) * nx) xb_add(&bar[XB_TOPGEN], 1u);
            else XB_SPIN(xb_ld(&bar[XB_TOPGEN]) == tg, bar);
            __builtin_amdgcn_fence(__ATOMIC_ACQUIRE, "agent");
            xb_add(&bar[XB_XGEN(b.x)], 1u);
            asm volatile("s_waitcnt vmcnt(0)" ::: "memory");
        } else {
            XB_SPIN(xb_ld(&bar[XB_XGEN(b.x)]) == gen, bar);
            __builtin_amdgcn_fence(__ATOMIC_ACQUIRE, "agent");
            asm volatile("s_waitcnt vmcnt(0)" ::: "memory");
        }
    }
    __syncthreads();
}

namespace pg8 {
constexpr int BM = 256, BK = 64, HALF = 128, HTB = HALF * BK * 2, STAGE_BYTES = 8 * HTB, NXCD = 8, WGM = 8;
__host__ __device__ __forceinline__ int lds_byte(int r, int c) { const int st = (r >> 4) * 2 + (c >> 5), rr = r & 15, cc = c & 31, ob = rr * 64 + cc * 2; return st * 1024 + (ob ^ (((ob >> 9) & 1) << 5)); }
__host__ __device__ __forceinline__ void stage_rc(int b, int& R, int& C) { const int st = b / 1024, sb = b % 1024, swz = sb ^ (((sb >> 9) & 1) << 5); R = (st >> 1) * 16 + swz / 64; C = (st & 1) * 32 + (swz % 64) / 2; }
__host__ __device__ __forceinline__ int perm32(int rho) { const int n = rho >> 4, i = rho & 15; return 8 * (i >> 2) + 4 * n + (i & 3); }
struct Unit { int pm, pn; };
struct Gemm { const bf16_t* A; const bf16_t* Bt; int M, N, K; };
struct StaticOrder {
    int nM, nN, nwg, G, c; bool swapmn;
    __host__ __device__ void init(int M, int N, int G_, int c_, bool sw = false) { swapmn = sw; nM = (sw ? N : M) / BM; nN = (sw ? M : N) / BM; nwg = nM * nN; G = G_; c = c_; }
    __host__ __device__ bool next(int i, Unit& u) const {
        const long L = (long)i * G + c; if (L >= nwg) return false;
        int wgid = (int)L; { const int q = nwg / NXCD, r = nwg % NXCD, xcd = wgid % NXCD, off = wgid / NXCD; wgid = (xcd < r ? xcd * (q + 1) : r * (q + 1) + (xcd - r) * q) + off; }
        const int nig = WGM * nN, gid = wgid / nig, fm = gid * WGM, gsz = (nM - fm) < WGM ? (nM - fm) : WGM;
        const int a = fm + ((wgid % nig) % gsz), b = (wgid % nig) / gsz;
        u.pm = swapmn ? b : a; u.pn = swapmn ? a : b; return true;
    }
    __device__ __forceinline__ void a_ready(const Unit&) const {}
    __device__ __forceinline__ void done(const Unit&) const {}
};

struct SlabOrder : StaticOrder {
    unsigned* ready; unsigned need; unsigned* tmo; int pre;
    __device__ __forceinline__ void a_ready(const Unit& u) const {
        const int g = u.pn >> 3;
        if (g >= pre && threadIdx.x < 64) {
            const unsigned long long t0 = __builtin_amdgcn_s_memrealtime(); unsigned polls = 0;
            while ((unsigned)__builtin_amdgcn_readfirstlane(__hip_atomic_load(ready + 64 * g, __ATOMIC_RELAXED, __HIP_MEMORY_SCOPE_AGENT)) < need) {
                if ((++polls & 255u) == 0u && __builtin_amdgcn_readfirstlane(__hip_atomic_load(tmo, __ATOMIC_RELAXED, __HIP_MEMORY_SCOPE_AGENT)) != 0u) break;
                if (__builtin_amdgcn_s_memrealtime() - t0 > 2000000ull) { if (threadIdx.x == 0) __hip_atomic_store(tmo, 1u, __ATOMIC_RELAXED, __HIP_MEMORY_SCOPE_AGENT); break; }
                __builtin_amdgcn_s_sleep(2); }
            __builtin_amdgcn_fence(__ATOMIC_ACQUIRE, "agent");
            asm volatile("s_waitcnt vmcnt(0)" ::: "memory");
        }
        asm volatile("" ::: "memory"); __builtin_amdgcn_s_barrier(); asm volatile("" ::: "memory");
    }
};
struct EpiProj {
    static constexpr bool PERM = true, AFTER_DRAIN = false;
    bf16_t* P; float* G;
    __device__ __forceinline__ void operator()(const f32x4 (&acc)[2][2][4][2], const Unit& u, int wr, int wc, int fr, int fq) const {
        const int row0 = u.pm * BM + wr * 64 + fr;
        if (u.pn < 104) {
            const int col0 = u.pn * BM + wc * 32 + 8 * fq;
#pragma unroll
            for (int ai = 0; ai < 2; ++ai)
#pragma unroll
                for (int m = 0; m < 4; ++m) { bf16_t* rowp = P + (size_t)(row0 + ai * HALF + m * 16) * P_LD + col0;
#pragma unroll
                    for (int bj = 0; bj < 2; ++bj) { const f32x4 v0 = acc[ai][bj][m][0], v1 = acc[ai][bj][m][1];
                        u32x4 w; w[0] = cvt_pk_bf16(v0[0], v0[1]); w[1] = cvt_pk_bf16(v0[2], v0[3]); w[2] = cvt_pk_bf16(v1[0], v1[1]); w[3] = cvt_pk_bf16(v1[2], v1[3]);
                        *(u32x4*)(rowp + bj * HALF) = w; } }
        } else {
#pragma unroll
            for (int ai = 0; ai < 2; ++ai)
#pragma unroll
                for (int m = 0; m < 4; ++m) { float* rowp = G + (size_t)(row0 + ai * HALF + m * 16) * G_LD + wc * 32 + 8 * fq;
                    *(f32x4*)(rowp) = acc[ai][0][m][0]; *(f32x4*)(rowp + 4) = acc[ai][0][m][1]; }
        }
    }
};
struct EpiOut {
    static constexpr bool PERM = false, AFTER_DRAIN = false;
    float* R; const float* xp; const float* xs;
    __device__ __forceinline__ void operator()(const f32x4 (&acc)[2][2][4][2], const Unit& u, int wr, int wc, int fr, int fq) const {
        const int row0 = u.pm * BM + wr * 64 + fr, col0 = u.pn * BM + wc * 32 + 4 * fq;
#pragma unroll
        for (int ai = 0; ai < 2; ++ai)
#pragma unroll
            for (int m = 0; m < 4; ++m) { const int r = row0 + ai * HALF + m * 16;
                { const float* xr = xp + (size_t)r * DM; float* rr = R + (size_t)r * DM;
#pragma unroll
                    for (int bj = 0; bj < 2; ++bj)
#pragma unroll
                        for (int n = 0; n < 2; ++n) { const int c = col0 + bj * HALF + n * 16; const f32x4 xv = *(const f32x4*)(xr + c); *(f32x4*)(rr + c) = acc[ai][bj][m][n] + ALPHA * xv; } } }
    }
};

template <class Epi, class Sched, bool ALIGN_EPI = false, bool SP2 = false>
__device__ __forceinline__ void gemm_phase(LAS unsigned char* lds, const Gemm g, const Sched& S, const Epi& E) {
    const int tid = threadIdx.x, wid = __builtin_amdgcn_readfirstlane(tid >> 6), lane = tid & 63, wr = wid >> 2, wc = wid & 3, fr = lane & 15, fq = lane >> 4;
    const int K = g.K, nt = K / BK;
    unsigned voffA[2], voffB[2];
#pragma unroll
    for (int i = 0; i < 2; ++i) { voffA[i] = (unsigned)(tid * 16 + i * 8192); voffB[i] = voffA[i]; }
    const size_t kstep = (size_t)(HTB);
    const size_t hstep = (size_t)HALF * K * 2;
    const size_t tstep = 2 * hstep;
    const unsigned ldsw = (unsigned)wid * 1024u;
    const int aoff = lds_byte(wr * 64 + fr, fq * 8), boff = lds_byte(wc * 32 + fr, fq * 8);
#define PG8_SA(b, h) (((b) * 2 + (h)) * HTB)
#define PG8_SB(b, h) ((4 + (b) * 2 + (h)) * HTB)
#define PG8_STAGE(bufoff, gbase, voff) do { _Pragma("unroll") for (int _i = 0; _i < 2; ++_i) \
        __builtin_amdgcn_global_load_lds((const unsigned*)((const char*)(gbase) + (voff)[_i]), (LAS unsigned*)(lds + (bufoff) + ldsw + _i * 8192), 16, 0, 0); } while (0)
#define PG8_LDA(dst, b, h) do { _Pragma("unroll") for (int m = 0; m < 4; ++m) _Pragma("unroll") for (int k = 0; k < 2; ++k) dst[m][k] = *(const LAS bf16x8*)(lds + PG8_SA(b, h) + aoff + m * 2048 + k * 1024); } while (0)
#define PG8_LDB(dst, b, h) do { _Pragma("unroll") for (int n = 0; n < 2; ++n) _Pragma("unroll") for (int k = 0; k < 2; ++k) dst[n][k] = *(const LAS bf16x8*)(lds + PG8_SB(b, h) + boff + n * 2048 + k * 1024); } while (0)
#define PG8_MMA(ai, bj, At, Bt) do { __builtin_amdgcn_s_setprio(1); _Pragma("unroll") for (int m = 0; m < 4; ++m) _Pragma("unroll") for (int n = 0; n < 2; ++n) _Pragma("unroll") for (int k = 0; k < 2; ++k) \
        acc[ai][bj][m][n] = __builtin_amdgcn_mfma_f32_16x16x32_bf16(Bt[n][k], At[m][k], acc[ai][bj][m][n], 0, 0, 0); __builtin_amdgcn_s_setprio(0); } while (0)
#define PG8_WAIT_V(n) asm volatile("s_waitcnt vmcnt(" #n ")" ::: "memory")
#define PG8_WAIT_L(n) asm volatile("s_waitcnt lgkmcnt(" #n ")" ::: "memory")
#define PG8_BAR __builtin_amdgcn_s_barrier()
#define PG8_SCHED __builtin_amdgcn_sched_barrier(0)
    Unit cur, nxt; int ui = 0;
    if (!S.next(0, cur)) return;
    f32x4 acc[2][2][4][2];
#pragma unroll
    for (int a = 0; a < 2; ++a)
#pragma unroll
        for (int b = 0; b < 2; ++b)
#pragma unroll
            for (int m = 0; m < 4; ++m)
#pragma unroll
                for (int n = 0; n < 2; ++n) acc[a][b][m][n] = (f32x4){0.f, 0.f, 0.f, 0.f};
    bf16x8 At[4][2], B0[2][2], B1[2][2];
    const char* cA = (const char*)g.A + (size_t)cur.pm * tstep; const char* cB = (const char*)g.Bt + (size_t)cur.pn * tstep;
    S.a_ready(cur);
    if constexpr (SP2) {
        PG8_STAGE(PG8_SB(0, 0), cB, voffB); PG8_STAGE(PG8_SB(0, 1), cB + hstep, voffB); PG8_STAGE(PG8_SA(0, 0), cA, voffA); PG8_STAGE(PG8_SA(0, 1), cA + hstep, voffA);
        if (wr == 1) PG8_BAR;
        PG8_WAIT_V(2); PG8_BAR;
        PG8_STAGE(PG8_SB(1, 0), cB + kstep, voffB); PG8_STAGE(PG8_SA(1, 0), cA + kstep, voffA); PG8_STAGE(PG8_SB(1, 1), cB + hstep + kstep, voffB);
        PG8_WAIT_V(6); PG8_BAR;
    } else {
        PG8_STAGE(PG8_SB(0, 0), cB, voffB); PG8_STAGE(PG8_SA(0, 0), cA, voffA); PG8_STAGE(PG8_SB(0, 1), cB + hstep, voffB); PG8_STAGE(PG8_SA(0, 1), cA + hstep, voffA);
        if (wr == 1) PG8_BAR;
        PG8_WAIT_V(4); PG8_BAR;
        PG8_STAGE(PG8_SB(1, 0), cB + kstep, voffB); PG8_STAGE(PG8_SA(1, 0), cA + kstep, voffA); PG8_STAGE(PG8_SB(1, 1), cB + hstep + kstep, voffB);
        PG8_WAIT_V(6); PG8_BAR;
    }
    for (;;) {
        const bool has_next = S.next(ui + 1, nxt);
        const char* nA = has_next ? (const char*)g.A + (size_t)nxt.pm * tstep : cA; const char* nB = has_next ? (const char*)g.Bt + (size_t)nxt.pn * tstep : cB;
        for (int t = 0; t < nt; t += 2) {
            const bool last = (t == nt - 2);
            const char* a1 = cA + (size_t)(t + 1) * kstep;
            const char* a2 = last ? nA : cA + (size_t)(t + 2) * kstep; const char* b2 = last ? nB : cB + (size_t)(t + 2) * kstep;
            const char* a3 = a2 + kstep; const char* b3 = b2 + kstep;
            if (last && has_next) S.a_ready(nxt);
            if constexpr (SP2) {
            PG8_LDB(B0, 0, 0); PG8_LDB(B1, 0, 1); PG8_SCHED; PG8_LDA(At, 0, 0); PG8_STAGE(PG8_SA(1, 1), a1 + hstep, voffA);
            PG8_WAIT_V(8); PG8_WAIT_L(0); PG8_BAR; PG8_MMA(0, 0, At, B0); PG8_MMA(0, 1, At, B1); PG8_BAR; PG8_SCHED;
            PG8_LDA(At, 0, 1); PG8_STAGE(PG8_SB(0, 0), b2, voffB); PG8_STAGE(PG8_SB(0, 1), b2 + hstep, voffB); PG8_STAGE(PG8_SA(0, 0), a2, voffA);
            PG8_WAIT_V(8); PG8_WAIT_L(0); PG8_BAR; PG8_MMA(1, 0, At, B0); PG8_MMA(1, 1, At, B1); PG8_BAR; PG8_SCHED;
            PG8_LDB(B0, 1, 0); PG8_LDB(B1, 1, 1); PG8_SCHED; PG8_LDA(At, 1, 0); PG8_STAGE(PG8_SA(0, 1), a2 + hstep, voffA);
            PG8_WAIT_V(8); PG8_WAIT_L(0); PG8_BAR; PG8_MMA(0, 0, At, B0); PG8_MMA(0, 1, At, B1); PG8_BAR; PG8_SCHED;
            PG8_LDA(At, 1, 1); PG8_STAGE(PG8_SB(1, 0), b3, voffB); PG8_STAGE(PG8_SB(1, 1), b3 + hstep, voffB); PG8_STAGE(PG8_SA(1, 0), a3, voffA);
            PG8_WAIT_V(8); PG8_WAIT_L(0); PG8_BAR; PG8_MMA(1, 0, At, B0); PG8_MMA(1, 1, At, B1); PG8_BAR; PG8_SCHED;
            } else {
            PG8_LDB(B0, 0, 0); PG8_SCHED; PG8_LDA(At, 0, 0); PG8_STAGE(PG8_SA(1, 1), a1 + hstep, voffA);
            PG8_WAIT_L(8); PG8_BAR; PG8_WAIT_L(0); PG8_MMA(0, 0, At, B0); PG8_BAR; PG8_SCHED;
            PG8_LDB(B1, 0, 1); PG8_STAGE(PG8_SB(0, 0), b2, voffB);
            PG8_BAR; PG8_WAIT_L(0); PG8_MMA(0, 1, At, B1); PG8_BAR;
            PG8_LDA(At, 0, 1); PG8_STAGE(PG8_SA(0, 0), a2, voffA);
            PG8_BAR; PG8_WAIT_L(0); PG8_MMA(1, 0, At, B0); PG8_BAR; PG8_SCHED;
            PG8_STAGE(PG8_SB(0, 1), b2 + hstep, voffB);
            PG8_WAIT_V(6); PG8_BAR; PG8_MMA(1, 1, At, B1); PG8_BAR;
            PG8_LDB(B0, 1, 0); PG8_SCHED; PG8_LDA(At, 1, 0); PG8_STAGE(PG8_SA(0, 1), a2 + hstep, voffA);
            PG8_WAIT_L(8); PG8_BAR; PG8_WAIT_L(0); PG8_MMA(0, 0, At, B0); PG8_BAR; PG8_SCHED;
            PG8_LDB(B1, 1, 1); PG8_STAGE(PG8_SB(1, 0), b3, voffB);
            PG8_BAR; PG8_WAIT_L(0); PG8_MMA(0, 1, At, B1); PG8_BAR;
            PG8_LDA(At, 1, 1); PG8_STAGE(PG8_SA(1, 0), a3, voffA);
            PG8_BAR; PG8_WAIT_L(0); PG8_MMA(1, 0, At, B0); PG8_BAR; PG8_SCHED;
            PG8_STAGE(PG8_SB(1, 1), b3 + hstep, voffB);
            PG8_WAIT_V(6); PG8_BAR; PG8_MMA(1, 1, At, B1); PG8_BAR;
            }
        }
        if constexpr (ALIGN_EPI) { if (wr == 0) PG8_BAR; }
        if constexpr (!Epi::AFTER_DRAIN) { E(acc, cur, wr, wc, fr, fq); S.done(cur); }
        if (!has_next) break;
#pragma unroll
        for (int a = 0; a < 2; ++a)
#pragma unroll
            for (int b = 0; b < 2; ++b)
#pragma unroll
                for (int m = 0; m < 4; ++m)
#pragma unroll
                    for (int n = 0; n < 2; ++n) acc[a][b][m][n] = (f32x4){0.f, 0.f, 0.f, 0.f};
        cur = nxt; cA = nA; cB = nB; ++ui;
        if constexpr (ALIGN_EPI) { if (wr == 1) PG8_BAR; }
    }
    PG8_WAIT_V(0);
    if constexpr (!ALIGN_EPI) { if (wr == 0) PG8_BAR; }
    PG8_BAR;
#undef PG8_SA
#undef PG8_SB
#undef PG8_STAGE
#undef PG8_LDA
#undef PG8_LDB
#undef PG8_MMA
#undef PG8_WAIT_V
#undef PG8_WAIT_L
#undef PG8_BAR
#undef PG8_SCHED
}
}

__device__ __forceinline__ f32x4 gload_nt_asm(const float* p) { f32x4 v; asm volatile("global_load_dwordx4 %0, %1, off nt" : "=v"(v) : "v"(p) : "memory"); return v; }
template <bool REMAP, bool PERM, bool SC1>
__device__ __forceinline__ void tconv_range(const float* __restrict__ src, int ldsrc, bf16_t* __restrict__ dst, int dst_bytes, int K, int t_first, int t_end, int t_stride, LAS unsigned char* lds) {
    constexpr int GT = 4;
    LAS unsigned* T = (LAS unsigned*)lds;
    const int tid = threadIdx.x, nkt = K / 128;
    const __amdgpu_buffer_rsrc_t rs = __builtin_amdgcn_make_buffer_rsrc((void*)dst, 0, dst_bytes, 0x00020000);
    f32x4 ra[GT][4], rb[GT][4];
#define TC_LOAD(tile_, v_) do { const int tl_ = (tile_) < t_end ? (tile_) : (t_end - 1); const int nt_ = tl_ / nkt, kt_ = tl_ - nt_ * nkt, n0_ = nt_ * 64, k0_ = kt_ * 128; int on0_ = n0_; \
        if (REMAP) { if (n0_ < 10240) on0_ = n0_; else if (n0_ < 26624) on0_ = n0_ + 64; else if (n0_ < 26688) on0_ = n0_ - 26624 + 10240; else if (n0_ < 26752) on0_ = n0_; else on0_ = 0; } \
        _Pragma("unroll") for (int i_ = 0; i_ < 2; ++i_) { const int rp_ = (tid >> 4) + 32 * i_, c4_ = tid & 15; const float* s_ = src + (size_t)(k0_ + 2 * rp_) * ldsrc + on0_ + c4_ * 4; \
            v_[2 * i_] = gload_nt_asm(s_); v_[2 * i_ + 1] = gload_nt_asm(s_ + ldsrc); } } while (0)
#define TC_LOADG(tile0_, set_) do { _Pragma("unroll") for (int u_ = 0; u_ < GT; ++u_) TC_LOAD((tile0_) + u_ * t_stride, set_[u_]); } while (0)
#define TC_WAIT(n_, set_) asm volatile("s_waitcnt vmcnt(" #n_ ")" : "+v"(set_[0][0]), "+v"(set_[0][1]), "+v"(set_[0][2]), "+v"(set_[0][3]), "+v"(set_[1][0]), "+v"(set_[1][1]), "+v"(set_[1][2]), "+v"(set_[1][3]), \
        "+v"(set_[2][0]), "+v"(set_[2][1]), "+v"(set_[2][2]), "+v"(set_[2][3]), "+v"(set_[3][0]), "+v"(set_[3][1]), "+v"(set_[3][2]), "+v"(set_[3][3]) :: "memory")
#define TC_PROC(tile0_, set_) do { _Pragma("unroll") for (int u = 0; u < GT; ++u) { const int tile = (tile0_) + u * t_stride; \
        if (tile < t_end) { const int nt = tile / nkt, kt = tile - nt * nkt, n0 = nt * 64, k0 = kt * 128; const bool zero = REMAP && n0 >= 26752; \
            _Pragma("unroll") for (int i = 0; i < 2; ++i) { const int rp = (tid >> 4) + 32 * i, c4 = tid & 15; \
                _Pragma("unroll") for (int j = 0; j < 4; ++j) T[(c4 * 4 + j) * 65 + rp] = zero ? 0u : cvt_pk_bf16(set_[u][2 * i][j], set_[u][2 * i + 1][j]); } \
            __syncthreads(); \
            _Pragma("unroll") for (int i = 0; i < 2; ++i) { const int n = (tid >> 4) + 32 * i, kc = tid & 15; \
                u32x4 v; v[0] = T[n * 65 + kc * 4]; v[1] = T[n * 65 + kc * 4 + 1]; v[2] = T[n * 65 + kc * 4 + 2]; v[3] = T[n * 65 + kc * 4 + 3]; \
                int nn = n0 + n; if (PERM) { const int x = nn & 31; nn = (nn & ~31) + 16 * ((x >> 2) & 1) + 4 * (x >> 3) + (x & 3); } \
                const size_t off = tiled_off(nn, k0 + kc * 8, K); \
                if (SC1) __builtin_amdgcn_raw_buffer_store_b128(v, rs, (int)(off * 2), 0, 16); else *(u32x4*)(dst + off) = v; } \
            __syncthreads(); } } } while (0)
    const int gstep = GT * t_stride;
    TC_LOADG(t_first, ra);
    for (int tile0 = t_first; tile0 < t_end; tile0 += 2 * gstep) {
        TC_LOADG(tile0 + gstep, rb);
        TC_WAIT(16, ra);
        TC_PROC(tile0, ra);
        TC_LOADG(tile0 + 2 * gstep, ra);
        TC_WAIT(16, rb);
        TC_PROC(tile0 + gstep, rb);
    }
    TC_WAIT(0, ra);
#undef TC_LOAD
#undef TC_LOADG
#undef TC_WAIT
#undef TC_PROC
}
__device__ __forceinline__ void phase_convert(const Params& p, LAS unsigned char* lds) {
    bf16_t* Xb = (bf16_t*)(p.ws + OFF_XB);
    const size_t n8 = (size_t)MPAD * DM / 8;
    for (size_t i = (size_t)blockIdx.x * 512 + threadIdx.x; i < n8; i += (size_t)gridDim.x * 512) {
        const size_t e = i * 8; const int row = (int)(e / DM);
        f32x4 a = (f32x4){0.f, 0.f, 0.f, 0.f}, b = a;
        if (row < NTP) { a = __builtin_nontemporal_load((const f32x4*)(p.x_prompt + e)); b = __builtin_nontemporal_load((const f32x4*)(p.x_prompt + e + 4)); }
        else if (row < NTOK) { const size_t e2 = e - (size_t)NTP * DM; a = *(const f32x4*)(p.x_sample + e2); b = *(const f32x4*)(p.x_sample + e2 + 4); }
        u32x4 o; o[0] = cvt_pk_bf16(a[0], a[1]); o[1] = cvt_pk_bf16(a[2], a[3]); o[2] = cvt_pk_bf16(b[0], b[1]); o[3] = cvt_pk_bf16(b[2], b[3]);
        *(u32x4*)(Xb + tiled_off(row, (int)(e - (size_t)row * DM), DM)) = o;
    }
    { u32x4* mz = (u32x4*)((bf16_t*)(p.ws + OFF_MIX) + (size_t)NTOK * MIXW); const size_t nz = (size_t)(MPAD - NTOK) * MIXW / 8;
      for (size_t i = (size_t)blockIdx.x * 512 + threadIdx.x; i < nz; i += (size_t)gridDim.x * 512) mz[i] = (u32x4){0u, 0u, 0u, 0u}; }
    tconv_range<true, true, false>(p.w_in, NPROJ, (bf16_t*)(p.ws + OFF_WB), NPAD * DM * 2, DM, (int)blockIdx.x, WIN_TILES, (int)gridDim.x, lds);
}

constexpr int N_GDN_P = 128, N_SSD_P = 128, N_WOUT = 0, N_GDN_S = 2048, N_SSD_S = 1024, N_ITEMS = N_GDN_P + N_SSD_P + N_WOUT + N_GDN_S + N_SSD_S;
constexpr int GO_LD = 132;
constexpr size_t SF_SXA = 0;
constexpr size_t SF_GQ  = SF_SXA + (size_t)NTS * 6144;
constexpr size_t SF_SDT = SF_GQ + (size_t)NTS * 12288;
constexpr size_t SF_SEA = SF_SDT + (size_t)NTS * 64;
constexpr size_t SF_GB  = SF_SEA + (size_t)NTS * 64;
constexpr size_t SF_GEG = SF_GB + (size_t)NTS * 32;
constexpr size_t SF_GO  = SF_GEG + (size_t)NTS * 32;
constexpr size_t SF_END = SF_GO + (size_t)NTS * 4096;

__device__ __forceinline__ void phase_sample_front(const Params& p) {
    const bf16_t* P = (const bf16_t*)(p.ws + OFF_P); const float* G = (const float*)(p.ws + OFF_G32); float* SF = (float*)(p.ws + OFF_SF);
    const int tid = threadIdx.x, lane = tid & 63;
    for (int item = blockIdx.x; item < NTS * 4; item += gridDim.x) {
        const int tok = item >> 2, sec = item & 3; const size_t row = (size_t)(NTP + tok);
        if (sec == 0) {
#pragma unroll 1
            for (int i = 0; i < 3; ++i) { const int ch = (tid + i * 512) * 4;
                f32x4 a = *(const f32x4*)(p.ssd_conv_b + ch);
#pragma unroll
                for (int j = 0; j < 4; ++j) { const f32x4 wv = *(const f32x4*)(p.ssd_conv_w + j * 6144 + ch);
                    const f32x4 rv = j < 3 ? *(const f32x4*)(p.state_ssd_conv + ((size_t)tok * 3 + j) * 6144 + ch) : ldbf4(P + row * P_LD + C_XBC + ch);
                    if (j >= 1) *(f32x4*)(p.out + O_SSDC_S + ((size_t)tok * 3 + (j - 1)) * 6144 + ch) = rv;
                    a += wv * rv; }
                *(f32x4*)(SF + SF_SXA + (size_t)tok * 6144 + ch) = (f32x4){silu_f(a[0]), silu_f(a[1]), silu_f(a[2]), silu_f(a[3])}; }
            if (tid < 64) { const float dt = softplus_f(G[row * G_LD + tid] + p.ssd_dt_bias[tid]); SF[SF_SDT + tok * 64 + tid] = dt; SF[SF_SEA + tok * 64 + tid] = expf(-expf(p.ssd_a_log[tid]) * dt); }
        } else {
            const int gs = sec - 1;
#pragma unroll 1
            for (int i = 0; i < 2; ++i) { const int cl = (tid + i * 512) * 4, ch = gs * 4096 + cl;
                f32x4 a = (f32x4){0.f, 0.f, 0.f, 0.f};
#pragma unroll
                for (int j = 0; j < 4; ++j) { const f32x4 wv = *(const f32x4*)(p.gdn_conv_w + j * 12288 + ch);
                    const f32x4 rv = j < 3 ? *(const f32x4*)(p.state_gdn_conv + ((size_t)tok * 3 + j) * 12288 + ch) : ldbf4(P + row * P_LD + C_QKV + ch);
                    if (j >= 1) *(f32x4*)(p.out + O_GDNC_S + ((size_t)tok * 3 + (j - 1)) * 12288 + ch) = rv;
                    a += wv * rv; }
                f32x4 o = (f32x4){silu_f(a[0]), silu_f(a[1]), silu_f(a[2]), silu_f(a[3])};
                if (gs < 2) {
                    float ss = o[0] * o[0] + o[1] * o[1] + o[2] * o[2] + o[3] * o[3];
                    ss += __shfl_xor(ss, 1); ss += __shfl_xor(ss, 2); ss += __shfl_xor(ss, 4); ss += __shfl_xor(ss, 8); ss += __shfl_xor(ss, 16);
                    const float rn = rsqrtf(ss + 1e-6f) * (gs == 0 ? 0.08838834764831845f : 1.f); o = o * rn; }
                *(f32x4*)(SF + SF_GQ + (size_t)tok * 12288 + ch) = o; }
            if (gs == 0 && tid < 32) { const float araw = G[row * G_LD + 96 + tid], braw = G[row * G_LD + 64 + tid];
                SF[SF_GB + tok * 32 + tid] = sigmoid_f(braw); SF[SF_GEG + tok * 32 + tid] = expf(-expf(p.gdn_a_log[tid]) * softplus_f(araw + p.gdn_dt_bias[tid])); }
        }
    }
    (void)lane;
}

__device__ __forceinline__ void ssd_sample_item(const Params& p, const int tok, const int g) {
    const float* SF = (const float*)(p.ws + OFF_SF); const bf16_t* P = (const bf16_t*)(p.ws + OFF_P);
    const int tid = opaque_tid(), w = tid >> 6, lane = tid & 63, half = lane >> 5, nq = lane & 31, h = g * 8 + w;
    const f32x4 B4 = *(const f32x4*)(SF + SF_SXA + (size_t)tok * 6144 + 4096 + g * 128 + nq * 4), C4 = *(const f32x4*)(SF + SF_SXA + (size_t)tok * 6144 + 5120 + g * 128 + nq * 4);
    const float xs_mine = SF[SF_SXA + (size_t)tok * 6144 + h * 64 + lane], dt = SF[SF_SDT + tok * 64 + h], eA = SF[SF_SEA + tok * 64 + h];
    const float z = bf2f(P[(size_t)(NTP + tok) * P_LD + C_ZS + h * 64 + lane]);
    const float xdt_mine = xs_mine * dt;
    const float* Hin = p.state_ssd + ((size_t)(tok * 64 + h) * 64 + 32 * half) * 128 + nq * 4; float* Hout = p.out + O_SSD_S + ((size_t)(tok * 64 + h) * 64 + 32 * half) * 128 + nq * 4;
    float y_mine = 0.f;
    f32x4 buf[2][8];
#pragma unroll
    for (int i = 0; i < 8; ++i) buf[0][i] = *(const f32x4*)(Hin + (size_t)i * 128);
#pragma unroll
    for (int bb = 0; bb < 4; ++bb) {
        if (bb < 3) {
#pragma unroll
            for (int i = 0; i < 8; ++i) buf[(bb + 1) & 1][i] = *(const f32x4*)(Hin + (size_t)((bb + 1) * 8 + i) * 128); }
#pragma unroll
        for (int i = 0; i < 8; ++i) { const int it = bb * 8 + i;
            const float xdt = __shfl(xdt_mine, it + 32 * half);
            const f32x4 hn = eA * buf[bb & 1][i] + xdt * B4;
            *(f32x4*)(Hout + (size_t)it * 128) = hn;
            float y = hn[0] * C4[0] + hn[1] * C4[1] + hn[2] * C4[2] + hn[3] * C4[3];
            y += __shfl_xor(y, 1); y += __shfl_xor(y, 2); y += __shfl_xor(y, 4); y += __shfl_xor(y, 8); y += __shfl_xor(y, 16);
            y_mine = (nq == it) ? y : y_mine; }
    }
    ((float*)(p.ws + OFF_U32))[(size_t)(NTP + tok) * DM + h * 64 + lane] = (y_mine + xs_mine * p.ssd_d[h]) * silu_f(z);
}
__device__ __forceinline__ void gdn_sample_item(const Params& p, const int tok, const int hp) {
    const float* SF = (const float*)(p.ws + OFF_SF); float* SFo = (float*)(p.ws + OFF_SF);
    const int tid = opaque_tid(), w = tid >> 6, lane = tid & 63, dg = lane >> 3, e4 = lane & 7, h = hp * 2 + (w >> 2), es = w & 3;
    const float* Sin = p.state_gdn + ((size_t)(tok * 32 + h) * 128 + dg * 16) * 128 + es * 32 + e4 * 4; float* Sout = p.out + O_GDN_S + ((size_t)(tok * 32 + h) * 128 + dg * 16) * 128 + es * 32 + e4 * 4;
    f32x4 S[16];
#pragma unroll
    for (int i = 0; i < 16; ++i) S[i] = *(const f32x4*)(Sin + (size_t)i * 128);
    const float* qp = SF + SF_GQ + (size_t)tok * 12288 + h * 128 + dg * 16; const float* kp = qp + 4096;
    f32x4 q4[4], k4[4];
#pragma unroll
    for (int i = 0; i < 4; ++i) { q4[i] = *(const f32x4*)(qp + 4 * i); k4[i] = *(const f32x4*)(kp + 4 * i); }
    const f32x4 v4 = *(const f32x4*)(SF + SF_GQ + (size_t)tok * 12288 + 8192 + h * 128 + es * 32 + e4 * 4);
    const float beta = SF[SF_GB + tok * 32 + h], eg = SF[SF_GEG + tok * 32 + h];
    f32x4 ks = (f32x4){0.f, 0.f, 0.f, 0.f};
#pragma unroll
    for (int i = 0; i < 16; ++i) ks += k4[i >> 2][i & 3] * S[i];
#pragma unroll
    for (int c = 0; c < 4; ++c) { ks[c] += __shfl_xor(ks[c], 8); ks[c] += __shfl_xor(ks[c], 16); ks[c] += __shfl_xor(ks[c], 32); }
    const f32x4 vn = beta * (v4 - eg * ks);
    f32x4 o = (f32x4){0.f, 0.f, 0.f, 0.f};
#pragma unroll
    for (int i = 0; i < 16; ++i) { S[i] = eg * S[i] + k4[i >> 2][i & 3] * vn; *(f32x4*)(Sout + (size_t)i * 128) = S[i]; o += q4[i >> 2][i & 3] * S[i]; }
#pragma unroll
    for (int c = 0; c < 4; ++c) { o[c] += __shfl_xor(o[c], 8); o[c] += __shfl_xor(o[c], 16); o[c] += __shfl_xor(o[c], 32); }
    if (dg == 0) *(f32x4*)(SFo + SF_GO + (size_t)tok * 4096 + h * 128 + es * 32 + e4 * 4) = o;
}

typedef __bf16 bf16x2_t __attribute__((ext_vector_type(2)));
typedef short bf16x4 __attribute__((ext_vector_type(4)));
__device__ __forceinline__ unsigned pk_bf16(float lo, float hi) { const f32x2v v = {lo, hi}; return __builtin_bit_cast(unsigned, __builtin_convertvector(v, bf16x2_t)); }
__device__ __forceinline__ bf16x8 pack2(const f32x4 lo, const f32x4 hi) { u32x4 r; r[0] = pk_bf16(lo[0], lo[1]); r[1] = pk_bf16(lo[2], lo[3]); r[2] = pk_bf16(hi[0], hi[1]); r[3] = pk_bf16(hi[2], hi[3]); return __builtin_bit_cast(bf16x8, r); }
__device__ __forceinline__ bf16x8 ld_perm(const LAS bf16_t* rowp, int q) { const u32x2 a = *(const LAS u32x2*)(rowp + 4 * q), b = *(const LAS u32x2*)(rowp + 16 + 4 * q); u32x4 r; r[0] = a[0]; r[1] = a[1]; r[2] = b[0]; r[3] = b[1]; return __builtin_bit_cast(bf16x8, r); }
__device__ __forceinline__ bf16x8 ld_nat(const LAS bf16_t* rowp, int q) { return *(const LAS bf16x8*)(rowp + 8 * q); }
#define MFMA16(a, b, c) __builtin_amdgcn_mfma_f32_16x16x32_bf16((a), (b), (c), 0, 0, 0)

#define BAR_LDS() do { asm volatile("s_waitcnt lgkmcnt(0)" ::: "memory"); __builtin_amdgcn_s_barrier(); asm volatile("" ::: "memory"); } while (0)
#define WAIT_VM0() asm volatile("s_waitcnt vmcnt(0)" ::: "memory")
#define LDP(base, off) __builtin_bit_cast(bf16x8, (u32x4){(*(const LAS u32x2*)((base) + (off)))[0], (*(const LAS u32x2*)((base) + (off)))[1], (*(const LAS u32x2*)((base) + (off) + 16))[0], (*(const LAS u32x2*)((base) + (off) + 16))[1]})
__device__ __forceinline__ float blo(unsigned v) { return __uint_as_float(v << 16); }
__device__ __forceinline__ float bhi(unsigned v) { return __uint_as_float(v & 0xffff0000u); }
__device__ __forceinline__ int kperm(int c) { return (c & ~31) | (((c >> 2) & 3) << 3) | (((c >> 4) & 1) << 2) | (c & 3); }
#define LDQ(base, off) (*(const LAS bf16x8*)((base) + (off)))
__device__ __forceinline__ void dma_raw(LAS unsigned char* lds_raw, const bf16_t* P, const bf16_t* zsrc, const size_t rowbase, const int t0, const int c0, const int c1, const int c2, const int w, const int lane) {
#pragma unroll
    for (int kk = 0; kk < 7; ++kk) {
        int k = w + 8 * kk; k = k > 50 ? 50 : k;
        int seg = 4 * k + (lane >> 4); seg = seg > 200 ? 200 : seg;
        const int row = seg / 3, sec = seg - row * 3, tt = t0 - 3 + row;
        const bf16_t* src = tt >= 0 ? P + (rowbase + tt) * P_LD + (sec == 0 ? c0 : (sec == 1 ? c1 : c2)) : zsrc;
        __builtin_amdgcn_global_load_lds((const unsigned*)(src + (lane & 15) * 8), (LAS unsigned*)(lds_raw + k * 1024), 16, 0, 0);
    }
}
__device__ __forceinline__ void dma_offsets(unsigned (&doff)[7], const int c0, const int c1, const int c2, const int w, const int lane) {
#pragma unroll
    for (int kk = 0; kk < 7; ++kk) { int k = w + 8 * kk; k = k > 50 ? 50 : k; int seg = 4 * k + (lane >> 4); seg = seg > 200 ? 200 : seg; const int row = seg / 3, sec = seg - row * 3;
        doff[kk] = (unsigned)((row * P_LD + (sec == 0 ? c0 : (sec == 1 ? c1 : c2)) + (lane & 15) * 8) * 2); }
}
__device__ __forceinline__ void dma_fast(LAS unsigned char* lds_raw, const char* base, const unsigned (&doff)[7], const int w) {
#pragma unroll
    for (int kk = 0; kk < 7; ++kk) { int k = w + 8 * kk; k = k > 50 ? 50 : k;
        __builtin_amdgcn_global_load_lds((const unsigned*)(base + doff[kk]), (LAS unsigned*)(lds_raw + k * 1024), 16, 0, 0); }
}
__device__ __forceinline__ float reduce16(float (&v)[16], const int lane) {
#pragma unroll
    for (int i = 0; i < 8; ++i) { const bool up = (lane & 32) != 0; const float send = up ? v[i] : v[i + 8], keep = up ? v[i + 8] : v[i]; v[i] = keep + __shfl_xor(send, 32); }
#pragma unroll
    for (int i = 0; i < 4; ++i) { const bool up = (lane & 16) != 0; const float send = up ? v[i] : v[i + 4], keep = up ? v[i + 4] : v[i]; v[i] = keep + __shfl_xor(send, 16); }
#pragma unroll
    for (int i = 0; i < 2; ++i) { const bool up = (lane & 8) != 0; const float send = up ? v[i] : v[i + 2], keep = up ? v[i + 2] : v[i]; v[i] = keep + __shfl_xor(send, 8); }
    { const bool up = (lane & 4) != 0; const float send = up ? v[0] : v[1], keep = up ? v[1] : v[0]; v[0] = keep + __shfl_xor(send, 4); }
    v[0] += __shfl_xor(v[0], 2); v[0] += __shfl_xor(v[0], 1);
    return v[0];
}

constexpr int GL_RAW = 0, GL_QA = 52224, GL_KA = 69632, GL_OB = GL_KA  , GL_KAT = 87040, GL_WL = 105472, GL_AB = 122880, GL_QK = 132096,
              GL_ADT = 141312, GL_TF = 145408, GL_TOK = 147456, GL_SSQ = 148480, GL_LAST = 148992, GL_WTS = 149056, GL_TOK2 = 155200, GL_NW = 156224;
__device__ __forceinline__ void gdn_chunk_item(const Params& p, LAS unsigned char* lds, const int b, const int h) {
    const bf16_t* P = (const bf16_t*)(p.ws + OFF_P); const float* G = (const float*)(p.ws + OFF_G32); bf16_t* MIX = (bf16_t*)(p.ws + OFF_MIX);
    const bf16_t* zsrc = (const bf16_t*)(p.ws + OFF_XB) + (size_t)NTOK * DM;
    const size_t rowbase = (size_t)b * 2048;
    const float Aneg = -expf(p.gdn_a_log[h]), dtb = p.gdn_dt_bias[h];
    const int c0 = C_QKV + h * 128, c1 = C_QKV + 4096 + h * 128, c2 = C_QKV + 8192 + h * 128;
    f32x4 Sacc[8];
#pragma unroll
    for (int j = 0; j < 8; ++j) Sacc[j] = (f32x4){0.f, 0.f, 0.f, 0.f};
    float g_araw = 0.f, g_braw = 0.f;
    unsigned doff[7];
    {
        const int tid = opaque_tid(), lane = tid & 63, w = __builtin_amdgcn_readfirstlane(tid >> 6);
        dma_offsets(doff, c0, c1, c2, w, lane);
        for (int i = tid; i < (9216 * 2) / 4; i += 512) ((LAS unsigned*)(lds + GL_AB))[i] = 0u;
        for (int i = tid; i < 1536; i += 512) { const int j = i / 384, cc = i - j * 384; ((LAS float*)(lds + GL_WTS))[i] = p.gdn_conv_w[j * 12288 + (cc >> 7) * 4096 + h * 128 + (cc & 127)]; }
        if (tid < 128) ((LAS float*)(lds + GL_NW))[tid] = p.gdn_norm_w[tid];
        if (w == 0) { g_araw = G[(rowbase + lane) * G_LD + 96 + h]; g_braw = G[(rowbase + lane) * G_LD + 64 + h]; }
        asm volatile("" : "+v"(g_araw), "+v"(g_braw));
        dma_raw(lds + GL_RAW, P, zsrc, rowbase, 0, c0, c1, c2, w, lane);
    }
#pragma unroll 1
    for (int c = 0; c < 32; ++c) {
        const int t0 = c * 64;
        if (c == 0) WAIT_VM0(); else asm volatile("s_waitcnt vmcnt(2)" ::: "memory");
        BAR_LDS();
        {
            const int tid = opaque_tid(), lane = tid & 63, w = tid >> 6;
            const LAS unsigned char* rawl = lds + GL_RAW + (8 * w) * 768 + lane * 4; const LAS float* wts = (const LAS float*)(lds + GL_WTS) + 2 * lane;
            float ssv[16];
#pragma unroll
            for (int sec = 0; sec < 2; ++sec) {
                f32x2v wj[4];
#pragma unroll
                for (int j = 0; j < 4; ++j) wj[j] = *(const LAS f32x2v*)(wts + j * 384 + sec * 128);
                float x0[11], x1[11];
#pragma unroll
                for (int rr = 0; rr < 11; ++rr) { const unsigned u = *(const LAS unsigned*)(rawl + rr * 768 + sec * 256); x0[rr] = blo(u); x1[rr] = bhi(u); }
                unsigned pk[8];
#pragma unroll
                for (int t = 0; t < 8; ++t) {
                    const float a0 = silu_f(wj[0][0] * x0[t] + wj[1][0] * x0[t + 1] + wj[2][0] * x0[t + 2] + wj[3][0] * x0[t + 3]);
                    const float a1 = silu_f(wj[0][1] * x1[t] + wj[1][1] * x1[t + 1] + wj[2][1] * x1[t + 2] + wj[3][1] * x1[t + 3]);
                    ssv[2 * t + sec] = a0 * a0 + a1 * a1; pk[t] = pk_bf16(a0, a1);
                    *(LAS unsigned*)(lds + (sec == 0 ? GL_QA : GL_KA) + ((8 * w + t) * 136 + kperm(2 * lane)) * 2) = pk[t];
                }
                if (sec == 1) {
                    u32x4 ke, ko;
#pragma unroll
                    for (int t2 = 0; t2 < 4; ++t2) { ke[t2] = (pk[2 * t2] & 0xffffu) | (pk[2 * t2 + 1] << 16); ko[t2] = (pk[2 * t2] >> 16) | (pk[2 * t2 + 1] & 0xffff0000u); }
                    const int tp = kperm(8 * w);
                    LAS unsigned char* k0 = lds + GL_KAT + ((2 * lane) * 72 + tp) * 2; LAS unsigned char* k1 = k0 + 144;
                    *(LAS u32x2*)k0 = (u32x2){ke[0], ke[1]}; *(LAS u32x2*)(k0 + 16) = (u32x2){ke[2], ke[3]}; *(LAS u32x2*)k1 = (u32x2){ko[0], ko[1]}; *(LAS u32x2*)(k1 + 16) = (u32x2){ko[2], ko[3]};
                }
            }
            const float tot = reduce16(ssv, lane);
            if ((lane & 3) == 0) ((LAS float*)(lds + GL_SSQ))[16 * w + (lane >> 2)] = tot;
            if (c == 31 && w == 7) {
                float* convout = p.out + O_GDNC_P + (size_t)b * 3 * 12288 + h * 128 + 2 * lane;
#pragma unroll
                for (int j = 0; j < 3; ++j)
#pragma unroll
                    for (int sec = 0; sec < 3; ++sec) { const unsigned u = *(const LAS unsigned*)(lds + GL_RAW + ((64 + j) * 3 + sec) * 256 + lane * 4); *(f32x2v*)(convout + j * 12288 + sec * 4096) = (f32x2v){blo(u), bhi(u)}; }
            }
        }
        BAR_LDS();
        {
            const int tid = opaque_tid(), lane = tid & 63;
            if ((tid >> 6) == 0) {
                const LAS float* ssq = (const LAS float*)(lds + GL_SSQ);
                float cs = Aneg * softplus_f(g_araw + dtb); const float beta = sigmoid_f(g_braw);
#pragma unroll
                for (int d = 1; d < 64; d <<= 1) { const float n = __shfl_up(cs, d); if (lane >= d) cs += n; }
                f32x4 tv; tv[0] = rsqrtf(ssq[lane * 2] + 1e-6f) * 0.08838834764831845f; tv[1] = rsqrtf(ssq[lane * 2 + 1] + 1e-6f); tv[2] = beta; tv[3] = cs;
                ((LAS f32x4*)(lds + GL_TOK))[lane] = tv; if (lane == 63) *(LAS float*)(lds + GL_LAST) = cs;
                const float lastv = __shfl(cs, 63), ec = __expf(cs);
                ((LAS f32x2v*)(lds + GL_TOK2))[lane] = (f32x2v){beta, tv[1] * beta * ec};
                ((LAS f32x2v*)(lds + GL_TOK2 + 512))[lane] = (f32x2v){tv[0] * ec, tv[1] * __expf(lastv - cs)};
            }
        }
        BAR_LDS();
        u32x4 zreg[2];
        {
            const int tid = opaque_tid(), lane = tid & 63;
#pragma unroll
            for (int it = 0; it < 2; ++it) { const int idx = tid + it * 512; zreg[it] = *(const u32x4*)(P + (rowbase + t0 + (idx >> 4)) * P_LD + C_ZG + h * 128 + (idx & 15) * 8); }
            if ((tid >> 6) == 0 && c < 31) { const size_t row = rowbase + t0 + 64 + lane; g_araw = G[row * G_LD + 96 + h]; g_braw = G[row * G_LD + 64 + h]; }
        }
        {
            const int tid = opaque_tid(), w = tid >> 6, lane = tid & 63, r = lane & 15, q = lane >> 4;
#pragma unroll 1
            for (int job = w; job < 20; job += 8) {
                const int tj = job < 10 ? job : job - 10; const bool isQK = job >= 10;
                const int ti = tj >= 6 ? 3 : (tj >= 3 ? 2 : (tj >= 1 ? 1 : 0)), si = tj - (ti * (ti + 1)) / 2;
                const LAS bf16_t* Ab = (const LAS bf16_t*)(lds + (isQK ? GL_QA : GL_KA)) + (ti * 16 + r) * 136 + 8 * q; const LAS bf16_t* Bb = (const LAS bf16_t*)(lds + GL_KA) + (si * 16 + r) * 136 + 8 * q;
                f32x4 acc = (f32x4){0.f, 0.f, 0.f, 0.f};
#pragma unroll
                for (int kk = 0; kk < 4; ++kk) acc = MFMA16(*(const LAS bf16x8*)(Ab + kk * 32), *(const LAS bf16x8*)(Bb + kk * 32), acc);
                const int s = si * 16 + r; const f32x4 ts = ((const LAS f32x4*)(lds + GL_TOK))[s];
                const LAS f32x4* tq = (const LAS f32x4*)(lds + GL_TOK) + ti * 16 + 4 * q;
                float val[4];
#pragma unroll
                for (int reg = 0; reg < 4; ++reg) { const int t = ti * 16 + 4 * q + reg; const f32x4 tt = tq[reg]; const float dec = __expf(tt[3] - ts[3]);
                    val[reg] = isQK ? (s <= t ? acc[reg] * tt[0] * ts[1] * dec : 0.f) : (s < t ? -(acc[reg] * tt[1] * ts[1] * tt[2] * dec) : 0.f); }
                LAS bf16_t* dst = (LAS bf16_t*)(lds + (isQK ? GL_QK : GL_AB)) + (ti * 16 + 4 * q) * 72 + kperm(s);
                const bool diagKK = (!isQK) && (ti == si);
#pragma unroll
                for (int reg = 0; reg < 4; ++reg) dst[reg * 72] = diagKK ? (bf16_t)0 : (bf16_t)(pk_bf16(val[reg], 0.f) & 0xffffu);
                if (diagKK) *(LAS f32x4*)((LAS float*)(lds + GL_ADT) + (ti * 16 + r) * 16 + 4 * q) = (f32x4){val[0], val[1], val[2], val[3]};
            }
        }
        BAR_LDS();
        {
            const int tid = opaque_tid(), w = tid >> 6, lane = tid & 63, r = lane & 15, q = lane >> 4;
            if (w < 4) {
                const LAS float* A = (const LAS float*)(lds + GL_ADT) + w * 256;
                float tr[16];
#pragma unroll
                for (int j = 15; j >= 0; --j) { float v = (j == r) ? 1.f : 0.f;
#pragma unroll
                    for (int k = j + 1; k < 16; ++k) v += tr[k] * A[j * 16 + k];
                    tr[j] = v; }
                const float s0 = q == 0 ? tr[0] : (q == 1 ? tr[4] : (q == 2 ? tr[8] : tr[12])), s1 = q == 0 ? tr[1] : (q == 1 ? tr[5] : (q == 2 ? tr[9] : tr[13]));
                const float s2 = q == 0 ? tr[2] : (q == 1 ? tr[6] : (q == 2 ? tr[10] : tr[14])), s3 = q == 0 ? tr[3] : (q == 1 ? tr[7] : (q == 2 ? tr[11] : tr[15]));
                u32x2 tv; tv[0] = pk_bf16(s0, s1); tv[1] = pk_bf16(s2, s3); ((LAS u32x2*)(lds + GL_TF))[w * 64 + lane] = tv;
            }
        }
        BAR_LDS();
        f32x4 U[4];
        {
            const int tid = opaque_tid(), w = tid >> 6, lane = tid & 63, r = lane & 15, q = lane >> 4, E = w * 16 + r;
            const LAS f32x2v* tq = (const LAS f32x2v*)(lds + GL_TOK2) + 4 * q;
            const LAS bf16_t* RvE = (const LAS bf16_t*)(lds + GL_RAW) + ((4 * q) * 3 + 2) * 128 + E; const LAS bf16_t* KaE = (const LAS bf16_t*)(lds + GL_KA) + (4 * q) * 136 + kperm(E);
            const LAS bf16_t* AbR = (const LAS bf16_t*)(lds + GL_AB) + r * 72 + 8 * q;
            const LAS u32x2* TfL = (const LAS u32x2*)(lds + GL_TF) + lane;
            LAS bf16_t* WlE = (LAS bf16_t*)(lds + GL_WL) + (4 * q) * 136 + kperm(E);
            const LAS float* wv = (const LAS float*)(lds + GL_WTS) + 256 + E;
            const float w0 = wv[0], w1 = wv[384], w2 = wv[768], w3 = wv[1152];
            float xr[4][7], ka[4][4]; f32x2v t3[4][4]; bf16x8 af[4]; u32x2 tf[4];
#pragma unroll
            for (int i = 0; i < 4; ++i) {
#pragma unroll
                for (int k = 0; k < 7; ++k) xr[i][k] = bf2f(RvE[(16 * i + k) * 384]);
#pragma unroll
                for (int reg = 0; reg < 4; ++reg) { ka[i][reg] = bf2f(KaE[(16 * i + reg) * 136]); t3[i][reg] = tq[16 * i + reg]; }
                tf[i] = TfL[i * 64];
            }
            af[0] = LDQ(AbR, 16 * 72); af[1] = LDQ(AbR, 32 * 72); af[2] = LDQ(AbR, 48 * 72); af[3] = LDQ(AbR, 48 * 72 + 32);
            __builtin_amdgcn_sched_barrier(0);
            f32x4 au[4], aw[4];
#pragma unroll
            for (int i = 0; i < 4; ++i)
#pragma unroll
                for (int reg = 0; reg < 4; ++reg) { au[i][reg] = silu_f(w0 * xr[i][reg] + w1 * xr[i][reg + 1] + w2 * xr[i][reg + 2] + w3 * xr[i][reg + 3]) * t3[i][reg][0]; aw[i][reg] = ka[i][reg] * t3[i][reg][1]; }
            u32x4 XU[2], XW[2];
            XU[0] = XU[1] = XW[0] = XW[1] = (u32x4){0u, 0u, 0u, 0u};
            const f32x4 z4 = (f32x4){0.f, 0.f, 0.f, 0.f};
#pragma unroll
            for (int i = 0; i < 4; ++i) {
                f32x4 cu = au[i], cw = aw[i];
                if (i >= 1) { cu = MFMA16(af[i - 1], __builtin_bit_cast(bf16x8, XU[0]), cu); cw = MFMA16(af[i - 1], __builtin_bit_cast(bf16x8, XW[0]), cw); }
                if (i == 3) { cu = MFMA16(af[3], __builtin_bit_cast(bf16x8, XU[1]), cu); cw = MFMA16(af[3], __builtin_bit_cast(bf16x8, XW[1]), cw); }
                const u32x4 ta = (u32x4){tf[i][0], tf[i][1], 0u, 0u};
                const u32x4 yu = (u32x4){pk_bf16(cu[0], cu[1]), pk_bf16(cu[2], cu[3]), 0u, 0u}, yw = (u32x4){pk_bf16(cw[0], cw[1]), pk_bf16(cw[2], cw[3]), 0u, 0u};
                const f32x4 xu = MFMA16(__builtin_bit_cast(bf16x8, ta), __builtin_bit_cast(bf16x8, yu), z4), xw = MFMA16(__builtin_bit_cast(bf16x8, ta), __builtin_bit_cast(bf16x8, yw), z4);
                U[i] = xu;
                XU[i >> 1][2 * (i & 1)] = pk_bf16(xu[0], xu[1]); XU[i >> 1][2 * (i & 1) + 1] = pk_bf16(xu[2], xu[3]);
                const unsigned n01 = pk_bf16(-xw[0], -xw[1]), n23 = pk_bf16(-xw[2], -xw[3]);
                XW[i >> 1][2 * (i & 1)] = n01 ^ 0x80008000u; XW[i >> 1][2 * (i & 1) + 1] = n23 ^ 0x80008000u;
                WlE[(16 * i + 0) * 136] = (bf16_t)(n01 & 0xffffu); WlE[(16 * i + 1) * 136] = (bf16_t)(n01 >> 16); WlE[(16 * i + 2) * 136] = (bf16_t)(n23 & 0xffffu); WlE[(16 * i + 3) * 136] = (bf16_t)(n23 >> 16);
            }
        }
        asm volatile("" : "+v"(zreg[0]), "+v"(zreg[1]), "+v"(g_araw), "+v"(g_braw));
        BAR_LDS();
        {
            const int tid = opaque_tid(), w = __builtin_amdgcn_readfirstlane(tid >> 6);
            dma_fast(lds + GL_RAW, (const char*)(P + (rowbase + (c < 31 ? t0 + 61 : t0 - 3)) * P_LD), doff, w);
        }
        {
            const int tid = opaque_tid(), w = tid >> 6, lane = tid & 63, r = lane & 15, q = lane >> 4, E = w * 16 + r;
            const LAS f32x2v* tq = (const LAS f32x2v*)(lds + GL_TOK2 + 512) + 4 * q;
            const LAS bf16_t* WlR = (const LAS bf16_t*)(lds + GL_WL) + r * 136 + 8 * q; const LAS bf16_t* QaR = (const LAS bf16_t*)(lds + GL_QA) + r * 136 + 8 * q;
            const LAS bf16_t* QkR = (const LAS bf16_t*)(lds + GL_QK) + r * 72 + 8 * q; const LAS bf16_t* KtR = (const LAS bf16_t*)(lds + GL_KAT) + r * 72 + 8 * q;
            LAS bf16_t* obE = (LAS bf16_t*)(lds + GL_OB) + (4 * q) * 136 + E;
#define SCHED_B() __builtin_amdgcn_sched_barrier(0)
            bf16x8 fa[8], fb[8];
#pragma unroll
            for (int x = 0; x < 8; ++x) fa[x] = LDQ(WlR, 16 * (x >> 2) * 136 + 32 * (x & 3));
            SCHED_B();
#pragma unroll
            for (int x = 0; x < 8; ++x) fb[x] = LDQ(WlR, 16 * (2 + (x >> 2)) * 136 + 32 * (x & 3));
            bf16x8 Sb[4];
#pragma unroll
            for (int kp = 0; kp < 4; ++kp) Sb[kp] = pack2(Sacc[2 * kp], Sacc[2 * kp + 1]);
            f32x2v t4[4][4];
#pragma unroll
            for (int i = 0; i < 4; ++i)
#pragma unroll
                for (int reg = 0; reg < 4; ++reg) t4[i][reg] = tq[16 * i + reg];
            const float el = __expf(*(const LAS float*)(lds + GL_LAST));
            SCHED_B();
            f32x4 vn[4], oo[4];
#pragma unroll
            for (int i = 0; i < 2; ++i) { f32x4 acc = U[i];
#pragma unroll
                for (int kp = 0; kp < 4; ++kp) acc = MFMA16(fa[4 * i + kp], Sb[kp], acc);
                vn[i] = acc; }
            SCHED_B();
#pragma unroll
            for (int x = 0; x < 8; ++x) fa[x] = LDQ(QaR, 16 * (x >> 2) * 136 + 32 * (x & 3));
            SCHED_B();
#pragma unroll
            for (int i = 0; i < 2; ++i) { f32x4 acc = U[2 + i];
#pragma unroll
                for (int kp = 0; kp < 4; ++kp) acc = MFMA16(fb[4 * i + kp], Sb[kp], acc);
                vn[2 + i] = acc; }
            SCHED_B();
#pragma unroll
            for (int x = 0; x < 8; ++x) fb[x] = LDQ(QaR, 16 * (2 + (x >> 2)) * 136 + 32 * (x & 3));
            SCHED_B();
#pragma unroll
            for (int i = 0; i < 2; ++i) { f32x4 acc = (f32x4){0.f, 0.f, 0.f, 0.f};
#pragma unroll
                for (int kp = 0; kp < 4; ++kp) acc = MFMA16(fa[4 * i + kp], Sb[kp], acc);
                oo[i] = acc; }
            SCHED_B();
            fa[0] = LDQ(QkR, 0); fa[1] = LDQ(QkR, 16 * 72); fa[2] = LDQ(QkR, 32 * 72); fa[3] = LDQ(QkR, 32 * 72 + 32); fa[4] = LDQ(QkR, 48 * 72); fa[5] = LDQ(QkR, 48 * 72 + 32);
            SCHED_B();
#pragma unroll
            for (int i = 0; i < 2; ++i) { f32x4 acc = (f32x4){0.f, 0.f, 0.f, 0.f};
#pragma unroll
                for (int kp = 0; kp < 4; ++kp) acc = MFMA16(fb[4 * i + kp], Sb[kp], acc);
                oo[2 + i] = acc; }
            f32x4 vs[4];
#pragma unroll
            for (int i = 0; i < 4; ++i)
#pragma unroll
                for (int reg = 0; reg < 4; ++reg) { oo[i][reg] *= t4[i][reg][0]; vs[i][reg] = vn[i][reg] * t4[i][reg][1]; }
            bf16x8 Vn[2], Vs[2];
            Vn[0] = pack2(vn[0], vn[1]); Vn[1] = pack2(vn[2], vn[3]); Vs[0] = pack2(vs[0], vs[1]); Vs[1] = pack2(vs[2], vs[3]);
            SCHED_B();
#pragma unroll
            for (int x = 0; x < 8; ++x) fb[x] = LDQ(KtR, 16 * (x >> 1) * 72 + 32 * (x & 1));
            SCHED_B();
            oo[0] = MFMA16(fa[0], Vn[0], oo[0]); oo[1] = MFMA16(fa[1], Vn[0], oo[1]);
            oo[2] = MFMA16(fa[2], Vn[0], oo[2]); oo[2] = MFMA16(fa[3], Vn[1], oo[2]);
            oo[3] = MFMA16(fa[4], Vn[0], oo[3]); oo[3] = MFMA16(fa[5], Vn[1], oo[3]);
            SCHED_B();
#pragma unroll
            for (int x = 0; x < 8; ++x) fa[x] = LDQ(KtR, 16 * (4 + (x >> 1)) * 72 + 32 * (x & 1));
            SCHED_B();
#pragma unroll
            for (int j = 0; j < 4; ++j) { f32x4 acc = Sacc[j] * el; acc = MFMA16(fb[2 * j], Vs[0], acc); acc = MFMA16(fb[2 * j + 1], Vs[1], acc); Sacc[j] = acc; }
#pragma unroll
            for (int i = 0; i < 4; ++i) { const unsigned o01 = pk_bf16(oo[i][0], oo[i][1]), o23 = pk_bf16(oo[i][2], oo[i][3]);
                obE[(16 * i + 0) * 136] = (bf16_t)(o01 & 0xffffu); obE[(16 * i + 1) * 136] = (bf16_t)(o01 >> 16); obE[(16 * i + 2) * 136] = (bf16_t)(o23 & 0xffffu); obE[(16 * i + 3) * 136] = (bf16_t)(o23 >> 16); }
            SCHED_B();
#pragma unroll
            for (int j = 0; j < 4; ++j) { f32x4 acc = Sacc[4 + j] * el; acc = MFMA16(fa[2 * j], Vs[0], acc); acc = MFMA16(fa[2 * j + 1], Vs[1], acc); Sacc[4 + j] = acc; }
        }
        BAR_LDS();
        {
            const int tid = opaque_tid();
#pragma unroll
            for (int it = 0; it < 2; ++it) { const int idx = tid + it * 512, t = idx >> 4, e8 = (idx & 15) * 8;
                const u32x4 ov = *(const LAS u32x4*)(lds + GL_OB + (t * 136 + e8) * 2);
                float o[8];
#pragma unroll
                for (int k = 0; k < 4; ++k) { o[2 * k] = blo(ov[k]); o[2 * k + 1] = bhi(ov[k]); }
                float ss = 0.f;
#pragma unroll
                for (int k = 0; k < 8; ++k) ss += o[k] * o[k];
                ss += __shfl_xor(ss, 1); ss += __shfl_xor(ss, 2); ss += __shfl_xor(ss, 4); ss += __shfl_xor(ss, 8);
                const float rs = rsqrtf(ss * (1.f / 128.f) + 1e-6f);
                const f32x4 n0 = *(const LAS f32x4*)(lds + GL_NW + e8 * 4), n1 = *(const LAS f32x4*)(lds + GL_NW + e8 * 4 + 16);
                u32x4 res;
#pragma unroll
                for (int k = 0; k < 4; ++k) { const float za = blo(zreg[it][k]), zb = bhi(zreg[it][k]); const float na = k < 2 ? n0[2 * k] : n1[2 * k - 4], nb = k < 2 ? n0[2 * k + 1] : n1[2 * k - 3];
                    res[k] = pk_bf16(o[2 * k] * rs * na * silu_f(za), o[2 * k + 1] * rs * nb * silu_f(zb)); }
                *(u32x4*)(MIX + tiled_off((int)(rowbase + t0 + t), 4096 + h * 128 + e8, MIXW)) = res; }
        }
    }
    WAIT_VM0();
    {
        const int tid = opaque_tid(), w = tid >> 6, lane = tid & 63, r = lane & 15, q = lane >> 4, E = w * 16 + r;
        float* So = p.out + O_GDN_P + (size_t)(b * 32 + h) * 16384 + (4 * q) * 128 + E;
#pragma unroll
        for (int j = 0; j < 8; ++j)
#pragma unroll
            for (int reg = 0; reg < 4; ++reg) So[(16 * j + reg) * 128] = Sacc[j][reg];
    }
}

constexpr int SL_RAW = 0, SL_CA = 52224, SL_BA = 69632, SL_BAT = 87040, SL_XST = 105472, SL_CB = 123904, SL_TOK = 133120, SL_LAST = 135168, SL_YB = 135232, SL_WTS = 152640, SL_BIAS = 158784;
__device__ __forceinline__ void ssd_chunk_item(const Params& p, LAS unsigned char* lds, const int b, const int g, const int hp) {
    const bf16_t* P = (const bf16_t*)(p.ws + OFF_P); const float* G = (const float*)(p.ws + OFF_G32); float* Uo = (float*)(p.ws + OFF_U32);
    const bf16_t* zsrc = (const bf16_t*)(p.ws + OFF_XB) + (size_t)NTOK * DM;
    const int h0 = g * 8 + hp * 2;
    const size_t rowbase = (size_t)b * 2048;
    const int c0 = C_XBC + h0 * 64, c1 = C_XBC + 4096 + g * 128, c2 = C_XBC + 5120 + g * 128;
    f32x4 Hacc[8];
#pragma unroll
    for (int j = 0; j < 8; ++j) Hacc[j] = (f32x4){0.f, 0.f, 0.f, 0.f};
    float g_dtraw = 0.f, g_A = 0.f, g_dtb = 0.f, g_D = 0.f, g_dtnext = 0.f;
    unsigned doff[7];
    {
        const int tid = opaque_tid(), lane = tid & 63, w = __builtin_amdgcn_readfirstlane(tid >> 6);
        dma_offsets(doff, c0, c1, c2, w, lane);
        for (int i = tid; i < 1536 + 384; i += 512) {
            const int j = i / 384, cc = i - j * 384, sec = cc >> 7, col = cc & 127, ch = sec == 0 ? h0 * 64 + col : (sec == 1 ? 4096 + g * 128 + col : 5120 + g * 128 + col);
            if (j < 4) ((LAS float*)(lds + SL_WTS))[i] = p.ssd_conv_w[j * 6144 + ch]; else ((LAS float*)(lds + SL_BIAS))[cc] = p.ssd_conv_b[ch]; }
        if (w < 2) { const int hh = h0 + w; g_dtraw = G[(rowbase + lane) * G_LD + hh]; g_A = -expf(p.ssd_a_log[hh]); g_dtb = p.ssd_dt_bias[hh]; }
        g_D = p.ssd_d[h0 + (w >> 2)];
        asm volatile("" : "+v"(g_dtraw), "+v"(g_A), "+v"(g_dtb), "+v"(g_D));
        dma_raw(lds + SL_RAW, P, zsrc, rowbase, 0, c0, c1, c2, w, lane);
    }
#pragma unroll 1
    for (int c = 0; c < 32; ++c) {
        const int t0 = c * 64;
        if (c == 0) WAIT_VM0(); else asm volatile("s_waitcnt vmcnt(4)" ::: "memory");
        BAR_LDS();
        u32x4 zreg[2];
        {
            const int tid = opaque_tid(), lane = tid & 63, w = tid >> 6;
#pragma unroll
            for (int it = 0; it < 2; ++it) { const int idx = tid + it * 512; zreg[it] = *(const u32x4*)(P + (rowbase + t0 + (idx >> 4)) * P_LD + C_ZS + h0 * 64 + (idx & 15) * 8); }
            if (w < 2 && c < 31) g_dtnext = G[(rowbase + t0 + 64 + lane) * G_LD + h0 + w];
        }
        {
            const int tid = opaque_tid(), lane = tid & 63, w = tid >> 6;
            const LAS unsigned char* rawl = lds + SL_RAW + (8 * w) * 768 + lane * 4; const LAS float* wts = (const LAS float*)(lds + SL_WTS) + 2 * lane; const LAS float* bia = (const LAS float*)(lds + SL_BIAS) + 2 * lane;
#pragma unroll
            for (int sec = 0; sec < 3; ++sec) {
                f32x2v wj[4];
#pragma unroll
                for (int j = 0; j < 4; ++j) wj[j] = *(const LAS f32x2v*)(wts + j * 384 + sec * 128);
                const f32x2v bj = *(const LAS f32x2v*)(bia + sec * 128);
                float x0[11], x1[11];
#pragma unroll
                for (int rr = 0; rr < 11; ++rr) { const unsigned u = *(const LAS unsigned*)(rawl + rr * 768 + sec * 256); x0[rr] = blo(u); x1[rr] = bhi(u); }
                unsigned pk[8];
#pragma unroll
                for (int t = 0; t < 8; ++t) {
                    const float a0 = silu_f(bj[0] + wj[0][0] * x0[t] + wj[1][0] * x0[t + 1] + wj[2][0] * x0[t + 2] + wj[3][0] * x0[t + 3]);
                    const float a1 = silu_f(bj[1] + wj[0][1] * x1[t] + wj[1][1] * x1[t + 1] + wj[2][1] * x1[t + 2] + wj[3][1] * x1[t + 3]);
                    pk[t] = pk_bf16(a0, a1);
                    if (sec >= 1) *(LAS unsigned*)(lds + (sec == 1 ? SL_BA : SL_CA) + ((8 * w + t) * 136 + kperm(2 * lane)) * 2) = pk[t];
                }
                if (sec <= 1) {
                    u32x4 ke, ko;
#pragma unroll
                    for (int t2 = 0; t2 < 4; ++t2) { ke[t2] = (pk[2 * t2] & 0xffffu) | (pk[2 * t2 + 1] << 16); ko[t2] = (pk[2 * t2] >> 16) | (pk[2 * t2 + 1] & 0xffff0000u); }
                    *(LAS u32x4*)(lds + (sec == 0 ? SL_XST : SL_BAT) + ((2 * lane) * 72 + 8 * w) * 2) = ke; *(LAS u32x4*)(lds + (sec == 0 ? SL_XST : SL_BAT) + ((2 * lane + 1) * 72 + 8 * w) * 2) = ko;
                }
            }
            if (c == 31 && w == 7) {
                float* convout = p.out + O_SSDC_P + (size_t)b * 3 * 6144 + 2 * lane;
#pragma unroll
                for (int j = 0; j < 3; ++j)
#pragma unroll
                    for (int sec = 0; sec < 3; ++sec) { if (sec == 0 || hp == 0) { const unsigned u = *(const LAS unsigned*)(lds + SL_RAW + ((64 + j) * 3 + sec) * 256 + lane * 4);
                        *(f32x2v*)(convout + j * 6144 + (sec == 0 ? h0 * 64 : (sec == 1 ? 4096 + g * 128 : 5120 + g * 128))) = (f32x2v){blo(u), bhi(u)}; } }
            }
        }
        asm volatile("" : "+v"(zreg[0]), "+v"(zreg[1]), "+v"(g_dtnext));
        BAR_LDS();
        {
            const int tid = opaque_tid(), lane = tid & 63, r = lane & 15, q = lane >> 4, w = __builtin_amdgcn_readfirstlane(tid >> 6);
            dma_fast(lds + SL_RAW, (const char*)(P + (rowbase + (c < 31 ? t0 + 61 : t0 - 3)) * P_LD), doff, w);
            if (w < 2) {
                const float dt = softplus_f(g_dtraw + g_dtb); g_dtraw = g_dtnext;
                float cs = g_A * dt;
#pragma unroll
                for (int d = 1; d < 64; d <<= 1) { const float n = __shfl_up(cs, d); if (lane >= d) cs += n; }
                const float lastv = __shfl(cs, 63);
                ((LAS f32x4*)(lds + SL_TOK))[w * 64 + lane] = (f32x4){dt, cs, __expf(cs), dt * __expf(lastv - cs)}; if (lane == 63) ((LAS float*)(lds + SL_LAST))[w] = cs;
            } else {
#pragma unroll 1
                for (int job = w - 2; job < 10; job += 6) {
                    const int ti = job >= 6 ? 3 : (job >= 3 ? 2 : (job >= 1 ? 1 : 0)), si = job - (ti * (ti + 1)) / 2;
                    const LAS bf16_t* Ab = (const LAS bf16_t*)(lds + SL_CA) + (ti * 16 + r) * 136 + 8 * q; const LAS bf16_t* Bb = (const LAS bf16_t*)(lds + SL_BA) + (si * 16 + r) * 136 + 8 * q;
                    f32x4 acc = (f32x4){0.f, 0.f, 0.f, 0.f};
#pragma unroll
                    for (int kk = 0; kk < 4; ++kk) acc = MFMA16(*(const LAS bf16x8*)(Ab + kk * 32), *(const LAS bf16x8*)(Bb + kk * 32), acc);
                    LAS bf16_t* dst = (LAS bf16_t*)(lds + SL_CB) + (ti * 16 + 4 * q) * 72 + si * 16 + r;
#pragma unroll
                    for (int reg = 0; reg < 4; ++reg) dst[reg * 72] = (bf16_t)(pk_bf16(acc[reg], 0.f) & 0xffffu);
                }
            }
        }
        BAR_LDS();
        {
            const int tid = opaque_tid(), w = tid >> 6, lane = tid & 63, r = lane & 15, q = lane >> 4, hl = w >> 2, Pc = (w & 3) * 16 + r;
            const float Dh = g_D;
            const LAS f32x4* tk = (const LAS f32x4*)(lds + SL_TOK) + hl * 64; const float last = ((const LAS float*)(lds + SL_LAST))[hl];
            const LAS bf16_t* XsP = (const LAS bf16_t*)(lds + SL_XST) + (hl * 64 + Pc) * 72;
            const LAS bf16_t* CaR = (const LAS bf16_t*)(lds + SL_CA) + r * 136 + 8 * q; const LAS bf16_t* CbR = (const LAS bf16_t*)(lds + SL_CB) + r * 72 + 8 * q;
            const LAS bf16_t* BtR = (const LAS bf16_t*)(lds + SL_BAT) + r * 72 + 8 * q;
            LAS bf16_t* ybE = (LAS bf16_t*)(lds + SL_YB) + (4 * q) * 136 + hl * 64 + Pc;
            bf16x8 Hb[4];
#pragma unroll
            for (int kp = 0; kp < 4; ++kp) Hb[kp] = pack2(Hacc[2 * kp], Hacc[2 * kp + 1]);
            bf16x8 xf[2], xw[2];
#pragma unroll
            for (int kp = 0; kp < 2; ++kp) { const u32x4 xv = *(const LAS u32x4*)(XsP + 32 * kp + 8 * q); xf[kp] = __builtin_bit_cast(bf16x8, xv);
                u32x4 xs;
#pragma unroll
                for (int e2 = 0; e2 < 4; ++e2) { const float wa = tk[32 * kp + 8 * q + 2 * e2][3], wb = tk[32 * kp + 8 * q + 2 * e2 + 1][3];
                    xs[e2] = pk_bf16(blo(xv[e2]) * wa, bhi(xv[e2]) * wb); }
                xw[kp] = __builtin_bit_cast(bf16x8, xs); }
#pragma unroll
            for (int i = 0; i < 4; ++i) {
                f32x4 acc = (f32x4){0.f, 0.f, 0.f, 0.f};
#pragma unroll
                for (int kp = 0; kp < 4; ++kp) acc = MFMA16(LDQ(CaR, 16 * i * 136 + 32 * kp), Hb[kp], acc);
#pragma unroll
                for (int reg = 0; reg < 4; ++reg) acc[reg] *= tk[16 * i + 4 * q + reg][2];
                const int t = 16 * i + r; const float cum_t = tk[t][1];
#pragma unroll
                for (int kp = 0; kp < 2; ++kp) { if (kp <= (i >> 1)) {
                    const u32x4 cbv = *(const LAS u32x4*)(CbR + 16 * i * 72 + 32 * kp);
                    float lv[8];
#pragma unroll
                    for (int jj = 0; jj < 8; ++jj) { const int s = 32 * kp + 8 * q + jj; const f32x4 ts = tk[s]; const float cb = (jj & 1) ? bhi(cbv[jj >> 1]) : blo(cbv[jj >> 1]);
                        lv[jj] = s <= t ? cb * __expf(cum_t - ts[1]) * ts[0] : 0.f; }
                    const u32x4 lw = (u32x4){pk_bf16(lv[0], lv[1]), pk_bf16(lv[2], lv[3]), pk_bf16(lv[4], lv[5]), pk_bf16(lv[6], lv[7])};
                    acc = MFMA16(__builtin_bit_cast(bf16x8, lw), xf[kp], acc); } }
                const u32x2 xd = *(const LAS u32x2*)(XsP + 16 * i + 4 * q);
                acc[0] += blo(xd[0]) * Dh; acc[1] += bhi(xd[0]) * Dh; acc[2] += blo(xd[1]) * Dh; acc[3] += bhi(xd[1]) * Dh;
#pragma unroll
                for (int reg = 0; reg < 4; ++reg) ybE[(16 * i + reg) * 136] = (bf16_t)(pk_bf16(acc[reg], 0.f) & 0xffffu);
            }
            const float el = __expf(last);
#pragma unroll
            for (int j = 0; j < 8; ++j) { f32x4 acc = Hacc[j] * el;
                acc = MFMA16(*(const LAS bf16x8*)(BtR + 16 * j * 72), xw[0], acc); acc = MFMA16(*(const LAS bf16x8*)(BtR + 16 * j * 72 + 32), xw[1], acc);
                Hacc[j] = acc; }
        }
        BAR_LDS();
        {
            const int tid = opaque_tid();
#pragma unroll
            for (int it = 0; it < 2; ++it) { const int idx = tid + it * 512, t = idx >> 4, e8 = (idx & 15) * 8;
                const u32x4 yv = *(const LAS u32x4*)(lds + SL_YB + (t * 136 + e8) * 2);
                f32x4 o0, o1;
                o0[0] = blo(yv[0]) * silu_f(blo(zreg[it][0])); o0[1] = bhi(yv[0]) * silu_f(bhi(zreg[it][0])); o0[2] = blo(yv[1]) * silu_f(blo(zreg[it][1])); o0[3] = bhi(yv[1]) * silu_f(bhi(zreg[it][1]));
                o1[0] = blo(yv[2]) * silu_f(blo(zreg[it][2])); o1[1] = bhi(yv[2]) * silu_f(bhi(zreg[it][2])); o1[2] = blo(yv[3]) * silu_f(blo(zreg[it][3])); o1[3] = bhi(yv[3]) * silu_f(bhi(zreg[it][3]));
                float* up = Uo + (rowbase + t0 + t) * DM + h0 * 64 + e8; *(f32x4*)up = o0; *(f32x4*)(up + 4) = o1; }
        }
    }
    WAIT_VM0();
    {
        const int tid = opaque_tid(), w = tid >> 6, lane = tid & 63, r = lane & 15, q = lane >> 4, hl = w >> 2, Pc = (w & 3) * 16 + r;
        float* Ho = p.out + O_SSD_P + ((size_t)(b * 64 + h0 + hl) * 64 + Pc) * 128 + 4 * q;
#pragma unroll
        for (int j = 0; j < 8; ++j) *(f32x4*)(Ho + 16 * j) = Hacc[j];
    }
}

__device__ __forceinline__ void phase_scan(const Params& p, LAS unsigned char* lds, const int qword = QCTR_WORD, const int item0 = 0, const int item_end = N_ITEMS) {
    LAS int* qslot = (LAS int*)(lds + LDS_MISC + 16);
    unsigned* qctr = (unsigned*)(p.ws + OFF_BAR) + qword;
    for (;;) {
        __syncthreads();
        if (threadIdx.x == 0) *qslot = item0 + (int)__hip_atomic_fetch_add(qctr, 1u, __ATOMIC_RELAXED, __HIP_MEMORY_SCOPE_AGENT);
        __syncthreads();
        const int item = __builtin_amdgcn_readfirstlane(*qslot);
        if (item >= item_end) break;
        if (item < N_GDN_P) gdn_chunk_item(p, lds, item >> 5, item & 31);
        else if (item < N_GDN_P + N_SSD_P) { const int i = item - N_GDN_P; ssd_chunk_item(p, lds, i >> 5, (i >> 2) & 7, i & 3); }
        else if (item < N_GDN_P + N_SSD_P + N_WOUT + N_GDN_S) { const int i = item - N_GDN_P - N_SSD_P - N_WOUT; gdn_sample_item(p, i >> 4, i & 15); }
        else { const int i = item - N_GDN_P - N_SSD_P - N_WOUT - N_GDN_S; ssd_sample_item(p, i >> 3, i & 7); }
    }
}

__device__ __forceinline__ void phase_outproj_sample(const Params& p, LAS unsigned char* lds) {
    const int tid = threadIdx.x, wid = __builtin_amdgcn_readfirstlane(tid >> 6), lane = tid & 63, wr = wid >> 2, wc = wid & 3, fr = lane & 15, fq = lane >> 4;
    const int aoff = pg8::lds_byte(wr * 64 + fr, fq * 8), boff = pg8::lds_byte((wc & 1) * 64 + fr, fq * 8) + 16384 + (wc >> 1) * 16384;
    for (int u = blockIdx.x; u < 256; u += gridDim.x) {
        const int pn = u & 15, ks = u >> 4;
        const char* gA = (const char*)(p.ws + OFF_MIX) + ((size_t)64 * 128 + ks * 8) * 16384;
        const char* gB0 = (const char*)(p.ws + OFF_WOB) + ((size_t)(2 * pn) * 128 + ks * 8) * 16384; const char* gB1 = gB0 + (size_t)128 * 16384;
#define OS_ISSUE(kt, st) do { _Pragma("unroll") for (int pc = 0; pc < 6; ++pc) { const char* s_ = (pc < 2 ? gA : (pc < 4 ? gB0 : gB1)) + (size_t)(kt) * 16384 + (pc & 1) * 8192 + tid * 16; \
            __builtin_amdgcn_global_load_lds((const unsigned*)s_, (LAS unsigned*)(lds + (st) * 49152 + pc * 8192 + wid * 1024), 16, 0, 0); } } while (0)
        f32x4 acc[4][4];
#pragma unroll
        for (int m = 0; m < 4; ++m)
#pragma unroll
            for (int n = 0; n < 4; ++n) acc[m][n] = (f32x4){0.f, 0.f, 0.f, 0.f};
        OS_ISSUE(0, 0); OS_ISSUE(1, 1); OS_ISSUE(2, 2);
#pragma unroll
        for (int kt = 0; kt < 8; ++kt) {
            if (kt <= 5) asm volatile("s_waitcnt vmcnt(12)" ::: "memory"); else if (kt == 6) asm volatile("s_waitcnt vmcnt(6)" ::: "memory"); else asm volatile("s_waitcnt vmcnt(0)" ::: "memory");
            __builtin_amdgcn_s_barrier(); asm volatile("" ::: "memory");
            const LAS unsigned char* sb = lds + (kt % 3) * 49152;
            bf16x8 af[4][2], bfr[4][2];
#pragma unroll
            for (int m = 0; m < 4; ++m)
#pragma unroll
                for (int k = 0; k < 2; ++k) { af[m][k] = *(const LAS bf16x8*)(sb + aoff + m * 2048 + k * 1024); bfr[m][k] = *(const LAS bf16x8*)(sb + boff + m * 2048 + k * 1024); }
#pragma unroll
            for (int m = 0; m < 4; ++m)
#pragma unroll
                for (int n = 0; n < 4; ++n)
#pragma unroll
                    for (int k = 0; k < 2; ++k) acc[m][n] = __builtin_amdgcn_mfma_f32_16x16x32_bf16(bfr[n][k], af[m][k], acc[m][n], 0, 0, 0);
            asm volatile("s_waitcnt lgkmcnt(0)" ::: "memory"); __builtin_amdgcn_s_barrier(); asm volatile("" ::: "memory");
            if (kt + 3 < 8) OS_ISSUE(kt + 3, kt % 3);
        }
#undef OS_ISSUE
        float* Rp = (float*)(p.ws + OFF_RPART) + ((size_t)ks * NTS + wr * 64 + fr) * DM + pn * 256 + wc * 64 + 4 * fq;
#pragma unroll
        for (int m = 0; m < 4; ++m)
#pragma unroll
            for (int n = 0; n < 4; ++n) *(f32x4*)(Rp + (size_t)(m * 16) * DM + n * 16) = acc[m][n];
    }
    __syncthreads();
}

__device__ __forceinline__ void phase_ssdnorm(const Params& p) {
    const float* U = (const float*)(p.ws + OFF_U32); bf16_t* MIX = (bf16_t*)(p.ws + OFF_MIX);
    const int lane = threadIdx.x & 63, gw = blockIdx.x * 8 + (threadIdx.x >> 6), nw = gridDim.x * 8;
    for (int it = gw; it < NTOK * 8; it += nw) {
        const int row = it >> 3, g = it & 7; const size_t off = (size_t)row * DM + g * 512 + lane * 8;
        const f32x4 a = *(const f32x4*)(U + off), b = *(const f32x4*)(U + off + 4);
        const float ss = wave_sum(a[0] * a[0] + a[1] * a[1] + a[2] * a[2] + a[3] * a[3] + b[0] * b[0] + b[1] * b[1] + b[2] * b[2] + b[3] * b[3]);
        const float rs = rsqrtf(ss * (1.f / 512.f) + 1e-6f);
        const f32x4 wa = *(const f32x4*)(p.ssd_norm_w + g * 512 + lane * 8), wb = *(const f32x4*)(p.ssd_norm_w + g * 512 + lane * 8 + 4);
        u32x4 o; o[0] = cvt_pk_bf16(a[0] * rs * wa[0], a[1] * rs * wa[1]); o[1] = cvt_pk_bf16(a[2] * rs * wa[2], a[3] * rs * wa[3]);
        o[2] = cvt_pk_bf16(b[0] * rs * wb[0], b[1] * rs * wb[1]); o[3] = cvt_pk_bf16(b[2] * rs * wb[2], b[3] * rs * wb[3]);
        *(u32x4*)(MIX + tiled_off(row, g * 512 + lane * 8, MIXW)) = o;
    }
    const float* GO = (const float*)(p.ws + OFF_SF) + SF_GO; const bf16_t* P = (const bf16_t*)(p.ws + OFF_P);
    for (int it = gw; it < NTS * 32; it += nw) {
        const int tok = it >> 5, h = it & 31;
        const float o0 = GO[(size_t)tok * 4096 + h * 128 + lane], o1 = GO[(size_t)tok * 4096 + h * 128 + 64 + lane];
        const float rs = rsqrtf(wave_sum(o0 * o0 + o1 * o1) * (1.f / 128.f) + 1e-6f);
        const size_t prow = (size_t)(NTP + tok) * P_LD + C_ZG + h * 128;
        MIX[tiled_off(NTP + tok, 4096 + h * 128 + lane, MIXW)] = f2bf(o0 * rs * p.gdn_norm_w[lane] * silu_f(bf2f(P[prow + lane])));
        MIX[tiled_off(NTP + tok, 4096 + h * 128 + 64 + lane, MIXW)] = f2bf(o1 * rs * p.gdn_norm_w[64 + lane] * silu_f(bf2f(P[prow + 64 + lane])));
    }
}

__device__ __forceinline__ void phase_ln(const Params& p) {
    const float* R = (const float*)(p.ws + OFF_R);
    const int lane = threadIdx.x & 63, gw = blockIdx.x * 8 + (threadIdx.x >> 6), nw = gridDim.x * 8;
    for (int row = gw; row < NTOK; row += nw) {
        const float* rr = R + (size_t)row * DM;
        f32x4 v[16]; float sum = 0.f;
        if (row < NTP) {
#pragma unroll
            for (int i = 0; i < 16; ++i) v[i] = *(const f32x4*)(rr + (i * 64 + lane) * 4);
        } else {
            const float* xr = p.x_sample + (size_t)(row - NTP) * DM; const float* pr = (const float*)(p.ws + OFF_RPART) + (size_t)(row - NTP) * DM;
#pragma unroll
            for (int i = 0; i < 16; ++i) v[i] = ALPHA * *(const f32x4*)(xr + (i * 64 + lane) * 4);
#pragma unroll 1
            for (int ks = 0; ks < 16; ++ks) {
#pragma unroll
                for (int i = 0; i < 16; ++i) v[i] += *(const f32x4*)(pr + (size_t)ks * NTS * DM + (i * 64 + lane) * 4); }
        }
#pragma unroll
        for (int i = 0; i < 16; ++i) sum += v[i][0] + v[i][1] + v[i][2] + v[i][3];
        const float mu = wave_sum(sum) * (1.f / 4096.f);
        float sq = 0.f;
#pragma unroll
        for (int i = 0; i < 16; ++i) { v[i] = v[i] - mu; sq += v[i][0] * v[i][0] + v[i][1] * v[i][1] + v[i][2] * v[i][2] + v[i][3] * v[i][3]; }
        const float rs = rsqrtf(wave_sum(sq) * (1.f / 4096.f) + 1e-5f);
        float* o = p.out + (row < NTP ? O_YP + (size_t)row * DM : O_YS + (size_t)(row - NTP) * DM);
#pragma unroll
        for (int i = 0; i < 16; ++i) { const int c = (i * 64 + lane) * 4; const f32x4 gg = *(const f32x4*)(p.ln_g + c), bb = *(const f32x4*)(p.ln_b + c);
            *(f32x4*)(o + c) = v[i] * rs * gg + bb; }
    }
}

template <int PH>
__global__ __launch_bounds__(512, 2) void mk_fwd(Params p) {
    extern __shared__ __attribute__((aligned(16))) unsigned char smem[];
    LAS unsigned char* lds = (LAS unsigned char*)smem;
    XcdBarrier bar;
    if (PH < 0) {
        if (threadIdx.x == 0) *(LAS u32x4*)(lds + LDS_MISC) = (u32x4){0u, 0u, 0u, 0u};
        __syncthreads();
        bar = xcd_barrier_post((unsigned*)(p.ws + OFF_BAR), (volatile LAS unsigned*)(lds + LDS_MISC));
    }
    if (PH < 0 || PH == 0) { phase_convert(p, lds); if (PROBE_REP == 1) { __syncthreads(); phase_convert(p, lds); } }
    if (PH < 0) xcd_barrier(bar);
    if (PH < 0 || PH == 1) {
        pg8::Gemm g{(const bf16_t*)(p.ws + OFF_XB), (const bf16_t*)(p.ws + OFF_WB), MPAD, NPAD, DM};
        pg8::StaticOrder S; S.init(MPAD, NPAD, (int)gridDim.x, (int)blockIdx.x, true);
        pg8::EpiProj E{(bf16_t*)(p.ws + OFF_P), (float*)(p.ws + OFF_G32)};
        pg8::gemm_phase<pg8::EpiProj, pg8::StaticOrder, true, true>(lds, g, S, E);
        if (PROBE_REP == 2) { __syncthreads(); pg8::gemm_phase<pg8::EpiProj, pg8::StaticOrder, true, true>(lds, g, S, E); }
        { const int G = (int)gridDim.x, nun = (MPAD / 256) * (NPAD / 256), lastfull = nun % G;
          if (lastfull != 0 && (int)blockIdx.x >= lastfull) { __syncthreads();
              tconv_range<false, false, false>(p.w_out, DM, (bf16_t*)(p.ws + OFF_WOB), DM * MIXW * 2, MIXW, (int)blockIdx.x - lastfull, WOUT_TILES, G - lastfull, lds); }
          else if (lastfull == 0) { __syncthreads(); tconv_range<false, false, false>(p.w_out, DM, (bf16_t*)(p.ws + OFF_WOB), DM * MIXW * 2, MIXW, (int)blockIdx.x, WOUT_TILES, G, lds); } }
    }
    if (PH < 0) xcd_barrier(bar);
    if (PH < 0 || PH == 2) { phase_sample_front(p); if (PH < 0) xcd_barrier(bar); else __syncthreads(); phase_scan(p, lds); if (PROBE_REP == 3) phase_scan(p, lds, QCTR_WORD + 64, 0); if (PROBE_REP == 4) phase_scan(p, lds, QCTR_WORD + 64, N_GDN_P + N_SSD_P + N_WOUT); if (PROBE_REP == 6) phase_scan(p, lds, QCTR_WORD + 64, 0, N_GDN_P); if (PROBE_REP == 7) phase_scan(p, lds, QCTR_WORD + 64, N_GDN_P, N_GDN_P + N_SSD_P); }
    if (PH < 0) xcd_barrier(bar);
    if (PH < 0 || PH == 3) phase_ssdnorm(p);
    if (PH < 0) xcd_barrier(bar);
    if (PH < 0 || PH == 4) {
        phase_outproj_sample(p, lds);
        pg8::Gemm g{(const bf16_t*)(p.ws + OFF_MIX), (const bf16_t*)(p.ws + OFF_WOB), NTP, DM, MIXW};
        pg8::StaticOrder S; S.init(NTP, DM, (int)gridDim.x, (int)blockIdx.x);
        pg8::EpiOut E{(float*)(p.ws + OFF_R), p.x_prompt, p.x_sample};
        pg8::gemm_phase<pg8::EpiOut, pg8::StaticOrder, true, true>(lds, g, S, E);
        if (PROBE_REP == 5) { __syncthreads(); pg8::gemm_phase<pg8::EpiOut, pg8::StaticOrder, true, true>(lds, g, S, E); }
    }
    if (PH < 0) xcd_barrier(bar);
    if (PH < 0 || PH == 5) phase_ln(p);
}

template <int PH> static void launch_phase(const Params& p, int grid, hipStream_t stream) {
    static bool attr = false;
    if (!attr) { (void)hipFuncSetAttribute((const void*)mk_fwd<PH>, hipFuncAttributeMaxDynamicSharedMemorySize, LDS_BYTES); attr = true; }
    hipLaunchKernelGGL((mk_fwd<PH>), dim3(grid), dim3(512), LDS_BYTES, stream, p);
}

extern "C" void kernel_launch(void* const* d_in, const int* in_sizes, int n_in, void* d_out, int out_size, void* d_ws, size_t ws_size, hipStream_t stream) {
    (void)in_sizes; (void)n_in; (void)out_size;
    if (ws_size < WS_END) { fprintf(stderr, "workspace too small: %zu < %zu\n", ws_size, (size_t)WS_END); return; }
    Params p{};
    p.x_prompt = (const float*)d_in[0]; p.x_sample = (const float*)d_in[1]; p.state_ssd = (const float*)d_in[2]; p.state_ssd_conv = (const float*)d_in[3];
    p.state_gdn = (const float*)d_in[4]; p.state_gdn_conv = (const float*)d_in[5]; p.w_in = (const float*)d_in[6]; p.ssd_conv_w = (const float*)d_in[7];
    p.ssd_conv_b = (const float*)d_in[8]; p.ssd_dt_bias = (const float*)d_in[9]; p.ssd_a_log = (const float*)d_in[10]; p.ssd_d = (const float*)d_in[11];
    p.ssd_norm_w = (const float*)d_in[12]; p.gdn_conv_w = (const float*)d_in[13]; p.gdn_dt_bias = (const float*)d_in[14]; p.gdn_a_log = (const float*)d_in[15];
    p.gdn_norm_w = (const float*)d_in[16]; p.w_out = (const float*)d_in[17]; p.ln_g = (const float*)d_in[18]; p.ln_b = (const float*)d_in[19];
    p.out = (float*)d_out; p.ws = (unsigned char*)d_ws;
    static int grid = 0;
    if (!grid) { int dev = 0, cus = 0; (void)hipGetDevice(&dev); (void)hipDeviceGetAttribute(&cus, hipDeviceAttributeMultiprocessorCount, dev); grid = cus > 0 ? cus : 256; }
    (void)hipMemsetAsync(d_ws, 0, 32768, stream);
#if MK_FUSED
    launch_phase<-1>(p, grid, stream);
#else
    launch_phase<0>(p, grid, stream); launch_phase<1>(p, grid, stream); launch_phase<2>(p, grid, stream);
    launch_phase<3>(p, grid, stream); launch_phase<4>(p, grid, stream); launch_phase<5>(p, grid, stream);
#endif
}
```

```cpp
#include <hip/hip_runtime.h>
#include <cstdio>
#include <cstdint>

#ifndef PROBE_REP
#define PROBE_REP 0
#endif
#ifndef MK_FUSED
#define MK_FUSED 1
#endif

#define LAS __attribute__((address_space(3)))
typedef unsigned short bf16_t;
typedef short bf16x8 __attribute__((ext_vector_type(8)));
typedef float f32x4 __attribute__((ext_vector_type(4)));
typedef float f32x2v __attribute__((ext_vector_type(2)));
typedef unsigned u32x4 __attribute__((ext_vector_type(4)));
typedef unsigned u32x2 __attribute__((ext_vector_type(2)));

constexpr int DM = 4096, NTP = 8192, NTS = 128, NTOK = 8320, MPAD = 8448;
constexpr int NPROJ = 26752, P_LD = 26624, NPAD = 26880, MIXW = 8192, G_LD = 256;
constexpr int C_ZS = 0, C_XBC = 4096, C_QKV = 10240, C_ZG = 22528;
constexpr float ALPHA = 1.189207115002721f;
constexpr int LDS_BYTES = 163840;
constexpr int LDS_MISC = LDS_BYTES - 64;

constexpr size_t OFF_BAR = 0;
constexpr size_t OFF_XB  = 32768;
constexpr size_t OFF_WB  = OFF_XB  + (size_t)MPAD * DM * 2;
constexpr size_t OFF_WOB = OFF_WB  + (size_t)NPAD * DM * 2;
constexpr size_t OFF_P   = OFF_WOB + (size_t)DM * MIXW * 2;
constexpr size_t OFF_G32 = OFF_P   + (size_t)MPAD * P_LD * 2;
constexpr size_t OFF_MIX = OFF_G32 + (size_t)MPAD * G_LD * 4;
constexpr size_t OFF_U32 = OFF_MIX + (size_t)MPAD * MIXW * 2;
constexpr size_t OFF_R   = OFF_U32 + (size_t)MPAD * DM * 4;
constexpr size_t OFF_RPART = OFF_R + (size_t)MPAD * DM * 4;
constexpr size_t OFF_SF  = OFF_RPART + (size_t)16 * NTS * DM * 4;
constexpr size_t WS_END  = OFF_SF + (size_t)16 * 1024 * 1024;
constexpr int QCTR_WORD = 3584;
constexpr int READY_WORD = 4096;
constexpr int HOOK_TMO_WORD = 5120;
constexpr int NCONV = 8;
constexpr int PRE_SLABS = 8;
constexpr int N_SLABS = 14, SLAB_TILES = 1024, WIN_TILES = 13440, WOUT_TILES = 4096;

constexpr size_t O_YP = 0;
constexpr size_t O_YS = O_YP + (size_t)NTP * DM;
constexpr size_t O_SSD_P = O_YS + (size_t)NTS * DM;
constexpr size_t O_SSDC_P = O_SSD_P + (size_t)4 * 64 * 64 * 128;
constexpr size_t O_GDN_P = O_SSDC_P + (size_t)4 * 3 * 6144;
constexpr size_t O_GDNC_P = O_GDN_P + (size_t)4 * 32 * 128 * 128;
constexpr size_t O_SSD_S = O_GDNC_P + (size_t)4 * 3 * 12288;
constexpr size_t O_SSDC_S = O_SSD_S + (size_t)128 * 64 * 64 * 128;
constexpr size_t O_GDN_S = O_SSDC_S + (size_t)128 * 3 * 6144;
constexpr size_t O_GDNC_S = O_GDN_S + (size_t)128 * 32 * 128 * 128;

struct Params {
    const float* x_prompt; const float* x_sample; const float* state_ssd; const float* state_ssd_conv; const float* state_gdn; const float* state_gdn_conv;
    const float* w_in; const float* ssd_conv_w; const float* ssd_conv_b; const float* ssd_dt_bias; const float* ssd_a_log; const float* ssd_d; const float* ssd_norm_w;
    const float* gdn_conv_w; const float* gdn_dt_bias; const float* gdn_a_log; const float* gdn_norm_w; const float* w_out; const float* ln_g; const float* ln_b;
    float* out; unsigned char* ws;
};

__device__ __forceinline__ unsigned cvt_pk_bf16(float lo, float hi) { unsigned r; asm volatile("v_cvt_pk_bf16_f32 %0, %1, %2" : "=v"(r) : "v"(lo), "v"(hi)); return r; }
__device__ __forceinline__ float bf2f(bf16_t v) { return __uint_as_float(((unsigned)v) << 16); }
__device__ __forceinline__ bf16_t f2bf(float f) { unsigned u = __float_as_uint(f); u += 0x7FFFu + ((u >> 16) & 1u); return (bf16_t)(u >> 16); }
__device__ __forceinline__ float silu_f(float x) { return x * __builtin_amdgcn_rcpf(1.f + __expf(-x)); }
__device__ __forceinline__ float sigmoid_f(float x) { return __builtin_amdgcn_rcpf(1.f + __expf(-x)); }
__device__ __forceinline__ float softplus_f(float x) { return x > 20.f ? x : log1pf(expf(x)); }
__device__ __forceinline__ f32x4 ldbf4(const bf16_t* p) { const u32x2 v = *(const u32x2*)p; f32x4 r; r[0] = __uint_as_float(v[0] << 16); r[1] = __uint_as_float(v[0] & 0xffff0000u); r[2] = __uint_as_float(v[1] << 16); r[3] = __uint_as_float(v[1] & 0xffff0000u); return r; }
__device__ __forceinline__ int opaque_tid() { int t = threadIdx.x; asm volatile("" : "+v"(t)); return t; }
__device__ __forceinline__ size_t tiled_off(int row, int col, int K) {
    const int r = row & 127, c = col & 63, st = (r >> 4) * 2 + (c >> 5), ob = (r & 15) * 64 + (c & 31) * 2;
    return ((size_t)(row >> 7) * (K >> 6) + (col >> 6)) * 8192 + ((st * 1024 + (ob ^ (((ob >> 9) & 1) << 5))) >> 1);
}
__device__ __forceinline__ float wave_sum(float v) {
#pragma unroll
    for (int m = 32; m >= 1; m >>= 1) v += __shfl_xor(v, m);
    return v;
}

#define XB_TMO      128
#define XB_XCNT(j)  (256  + 64 * (j))
#define XB_XSUB(j)  (1280 + 64 * (j))
#define XB_XGEN(j)  (2304 + 64 * (j))
#define XB_TOP      3328
#define XB_TOPGEN   3392
#define XCD_BAR_WORDS 3456
#define XB_SPIN_CAP (1u << 18)
__device__ __forceinline__ unsigned xb_ld(unsigned* p)              { return __hip_atomic_load(p, __ATOMIC_RELAXED, __HIP_MEMORY_SCOPE_AGENT); }
__device__ __forceinline__ unsigned xb_add(unsigned* p, unsigned v) { return __hip_atomic_fetch_add(p, v, __ATOMIC_RELAXED, __HIP_MEMORY_SCOPE_AGENT); }
__device__ __forceinline__ unsigned xb_xcc_id() { return (unsigned)__builtin_amdgcn_s_getreg((3 << 11) | 20) & 0xFu; }
#define XB_SPIN(cond, bar) do { unsigned _sp = 0; while (cond) { __builtin_amdgcn_s_sleep(1); \
    if ((++_sp & 255u) == 0u) { if (xb_ld(&(bar)[XB_TMO])) break; if (_sp > XB_SPIN_CAP) { atomicAdd(&(bar)[XB_TMO], 1u); break; } } } } while (0)
struct XcdBarrier { unsigned* bar; unsigned x; volatile LAS unsigned* st; };
__device__ __forceinline__ XcdBarrier xcd_barrier_post(unsigned* bar, volatile LAS unsigned* st) {
    XcdBarrier b; b.bar = bar; b.x = xb_xcc_id(); b.st = st;
    if (threadIdx.x == 0) (void)xb_add(&bar[XB_XCNT(b.x)], 1u);
    return b;
}
__device__ __forceinline__ void xcd_barrier_complete(unsigned* bar, unsigned x, unsigned& nloc, unsigned& nx) {
    const unsigned G = gridDim.x * gridDim.y * gridDim.z;
    unsigned sum, cnt, mine, sp = 0u;
    for (;;) {
        sum = 0u; cnt = 0u; mine = 0u;
#pragma unroll
        for (unsigned j = 0; j < 16; ++j) { const unsigned c = xb_ld(&bar[XB_XCNT(j)]); sum += c; cnt += (c > 0u) ? 1u : 0u; mine = (j == x) ? c : mine; }
        if (sum == G) break;
        __builtin_amdgcn_s_sleep(1);
        if ((++sp & 255u) == 0u) { if (xb_ld(&bar[XB_TMO])) break; if (sp > XB_SPIN_CAP) { atomicAdd(&bar[XB_TMO], 1u); break; } }
    }
    nloc = mine > 0u ? mine : 1u; nx = cnt > 0u ? cnt : 1u;
}
__device__ __forceinline__ void xcd_barrier(const XcdBarrier& b) {
    asm volatile("s_waitcnt vmcnt(0)" ::: "memory");
    __syncthreads();
    if (threadIdx.x == 0) {
        unsigned* bar = b.bar;
        __builtin_amdgcn_s_waitcnt(0);
        unsigned nloc = b.st[0], nx = b.st[1];
        if (nloc == 0u) { xcd_barrier_complete(bar, b.x, nloc, nx); b.st[0] = nloc; b.st[1] = nx; }
        const unsigned old = xb_add(&bar[XB_XSUB(b.x)], 1u);
        const unsigned gen = old / nloc;
        if (old + 1u == (gen + 1u) * nloc) {
            __builtin_amdgcn_fence(__ATOMIC_RELEASE, "agent");
            asm volatile("s_waitcnt vmcnt(0)" ::: "memory");
            const unsigned og = xb_add(&bar[XB_TOP], 1u);
            const unsigned tg = og / nx;
            if (og + 1u == (tg + 1u) * nx) xb_add(&bar[XB_TOPGEN], 1u);
            else XB_SPIN(xb_ld(&bar[XB_TOPGEN]) == tg, bar);
            __builtin_amdgcn_fence(__ATOMIC_ACQUIRE, "agent");
            xb_add(&bar[XB_XGEN(b.x)], 1u);
            asm volatile("s_waitcnt vmcnt(0)" ::: "memory");
        } else {
            XB_SPIN(xb_ld(&bar[XB_XGEN(b.x)]) == gen, bar);
            __builtin_amdgcn_fence(__ATOMIC_ACQUIRE, "agent");
            asm volatile("s_waitcnt vmcnt(0)" ::: "memory");
        }
    }
    __syncthreads();
}

namespace pg8 {
constexpr int BM = 256, BK = 64, HALF = 128, HTB = HALF * BK * 2, STAGE_BYTES = 8 * HTB, NXCD = 8, WGM = 8;
__host__ __device__ __forceinline__ int lds_byte(int r, int c) { const int st = (r >> 4) * 2 + (c >> 5), rr = r & 15, cc = c & 31, ob = rr * 64 + cc * 2; return st * 1024 + (ob ^ (((ob >> 9) & 1) << 5)); }
__host__ __device__ __forceinline__ void stage_rc(int b, int& R, int& C) { const int st = b / 1024, sb = b % 1024, swz = sb ^ (((sb >> 9) & 1) << 5); R = (st >> 1) * 16 + swz / 64; C = (st & 1) * 32 + (swz % 64) / 2; }
__host__ __device__ __forceinline__ int perm32(int rho) { const int n = rho >> 4, i = rho & 15; return 8 * (i >> 2) + 4 * n + (i & 3); }
struct Unit { int pm, pn; };
struct Gemm { const bf16_t* A; const bf16_t* Bt; int M, N, K; };
struct StaticOrder {
    int nM, nN, nwg, G, c; bool swapmn;
    __host__ __device__ void init(int M, int N, int G_, int c_, bool sw = false) { swapmn = sw; nM = (sw ? N : M) / BM; nN = (sw ? M : N) / BM; nwg = nM * nN; G = G_; c = c_; }
    __host__ __device__ bool next(int i, Unit& u) const {
        const long L = (long)i * G + c; if (L >= nwg) return false;
        int wgid = (int)L; { const int q = nwg / NXCD, r = nwg % NXCD, xcd = wgid % NXCD, off = wgid / NXCD; wgid = (xcd < r ? xcd * (q + 1) : r * (q + 1) + (xcd - r) * q) + off; }
        const int nig = WGM * nN, gid = wgid / nig, fm = gid * WGM, gsz = (nM - fm) < WGM ? (nM - fm) : WGM;
        const int a = fm + ((wgid % nig) % gsz), b = (wgid % nig) / gsz;
        u.pm = swapmn ? b : a; u.pn = swapmn ? a : b; return true;
    }
    __device__ __forceinline__ void a_ready(const Unit&) const {}
    __device__ __forceinline__ void done(const Unit&) const {}
};

struct SlabOrder : StaticOrder {
    unsigned* ready; unsigned need; unsigned* tmo; int pre;
    __device__ __forceinline__ void a_ready(const Unit& u) const {
        const int g = u.pn >> 3;
        if (g >= pre && threadIdx.x < 64) {
            const unsigned long long t0 = __builtin_amdgcn_s_memrealtime(); unsigned polls = 0;
            while ((unsigned)__builtin_amdgcn_readfirstlane(__hip_atomic_load(ready + 64 * g, __ATOMIC_RELAXED, __HIP_MEMORY_SCOPE_AGENT)) < need) {
                if ((++polls & 255u) == 0u && __builtin_amdgcn_readfirstlane(__hip_atomic_load(tmo, __ATOMIC_RELAXED, __HIP_MEMORY_SCOPE_AGENT)) != 0u) break;
                if (__builtin_amdgcn_s_memrealtime() - t0 > 2000000ull) { if (threadIdx.x == 0) __hip_atomic_store(tmo, 1u, __ATOMIC_RELAXED, __HIP_MEMORY_SCOPE_AGENT); break; }
                __builtin_amdgcn_s_sleep(2); }
            __builtin_amdgcn_fence(__ATOMIC_ACQUIRE, "agent");
            asm volatile("s_waitcnt vmcnt(0)" ::: "memory");
        }
        asm volatile("" ::: "memory"); __builtin_amdgcn_s_barrier(); asm volatile("" ::: "memory");
    }
};
struct EpiProj {
    static constexpr bool PERM = true, AFTER_DRAIN = false;
    bf16_t* P; float* G;
    __device__ __forceinline__ void operator()(const f32x4 (&acc)[2][2][4][2], const Unit& u, int wr, int wc, int fr, int fq) const {
        const int row0 = u.pm * BM + wr * 64 + fr;
        if (u.pn < 104) {
            const int col0 = u.pn * BM + wc * 32 + 8 * fq;
#pragma unroll
            for (int ai = 0; ai < 2; ++ai)
#pragma unroll
                for (int m = 0; m < 4; ++m) { bf16_t* rowp = P + (size_t)(row0 + ai * HALF + m * 16) * P_LD + col0;
#pragma unroll
                    for (int bj = 0; bj < 2; ++bj) { const f32x4 v0 = acc[ai][bj][m][0], v1 = acc[ai][bj][m][1];
                        u32x4 w; w[0] = cvt_pk_bf16(v0[0], v0[1]); w[1] = cvt_pk_bf16(v0[2], v0[3]); w[2] = cvt_pk_bf16(v1[0], v1[1]); w[3] = cvt_pk_bf16(v1[2], v1[3]);
                        *(u32x4*)(rowp + bj * HALF) = w; } }
        } else {
#pragma unroll
            for (int ai = 0; ai < 2; ++ai)
#pragma unroll
                for (int m = 0; m < 4; ++m) { float* rowp = G + (size_t)(row0 + ai * HALF + m * 16) * G_LD + wc * 32 + 8 * fq;
                    *(f32x4*)(rowp) = acc[ai][0][m][0]; *(f32x4*)(rowp + 4) = acc[ai][0][m][1]; }
        }
    }
};
struct EpiOut {
    static constexpr bool PERM = false, AFTER_DRAIN = false;
    float* R; const float* xp; const float* xs;
    __device__ __forceinline__ void operator()(const f32x4 (&acc)[2][2][4][2], const Unit& u, int wr, int wc, int fr, int fq) const {
        const int row0 = u.pm * BM + wr * 64 + fr, col0 = u.pn * BM + wc * 32 + 4 * fq;
#pragma unroll
        for (int ai = 0; ai < 2; ++ai)
#pragma unroll
            for (int m = 0; m < 4; ++m) { const int r = row0 + ai * HALF + m * 16;
                { const float* xr = xp + (size_t)r * DM; float* rr = R + (size_t)r * DM;
#pragma unroll
                    for (int bj = 0; bj < 2; ++bj)
#pragma unroll
                        for (int n = 0; n < 2; ++n) { const int c = col0 + bj * HALF + n * 16; const f32x4 xv = *(const f32x4*)(xr + c); *(f32x4*)(rr + c) = acc[ai][bj][m][n] + ALPHA * xv; } } }
    }
};

template <class Epi, class Sched, bool ALIGN_EPI = false, bool SP2 = false>
__device__ __forceinline__ void gemm_phase(LAS unsigned char* lds, const Gemm g, const Sched& S, const Epi& E) {
    const int tid = threadIdx.x, wid = __builtin_amdgcn_readfirstlane(tid >> 6), lane = tid & 63, wr = wid >> 2, wc = wid & 3, fr = lane & 15, fq = lane >> 4;
    const int K = g.K, nt = K / BK;
    unsigned voffA[2], voffB[2];
#pragma unroll
    for (int i = 0; i < 2; ++i) { voffA[i] = (unsigned)(tid * 16 + i * 8192); voffB[i] = voffA[i]; }
    const size_t kstep = (size_t)(HTB);
    const size_t hstep = (size_t)HALF * K * 2;
    const size_t tstep = 2 * hstep;
    const unsigned ldsw = (unsigned)wid * 1024u;
    const int aoff = lds_byte(wr * 64 + fr, fq * 8), boff = lds_byte(wc * 32 + fr, fq * 8);
#define PG8_SA(b, h) (((b) * 2 + (h)) * HTB)
#define PG8_SB(b, h) ((4 + (b) * 2 + (h)) * HTB)
#define PG8_STAGE(bufoff, gbase, voff) do { _Pragma("unroll") for (int _i = 0; _i < 2; ++_i) \
        __builtin_amdgcn_global_load_lds((const unsigned*)((const char*)(gbase) + (voff)[_i]), (LAS unsigned*)(lds + (bufoff) + ldsw + _i * 8192), 16, 0, 0); } while (0)
#define PG8_LDA(dst, b, h) do { _Pragma("unroll") for (int m = 0; m < 4; ++m) _Pragma("unroll") for (int k = 0; k < 2; ++k) dst[m][k] = *(const LAS bf16x8*)(lds + PG8_SA(b, h) + aoff + m * 2048 + k * 1024); } while (0)
#define PG8_LDB(dst, b, h) do { _Pragma("unroll") for (int n = 0; n < 2; ++n) _Pragma("unroll") for (int k = 0; k < 2; ++k) dst[n][k] = *(const LAS bf16x8*)(lds + PG8_SB(b, h) + boff + n * 2048 + k * 1024); } while (0)
#define PG8_MMA(ai, bj, At, Bt) do { __builtin_amdgcn_s_setprio(1); _Pragma("unroll") for (int m = 0; m < 4; ++m) _Pragma("unroll") for (int n = 0; n < 2; ++n) _Pragma("unroll") for (int k = 0; k < 2; ++k) \
        acc[ai][bj][m][n] = __builtin_amdgcn_mfma_f32_16x16x32_bf16(Bt[n][k], At[m][k], acc[ai][bj][m][n], 0, 0, 0); __builtin_amdgcn_s_setprio(0); } while (0)
#define PG8_WAIT_V(n) asm volatile("s_waitcnt vmcnt(" #n ")" ::: "memory")
#define PG8_WAIT_L(n) asm volatile("s_waitcnt lgkmcnt(" #n ")" ::: "memory")
#define PG8_BAR __builtin_amdgcn_s_barrier()
#define PG8_SCHED __builtin_amdgcn_sched_barrier(0)
    Unit cur, nxt; int ui = 0;
    if (!S.next(0, cur)) return;
    f32x4 acc[2][2][4][2];
#pragma unroll
    for (int a = 0; a < 2; ++a)
#pragma unroll
        for (int b = 0; b < 2; ++b)
#pragma unroll
            for (int m = 0; m < 4; ++m)
#pragma unroll
                for (int n = 0; n < 2; ++n) acc[a][b][m][n] = (f32x4){0.f, 0.f, 0.f, 0.f};
    bf16x8 At[4][2], B0[2][2], B1[2][2];
    const char* cA = (const char*)g.A + (size_t)cur.pm * tstep; const char* cB = (const char*)g.Bt + (size_t)cur.pn * tstep;
    S.a_ready(cur);
    if constexpr (SP2) {
        PG8_STAGE(PG8_SB(0, 0), cB, voffB); PG8_STAGE(PG8_SB(0, 1), cB + hstep, voffB); PG8_STAGE(PG8_SA(0, 0), cA, voffA); PG8_STAGE(PG8_SA(0, 1), cA + hstep, voffA);
        if (wr == 1) PG8_BAR;
        PG8_WAIT_V(2); PG8_BAR;
        PG8_STAGE(PG8_SB(1, 0), cB + kstep, voffB); PG8_STAGE(PG8_SA(1, 0), cA + kstep, voffA); PG8_STAGE(PG8_SB(1, 1), cB + hstep + kstep, voffB);
        PG8_WAIT_V(6); PG8_BAR;
    } else {
        PG8_STAGE(PG8_SB(0, 0), cB, voffB); PG8_STAGE(PG8_SA(0, 0), cA, voffA); PG8_STAGE(PG8_SB(0, 1), cB + hstep, voffB); PG8_STAGE(PG8_SA(0, 1), cA + hstep, voffA);
        if (wr == 1) PG8_BAR;
        PG8_WAIT_V(4); PG8_BAR;
        PG8_STAGE(PG8_SB(1, 0), cB + kstep, voffB); PG8_STAGE(PG8_SA(1, 0), cA + kstep, voffA); PG8_STAGE(PG8_SB(1, 1), cB + hstep + kstep, voffB);
        PG8_WAIT_V(6); PG8_BAR;
    }
    for (;;) {
        const bool has_next = S.next(ui + 1, nxt);
        const char* nA = has_next ? (const char*)g.A + (size_t)nxt.pm * tstep : cA; const char* nB = has_next ? (const char*)g.Bt + (size_t)nxt.pn * tstep : cB;
        for (int t = 0; t < nt; t += 2) {
            const bool last = (t == nt - 2);
            const char* a1 = cA + (size_t)(t + 1) * kstep;
            const char* a2 = last ? nA : cA + (size_t)(t + 2) * kstep; const char* b2 = last ? nB : cB + (size_t)(t + 2) * kstep;
            const char* a3 = a2 + kstep; const char* b3 = b2 + kstep;
            if (last && has_next) S.a_ready(nxt);
            if constexpr (SP2) {
            PG8_LDB(B0, 0, 0); PG8_LDB(B1, 0, 1); PG8_SCHED; PG8_LDA(At, 0, 0); PG8_STAGE(PG8_SA(1, 1), a1 + hstep, voffA);
            PG8_WAIT_V(8); PG8_WAIT_L(0); PG8_BAR; PG8_MMA(0, 0, At, B0); PG8_MMA(0, 1, At, B1); PG8_BAR; PG8_SCHED;
            PG8_LDA(At, 0, 1); PG8_STAGE(PG8_SB(0, 0), b2, voffB); PG8_STAGE(PG8_SB(0, 1), b2 + hstep, voffB); PG8_STAGE(PG8_SA(0, 0), a2, voffA);
            PG8_WAIT_V(8); PG8_WAIT_L(0); PG8_BAR; PG8_MMA(1, 0, At, B0); PG8_MMA(1, 1, At, B1); PG8_BAR; PG8_SCHED;
            PG8_LDB(B0, 1, 0); PG8_LDB(B1, 1, 1); PG8_SCHED; PG8_LDA(At, 1, 0); PG8_STAGE(PG8_SA(0, 1), a2 + hstep, voffA);
            PG8_WAIT_V(8); PG8_WAIT_L(0); PG8_BAR; PG8_MMA(0, 0, At, B0); PG8_MMA(0, 1, At, B1); PG8_BAR; PG8_SCHED;
            PG8_LDA(At, 1, 1); PG8_STAGE(PG8_SB(1, 0), b3, voffB); PG8_STAGE(PG8_SB(1, 1), b3 + hstep, voffB); PG8_STAGE(PG8_SA(1, 0), a3, voffA);
            PG8_WAIT_V(8); PG8_WAIT_L(0); PG8_BAR; PG8_MMA(1, 0, At, B0); PG8_MMA(1, 1, At, B1); PG8_BAR; PG8_SCHED;
            } else {
            PG8_LDB(B0, 0, 0); PG8_SCHED; PG8_LDA(At, 0, 0); PG8_STAGE(PG8_SA(1, 1), a1 + hstep, voffA);
            PG8_WAIT_L(8); PG8_BAR; PG8_WAIT_L(0); PG8_MMA(0, 0, At, B0); PG8_BAR; PG8_SCHED;
            PG8_LDB(B1, 0, 1); PG8_STAGE(PG8_SB(0, 0), b2, voffB);
            PG8_BAR; PG8_WAIT_L(0); PG8_MMA(0, 1, At, B1); PG8_BAR;
            PG8_LDA(At, 0, 1); PG8_STAGE(PG8_SA(0, 0), a2, voffA);
            PG8_BAR; PG8_WAIT_L(0); PG8_MMA(1, 0, At, B0); PG8_BAR; PG8_SCHED;
            PG8_STAGE(PG8_SB(0, 1), b2 + hstep, voffB);
            PG8_WAIT_V(6); PG8_BAR; PG8_MMA(1, 1, At, B1); PG8_BAR;
            PG8_LDB(B0, 1, 0); PG8_SCHED; PG8_LDA(At, 1, 0); PG8_STAGE(PG8_SA(0, 1), a2 + hstep, voffA);
            PG8_WAIT_L(8); PG8_BAR; PG8_WAIT_L(0); PG8_MMA(0, 0, At, B0); PG8_BAR; PG8_SCHED;
            PG8_LDB(B1, 1, 1); PG8_STAGE(PG8_SB(1, 0), b3, voffB);
            PG8_BAR; PG8_WAIT_L(0); PG8_MMA(0, 1, At, B1); PG8_BAR;
            PG8_LDA(At, 1, 1); PG8_STAGE(PG8_SA(1, 0), a3, voffA);
            PG8_BAR; PG8_WAIT_L(0); PG8_MMA(1, 0, At, B0); PG8_BAR; PG8_SCHED;
            PG8_STAGE(PG8_SB(1, 1), b3 + hstep, voffB);
            PG8_WAIT_V(6); PG8_BAR; PG8_MMA(1, 1, At, B1); PG8_BAR;
            }
        }
        if constexpr (ALIGN_EPI) { if (wr == 0) PG8_BAR; }
        if constexpr (!Epi::AFTER_DRAIN) { E(acc, cur, wr, wc, fr, fq); S.done(cur); }
        if (!has_next) break;
#pragma unroll
        for (int a = 0; a < 2; ++a)
#pragma unroll
            for (int b = 0; b < 2; ++b)
#pragma unroll
                for (int m = 0; m < 4; ++m)
#pragma unroll
                    for (int n = 0; n < 2; ++n) acc[a][b][m][n] = (f32x4){0.f, 0.f, 0.f, 0.f};
        cur = nxt; cA = nA; cB = nB; ++ui;
        if constexpr (ALIGN_EPI) { if (wr == 1) PG8_BAR; }
    }
    PG8_WAIT_V(0);
    if constexpr (!ALIGN_EPI) { if (wr == 0) PG8_BAR; }
    PG8_BAR;
#undef PG8_SA
#undef PG8_SB
#undef PG8_STAGE
#undef PG8_LDA
#undef PG8_LDB
#undef PG8_MMA
#undef PG8_WAIT_V
#undef PG8_WAIT_L
#undef PG8_BAR
#undef PG8_SCHED
}
}

__device__ __forceinline__ f32x4 gload_nt_asm(const float* p) { f32x4 v; asm volatile("global_load_dwordx4 %0, %1, off nt" : "=v"(v) : "v"(p) : "memory"); return v; }
template <bool REMAP, bool PERM, bool SC1>
__device__ __forceinline__ void tconv_range(const float* __restrict__ src, int ldsrc, bf16_t* __restrict__ dst, int dst_bytes, int K, int t_first, int t_end, int t_stride, LAS unsigned char* lds) {
    constexpr int GT = 4;
    LAS unsigned* T = (LAS unsigned*)lds;
    const int tid = threadIdx.x, nkt = K / 128;
    const __amdgpu_buffer_rsrc_t rs = __builtin_amdgcn_make_buffer_rsrc((void*)dst, 0, dst_bytes, 0x00020000);
    f32x4 ra[GT][4], rb[GT][4];
#define TC_LOAD(tile_, v_) do { const int tl_ = (tile_) < t_end ? (tile_) : (t_end - 1); const int nt_ = tl_ / nkt, kt_ = tl_ - nt_ * nkt, n0_ = nt_ * 64, k0_ = kt_ * 128; int on0_ = n0_; \
        if (REMAP) { if (n0_ < 10240) on0_ = n0_; else if (n0_ < 26624) on0_ = n0_ + 64; else if (n0_ < 26688) on0_ = n0_ - 26624 + 10240; else if (n0_ < 26752) on0_ = n0_; else on0_ = 0; } \
        _Pragma("unroll") for (int i_ = 0; i_ < 2; ++i_) { const int rp_ = (tid >> 4) + 32 * i_, c4_ = tid & 15; const float* s_ = src + (size_t)(k0_ + 2 * rp_) * ldsrc + on0_ + c4_ * 4; \
            v_[2 * i_] = gload_nt_asm(s_); v_[2 * i_ + 1] = gload_nt_asm(s_ + ldsrc); } } while (0)
#define TC_LOADG(tile0_, set_) do { _Pragma("unroll") for (int u_ = 0; u_ < GT; ++u_) TC_LOAD((tile0_) + u_ * t_stride, set_[u_]); } while (0)
#define TC_WAIT(n_, set_) asm volatile("s_waitcnt vmcnt(" #n_ ")" : "+v"(set_[0][0]), "+v"(set_[0][1]), "+v"(set_[0][2]), "+v"(set_[0][3]), "+v"(set_[1][0]), "+v"(set_[1][1]), "+v"(set_[1][2]), "+v"(set_[1][3]), \
        "+v"(set_[2][0]), "+v"(set_[2][1]), "+v"(set_[2][2]), "+v"(set_[2][3]), "+v"(set_[3][0]), "+v"(set_[3][1]), "+v"(set_[3][2]), "+v"(set_[3][3]) :: "memory")
#define TC_PROC(tile0_, set_) do { _Pragma("unroll") for (int u = 0; u < GT; ++u) { const int tile = (tile0_) + u * t_stride; \
        if (tile < t_end) { const int nt = tile / nkt, kt = tile - nt * nkt, n0 = nt * 64, k0 = kt * 128; const bool zero = REMAP && n0 >= 26752; \
            _Pragma("unroll") for (int i = 0; i < 2; ++i) { const int rp = (tid >> 4) + 32 * i, c4 = tid & 15; \
                _Pragma("unroll") for (int j = 0; j < 4; ++j) T[(c4 * 4 + j) * 65 + rp] = zero ? 0u : cvt_pk_bf16(set_[u][2 * i][j], set_[u][2 * i + 1][j]); } \
            __syncthreads(); \
            _Pragma("unroll") for (int i = 0; i < 2; ++i) { const int n = (tid >> 4) + 32 * i, kc = tid & 15; \
                u32x4 v; v[0] = T[n * 65 + kc * 4]; v[1] = T[n * 65 + kc * 4 + 1]; v[2] = T[n * 65 + kc * 4 + 2]; v[3] = T[n * 65 + kc * 4 + 3]; \
                int nn = n0 + n; if (PERM) { const int x = nn & 31; nn = (nn & ~31) + 16 * ((x >> 2) & 1) + 4 * (x >> 3) + (x & 3); } \
                const size_t off = tiled_off(nn, k0 + kc * 8, K); \
                if (SC1) __builtin_amdgcn_raw_buffer_store_b128(v, rs, (int)(off * 2), 0, 16); else *(u32x4*)(dst + off) = v; } \
            __syncthreads(); } } } while (0)
    const int gstep = GT * t_stride;
    TC_LOADG(t_first, ra);
    for (int tile0 = t_first; tile0 < t_end; tile0 += 2 * gstep) {
        TC_LOADG(tile0 + gstep, rb);
        TC_WAIT(16, ra);
        TC_PROC(tile0, ra);
        TC_LOADG(tile0 + 2 * gstep, ra);
        TC_WAIT(16, rb);
        TC_PROC(tile0 + gstep, rb);
    }
    TC_WAIT(0, ra);
#undef TC_LOAD
#undef TC_LOADG
#undef TC_WAIT
#undef TC_PROC
}
__device__ __forceinline__ void phase_convert(const Params& p, LAS unsigned char* lds) {
    bf16_t* Xb = (bf16_t*)(p.ws + OFF_XB);
    const size_t n8 = (size_t)MPAD * DM / 8;
    for (size_t i = (size_t)blockIdx.x * 512 + threadIdx.x; i < n8; i += (size_t)gridDim.x * 512) {
        const size_t e = i * 8; const int row = (int)(e / DM);
        f32x4 a = (f32x4){0.f, 0.f, 0.f, 0.f}, b = a;
        if (row < NTP) { a = __builtin_nontemporal_load((const f32x4*)(p.x_prompt + e)); b = __builtin_nontemporal_load((const f32x4*)(p.x_prompt + e + 4)); }
        else if (row < NTOK) { const size_t e2 = e - (size_t)NTP * DM; a = *(const f32x4*)(p.x_sample + e2); b = *(const f32x4*)(p.x_sample + e2 + 4); }
        u32x4 o; o[0] = cvt_pk_bf16(a[0], a[1]); o[1] = cvt_pk_bf16(a[2], a[3]); o[2] = cvt_pk_bf16(b[0], b[1]); o[3] = cvt_pk_bf16(b[2], b[3]);
        *(u32x4*)(Xb + tiled_off(row, (int)(e - (size_t)row * DM), DM)) = o;
    }
    { u32x4* mz = (u32x4*)((bf16_t*)(p.ws + OFF_MIX) + (size_t)NTOK * MIXW); const size_t nz = (size_t)(MPAD - NTOK) * MIXW / 8;
      for (size_t i = (size_t)blockIdx.x * 512 + threadIdx.x; i < nz; i += (size_t)gridDim.x * 512) mz[i] = (u32x4){0u, 0u, 0u, 0u}; }
    tconv_range<true, true, false>(p.w_in, NPROJ, (bf16_t*)(p.ws + OFF_WB), NPAD * DM * 2, DM, (int)blockIdx.x, WIN_TILES, (int)gridDim.x, lds);
}

constexpr int N_GDN_P = 128, N_SSD_P = 128, N_WOUT = 0, N_GDN_S = 2048, N_SSD_S = 1024, N_ITEMS = N_GDN_P + N_SSD_P + N_WOUT + N_GDN_S + N_SSD_S;
constexpr int GO_LD = 132;
constexpr size_t SF_SXA = 0;
constexpr size_t SF_GQ  = SF_SXA + (size_t)NTS * 6144;
constexpr size_t SF_SDT = SF_GQ + (size_t)NTS * 12288;
constexpr size_t SF_SEA = SF_SDT + (size_t)NTS * 64;
constexpr size_t SF_GB  = SF_SEA + (size_t)NTS * 64;
constexpr size_t SF_GEG = SF_GB + (size_t)NTS * 32;
constexpr size_t SF_GO  = SF_GEG + (size_t)NTS * 32;
constexpr size_t SF_END = SF_GO + (size_t)NTS * 4096;

__device__ __forceinline__ void phase_sample_front(const Params& p) {
    const bf16_t* P = (const bf16_t*)(p.ws + OFF_P); const float* G = (const float*)(p.ws + OFF_G32); float* SF = (float*)(p.ws + OFF_SF);
    const int tid = threadIdx.x, lane = tid & 63;
    for (int item = blockIdx.x; item < NTS * 4; item += gridDim.x) {
        const int tok = item >> 2, sec = item & 3; const size_t row = (size_t)(NTP + tok);
        if (sec == 0) {
#pragma unroll 1
            for (int i = 0; i < 3; ++i) { const int ch = (tid + i * 512) * 4;
                f32x4 a = *(const f32x4*)(p.ssd_conv_b + ch);
#pragma unroll
                for (int j = 0; j < 4; ++j) { const f32x4 wv = *(const f32x4*)(p.ssd_conv_w + j * 6144 + ch);
                    const f32x4 rv = j < 3 ? *(const f32x4*)(p.state_ssd_conv + ((size_t)tok * 3 + j) * 6144 + ch) : ldbf4(P + row * P_LD + C_XBC + ch);
                    if (j >= 1) *(f32x4*)(p.out + O_SSDC_S + ((size_t)tok * 3 + (j - 1)) * 6144 + ch) = rv;
                    a += wv * rv; }
                *(f32x4*)(SF + SF_SXA + (size_t)tok * 6144 + ch) = (f32x4){silu_f(a[0]), silu_f(a[1]), silu_f(a[2]), silu_f(a[3])}; }
            if (tid < 64) { const float dt = softplus_f(G[row * G_LD + tid] + p.ssd_dt_bias[tid]); SF[SF_SDT + tok * 64 + tid] = dt; SF[SF_SEA + tok * 64 + tid] = expf(-expf(p.ssd_a_log[tid]) * dt); }
        } else {
            const int gs = sec - 1;
#pragma unroll 1
            for (int i = 0; i < 2; ++i) { const int cl = (tid + i * 512) * 4, ch = gs * 4096 + cl;
                f32x4 a = (f32x4){0.f, 0.f, 0.f, 0.f};
#pragma unroll
                for (int j = 0; j < 4; ++j) { const f32x4 wv = *(const f32x4*)(p.gdn_conv_w + j * 12288 + ch);
                    const f32x4 rv = j < 3 ? *(const f32x4*)(p.state_gdn_conv + ((size_t)tok * 3 + j) * 12288 + ch) : ldbf4(P + row * P_LD + C_QKV + ch);
                    if (j >= 1) *(f32x4*)(p.out + O_GDNC_S + ((size_t)tok * 3 + (j - 1)) * 12288 + ch) = rv;
                    a += wv * rv; }
                f32x4 o = (f32x4){silu_f(a[0]), silu_f(a[1]), silu_f(a[2]), silu_f(a[3])};
                if (gs < 2) {
                    float ss = o[0] * o[0] + o[1] * o[1] + o[2] * o[2] + o[3] * o[3];
                    ss += __shfl_xor(ss, 1); ss += __shfl_xor(ss, 2); ss += __shfl_xor(ss, 4); ss += __shfl_xor(ss, 8); ss += __shfl_xor(ss, 16);
                    const float rn = rsqrtf(ss + 1e-6f) * (gs == 0 ? 0.08838834764831845f : 1.f); o = o * rn; }
                *(f32x4*)(SF + SF_GQ + (size_t)tok * 12288 + ch) = o; }
            if (gs == 0 && tid < 32) { const float araw = G[row * G_LD + 96 + tid], braw = G[row * G_LD + 64 + tid];
                SF[SF_GB + tok * 32 + tid] = sigmoid_f(braw); SF[SF_GEG + tok * 32 + tid] = expf(-expf(p.gdn_a_log[tid]) * softplus_f(araw + p.gdn_dt_bias[tid])); }
        }
    }
    (void)lane;
}

__device__ __forceinline__ void ssd_sample_item(const Params& p, const int tok, const int g) {
    const float* SF = (const float*)(p.ws + OFF_SF); const bf16_t* P = (const bf16_t*)(p.ws + OFF_P);
    const int tid = opaque_tid(), w = tid >> 6, lane = tid & 63, half = lane >> 5, nq = lane & 31, h = g * 8 + w;
    const f32x4 B4 = *(const f32x4*)(SF + SF_SXA + (size_t)tok * 6144 + 4096 + g * 128 + nq * 4), C4 = *(const f32x4*)(SF + SF_SXA + (size_t)tok * 6144 + 5120 + g * 128 + nq * 4);
    const float xs_mine = SF[SF_SXA + (size_t)tok * 6144 + h * 64 + lane], dt = SF[SF_SDT + tok * 64 + h], eA = SF[SF_SEA + tok * 64 + h];
    const float z = bf2f(P[(size_t)(NTP + tok) * P_LD + C_ZS + h * 64 + lane]);
    const float xdt_mine = xs_mine * dt;
    const float* Hin = p.state_ssd + ((size_t)(tok * 64 + h) * 64 + 32 * half) * 128 + nq * 4; float* Hout = p.out + O_SSD_S + ((size_t)(tok * 64 + h) * 64 + 32 * half) * 128 + nq * 4;
    float y_mine = 0.f;
    f32x4 buf[2][8];
#pragma unroll
    for (int i = 0; i < 8; ++i) buf[0][i] = *(const f32x4*)(Hin + (size_t)i * 128);
#pragma unroll
    for (int bb = 0; bb < 4; ++bb) {
        if (bb < 3) {
#pragma unroll
            for (int i = 0; i < 8; ++i) buf[(bb + 1) & 1][i] = *(const f32x4*)(Hin + (size_t)((bb + 1) * 8 + i) * 128); }
#pragma unroll
        for (int i = 0; i < 8; ++i) { const int it = bb * 8 + i;
            const float xdt = __shfl(xdt_mine, it + 32 * half);
            const f32x4 hn = eA * buf[bb & 1][i] + xdt * B4;
            *(f32x4*)(Hout + (size_t)it * 128) = hn;
            float y = hn[0] * C4[0] + hn[1] * C4[1] + hn[2] * C4[2] + hn[3] * C4[3];
            y += __shfl_xor(y, 1); y += __shfl_xor(y, 2); y += __shfl_xor(y, 4); y += __shfl_xor(y, 8); y += __shfl_xor(y, 16);
            y_mine = (nq == it) ? y : y_mine; }
    }
    ((bf16_t*)(p.ws + OFF_U32))[(size_t)(NTP + tok) * DM + h * 64 + lane] = f2bf((y_mine + xs_mine * p.ssd_d[h]) * silu_f(z));
}
__device__ __forceinline__ void gdn_sample_item(const Params& p, const int tok, const int hp) {
    const float* SF = (const float*)(p.ws + OFF_SF); float* SFo = (float*)(p.ws + OFF_SF);
    const int tid = opaque_tid(), w = tid >> 6, lane = tid & 63, dg = lane >> 3, e4 = lane & 7, h = hp * 2 + (w >> 2), es = w & 3;
    const float* Sin = p.state_gdn + ((size_t)(tok * 32 + h) * 128 + dg * 16) * 128 + es * 32 + e4 * 4; float* Sout = p.out + O_GDN_S + ((size_t)(tok * 32 + h) * 128 + dg * 16) * 128 + es * 32 + e4 * 4;
    f32x4 S[16];
#pragma unroll
    for (int i = 0; i < 16; ++i) S[i] = *(const f32x4*)(Sin + (size_t)i * 128);
    const float* qp = SF + SF_GQ + (size_t)tok * 12288 + h * 128 + dg * 16; const float* kp = qp + 4096;
    f32x4 q4[4], k4[4];
#pragma unroll
    for (int i = 0; i < 4; ++i) { q4[i] = *(const f32x4*)(qp + 4 * i); k4[i] = *(const f32x4*)(kp + 4 * i); }
    const f32x4 v4 = *(const f32x4*)(SF + SF_GQ + (size_t)tok * 12288 + 8192 + h * 128 + es * 32 + e4 * 4);
    const float beta = SF[SF_GB + tok * 32 + h], eg = SF[SF_GEG + tok * 32 + h];
    f32x4 ks = (f32x4){0.f, 0.f, 0.f, 0.f};
#pragma unroll
    for (int i = 0; i < 16; ++i) ks += k4[i >> 2][i & 3] * S[i];
#pragma unroll
    for (int c = 0; c < 4; ++c) { ks[c] += __shfl_xor(ks[c], 8); ks[c] += __shfl_xor(ks[c], 16); ks[c] += __shfl_xor(ks[c], 32); }
    const f32x4 vn = beta * (v4 - eg * ks);
    f32x4 o = (f32x4){0.f, 0.f, 0.f, 0.f};
#pragma unroll
    for (int i = 0; i < 16; ++i) { S[i] = eg * S[i] + k4[i >> 2][i & 3] * vn; *(f32x4*)(Sout + (size_t)i * 128) = S[i]; o += q4[i >> 2][i & 3] * S[i]; }
#pragma unroll
    for (int c = 0; c < 4; ++c) { o[c] += __shfl_xor(o[c], 8); o[c] += __shfl_xor(o[c], 16); o[c] += __shfl_xor(o[c], 32); }
    if (dg == 0) *(f32x4*)(SFo + SF_GO + (size_t)tok * 4096 + h * 128 + es * 32 + e4 * 4) = o;
}

typedef __bf16 bf16x2_t __attribute__((ext_vector_type(2)));
typedef short bf16x4 __attribute__((ext_vector_type(4)));
__device__ __forceinline__ unsigned pk_bf16(float lo, float hi) { const f32x2v v = {lo, hi}; return __builtin_bit_cast(unsigned, __builtin_convertvector(v, bf16x2_t)); }
__device__ __forceinline__ bf16x8 pack2(const f32x4 lo, const f32x4 hi) { u32x4 r; r[0] = pk_bf16(lo[0], lo[1]); r[1] = pk_bf16(lo[2], lo[3]); r[2] = pk_bf16(hi[0], hi[1]); r[3] = pk_bf16(hi[2], hi[3]); return __builtin_bit_cast(bf16x8, r); }
__device__ __forceinline__ bf16x8 ld_perm(const LAS bf16_t* rowp, int q) { const u32x2 a = *(const LAS u32x2*)(rowp + 4 * q), b = *(const LAS u32x2*)(rowp + 16 + 4 * q); u32x4 r; r[0] = a[0]; r[1] = a[1]; r[2] = b[0]; r[3] = b[1]; return __builtin_bit_cast(bf16x8, r); }
__device__ __forceinline__ bf16x8 ld_nat(const LAS bf16_t* rowp, int q) { return *(const LAS bf16x8*)(rowp + 8 * q); }
#define MFMA16(a, b, c) __builtin_amdgcn_mfma_f32_16x16x32_bf16((a), (b), (c), 0, 0, 0)

#define BAR_LDS() do { asm volatile("s_waitcnt lgkmcnt(0)" ::: "memory"); __builtin_amdgcn_s_barrier(); asm volatile("" ::: "memory"); } while (0)
#define WAIT_VM0() asm volatile("s_waitcnt vmcnt(0)" ::: "memory")
#define LDP(base, off) __builtin_bit_cast(bf16x8, (u32x4){(*(const LAS u32x2*)((base) + (off)))[0], (*(const LAS u32x2*)((base) + (off)))[1], (*(const LAS u32x2*)((base) + (off) + 16))[0], (*(const LAS u32x2*)((base) + (off) + 16))[1]})
__device__ __forceinline__ float blo(unsigned v) { return __uint_as_float(v << 16); }
__device__ __forceinline__ float bhi(unsigned v) { return __uint_as_float(v & 0xffff0000u); }
__device__ __forceinline__ int kperm(int c) { return (c & ~31) | (((c >> 2) & 3) << 3) | (((c >> 4) & 1) << 2) | (c & 3); }
#define LDQ(base, off) (*(const LAS bf16x8*)((base) + (off)))
__device__ __forceinline__ void dma_raw(LAS unsigned char* lds_raw, const bf16_t* P, const bf16_t* zsrc, const size_t rowbase, const int t0, const int c0, const int c1, const int c2, const int w, const int lane) {
#pragma unroll
    for (int kk = 0; kk < 7; ++kk) {
        int k = w + 8 * kk; k = k > 50 ? 50 : k;
        int seg = 4 * k + (lane >> 4); seg = seg > 200 ? 200 : seg;
        const int row = seg / 3, sec = seg - row * 3, tt = t0 - 3 + row;
        const bf16_t* src = tt >= 0 ? P + (rowbase + tt) * P_LD + (sec == 0 ? c0 : (sec == 1 ? c1 : c2)) : zsrc;
        __builtin_amdgcn_global_load_lds((const unsigned*)(src + (lane & 15) * 8), (LAS unsigned*)(lds_raw + k * 1024), 16, 0, 0);
    }
}
__device__ __forceinline__ void dma_offsets(unsigned (&doff)[7], const int c0, const int c1, const int c2, const int w, const int lane) {
#pragma unroll
    for (int kk = 0; kk < 7; ++kk) { int k = w + 8 * kk; k = k > 50 ? 50 : k; int seg = 4 * k + (lane >> 4); seg = seg > 200 ? 200 : seg; const int row = seg / 3, sec = seg - row * 3;
        doff[kk] = (unsigned)((row * P_LD + (sec == 0 ? c0 : (sec == 1 ? c1 : c2)) + (lane & 15) * 8) * 2); }
}
__device__ __forceinline__ void dma_fast(LAS unsigned char* lds_raw, const char* base, const unsigned (&doff)[7], const int w) {
#pragma unroll
    for (int kk = 0; kk < 7; ++kk) { int k = w + 8 * kk; k = k > 50 ? 50 : k;
        __builtin_amdgcn_global_load_lds((const unsigned*)(base + doff[kk]), (LAS unsigned*)(lds_raw + k * 1024), 16, 0, 0); }
}
__device__ __forceinline__ float reduce16(float (&v)[16], const int lane) {
#pragma unroll
    for (int i = 0; i < 8; ++i) { const bool up = (lane & 32) != 0; const float send = up ? v[i] : v[i + 8], keep = up ? v[i + 8] : v[i]; v[i] = keep + __shfl_xor(send, 32); }
#pragma unroll
    for (int i = 0; i < 4; ++i) { const bool up = (lane & 16) != 0; const float send = up ? v[i] : v[i + 4], keep = up ? v[i + 4] : v[i]; v[i] = keep + __shfl_xor(send, 16); }
#pragma unroll
    for (int i = 0; i < 2; ++i) { const bool up = (lane & 8) != 0; const float send = up ? v[i] : v[i + 2], keep = up ? v[i + 2] : v[i]; v[i] = keep + __shfl_xor(send, 8); }
    { const bool up = (lane & 4) != 0; const float send = up ? v[0] : v[1], keep = up ? v[1] : v[0]; v[0] = keep + __shfl_xor(send, 4); }
    v[0] += __shfl_xor(v[0], 2); v[0] += __shfl_xor(v[0], 1);
    return v[0];
}

constexpr int GL_RAW = 0, GL_QA = 52224, GL_KA = 69632, GL_OB = GL_KA  , GL_KAT = 87040, GL_WL = 105472, GL_AB = 122880, GL_QK = 132096,
              GL_ADT = 141312, GL_TF = 145408, GL_TOK = 147456, GL_SSQ = 148480, GL_LAST = 148992, GL_WTS = 149056, GL_TOK2 = 155200, GL_NW = 156224;
__device__ __forceinline__ void gdn_chunk_item(const Params& p, LAS unsigned char* lds, const int b, const int h) {
    const bf16_t* P = (const bf16_t*)(p.ws + OFF_P); const float* G = (const float*)(p.ws + OFF_G32); bf16_t* MIX = (bf16_t*)(p.ws + OFF_MIX);
    const bf16_t* zsrc = (const bf16_t*)(p.ws + OFF_XB) + (size_t)NTOK * DM;
    const size_t rowbase = (size_t)b * 2048;
    const float Aneg = -expf(p.gdn_a_log[h]), dtb = p.gdn_dt_bias[h];
    const int c0 = C_QKV + h * 128, c1 = C_QKV + 4096 + h * 128, c2 = C_QKV + 8192 + h * 128;
    f32x4 Sacc[8];
#pragma unroll
    for (int j = 0; j < 8; ++j) Sacc[j] = (f32x4){0.f, 0.f, 0.f, 0.f};
    float g_araw = 0.f, g_braw = 0.f;
    unsigned doff[7];
    {
        const int tid = opaque_tid(), lane = tid & 63, w = __builtin_amdgcn_readfirstlane(tid >> 6);
        dma_offsets(doff, c0, c1, c2, w, lane);
        for (int i = tid; i < (9216 * 2) / 4; i += 512) ((LAS unsigned*)(lds + GL_AB))[i] = 0u;
        for (int i = tid; i < 1536; i += 512) { const int j = i / 384, cc = i - j * 384; ((LAS float*)(lds + GL_WTS))[i] = p.gdn_conv_w[j * 12288 + (cc >> 7) * 4096 + h * 128 + (cc & 127)]; }
        if (tid < 128) ((LAS float*)(lds + GL_NW))[tid] = p.gdn_norm_w[tid];
        if (w == 0) { g_araw = G[(rowbase + lane) * G_LD + 96 + h]; g_braw = G[(rowbase + lane) * G_LD + 64 + h]; }
        asm volatile("" : "+v"(g_araw), "+v"(g_braw));
        dma_raw(lds + GL_RAW, P, zsrc, rowbase, 0, c0, c1, c2, w, lane);
    }
#pragma unroll 1
    for (int c = 0; c < 32; ++c) {
        const int t0 = c * 64;
        if (c == 0) WAIT_VM0(); else asm volatile("s_waitcnt vmcnt(2)" ::: "memory");
        BAR_LDS();
        {
            const int tid = opaque_tid(), lane = tid & 63, w = tid >> 6;
            const LAS unsigned char* rawl = lds + GL_RAW + (8 * w) * 768 + lane * 4; const LAS float* wts = (const LAS float*)(lds + GL_WTS) + 2 * lane;
            float ssv[16];
#pragma unroll
            for (int sec = 0; sec < 2; ++sec) {
                f32x2v wj[4];
#pragma unroll
                for (int j = 0; j < 4; ++j) wj[j] = *(const LAS f32x2v*)(wts + j * 384 + sec * 128);
                float x0[11], x1[11];
#pragma unroll
                for (int rr = 0; rr < 11; ++rr) { const unsigned u = *(const LAS unsigned*)(rawl + rr * 768 + sec * 256); x0[rr] = blo(u); x1[rr] = bhi(u); }
                unsigned pk[8];
#pragma unroll
                for (int t = 0; t < 8; ++t) {
                    const float a0 = silu_f(wj[0][0] * x0[t] + wj[1][0] * x0[t + 1] + wj[2][0] * x0[t + 2] + wj[3][0] * x0[t + 3]);
                    const float a1 = silu_f(wj[0][1] * x1[t] + wj[1][1] * x1[t + 1] + wj[2][1] * x1[t + 2] + wj[3][1] * x1[t + 3]);
                    ssv[2 * t + sec] = a0 * a0 + a1 * a1; pk[t] = pk_bf16(a0, a1);
                    *(LAS unsigned*)(lds + (sec == 0 ? GL_QA : GL_KA) + ((8 * w + t) * 136 + kperm(2 * lane)) * 2) = pk[t];
                }
                if (sec == 1) {
                    u32x4 ke, ko;
#pragma unroll
                    for (int t2 = 0; t2 < 4; ++t2) { ke[t2] = (pk[2 * t2] & 0xffffu) | (pk[2 * t2 + 1] << 16); ko[t2] = (pk[2 * t2] >> 16) | (pk[2 * t2 + 1] & 0xffff0000u); }
                    const int tp = kperm(8 * w);
                    LAS unsigned char* k0 = lds + GL_KAT + ((2 * lane) * 72 + tp) * 2; LAS unsigned char* k1 = k0 + 144;
                    *(LAS u32x2*)k0 = (u32x2){ke[0], ke[1]}; *(LAS u32x2*)(k0 + 16) = (u32x2){ke[2], ke[3]}; *(LAS u32x2*)k1 = (u32x2){ko[0], ko[1]}; *(LAS u32x2*)(k1 + 16) = (u32x2){ko[2], ko[3]};
                }
            }
            const float tot = reduce16(ssv, lane);
            if ((lane & 3) == 0) ((LAS float*)(lds + GL_SSQ))[16 * w + (lane >> 2)] = tot;
            if (c == 31 && w == 7) {
                float* convout = p.out + O_GDNC_P + (size_t)b * 3 * 12288 + h * 128 + 2 * lane;
#pragma unroll
                for (int j = 0; j < 3; ++j)
#pragma unroll
                    for (int sec = 0; sec < 3; ++sec) { const unsigned u = *(const LAS unsigned*)(lds + GL_RAW + ((64 + j) * 3 + sec) * 256 + lane * 4); *(f32x2v*)(convout + j * 12288 + sec * 4096) = (f32x2v){blo(u), bhi(u)}; }
            }
        }
        BAR_LDS();
        u32x4 zreg[2];
        {
            const int tid = opaque_tid(), lane = tid & 63;
#pragma unroll
            for (int it = 0; it < 2; ++it) { const int idx = tid + it * 512; zreg[it] = *(const u32x4*)(P + (rowbase + t0 + (idx >> 4)) * P_LD + C_ZG + h * 128 + (idx & 15) * 8); }
        }
        f32x4 rawt[3]; int jb[3];
        {
            const int tid = opaque_tid(), w = __builtin_amdgcn_readfirstlane(tid >> 6), lane = tid & 63, r = lane & 15, q = lane >> 4;
#define OJ(i_) ((i_) < 6 ? ((i_) + 1 + ((i_) >= 1 ? 1 : 0) + ((i_) >= 3 ? 1 : 0)) : (4 + (i_)))
            if (w < 4) { jb[0] = (w * (w + 3)) / 2; jb[1] = w == 0 ? -1 : OJ(w == 3 ? 2 : w - 1); jb[2] = w == 3 ? OJ(3) : -1; }
            else { const int b0 = 4 + 3 * (w - 4); jb[0] = OJ(b0); jb[1] = OJ(b0 + 1); jb[2] = OJ(b0 + 2); }
#undef OJ
            if (w == 0) {
                const LAS float* ssq = (const LAS float*)(lds + GL_SSQ);
                float cs = Aneg * softplus_f(g_araw + dtb); const float beta = sigmoid_f(g_braw);
                if (c < 31) { const size_t row = rowbase + t0 + 64 + lane; g_araw = G[row * G_LD + 96 + h]; g_braw = G[row * G_LD + 64 + h]; }
#pragma unroll
                for (int d = 1; d < 64; d <<= 1) { const float n = __shfl_up(cs, d); if (lane >= d) cs += n; }
                f32x4 tv; tv[0] = rsqrtf(ssq[lane * 2] + 1e-6f) * 0.08838834764831845f; tv[1] = rsqrtf(ssq[lane * 2 + 1] + 1e-6f); tv[2] = beta; tv[3] = cs;
                ((LAS f32x4*)(lds + GL_TOK))[lane] = tv; if (lane == 63) *(LAS float*)(lds + GL_LAST) = cs;
                const float lastv = __shfl(cs, 63), ec = __expf(cs);
                ((LAS f32x2v*)(lds + GL_TOK2))[lane] = (f32x2v){beta, tv[1] * beta * ec};
                ((LAS f32x2v*)(lds + GL_TOK2 + 512))[lane] = (f32x2v){tv[0] * ec, tv[1] * __expf(lastv - cs)};
            }
#pragma unroll
            for (int k = 0; k < 3; ++k) { rawt[k] = (f32x4){0.f, 0.f, 0.f, 0.f};
                if (jb[k] >= 0) { const int job = jb[k], tj = job < 10 ? job : job - 10; const bool isQK = job >= 10;
                    const int ti = tj >= 6 ? 3 : (tj >= 3 ? 2 : (tj >= 1 ? 1 : 0)), si = tj - (ti * (ti + 1)) / 2;
                    const LAS bf16_t* Ab = (const LAS bf16_t*)(lds + (isQK ? GL_QA : GL_KA)) + (ti * 16 + r) * 136 + 8 * q; const LAS bf16_t* Bb = (const LAS bf16_t*)(lds + GL_KA) + (si * 16 + r) * 136 + 8 * q;
                    f32x4 acc = (f32x4){0.f, 0.f, 0.f, 0.f};
#pragma unroll
                    for (int kk = 0; kk < 4; ++kk) acc = MFMA16(*(const LAS bf16x8*)(Ab + kk * 32), *(const LAS bf16x8*)(Bb + kk * 32), acc);
                    rawt[k] = acc; } }
        }
        BAR_LDS();
        {
            const int tid = opaque_tid(), w = __builtin_amdgcn_readfirstlane(tid >> 6), lane = tid & 63, r = lane & 15, q = lane >> 4;
#pragma unroll
            for (int k = 0; k < 3; ++k) { if (jb[k] >= 0) { const int job = jb[k], tj = job < 10 ? job : job - 10; const bool isQK = job >= 10;
                const int ti = tj >= 6 ? 3 : (tj >= 3 ? 2 : (tj >= 1 ? 1 : 0)), si = tj - (ti * (ti + 1)) / 2;
                const f32x4 acc = rawt[k];
                const int s = si * 16 + r; const f32x4 ts = ((const LAS f32x4*)(lds + GL_TOK))[s];
                const LAS f32x4* tq = (const LAS f32x4*)(lds + GL_TOK) + ti * 16 + 4 * q;
                float val[4];
#pragma unroll
                for (int reg = 0; reg < 4; ++reg) { const int t = ti * 16 + 4 * q + reg; const f32x4 tt = tq[reg]; const float dec = __expf(tt[3] - ts[3]);
                    val[reg] = isQK ? (s <= t ? acc[reg] * tt[0] * ts[1] * dec : 0.f) : (s < t ? -(acc[reg] * tt[1] * ts[1] * tt[2] * dec) : 0.f); }
                LAS bf16_t* dst = (LAS bf16_t*)(lds + (isQK ? GL_QK : GL_AB)) + (ti * 16 + 4 * q) * 72 + kperm(s);
                const bool diagKK = (!isQK) && (ti == si);
#pragma unroll
                for (int reg = 0; reg < 4; ++reg) dst[reg * 72] = diagKK ? (bf16_t)0 : (bf16_t)(pk_bf16(val[reg], 0.f) & 0xffffu);
                if (diagKK) *(LAS f32x4*)((LAS float*)(lds + GL_ADT) + (ti * 16 + r) * 16 + 4 * q) = (f32x4){val[0], val[1], val[2], val[3]};
            } }
            if (w < 4) {
                asm volatile("s_waitcnt lgkmcnt(0)" ::: "memory");
                const LAS float* A = (const LAS float*)(lds + GL_ADT) + w * 256;
                float tr[16];
#pragma unroll
                for (int j = 15; j >= 0; --j) { float v = (j == r) ? 1.f : 0.f;
#pragma unroll
                    for (int k = j + 1; k < 16; ++k) v += tr[k] * A[j * 16 + k];
                    tr[j] = v; }
                const float s0 = q == 0 ? tr[0] : (q == 1 ? tr[4] : (q == 2 ? tr[8] : tr[12])), s1 = q == 0 ? tr[1] : (q == 1 ? tr[5] : (q == 2 ? tr[9] : tr[13]));
                const float s2 = q == 0 ? tr[2] : (q == 1 ? tr[6] : (q == 2 ? tr[10] : tr[14])), s3 = q == 0 ? tr[3] : (q == 1 ? tr[7] : (q == 2 ? tr[11] : tr[15]));
                u32x2 tv; tv[0] = pk_bf16(s0, s1); tv[1] = pk_bf16(s2, s3); ((LAS u32x2*)(lds + GL_TF))[w * 64 + lane] = tv;
            }
        }
        BAR_LDS();
        f32x4 U[4];
        {
            const int tid = opaque_tid(), w = tid >> 6, lane = tid & 63, r = lane & 15, q = lane >> 4, E = w * 16 + r;
            const LAS f32x2v* tq = (const LAS f32x2v*)(lds + GL_TOK2) + 4 * q;
            const LAS bf16_t* RvE = (const LAS bf16_t*)(lds + GL_RAW) + ((4 * q) * 3 + 2) * 128 + E; const LAS bf16_t* KaE = (const LAS bf16_t*)(lds + GL_KA) + (4 * q) * 136 + kperm(E);
            const LAS bf16_t* AbR = (const LAS bf16_t*)(lds + GL_AB) + r * 72 + 8 * q;
            const LAS u32x2* TfL = (const LAS u32x2*)(lds + GL_TF) + lane;
            LAS bf16_t* WlE = (LAS bf16_t*)(lds + GL_WL) + (4 * q) * 136 + kperm(E);
            const LAS float* wv = (const LAS float*)(lds + GL_WTS) + 256 + E;
            const float w0 = wv[0], w1 = wv[384], w2 = wv[768], w3 = wv[1152];
            float xr[4][7], ka[4][4]; f32x2v t3[4][4]; bf16x8 af[4]; u32x2 tf[4];
#pragma unroll
            for (int i = 0; i < 4; ++i) {
#pragma unroll
                for (int k = 0; k < 7; ++k) xr[i][k] = bf2f(RvE[(16 * i + k) * 384]);
#pragma unroll
                for (int reg = 0; reg < 4; ++reg) { ka[i][reg] = bf2f(KaE[(16 * i + reg) * 136]); t3[i][reg] = tq[16 * i + reg]; }
                tf[i] = TfL[i * 64];
            }
            af[0] = LDQ(AbR, 16 * 72); af[1] = LDQ(AbR, 32 * 72); af[2] = LDQ(AbR, 48 * 72); af[3] = LDQ(AbR, 48 * 72 + 32);
            __builtin_amdgcn_sched_barrier(0);
            f32x4 au[4], aw[4];
#pragma unroll
            for (int i = 0; i < 4; ++i)
#pragma unroll
                for (int reg = 0; reg < 4; ++reg) { au[i][reg] = silu_f(w0 * xr[i][reg] + w1 * xr[i][reg + 1] + w2 * xr[i][reg + 2] + w3 * xr[i][reg + 3]) * t3[i][reg][0]; aw[i][reg] = ka[i][reg] * t3[i][reg][1]; }
            u32x4 XU[2], XW[2];
            XU[0] = XU[1] = XW[0] = XW[1] = (u32x4){0u, 0u, 0u, 0u};
            const f32x4 z4 = (f32x4){0.f, 0.f, 0.f, 0.f};
#pragma unroll
            for (int i = 0; i < 4; ++i) {
                f32x4 cu = au[i], cw = aw[i];
                if (i >= 1) { cu = MFMA16(af[i - 1], __builtin_bit_cast(bf16x8, XU[0]), cu); cw = MFMA16(af[i - 1], __builtin_bit_cast(bf16x8, XW[0]), cw); }
                if (i == 3) { cu = MFMA16(af[3], __builtin_bit_cast(bf16x8, XU[1]), cu); cw = MFMA16(af[3], __builtin_bit_cast(bf16x8, XW[1]), cw); }
                const u32x4 ta = (u32x4){tf[i][0], tf[i][1], 0u, 0u};
                const u32x4 yu = (u32x4){pk_bf16(cu[0], cu[1]), pk_bf16(cu[2], cu[3]), 0u, 0u}, yw = (u32x4){pk_bf16(cw[0], cw[1]), pk_bf16(cw[2], cw[3]), 0u, 0u};
                const f32x4 xu = MFMA16(__builtin_bit_cast(bf16x8, ta), __builtin_bit_cast(bf16x8, yu), z4), xw = MFMA16(__builtin_bit_cast(bf16x8, ta), __builtin_bit_cast(bf16x8, yw), z4);
                U[i] = xu;
                XU[i >> 1][2 * (i & 1)] = pk_bf16(xu[0], xu[1]); XU[i >> 1][2 * (i & 1) + 1] = pk_bf16(xu[2], xu[3]);
                const unsigned n01 = pk_bf16(-xw[0], -xw[1]), n23 = pk_bf16(-xw[2], -xw[3]);
                XW[i >> 1][2 * (i & 1)] = n01 ^ 0x80008000u; XW[i >> 1][2 * (i & 1) + 1] = n23 ^ 0x80008000u;
                WlE[(16 * i + 0) * 136] = (bf16_t)(n01 & 0xffffu); WlE[(16 * i + 1) * 136] = (bf16_t)(n01 >> 16); WlE[(16 * i + 2) * 136] = (bf16_t)(n23 & 0xffffu); WlE[(16 * i + 3) * 136] = (bf16_t)(n23 >> 16);
            }
        }
        asm volatile("" : "+v"(zreg[0]), "+v"(zreg[1]), "+v"(g_araw), "+v"(g_braw));
        BAR_LDS();
        {
            const int tid = opaque_tid(), w = __builtin_amdgcn_readfirstlane(tid >> 6);
            dma_fast(lds + GL_RAW, (const char*)(P + (rowbase + (c < 31 ? t0 + 61 : t0 - 3)) * P_LD), doff, w);
        }
        {
            const int tid = opaque_tid(), w = tid >> 6, lane = tid & 63, r = lane & 15, q = lane >> 4, E = w * 16 + r;
            const LAS f32x2v* tq = (const LAS f32x2v*)(lds + GL_TOK2 + 512) + 4 * q;
            const LAS bf16_t* WlR = (const LAS bf16_t*)(lds + GL_WL) + r * 136 + 8 * q; const LAS bf16_t* QaR = (const LAS bf16_t*)(lds + GL_QA) + r * 136 + 8 * q;
            const LAS bf16_t* QkR = (const LAS bf16_t*)(lds + GL_QK) + r * 72 + 8 * q; const LAS bf16_t* KtR = (const LAS bf16_t*)(lds + GL_KAT) + r * 72 + 8 * q;
            LAS bf16_t* obE = (LAS bf16_t*)(lds + GL_OB) + (4 * q) * 136 + E;
#define SCHED_B() __builtin_amdgcn_sched_barrier(0)
            bf16x8 fa[8], fb[8];
#pragma unroll
            for (int x = 0; x < 8; ++x) fa[x] = LDQ(WlR, 16 * (x >> 2) * 136 + 32 * (x & 3));
            SCHED_B();
#pragma unroll
            for (int x = 0; x < 8; ++x) fb[x] = LDQ(WlR, 16 * (2 + (x >> 2)) * 136 + 32 * (x & 3));
            bf16x8 Sb[4];
#pragma unroll
            for (int kp = 0; kp < 4; ++kp) Sb[kp] = pack2(Sacc[2 * kp], Sacc[2 * kp + 1]);
            f32x2v t4[4][4];
#pragma unroll
            for (int i = 0; i < 4; ++i)
#pragma unroll
                for (int reg = 0; reg < 4; ++reg) t4[i][reg] = tq[16 * i + reg];
            const float el = __expf(*(const LAS float*)(lds + GL_LAST));
            SCHED_B();
            f32x4 vn[4], oo[4];
#pragma unroll
            for (int i = 0; i < 2; ++i) { f32x4 acc = U[i];
#pragma unroll
                for (int kp = 0; kp < 4; ++kp) acc = MFMA16(fa[4 * i + kp], Sb[kp], acc);
                vn[i] = acc; }
            SCHED_B();
#pragma unroll
            for (int x = 0; x < 8; ++x) fa[x] = LDQ(QaR, 16 * (x >> 2) * 136 + 32 * (x & 3));
            SCHED_B();
#pragma unroll
            for (int i = 0; i < 2; ++i) { f32x4 acc = U[2 + i];
#pragma unroll
                for (int kp = 0; kp < 4; ++kp) acc = MFMA16(fb[4 * i + kp], Sb[kp], acc);
                vn[2 + i] = acc; }
            SCHED_B();
#pragma unroll
            for (int x = 0; x < 8; ++x) fb[x] = LDQ(QaR, 16 * (2 + (x >> 2)) * 136 + 32 * (x & 3));
            SCHED_B();
#pragma unroll
            for (int i = 0; i < 2; ++i) { f32x4 acc = (f32x4){0.f, 0.f, 0.f, 0.f};
#pragma unroll
                for (int kp = 0; kp < 4; ++kp) acc = MFMA16(fa[4 * i + kp], Sb[kp], acc);
                oo[i] = acc; }
            SCHED_B();
            fa[0] = LDQ(QkR, 0); fa[1] = LDQ(QkR, 16 * 72); fa[2] = LDQ(QkR, 32 * 72); fa[3] = LDQ(QkR, 32 * 72 + 32); fa[4] = LDQ(QkR, 48 * 72); fa[5] = LDQ(QkR, 48 * 72 + 32);
            SCHED_B();
#pragma unroll
            for (int i = 0; i < 2; ++i) { f32x4 acc = (f32x4){0.f, 0.f, 0.f, 0.f};
#pragma unroll
                for (int kp = 0; kp < 4; ++kp) acc = MFMA16(fb[4 * i + kp], Sb[kp], acc);
                oo[2 + i] = acc; }
            f32x4 vs[4];
#pragma unroll
            for (int i = 0; i < 4; ++i)
#pragma unroll
                for (int reg = 0; reg < 4; ++reg) { oo[i][reg] *= t4[i][reg][0]; vs[i][reg] = vn[i][reg] * t4[i][reg][1]; }
            bf16x8 Vn[2], Vs[2];
            Vn[0] = pack2(vn[0], vn[1]); Vn[1] = pack2(vn[2], vn[3]); Vs[0] = pack2(vs[0], vs[1]); Vs[1] = pack2(vs[2], vs[3]);
            SCHED_B();
#pragma unroll
            for (int x = 0; x < 8; ++x) fb[x] = LDQ(KtR, 16 * (x >> 1) * 72 + 32 * (x & 1));
            SCHED_B();
            oo[0] = MFMA16(fa[0], Vn[0], oo[0]); oo[1] = MFMA16(fa[1], Vn[0], oo[1]);
            oo[2] = MFMA16(fa[2], Vn[0], oo[2]); oo[2] = MFMA16(fa[3], Vn[1], oo[2]);
            oo[3] = MFMA16(fa[4], Vn[0], oo[3]); oo[3] = MFMA16(fa[5], Vn[1], oo[3]);
            SCHED_B();
#pragma unroll
            for (int x = 0; x < 8; ++x) fa[x] = LDQ(KtR, 16 * (4 + (x >> 1)) * 72 + 32 * (x & 1));
            SCHED_B();
#pragma unroll
            for (int j = 0; j < 4; ++j) { f32x4 acc = Sacc[j] * el; acc = MFMA16(fb[2 * j], Vs[0], acc); acc = MFMA16(fb[2 * j + 1], Vs[1], acc); Sacc[j] = acc; }
#pragma unroll
            for (int i = 0; i < 4; ++i) { const unsigned o01 = pk_bf16(oo[i][0], oo[i][1]), o23 = pk_bf16(oo[i][2], oo[i][3]);
                obE[(16 * i + 0) * 136] = (bf16_t)(o01 & 0xffffu); obE[(16 * i + 1) * 136] = (bf16_t)(o01 >> 16); obE[(16 * i + 2) * 136] = (bf16_t)(o23 & 0xffffu); obE[(16 * i + 3) * 136] = (bf16_t)(o23 >> 16); }
            SCHED_B();
#pragma unroll
            for (int j = 0; j < 4; ++j) { f32x4 acc = Sacc[4 + j] * el; acc = MFMA16(fa[2 * j], Vs[0], acc); acc = MFMA16(fa[2 * j + 1], Vs[1], acc); Sacc[4 + j] = acc; }
        }
        BAR_LDS();
        {
            const int tid = opaque_tid();
#pragma unroll
            for (int it = 0; it < 2; ++it) { const int idx = tid + it * 512, t = idx >> 4, e8 = (idx & 15) * 8;
                const u32x4 ov = *(const LAS u32x4*)(lds + GL_OB + (t * 136 + e8) * 2);
                float o[8];
#pragma unroll
                for (int k = 0; k < 4; ++k) { o[2 * k] = blo(ov[k]); o[2 * k + 1] = bhi(ov[k]); }
                float ss = 0.f;
#pragma unroll
                for (int k = 0; k < 8; ++k) ss += o[k] * o[k];
                ss += __shfl_xor(ss, 1); ss += __shfl_xor(ss, 2); ss += __shfl_xor(ss, 4); ss += __shfl_xor(ss, 8);
                const float rs = rsqrtf(ss * (1.f / 128.f) + 1e-6f);
                const f32x4 n0 = *(const LAS f32x4*)(lds + GL_NW + e8 * 4), n1 = *(const LAS f32x4*)(lds + GL_NW + e8 * 4 + 16);
                u32x4 res;
#pragma unroll
                for (int k = 0; k < 4; ++k) { const float za = blo(zreg[it][k]), zb = bhi(zreg[it][k]); const float na = k < 2 ? n0[2 * k] : n1[2 * k - 4], nb = k < 2 ? n0[2 * k + 1] : n1[2 * k - 3];
                    res[k] = pk_bf16(o[2 * k] * rs * na * silu_f(za), o[2 * k + 1] * rs * nb * silu_f(zb)); }
                *(u32x4*)(MIX + tiled_off((int)(rowbase + t0 + t), 4096 + h * 128 + e8, MIXW)) = res; }
        }
    }
    WAIT_VM0();
    {
        const int tid = opaque_tid(), w = tid >> 6, lane = tid & 63, r = lane & 15, q = lane >> 4, E = w * 16 + r;
        float* So = p.out + O_GDN_P + (size_t)(b * 32 + h) * 16384 + (4 * q) * 128 + E;
#pragma unroll
        for (int j = 0; j < 8; ++j)
#pragma unroll
            for (int reg = 0; reg < 4; ++reg) So[(16 * j + reg) * 128] = Sacc[j][reg];
    }
}

constexpr int SL_RAW = 0, SL_CA = 52224, SL_BA = 69632, SL_BAT = 87040, SL_XST = 105472, SL_CB = 123904, SL_TOK = 133120, SL_LAST = 135168, SL_YB = 135232, SL_WTS = 152640, SL_BIAS = 158784;
__device__ __forceinline__ void ssd_chunk_item(const Params& p, LAS unsigned char* lds, const int b, const int g, const int hp) {
    const bf16_t* P = (const bf16_t*)(p.ws + OFF_P); const float* G = (const float*)(p.ws + OFF_G32); bf16_t* Uo = (bf16_t*)(p.ws + OFF_U32);
    const bf16_t* zsrc = (const bf16_t*)(p.ws + OFF_XB) + (size_t)NTOK * DM;
    const int h0 = g * 8 + hp * 2;
    const size_t rowbase = (size_t)b * 2048;
    const int c0 = C_XBC + h0 * 64, c1 = C_XBC + 4096 + g * 128, c2 = C_XBC + 5120 + g * 128;
    f32x4 Hacc[8];
#pragma unroll
    for (int j = 0; j < 8; ++j) Hacc[j] = (f32x4){0.f, 0.f, 0.f, 0.f};
    float g_dtraw = 0.f, g_A = 0.f, g_dtb = 0.f, g_D = 0.f, g_dtnext = 0.f;
    unsigned doff[7];
    {
        const int tid = opaque_tid(), lane = tid & 63, w = __builtin_amdgcn_readfirstlane(tid >> 6);
        dma_offsets(doff, c0, c1, c2, w, lane);
        for (int i = tid; i < 1536 + 384; i += 512) {
            const int j = i / 384, cc = i - j * 384, sec = cc >> 7, col = cc & 127, ch = sec == 0 ? h0 * 64 + col : (sec == 1 ? 4096 + g * 128 + col : 5120 + g * 128 + col);
            if (j < 4) ((LAS float*)(lds + SL_WTS))[i] = p.ssd_conv_w[j * 6144 + ch]; else ((LAS float*)(lds + SL_BIAS))[cc] = p.ssd_conv_b[ch]; }
        if (w < 2) { const int hh = h0 + w; g_dtraw = G[(rowbase + lane) * G_LD + hh]; g_A = -expf(p.ssd_a_log[hh]); g_dtb = p.ssd_dt_bias[hh]; }
        g_D = p.ssd_d[h0 + (w >> 2)];
        asm volatile("" : "+v"(g_dtraw), "+v"(g_A), "+v"(g_dtb), "+v"(g_D));
        dma_raw(lds + SL_RAW, P, zsrc, rowbase, 0, c0, c1, c2, w, lane);
    }
#pragma unroll 1
    for (int c = 0; c < 32; ++c) {
        const int t0 = c * 64;
        if (c == 0) WAIT_VM0(); else asm volatile("s_waitcnt vmcnt(2)" ::: "memory");
        BAR_LDS();
        u32x4 zreg[2];
        {
            const int tid = opaque_tid(), lane = tid & 63, w = tid >> 6;
#pragma unroll
            for (int it = 0; it < 2; ++it) { const int idx = tid + it * 512; zreg[it] = *(const u32x4*)(P + (rowbase + t0 + (idx >> 4)) * P_LD + C_ZS + h0 * 64 + (idx & 15) * 8); }
            if (w < 2 && c < 31) g_dtnext = G[(rowbase + t0 + 64 + lane) * G_LD + h0 + w];
        }
        {
            const int tid = opaque_tid(), lane = tid & 63, w = tid >> 6;
            const LAS unsigned char* rawl = lds + SL_RAW + (8 * w) * 768 + lane * 4; const LAS float* wts = (const LAS float*)(lds + SL_WTS) + 2 * lane; const LAS float* bia = (const LAS float*)(lds + SL_BIAS) + 2 * lane;
#pragma unroll
            for (int sec = 0; sec < 3; ++sec) {
                f32x2v wj[4];
#pragma unroll
                for (int j = 0; j < 4; ++j) wj[j] = *(const LAS f32x2v*)(wts + j * 384 + sec * 128);
                const f32x2v bj = *(const LAS f32x2v*)(bia + sec * 128);
                float x0[11], x1[11];
#pragma unroll
                for (int rr = 0; rr < 11; ++rr) { const unsigned u = *(const LAS unsigned*)(rawl + rr * 768 + sec * 256); x0[rr] = blo(u); x1[rr] = bhi(u); }
                unsigned pk[8];
#pragma unroll
                for (int t = 0; t < 8; ++t) {
                    const float a0 = silu_f(bj[0] + wj[0][0] * x0[t] + wj[1][0] * x0[t + 1] + wj[2][0] * x0[t + 2] + wj[3][0] * x0[t + 3]);
                    const float a1 = silu_f(bj[1] + wj[0][1] * x1[t] + wj[1][1] * x1[t + 1] + wj[2][1] * x1[t + 2] + wj[3][1] * x1[t + 3]);
                    pk[t] = pk_bf16(a0, a1);
                    if (sec >= 1) *(LAS unsigned*)(lds + (sec == 1 ? SL_BA : SL_CA) + ((8 * w + t) * 136 + kperm(2 * lane)) * 2) = pk[t];
                }
                if (sec <= 1) {
                    u32x4 ke, ko;
#pragma unroll
                    for (int t2 = 0; t2 < 4; ++t2) { ke[t2] = (pk[2 * t2] & 0xffffu) | (pk[2 * t2 + 1] << 16); ko[t2] = (pk[2 * t2] >> 16) | (pk[2 * t2 + 1] & 0xffff0000u); }
                    *(LAS u32x4*)(lds + (sec == 0 ? SL_XST : SL_BAT) + ((2 * lane) * 72 + 8 * w) * 2) = ke; *(LAS u32x4*)(lds + (sec == 0 ? SL_XST : SL_BAT) + ((2 * lane + 1) * 72 + 8 * w) * 2) = ko;
                }
            }
            if (c == 31 && w == 7) {
                float* convout = p.out + O_SSDC_P + (size_t)b * 3 * 6144 + 2 * lane;
#pragma unroll
                for (int j = 0; j < 3; ++j)
#pragma unroll
                    for (int sec = 0; sec < 3; ++sec) { if (sec == 0 || hp == 0) { const unsigned u = *(const LAS unsigned*)(lds + SL_RAW + ((64 + j) * 3 + sec) * 256 + lane * 4);
                        *(f32x2v*)(convout + j * 6144 + (sec == 0 ? h0 * 64 : (sec == 1 ? 4096 + g * 128 : 5120 + g * 128))) = (f32x2v){blo(u), bhi(u)}; } }
            }
        }
        asm volatile("" : "+v"(zreg[0]), "+v"(zreg[1]), "+v"(g_dtnext));
        BAR_LDS();
        {
            const int tid = opaque_tid(), lane = tid & 63, r = lane & 15, q = lane >> 4, w = __builtin_amdgcn_readfirstlane(tid >> 6);
            dma_fast(lds + SL_RAW, (const char*)(P + (rowbase + (c < 31 ? t0 + 61 : t0 - 3)) * P_LD), doff, w);
            if (w < 2) {
                const float dt = softplus_f(g_dtraw + g_dtb); g_dtraw = g_dtnext;
                float cs = g_A * dt;
#pragma unroll
                for (int d = 1; d < 64; d <<= 1) { const float n = __shfl_up(cs, d); if (lane >= d) cs += n; }
                const float lastv = __shfl(cs, 63);
                ((LAS f32x4*)(lds + SL_TOK))[w * 64 + lane] = (f32x4){dt, cs, __expf(cs), dt * __expf(lastv - cs)}; if (lane == 63) ((LAS float*)(lds + SL_LAST))[w] = cs;
            } else {
#pragma unroll 1
                for (int job = w - 2; job < 10; job += 6) {
                    const int ti = job >= 6 ? 3 : (job >= 3 ? 2 : (job >= 1 ? 1 : 0)), si = job - (ti * (ti + 1)) / 2;
                    const LAS bf16_t* Ab = (const LAS bf16_t*)(lds + SL_CA) + (ti * 16 + r) * 136 + 8 * q; const LAS bf16_t* Bb = (const LAS bf16_t*)(lds + SL_BA) + (si * 16 + r) * 136 + 8 * q;
                    f32x4 acc = (f32x4){0.f, 0.f, 0.f, 0.f};
#pragma unroll
                    for (int kk = 0; kk < 4; ++kk) acc = MFMA16(*(const LAS bf16x8*)(Ab + kk * 32), *(const LAS bf16x8*)(Bb + kk * 32), acc);
                    LAS bf16_t* dst = (LAS bf16_t*)(lds + SL_CB) + (ti * 16 + 4 * q) * 72 + si * 16 + r;
#pragma unroll
                    for (int reg = 0; reg < 4; ++reg) dst[reg * 72] = (bf16_t)(pk_bf16(acc[reg], 0.f) & 0xffffu);
                }
            }
        }
        BAR_LDS();
        {
            const int tid = opaque_tid(), w = tid >> 6, lane = tid & 63, r = lane & 15, q = lane >> 4, hl = w >> 2, Pc = (w & 3) * 16 + r;
            const float Dh = g_D;
            const LAS f32x4* tk = (const LAS f32x4*)(lds + SL_TOK) + hl * 64; const float last = ((const LAS float*)(lds + SL_LAST))[hl];
            const LAS bf16_t* XsP = (const LAS bf16_t*)(lds + SL_XST) + (hl * 64 + Pc) * 72;
            const LAS bf16_t* CaR = (const LAS bf16_t*)(lds + SL_CA) + r * 136 + 8 * q; const LAS bf16_t* CbR = (const LAS bf16_t*)(lds + SL_CB) + r * 72 + 8 * q;
            const LAS bf16_t* BtR = (const LAS bf16_t*)(lds + SL_BAT) + r * 72 + 8 * q;
            LAS bf16_t* ybE = (LAS bf16_t*)(lds + SL_YB) + (4 * q) * 136 + hl * 64 + Pc;
            bf16x8 Hb[4];
#pragma unroll
            for (int kp = 0; kp < 4; ++kp) Hb[kp] = pack2(Hacc[2 * kp], Hacc[2 * kp + 1]);
            bf16x8 xf[2], xw[2];
#pragma unroll
            for (int kp = 0; kp < 2; ++kp) { const u32x4 xv = *(const LAS u32x4*)(XsP + 32 * kp + 8 * q); xf[kp] = __builtin_bit_cast(bf16x8, xv);
                u32x4 xs;
#pragma unroll
                for (int e2 = 0; e2 < 4; ++e2) { const float wa = tk[32 * kp + 8 * q + 2 * e2][3], wb = tk[32 * kp + 8 * q + 2 * e2 + 1][3];
                    xs[e2] = pk_bf16(blo(xv[e2]) * wa, bhi(xv[e2]) * wb); }
                xw[kp] = __builtin_bit_cast(bf16x8, xs); }
#pragma unroll
            for (int i = 0; i < 4; ++i) {
                f32x4 acc = (f32x4){0.f, 0.f, 0.f, 0.f};
#pragma unroll
                for (int kp = 0; kp < 4; ++kp) acc = MFMA16(LDQ(CaR, 16 * i * 136 + 32 * kp), Hb[kp], acc);
#pragma unroll
                for (int reg = 0; reg < 4; ++reg) acc[reg] *= tk[16 * i + 4 * q + reg][2];
                const int t = 16 * i + r; const float cum_t = tk[t][1];
#pragma unroll
                for (int kp = 0; kp < 2; ++kp) { if (kp <= (i >> 1)) {
                    const u32x4 cbv = *(const LAS u32x4*)(CbR + 16 * i * 72 + 32 * kp);
                    float lv[8];
#pragma unroll
                    for (int jj = 0; jj < 8; ++jj) { const int s = 32 * kp + 8 * q + jj; const f32x4 ts = tk[s]; const float cb = (jj & 1) ? bhi(cbv[jj >> 1]) : blo(cbv[jj >> 1]);
                        lv[jj] = s <= t ? cb * __expf(cum_t - ts[1]) * ts[0] : 0.f; }
                    const u32x4 lw = (u32x4){pk_bf16(lv[0], lv[1]), pk_bf16(lv[2], lv[3]), pk_bf16(lv[4], lv[5]), pk_bf16(lv[6], lv[7])};
                    acc = MFMA16(__builtin_bit_cast(bf16x8, lw), xf[kp], acc); } }
                const u32x2 xd = *(const LAS u32x2*)(XsP + 16 * i + 4 * q);
                acc[0] += blo(xd[0]) * Dh; acc[1] += bhi(xd[0]) * Dh; acc[2] += blo(xd[1]) * Dh; acc[3] += bhi(xd[1]) * Dh;
#pragma unroll
                for (int reg = 0; reg < 4; ++reg) ybE[(16 * i + reg) * 136] = (bf16_t)(pk_bf16(acc[reg], 0.f) & 0xffffu);
            }
            const float el = __expf(last);
#pragma unroll
            for (int j = 0; j < 8; ++j) { f32x4 acc = Hacc[j] * el;
                acc = MFMA16(*(const LAS bf16x8*)(BtR + 16 * j * 72), xw[0], acc); acc = MFMA16(*(const LAS bf16x8*)(BtR + 16 * j * 72 + 32), xw[1], acc);
                Hacc[j] = acc; }
        }
        BAR_LDS();
        {
            const int tid = opaque_tid();
#pragma unroll
            for (int it = 0; it < 2; ++it) { const int idx = tid + it * 512, t = idx >> 4, e8 = (idx & 15) * 8;
                const u32x4 yv = *(const LAS u32x4*)(lds + SL_YB + (t * 136 + e8) * 2);
                f32x4 o0, o1;
                o0[0] = blo(yv[0]) * silu_f(blo(zreg[it][0])); o0[1] = bhi(yv[0]) * silu_f(bhi(zreg[it][0])); o0[2] = blo(yv[1]) * silu_f(blo(zreg[it][1])); o0[3] = bhi(yv[1]) * silu_f(bhi(zreg[it][1]));
                o1[0] = blo(yv[2]) * silu_f(blo(zreg[it][2])); o1[1] = bhi(yv[2]) * silu_f(bhi(zreg[it][2])); o1[2] = blo(yv[3]) * silu_f(blo(zreg[it][3])); o1[3] = bhi(yv[3]) * silu_f(bhi(zreg[it][3]));
                *(u32x4*)(Uo + (rowbase + t0 + t) * DM + h0 * 64 + e8) = (u32x4){pk_bf16(o0[0], o0[1]), pk_bf16(o0[2], o0[3]), pk_bf16(o1[0], o1[1]), pk_bf16(o1[2], o1[3])}; }
        }
    }
    WAIT_VM0();
    {
        const int tid = opaque_tid(), w = tid >> 6, lane = tid & 63, r = lane & 15, q = lane >> 4, hl = w >> 2, Pc = (w & 3) * 16 + r;
        float* Ho = p.out + O_SSD_P + ((size_t)(b * 64 + h0 + hl) * 64 + Pc) * 128 + 4 * q;
#pragma unroll
        for (int j = 0; j < 8; ++j) *(f32x4*)(Ho + 16 * j) = Hacc[j];
    }
}

__device__ __forceinline__ void phase_scan(const Params& p, LAS unsigned char* lds, const int qword = QCTR_WORD, const int item0 = 0, const int item_end = N_ITEMS) {
    LAS int* qslot = (LAS int*)(lds + LDS_MISC + 16);
    unsigned* qctr = (unsigned*)(p.ws + OFF_BAR) + qword;
    for (;;) {
        __syncthreads();
        if (threadIdx.x == 0) *qslot = item0 + (int)__hip_atomic_fetch_add(qctr, 1u, __ATOMIC_RELAXED, __HIP_MEMORY_SCOPE_AGENT);
        __syncthreads();
        const int item = __builtin_amdgcn_readfirstlane(*qslot);
        if (item >= item_end) break;
        if (item < N_GDN_P) gdn_chunk_item(p, lds, item >> 5, item & 31);
        else if (item < N_GDN_P + N_SSD_P) { const int i = item - N_GDN_P; ssd_chunk_item(p, lds, i >> 5, (i >> 2) & 7, i & 3); }
        else if (item < N_GDN_P + N_SSD_P + N_WOUT + N_GDN_S) { const int i = item - N_GDN_P - N_SSD_P - N_WOUT; gdn_sample_item(p, i >> 4, i & 15); }
        else { const int i = item - N_GDN_P - N_SSD_P - N_WOUT - N_GDN_S; ssd_sample_item(p, i >> 3, i & 7); }
    }
}

__device__ __forceinline__ void phase_outproj_sample(const Params& p, LAS unsigned char* lds) {
    const int tid = threadIdx.x, wid = __builtin_amdgcn_readfirstlane(tid >> 6), lane = tid & 63, wr = wid >> 2, wc = wid & 3, fr = lane & 15, fq = lane >> 4;
    const int aoff = pg8::lds_byte(wr * 64 + fr, fq * 8), boff = pg8::lds_byte((wc & 1) * 64 + fr, fq * 8) + 16384 + (wc >> 1) * 16384;
    for (int u = blockIdx.x; u < 256; u += gridDim.x) {
        const int pn = u & 15, ks = u >> 4;
        const char* gA = (const char*)(p.ws + OFF_MIX) + ((size_t)64 * 128 + ks * 8) * 16384;
        const char* gB0 = (const char*)(p.ws + OFF_WOB) + ((size_t)(2 * pn) * 128 + ks * 8) * 16384; const char* gB1 = gB0 + (size_t)128 * 16384;
#define OS_ISSUE(kt, st) do { _Pragma("unroll") for (int pc = 0; pc < 6; ++pc) { const char* s_ = (pc < 2 ? gA : (pc < 4 ? gB0 : gB1)) + (size_t)(kt) * 16384 + (pc & 1) * 8192 + tid * 16; \
            __builtin_amdgcn_global_load_lds((const unsigned*)s_, (LAS unsigned*)(lds + (st) * 49152 + pc * 8192 + wid * 1024), 16, 0, 0); } } while (0)
        f32x4 acc[4][4];
#pragma unroll
        for (int m = 0; m < 4; ++m)
#pragma unroll
            for (int n = 0; n < 4; ++n) acc[m][n] = (f32x4){0.f, 0.f, 0.f, 0.f};
        OS_ISSUE(0, 0); OS_ISSUE(1, 1); OS_ISSUE(2, 2);
#pragma unroll
        for (int kt = 0; kt < 8; ++kt) {
            if (kt <= 5) asm volatile("s_waitcnt vmcnt(12)" ::: "memory"); else if (kt == 6) asm volatile("s_waitcnt vmcnt(6)" ::: "memory"); else asm volatile("s_waitcnt vmcnt(0)" ::: "memory");
            __builtin_amdgcn_s_barrier(); asm volatile("" ::: "memory");
            const LAS unsigned char* sb = lds + (kt % 3) * 49152;
            bf16x8 af[4][2], bfr[4][2];
#pragma unroll
            for (int m = 0; m < 4; ++m)
#pragma unroll
                for (int k = 0; k < 2; ++k) { af[m][k] = *(const LAS bf16x8*)(sb + aoff + m * 2048 + k * 1024); bfr[m][k] = *(const LAS bf16x8*)(sb + boff + m * 2048 + k * 1024); }
#pragma unroll
            for (int m = 0; m < 4; ++m)
#pragma unroll
                for (int n = 0; n < 4; ++n)
#pragma unroll
                    for (int k = 0; k < 2; ++k) acc[m][n] = __builtin_amdgcn_mfma_f32_16x16x32_bf16(bfr[n][k], af[m][k], acc[m][n], 0, 0, 0);
            asm volatile("s_waitcnt lgkmcnt(0)" ::: "memory"); __builtin_amdgcn_s_barrier(); asm volatile("" ::: "memory");
            if (kt + 3 < 8) OS_ISSUE(kt + 3, kt % 3);
        }
#undef OS_ISSUE
        float* Rp = (float*)(p.ws + OFF_RPART) + ((size_t)ks * NTS + wr * 64 + fr) * DM + pn * 256 + wc * 64 + 4 * fq;
#pragma unroll
        for (int m = 0; m < 4; ++m)
#pragma unroll
            for (int n = 0; n < 4; ++n) *(f32x4*)(Rp + (size_t)(m * 16) * DM + n * 16) = acc[m][n];
    }
    __syncthreads();
}

__device__ __forceinline__ void phase_ssdnorm(const Params& p) {
    const bf16_t* U = (const bf16_t*)(p.ws + OFF_U32); bf16_t* MIX = (bf16_t*)(p.ws + OFF_MIX);
    const int lane = threadIdx.x & 63, gw = blockIdx.x * 8 + (threadIdx.x >> 6), nw = gridDim.x * 8;
    for (int it = gw; it < NTOK * 8; it += nw) {
        const int row = it >> 3, g = it & 7; const size_t off = (size_t)row * DM + g * 512 + lane * 8;
        const u32x4 uv = *(const u32x4*)(U + off); const f32x4 a = (f32x4){blo(uv[0]), bhi(uv[0]), blo(uv[1]), bhi(uv[1])}, b = (f32x4){blo(uv[2]), bhi(uv[2]), blo(uv[3]), bhi(uv[3])};
        const float ss = wave_sum(a[0] * a[0] + a[1] * a[1] + a[2] * a[2] + a[3] * a[3] + b[0] * b[0] + b[1] * b[1] + b[2] * b[2] + b[3] * b[3]);
        const float rs = rsqrtf(ss * (1.f / 512.f) + 1e-6f);
        const f32x4 wa = *(const f32x4*)(p.ssd_norm_w + g * 512 + lane * 8), wb = *(const f32x4*)(p.ssd_norm_w + g * 512 + lane * 8 + 4);
        u32x4 o; o[0] = cvt_pk_bf16(a[0] * rs * wa[0], a[1] * rs * wa[1]); o[1] = cvt_pk_bf16(a[2] * rs * wa[2], a[3] * rs * wa[3]);
        o[2] = cvt_pk_bf16(b[0] * rs * wb[0], b[1] * rs * wb[1]); o[3] = cvt_pk_bf16(b[2] * rs * wb[2], b[3] * rs * wb[3]);
        *(u32x4*)(MIX + tiled_off(row, g * 512 + lane * 8, MIXW)) = o;
    }
    const float* GO = (const float*)(p.ws + OFF_SF) + SF_GO; const bf16_t* P = (const bf16_t*)(p.ws + OFF_P);
    for (int it = gw; it < NTS * 32; it += nw) {
        const int tok = it >> 5, h = it & 31;
        const float o0 = GO[(size_t)tok * 4096 + h * 128 + lane], o1 = GO[(size_t)tok * 4096 + h * 128 + 64 + lane];
        const float rs = rsqrtf(wave_sum(o0 * o0 + o1 * o1) * (1.f / 128.f) + 1e-6f);
        const size_t prow = (size_t)(NTP + tok) * P_LD + C_ZG + h * 128;
        MIX[tiled_off(NTP + tok, 4096 + h * 128 + lane, MIXW)] = f2bf(o0 * rs * p.gdn_norm_w[lane] * silu_f(bf2f(P[prow + lane])));
        MIX[tiled_off(NTP + tok, 4096 + h * 128 + 64 + lane, MIXW)] = f2bf(o1 * rs * p.gdn_norm_w[64 + lane] * silu_f(bf2f(P[prow + 64 + lane])));
    }
}

__device__ __forceinline__ void phase_ln(const Params& p) {
    const float* R = (const float*)(p.ws + OFF_R);
    const int lane = threadIdx.x & 63, gw = blockIdx.x * 8 + (threadIdx.x >> 6), nw = gridDim.x * 8;
    for (int row = gw; row < NTOK; row += nw) {
        const float* rr = R + (size_t)row * DM;
        f32x4 v[16]; float sum = 0.f;
        if (row < NTP) {
#pragma unroll
            for (int i = 0; i < 16; ++i) v[i] = *(const f32x4*)(rr + (i * 64 + lane) * 4);
        } else {
            const float* xr = p.x_sample + (size_t)(row - NTP) * DM; const float* pr = (const float*)(p.ws + OFF_RPART) + (size_t)(row - NTP) * DM;
#pragma unroll
            for (int i = 0; i < 16; ++i) v[i] = ALPHA * *(const f32x4*)(xr + (i * 64 + lane) * 4);
#pragma unroll 1
            for (int ks = 0; ks < 16; ++ks) {
#pragma unroll
                for (int i = 0; i < 16; ++i) v[i] += *(const f32x4*)(pr + (size_t)ks * NTS * DM + (i * 64 + lane) * 4); }
        }
#pragma unroll
        for (int i = 0; i < 16; ++i) sum += v[i][0] + v[i][1] + v[i][2] + v[i][3];
        const float mu = wave_sum(sum) * (1.f / 4096.f);
        float sq = 0.f;
#pragma unroll
        for (int i = 0; i < 16; ++i) { v[i] = v[i] - mu; sq += v[i][0] * v[i][0] + v[i][1] * v[i][1] + v[i][2] * v[i][2] + v[i][3] * v[i][3]; }
        const float rs = rsqrtf(wave_sum(sq) * (1.f / 4096.f) + 1e-5f);
        float* o = p.out + (row < NTP ? O_YP + (size_t)row * DM : O_YS + (size_t)(row - NTP) * DM);
#pragma unroll
        for (int i = 0; i < 16; ++i) { const int c = (i * 64 + lane) * 4; const f32x4 gg = *(const f32x4*)(p.ln_g + c), bb = *(const f32x4*)(p.ln_b + c);
            *(f32x4*)(o + c) = v[i] * rs * gg + bb; }
    }
}

template <int PH>
__global__ __launch_bounds__(512, 2) void mk_fwd(Params p) {
    extern __shared__ __attribute__((aligned(16))) unsigned char smem[];
    LAS unsigned char* lds = (LAS unsigned char*)smem;
    XcdBarrier bar;
    if (PH < 0) {
        if (threadIdx.x == 0) *(LAS u32x4*)(lds + LDS_MISC) = (u32x4){0u, 0u, 0u, 0u};
        __syncthreads();
        bar = xcd_barrier_post((unsigned*)(p.ws + OFF_BAR), (volatile LAS unsigned*)(lds + LDS_MISC));
    }
    if (PH < 0 || PH == 0) { phase_convert(p, lds); if (PROBE_REP == 1) { __syncthreads(); phase_convert(p, lds); } }
    if (PH < 0) xcd_barrier(bar);
    if (PH < 0 || PH == 1) {
        pg8::Gemm g{(const bf16_t*)(p.ws + OFF_XB), (const bf16_t*)(p.ws + OFF_WB), MPAD, NPAD, DM};
        pg8::StaticOrder S; S.init(MPAD, NPAD, (int)gridDim.x, (int)blockIdx.x, true);
        pg8::EpiProj E{(bf16_t*)(p.ws + OFF_P), (float*)(p.ws + OFF_G32)};
        pg8::gemm_phase<pg8::EpiProj, pg8::StaticOrder, true, true>(lds, g, S, E);
        if (PROBE_REP == 2) { __syncthreads(); pg8::gemm_phase<pg8::EpiProj, pg8::StaticOrder, true, true>(lds, g, S, E); }
        { const int G = (int)gridDim.x, nun = (MPAD / 256) * (NPAD / 256), lastfull = nun % G;
          if (lastfull != 0 && (int)blockIdx.x >= lastfull) { __syncthreads();
              tconv_range<false, false, false>(p.w_out, DM, (bf16_t*)(p.ws + OFF_WOB), DM * MIXW * 2, MIXW, (int)blockIdx.x - lastfull, WOUT_TILES, G - lastfull, lds); }
          else if (lastfull == 0) { __syncthreads(); tconv_range<false, false, false>(p.w_out, DM, (bf16_t*)(p.ws + OFF_WOB), DM * MIXW * 2, MIXW, (int)blockIdx.x, WOUT_TILES, G, lds); } }
    }
    if (PH < 0) xcd_barrier(bar);
    if (PH < 0 || PH == 2) { phase_sample_front(p); if (PH < 0) xcd_barrier(bar); else __syncthreads(); phase_scan(p, lds); if (PROBE_REP == 3) phase_scan(p, lds, QCTR_WORD + 64, 0); if (PROBE_REP == 4) phase_scan(p, lds, QCTR_WORD + 64, N_GDN_P + N_SSD_P + N_WOUT); if (PROBE_REP == 6) phase_scan(p, lds, QCTR_WORD + 64, 0, N_GDN_P); if (PROBE_REP == 7) phase_scan(p, lds, QCTR_WORD + 64, N_GDN_P, N_GDN_P + N_SSD_P); }
    if (PH < 0) xcd_barrier(bar);
    if (PH < 0 || PH == 3) phase_ssdnorm(p);
    if (PH < 0) xcd_barrier(bar);
    if (PH < 0 || PH == 4) {
        phase_outproj_sample(p, lds);
        pg8::Gemm g{(const bf16_t*)(p.ws + OFF_MIX), (const bf16_t*)(p.ws + OFF_WOB), NTP, DM, MIXW};
        pg8::StaticOrder S; S.init(NTP, DM, (int)gridDim.x, (int)blockIdx.x);
        pg8::EpiOut E{(float*)(p.ws + OFF_R), p.x_prompt, p.x_sample};
        pg8::gemm_phase<pg8::EpiOut, pg8::StaticOrder, true, true>(lds, g, S, E);
        if (PROBE_REP == 5) { __syncthreads(); pg8::gemm_phase<pg8::EpiOut, pg8::StaticOrder, true, true>(lds, g, S, E); }
    }
    if (PH < 0) xcd_barrier(bar);
    if (PH < 0 || PH == 5) phase_ln(p);
}

template <int PH> static void launch_phase(const Params& p, int grid, hipStream_t stream) {
    static bool attr = false;
    if (!attr) { (void)hipFuncSetAttribute((const void*)mk_fwd<PH>, hipFuncAttributeMaxDynamicSharedMemorySize, LDS_BYTES); attr = true; }
    hipLaunchKernelGGL((mk_fwd<PH>), dim3(grid), dim3(512), LDS_BYTES, stream, p);
}

extern "C" void kernel_launch(void* const* d_in, const int* in_sizes, int n_in, void* d_out, int out_size, void* d_ws, size_t ws_size, hipStream_t stream) {
    (void)in_sizes; (void)n_in; (void)out_size;
    if (ws_size < WS_END) { fprintf(stderr, "workspace too small: %zu < %zu\n", ws_size, (size_t)WS_END); return; }
    Params p{};
    p.x_prompt = (const float*)d_in[0]; p.x_sample = (const float*)d_in[1]; p.state_ssd = (const float*)d_in[2]; p.state_ssd_conv = (const float*)d_in[3];
    p.state_gdn = (const float*)d_in[4]; p.state_gdn_conv = (const float*)d_in[5]; p.w_in = (const float*)d_in[6]; p.ssd_conv_w = (const float*)d_in[7];
    p.ssd_conv_b = (const float*)d_in[8]; p.ssd_dt_bias = (const float*)d_in[9]; p.ssd_a_log = (const float*)d_in[10]; p.ssd_d = (const float*)d_in[11];
    p.ssd_norm_w = (const float*)d_in[12]; p.gdn_conv_w = (const float*)d_in[13]; p.gdn_dt_bias = (const float*)d_in[14]; p.gdn_a_log = (const float*)d_in[15];
    p.gdn_norm_w = (const float*)d_in[16]; p.w_out = (const float*)d_in[17]; p.ln_g = (const float*)d_in[18]; p.ln_b = (const float*)d_in[19];
    p.out = (float*)d_out; p.ws = (unsigned char*)d_ws;
    static int grid = 0;
    if (!grid) { int dev = 0, cus = 0; (void)hipGetDevice(&dev); (void)hipDeviceGetAttribute(&cus, hipDeviceAttributeMultiprocessorCount, dev); grid = cus > 0 ? cus : 256; }
    (void)hipMemsetAsync(d_ws, 0, 32768, stream);
#if MK_FUSED
    launch_phase<-1>(p, grid, stream);
#else
    launch_phase<0>(p, grid, stream); launch_phase<1>(p, grid, stream); launch_phase<2>(p, grid, stream);
    launch_phase<3>(p, grid, stream); launch_phase<4>(p, grid, stream); launch_phase<5>(p, grid, stream);
#endif
}
```

```cpp
#include <hip/hip_runtime.h>
#include <cstdio>
#include <cstdint>

#ifndef PROBE_REP
#define PROBE_REP 0
#endif
#ifndef MK_FUSED
#define MK_FUSED 1
#endif

#define LAS __attribute__((address_space(3)))
typedef unsigned short bf16_t;
typedef short bf16x8 __attribute__((ext_vector_type(8)));
typedef float f32x4 __attribute__((ext_vector_type(4)));
typedef float f32x2v __attribute__((ext_vector_type(2)));
typedef unsigned u32x4 __attribute__((ext_vector_type(4)));
typedef unsigned u32x2 __attribute__((ext_vector_type(2)));

constexpr int DM = 4096, NTP = 8192, NTS = 128, NTOK = 8320, MPAD = 8448;
constexpr int NPROJ = 26752, P_LD = 26624, NPAD = 26880, MIXW = 8192, G_LD = 256;
constexpr int C_ZS = 0, C_XBC = 4096, C_QKV = 10240, C_ZG = 22528;
constexpr float ALPHA = 1.189207115002721f;
constexpr int LDS_BYTES = 163840;
constexpr int LDS_MISC = LDS_BYTES - 64;

constexpr size_t OFF_BAR = 0;
constexpr size_t OFF_XB  = 32768;
constexpr size_t OFF_WB  = OFF_XB  + (size_t)MPAD * DM * 2;
constexpr size_t OFF_WOB = OFF_WB  + (size_t)NPAD * DM * 2;
constexpr size_t OFF_P   = OFF_WOB + (size_t)DM * MIXW * 2;
constexpr size_t OFF_G32 = OFF_P   + (size_t)MPAD * P_LD * 2;
constexpr size_t OFF_MIX = OFF_G32 + (size_t)MPAD * G_LD * 4;
constexpr size_t OFF_U32 = OFF_MIX + (size_t)MPAD * MIXW * 2;
constexpr size_t OFF_R   = OFF_U32 + (size_t)MPAD * DM * 4;
constexpr size_t OFF_RPART = OFF_R + (size_t)MPAD * DM * 4;
constexpr size_t OFF_SF  = OFF_RPART + (size_t)16 * NTS * DM * 4;
constexpr size_t WS_END  = OFF_SF + (size_t)16 * 1024 * 1024;
constexpr int QCTR_WORD = 3584;
constexpr int READY_WORD = 4096;
constexpr int HOOK_TMO_WORD = 5120;
constexpr int NCONV = 8;
constexpr int PRE_SLABS = 8;
constexpr int N_SLABS = 14, SLAB_TILES = 1024, WIN_TILES = 13440, WOUT_TILES = 4096;

constexpr size_t O_YP = 0;
constexpr size_t O_YS = O_YP + (size_t)NTP * DM;
constexpr size_t O_SSD_P = O_YS + (size_t)NTS * DM;
constexpr size_t O_SSDC_P = O_SSD_P + (size_t)4 * 64 * 64 * 128;
constexpr size_t O_GDN_P = O_SSDC_P + (size_t)4 * 3 * 6144;
constexpr size_t O_GDNC_P = O_GDN_P + (size_t)4 * 32 * 128 * 128;
constexpr size_t O_SSD_S = O_GDNC_P + (size_t)4 * 3 * 12288;
constexpr size_t O_SSDC_S = O_SSD_S + (size_t)128 * 64 * 64 * 128;
constexpr size_t O_GDN_S = O_SSDC_S + (size_t)128 * 3 * 6144;
constexpr size_t O_GDNC_S = O_GDN_S + (size_t)128 * 32 * 128 * 128;

struct Params {
    const float* x_prompt; const float* x_sample; const float* state_ssd; const float* state_ssd_conv; const float* state_gdn; const float* state_gdn_conv;
    const float* w_in; const float* ssd_conv_w; const float* ssd_conv_b; const float* ssd_dt_bias; const float* ssd_a_log; const float* ssd_d; const float* ssd_norm_w;
    const float* gdn_conv_w; const float* gdn_dt_bias; const float* gdn_a_log; const float* gdn_norm_w; const float* w_out; const float* ln_g; const float* ln_b;
    float* out; unsigned char* ws;
};

__device__ __forceinline__ unsigned cvt_pk_bf16(float lo, float hi) { unsigned r; asm volatile("v_cvt_pk_bf16_f32 %0, %1, %2" : "=v"(r) : "v"(lo), "v"(hi)); return r; }
__device__ __forceinline__ float bf2f(bf16_t v) { return __uint_as_float(((unsigned)v) << 16); }
__device__ __forceinline__ bf16_t f2bf(float f) { unsigned u = __float_as_uint(f); u += 0x7FFFu + ((u >> 16) & 1u); return (bf16_t)(u >> 16); }
__device__ __forceinline__ float silu_f(float x) { return x * __builtin_amdgcn_rcpf(1.f + __expf(-x)); }
__device__ __forceinline__ float sigmoid_f(float x) { return __builtin_amdgcn_rcpf(1.f + __expf(-x)); }
__device__ __forceinline__ float softplus_f(float x) { const float e = __expf(x); const float s = e < 0.03125f ? e * (1.f - e * (0.5f - e * (0.33333334f - 0.25f * e))) : __logf(1.f + e); return x > 20.f ? x : s; }
__device__ __forceinline__ f32x4 ldbf4(const bf16_t* p) { const u32x2 v = *(const u32x2*)p; f32x4 r; r[0] = __uint_as_float(v[0] << 16); r[1] = __uint_as_float(v[0] & 0xffff0000u); r[2] = __uint_as_float(v[1] << 16); r[3] = __uint_as_float(v[1] & 0xffff0000u); return r; }
__device__ __forceinline__ int opaque_tid() { int t = threadIdx.x; asm volatile("" : "+v"(t)); return t; }
__device__ __forceinline__ size_t tiled_off(int row, int col, int K) {
    const int r = row & 127, c = col & 63, st = (r >> 4) * 2 + (c >> 5), ob = (r & 15) * 64 + (c & 31) * 2;
    return ((size_t)(row >> 7) * (K >> 6) + (col >> 6)) * 8192 + ((st * 1024 + (ob ^ (((ob >> 9) & 1) << 5))) >> 1);
}
__device__ __forceinline__ float wave_sum(float v) {
#pragma unroll
    for (int m = 32; m >= 1; m >>= 1) v += __shfl_xor(v, m);
    return v;
}

#define XB_TMO      128
#define XB_XCNT(j)  (256  + 64 * (j))
#define XB_XSUB(j)  (1280 + 64 * (j))
#define XB_XGEN(j)  (2304 + 64 * (j))
#define XB_TOP      3328
#define XB_TOPGEN   3392
#define XCD_BAR_WORDS 3456
#define XB_SPIN_CAP (1u << 18)
__device__ __forceinline__ unsigned xb_ld(unsigned* p)              { return __hip_atomic_load(p, __ATOMIC_RELAXED, __HIP_MEMORY_SCOPE_AGENT); }
__device__ __forceinline__ unsigned xb_add(unsigned* p, unsigned v) { return __hip_atomic_fetch_add(p, v, __ATOMIC_RELAXED, __HIP_MEMORY_SCOPE_AGENT); }
__device__ __forceinline__ unsigned xb_xcc_id() { return (unsigned)__builtin_amdgcn_s_getreg((3 << 11) | 20) & 0xFu; }
#define XB_SPIN(cond, bar) do { unsigned _sp = 0; while (cond) { __builtin_amdgcn_s_sleep(1); \
    if ((++_sp & 255u) == 0u) { if (xb_ld(&(bar)[XB_TMO])) break; if (_sp > XB_SPIN_CAP) { atomicAdd(&(bar)[XB_TMO], 1u); break; } } } } while (0)
struct XcdBarrier { unsigned* bar; unsigned x; volatile LAS unsigned* st; };
__device__ __forceinline__ XcdBarrier xcd_barrier_post(unsigned* bar, volatile LAS unsigned* st) {
    XcdBarrier b; b.bar = bar; b.x = xb_xcc_id(); b.st = st;
    if (threadIdx.x == 0) (void)xb_add(&bar[XB_XCNT(b.x)], 1u);
    return b;
}
__device__ __forceinline__ void xcd_barrier_complete(unsigned* bar, unsigned x, unsigned& nloc, unsigned& nx) {
    const unsigned G = gridDim.x * gridDim.y * gridDim.z;
    unsigned sum, cnt, mine, sp = 0u;
    for (;;) {
        sum = 0u; cnt = 0u; mine = 0u;
#pragma unroll
        for (unsigned j = 0; j < 16; ++j) { const unsigned c = xb_ld(&bar[XB_XCNT(j)]); sum += c; cnt += (c > 0u) ? 1u : 0u; mine = (j == x) ? c : mine; }
        if (sum == G) break;
        __builtin_amdgcn_s_sleep(1);
        if ((++sp & 255u) == 0u) { if (xb_ld(&bar[XB_TMO])) break; if (sp > XB_SPIN_CAP) { atomicAdd(&bar[XB_TMO], 1u); break; } }
    }
    nloc = mine > 0u ? mine : 1u; nx = cnt > 0u ? cnt : 1u;
}
__device__ __forceinline__ void xcd_barrier(const XcdBarrier& b) {
    asm volatile("s_waitcnt vmcnt(0)" ::: "memory");
    __syncthreads();
    if (threadIdx.x == 0) {
        unsigned* bar = b.bar;
        __builtin_amdgcn_s_waitcnt(0);
        unsigned nloc = b.st[0], nx = b.st[1];
        if (nloc == 0u) { xcd_barrier_complete(bar, b.x, nloc, nx); b.st[0] = nloc; b.st[1] = nx; }
        const unsigned old = xb_add(&bar[XB_XSUB(b.x)], 1u);
        const unsigned gen = old / nloc;
        if (old + 1u == (gen + 1u) * nloc) {
            __builtin_amdgcn_fence(__ATOMIC_RELEASE, "agent");
            asm volatile("s_waitcnt vmcnt(0)" ::: "memory");
            const unsigned og = xb_add(&bar[XB_TOP], 1u);
            const unsigned tg = og / nx;
            if (og + 1u == (tg + 1u) * nx) xb_add(&bar[XB_TOPGEN], 1u);
            else XB_SPIN(xb_ld(&bar[XB_TOPGEN]) == tg, bar);
            __builtin_amdgcn_fence(__ATOMIC_ACQUIRE, "agent");
            xb_add(&bar[XB_XGEN(b.x)], 1u);
            asm volatile("s_waitcnt vmcnt(0)" ::: "memory");
        } else {
            XB_SPIN(xb_ld(&bar[XB_XGEN(b.x)]) == gen, bar);
            __builtin_amdgcn_fence(__ATOMIC_ACQUIRE, "agent");
            asm volatile("s_waitcnt vmcnt(0)" ::: "memory");
        }
    }
    __syncthreads();
}

namespace pg8 {
constexpr int BM = 256, BK = 64, HALF = 128, HTB = HALF * BK * 2, STAGE_BYTES = 8 * HTB, NXCD = 8, WGM = 8;
__host__ __device__ __forceinline__ int lds_byte(int r, int c) { const int st = (r >> 4) * 2 + (c >> 5), rr = r & 15, cc = c & 31, ob = rr * 64 + cc * 2; return st * 1024 + (ob ^ (((ob >> 9) & 1) << 5)); }
__host__ __device__ __forceinline__ void stage_rc(int b, int& R, int& C) { const int st = b / 1024, sb = b % 1024, swz = sb ^ (((sb >> 9) & 1) << 5); R = (st >> 1) * 16 + swz / 64; C = (st & 1) * 32 + (swz % 64) / 2; }
__host__ __device__ __forceinline__ int perm32(int rho) { const int n = rho >> 4, i = rho & 15; return 8 * (i >> 2) + 4 * n + (i & 3); }
struct Unit { int pm, pn; };
struct Gemm { const bf16_t* A; const bf16_t* Bt; int M, N, K; };
struct StaticOrder {
    int nM, nN, nwg, G, c; bool swapmn;
    __host__ __device__ void init(int M, int N, int G_, int c_, bool sw = false) { swapmn = sw; nM = (sw ? N : M) / BM; nN = (sw ? M : N) / BM; nwg = nM * nN; G = G_; c = c_; }
    __host__ __device__ bool next(int i, Unit& u) const {
        const long L = (long)i * G + c; if (L >= nwg) return false;
        int wgid = (int)L; { const int q = nwg / NXCD, r = nwg % NXCD, xcd = wgid % NXCD, off = wgid / NXCD; wgid = (xcd < r ? xcd * (q + 1) : r * (q + 1) + (xcd - r) * q) + off; }
        const int nig = WGM * nN, gid = wgid / nig, fm = gid * WGM, gsz = (nM - fm) < WGM ? (nM - fm) : WGM;
        const int a = fm + ((wgid % nig) % gsz), b = (wgid % nig) / gsz;
        u.pm = swapmn ? b : a; u.pn = swapmn ? a : b; return true;
    }
    __device__ __forceinline__ void a_ready(const Unit&) const {}
    __device__ __forceinline__ void done(const Unit&) const {}
};

struct SlabOrder : StaticOrder {
    unsigned* ready; unsigned need; unsigned* tmo; int pre;
    __device__ __forceinline__ void a_ready(const Unit& u) const {
        const int g = u.pn >> 3;
        if (g >= pre && threadIdx.x < 64) {
            const unsigned long long t0 = __builtin_amdgcn_s_memrealtime(); unsigned polls = 0;
            while ((unsigned)__builtin_amdgcn_readfirstlane(__hip_atomic_load(ready + 64 * g, __ATOMIC_RELAXED, __HIP_MEMORY_SCOPE_AGENT)) < need) {
                if ((++polls & 255u) == 0u && __builtin_amdgcn_readfirstlane(__hip_atomic_load(tmo, __ATOMIC_RELAXED, __HIP_MEMORY_SCOPE_AGENT)) != 0u) break;
                if (__builtin_amdgcn_s_memrealtime() - t0 > 2000000ull) { if (threadIdx.x == 0) __hip_atomic_store(tmo, 1u, __ATOMIC_RELAXED, __HIP_MEMORY_SCOPE_AGENT); break; }
                __builtin_amdgcn_s_sleep(2); }
            __builtin_amdgcn_fence(__ATOMIC_ACQUIRE, "agent");
            asm volatile("s_waitcnt vmcnt(0)" ::: "memory");
        }
        asm volatile("" ::: "memory"); __builtin_amdgcn_s_barrier(); asm volatile("" ::: "memory");
    }
};
struct EpiProj {
    static constexpr bool PERM = true, AFTER_DRAIN = false;
    bf16_t* P; float* G;
    __device__ __forceinline__ void operator()(const f32x4 (&acc)[2][2][4][2], const Unit& u, int wr, int wc, int fr, int fq) const {
        const int row0 = u.pm * BM + wr * 64 + fr;
        if (u.pn < 104) {
            const int col0 = u.pn * BM + wc * 32 + 8 * fq;
#pragma unroll
            for (int ai = 0; ai < 2; ++ai)
#pragma unroll
                for (int m = 0; m < 4; ++m) { bf16_t* rowp = P + (size_t)(row0 + ai * HALF + m * 16) * P_LD + col0;
#pragma unroll
                    for (int bj = 0; bj < 2; ++bj) { const f32x4 v0 = acc[ai][bj][m][0], v1 = acc[ai][bj][m][1];
                        u32x4 w; w[0] = cvt_pk_bf16(v0[0], v0[1]); w[1] = cvt_pk_bf16(v0[2], v0[3]); w[2] = cvt_pk_bf16(v1[0], v1[1]); w[3] = cvt_pk_bf16(v1[2], v1[3]);
                        *(u32x4*)(rowp + bj * HALF) = w; } }
        } else {
#pragma unroll
            for (int ai = 0; ai < 2; ++ai)
#pragma unroll
                for (int m = 0; m < 4; ++m) { float* rowp = G + (size_t)(row0 + ai * HALF + m * 16) * G_LD + wc * 32 + 8 * fq;
                    *(f32x4*)(rowp) = acc[ai][0][m][0]; *(f32x4*)(rowp + 4) = acc[ai][0][m][1]; }
        }
    }
};
struct EpiOut {
    static constexpr bool PERM = false, AFTER_DRAIN = false;
    float* R; const float* xp; const float* xs;
    __device__ __forceinline__ void operator()(const f32x4 (&acc)[2][2][4][2], const Unit& u, int wr, int wc, int fr, int fq) const {
        const int row0 = u.pm * BM + wr * 64 + fr, col0 = u.pn * BM + wc * 32 + 4 * fq;
#pragma unroll
        for (int ai = 0; ai < 2; ++ai)
#pragma unroll
            for (int m = 0; m < 4; ++m) { const int r = row0 + ai * HALF + m * 16;
                { const float* xr = xp + (size_t)r * DM; float* rr = R + (size_t)r * DM;
#pragma unroll
                    for (int bj = 0; bj < 2; ++bj)
#pragma unroll
                        for (int n = 0; n < 2; ++n) { const int c = col0 + bj * HALF + n * 16; const f32x4 xv = *(const f32x4*)(xr + c); *(f32x4*)(rr + c) = acc[ai][bj][m][n] + ALPHA * xv; } } }
    }
};

template <class Epi, class Sched, bool ALIGN_EPI = false, bool SP2 = false>
__device__ __forceinline__ void gemm_phase(LAS unsigned char* lds, const Gemm g, const Sched& S, const Epi& E) {
    const int tid = threadIdx.x, wid = __builtin_amdgcn_readfirstlane(tid >> 6), lane = tid & 63, wr = wid >> 2, wc = wid & 3, fr = lane & 15, fq = lane >> 4;
    const int K = g.K, nt = K / BK;
    unsigned voffA[2], voffB[2];
#pragma unroll
    for (int i = 0; i < 2; ++i) { voffA[i] = (unsigned)(tid * 16 + i * 8192); voffB[i] = voffA[i]; }
    const size_t kstep = (size_t)(HTB);
    const size_t hstep = (size_t)HALF * K * 2;
    const size_t tstep = 2 * hstep;
    const unsigned ldsw = (unsigned)wid * 1024u;
    const int aoff = lds_byte(wr * 64 + fr, fq * 8), boff = lds_byte(wc * 32 + fr, fq * 8);
#define PG8_SA(b, h) (((b) * 2 + (h)) * HTB)
#define PG8_SB(b, h) ((4 + (b) * 2 + (h)) * HTB)
#define PG8_STAGE(bufoff, gbase, voff) do { _Pragma("unroll") for (int _i = 0; _i < 2; ++_i) \
        __builtin_amdgcn_global_load_lds((const unsigned*)((const char*)(gbase) + (voff)[_i]), (LAS unsigned*)(lds + (bufoff) + ldsw + _i * 8192), 16, 0, 0); } while (0)
#define PG8_LDA(dst, b, h) do { _Pragma("unroll") for (int m = 0; m < 4; ++m) _Pragma("unroll") for (int k = 0; k < 2; ++k) dst[m][k] = *(const LAS bf16x8*)(lds + PG8_SA(b, h) + aoff + m * 2048 + k * 1024); } while (0)
#define PG8_LDB(dst, b, h) do { _Pragma("unroll") for (int n = 0; n < 2; ++n) _Pragma("unroll") for (int k = 0; k < 2; ++k) dst[n][k] = *(const LAS bf16x8*)(lds + PG8_SB(b, h) + boff + n * 2048 + k * 1024); } while (0)
#define PG8_MMA(ai, bj, At, Bt) do { __builtin_amdgcn_s_setprio(1); _Pragma("unroll") for (int m = 0; m < 4; ++m) _Pragma("unroll") for (int n = 0; n < 2; ++n) _Pragma("unroll") for (int k = 0; k < 2; ++k) \
        acc[ai][bj][m][n] = __builtin_amdgcn_mfma_f32_16x16x32_bf16(Bt[n][k], At[m][k], acc[ai][bj][m][n], 0, 0, 0); __builtin_amdgcn_s_setprio(0); } while (0)
#define PG8_WAIT_V(n) asm volatile("s_waitcnt vmcnt(" #n ")" ::: "memory")
#define PG8_WAIT_L(n) asm volatile("s_waitcnt lgkmcnt(" #n ")" ::: "memory")
#define PG8_BAR __builtin_amdgcn_s_barrier()
#define PG8_SCHED __builtin_amdgcn_sched_barrier(0)
    Unit cur, nxt; int ui = 0;
    if (!S.next(0, cur)) return;
    f32x4 acc[2][2][4][2];
#pragma unroll
    for (int a = 0; a < 2; ++a)
#pragma unroll
        for (int b = 0; b < 2; ++b)
#pragma unroll
            for (int m = 0; m < 4; ++m)
#pragma unroll
                for (int n = 0; n < 2; ++n) acc[a][b][m][n] = (f32x4){0.f, 0.f, 0.f, 0.f};
    bf16x8 At[4][2], B0[2][2], B1[2][2];
    const char* cA = (const char*)g.A + (size_t)cur.pm * tstep; const char* cB = (const char*)g.Bt + (size_t)cur.pn * tstep;
    S.a_ready(cur);
    if constexpr (SP2) {
        PG8_STAGE(PG8_SB(0, 0), cB, voffB); PG8_STAGE(PG8_SB(0, 1), cB + hstep, voffB); PG8_STAGE(PG8_SA(0, 0), cA, voffA); PG8_STAGE(PG8_SA(0, 1), cA + hstep, voffA);
        if (wr == 1) PG8_BAR;
        PG8_WAIT_V(2); PG8_BAR;
        PG8_STAGE(PG8_SB(1, 0), cB + kstep, voffB); PG8_STAGE(PG8_SA(1, 0), cA + kstep, voffA); PG8_STAGE(PG8_SB(1, 1), cB + hstep + kstep, voffB);
        PG8_WAIT_V(6); PG8_BAR;
    } else {
        PG8_STAGE(PG8_SB(0, 0), cB, voffB); PG8_STAGE(PG8_SA(0, 0), cA, voffA); PG8_STAGE(PG8_SB(0, 1), cB + hstep, voffB); PG8_STAGE(PG8_SA(0, 1), cA + hstep, voffA);
        if (wr == 1) PG8_BAR;
        PG8_WAIT_V(4); PG8_BAR;
        PG8_STAGE(PG8_SB(1, 0), cB + kstep, voffB); PG8_STAGE(PG8_SA(1, 0), cA + kstep, voffA); PG8_STAGE(PG8_SB(1, 1), cB + hstep + kstep, voffB);
        PG8_WAIT_V(6); PG8_BAR;
    }
    for (;;) {
        const bool has_next = S.next(ui + 1, nxt);
        const char* nA = has_next ? (const char*)g.A + (size_t)nxt.pm * tstep : cA; const char* nB = has_next ? (const char*)g.Bt + (size_t)nxt.pn * tstep : cB;
        for (int t = 0; t < nt; t += 2) {
            const bool last = (t == nt - 2);
            const char* a1 = cA + (size_t)(t + 1) * kstep;
            const char* a2 = last ? nA : cA + (size_t)(t + 2) * kstep; const char* b2 = last ? nB : cB + (size_t)(t + 2) * kstep;
            const char* a3 = a2 + kstep; const char* b3 = b2 + kstep;
            if (last && has_next) S.a_ready(nxt);
            if constexpr (SP2) {
            PG8_LDB(B0, 0, 0); PG8_LDB(B1, 0, 1); PG8_SCHED; PG8_LDA(At, 0, 0); PG8_STAGE(PG8_SA(1, 1), a1 + hstep, voffA);
            PG8_WAIT_V(8); PG8_WAIT_L(0); PG8_BAR; PG8_MMA(0, 0, At, B0); PG8_MMA(0, 1, At, B1); PG8_BAR; PG8_SCHED;
            PG8_LDA(At, 0, 1); PG8_STAGE(PG8_SB(0, 0), b2, voffB); PG8_STAGE(PG8_SB(0, 1), b2 + hstep, voffB); PG8_STAGE(PG8_SA(0, 0), a2, voffA);
            PG8_WAIT_V(8); PG8_WAIT_L(0); PG8_BAR; PG8_MMA(1, 0, At, B0); PG8_MMA(1, 1, At, B1); PG8_BAR; PG8_SCHED;
            PG8_LDB(B0, 1, 0); PG8_LDB(B1, 1, 1); PG8_SCHED; PG8_LDA(At, 1, 0); PG8_STAGE(PG8_SA(0, 1), a2 + hstep, voffA);
            PG8_WAIT_V(8); PG8_WAIT_L(0); PG8_BAR; PG8_MMA(0, 0, At, B0); PG8_MMA(0, 1, At, B1); PG8_BAR; PG8_SCHED;
            PG8_LDA(At, 1, 1); PG8_STAGE(PG8_SB(1, 0), b3, voffB); PG8_STAGE(PG8_SB(1, 1), b3 + hstep, voffB); PG8_STAGE(PG8_SA(1, 0), a3, voffA);
            PG8_WAIT_V(8); PG8_WAIT_L(0); PG8_BAR; PG8_MMA(1, 0, At, B0); PG8_MMA(1, 1, At, B1); PG8_BAR; PG8_SCHED;
            } else {
            PG8_LDB(B0, 0, 0); PG8_SCHED; PG8_LDA(At, 0, 0); PG8_STAGE(PG8_SA(1, 1), a1 + hstep, voffA);
            PG8_WAIT_L(8); PG8_BAR; PG8_WAIT_L(0); PG8_MMA(0, 0, At, B0); PG8_BAR; PG8_SCHED;
            PG8_LDB(B1, 0, 1); PG8_STAGE(PG8_SB(0, 0), b2, voffB);
            PG8_BAR; PG8_WAIT_L(0); PG8_MMA(0, 1, At, B1); PG8_BAR;
            PG8_LDA(At, 0, 1); PG8_STAGE(PG8_SA(0, 0), a2, voffA);
            PG8_BAR; PG8_WAIT_L(0); PG8_MMA(1, 0, At, B0); PG8_BAR; PG8_SCHED;
            PG8_STAGE(PG8_SB(0, 1), b2 + hstep, voffB);
            PG8_WAIT_V(6); PG8_BAR; PG8_MMA(1, 1, At, B1); PG8_BAR;
            PG8_LDB(B0, 1, 0); PG8_SCHED; PG8_LDA(At, 1, 0); PG8_STAGE(PG8_SA(0, 1), a2 + hstep, voffA);
            PG8_WAIT_L(8); PG8_BAR; PG8_WAIT_L(0); PG8_MMA(0, 0, At, B0); PG8_BAR; PG8_SCHED;
            PG8_LDB(B1, 1, 1); PG8_STAGE(PG8_SB(1, 0), b3, voffB);
            PG8_BAR; PG8_WAIT_L(0); PG8_MMA(0, 1, At, B1); PG8_BAR;
            PG8_LDA(At, 1, 1); PG8_STAGE(PG8_SA(1, 0), a3, voffA);
            PG8_BAR; PG8_WAIT_L(0); PG8_MMA(1, 0, At, B0); PG8_BAR; PG8_SCHED;
            PG8_STAGE(PG8_SB(1, 1), b3 + hstep, voffB);
            PG8_WAIT_V(6); PG8_BAR; PG8_MMA(1, 1, At, B1); PG8_BAR;
            }
        }
        if constexpr (ALIGN_EPI) { if (wr == 0) PG8_BAR; }
        if constexpr (!Epi::AFTER_DRAIN) { E(acc, cur, wr, wc, fr, fq); S.done(cur); }
        if (!has_next) break;
#pragma unroll
        for (int a = 0; a < 2; ++a)
#pragma unroll
            for (int b = 0; b < 2; ++b)
#pragma unroll
                for (int m = 0; m < 4; ++m)
#pragma unroll
                    for (int n = 0; n < 2; ++n) acc[a][b][m][n] = (f32x4){0.f, 0.f, 0.f, 0.f};
        cur = nxt; cA = nA; cB = nB; ++ui;
        if constexpr (ALIGN_EPI) { if (wr == 1) PG8_BAR; }
    }
    PG8_WAIT_V(0);
    if constexpr (!ALIGN_EPI) { if (wr == 0) PG8_BAR; }
    PG8_BAR;
#undef PG8_SA
#undef PG8_SB
#undef PG8_STAGE
#undef PG8_LDA
#undef PG8_LDB
#undef PG8_MMA
#undef PG8_WAIT_V
#undef PG8_WAIT_L
#undef PG8_BAR
#undef PG8_SCHED
}
}

__device__ __forceinline__ f32x4 gload_nt_asm(const float* p) { f32x4 v; asm volatile("global_load_dwordx4 %0, %1, off nt" : "=v"(v) : "v"(p) : "memory"); return v; }
template <bool REMAP, bool PERM, bool SC1>
__device__ __forceinline__ void tconv_range(const float* __restrict__ src, int ldsrc, bf16_t* __restrict__ dst, int dst_bytes, int K, int t_first, int t_end, int t_stride, LAS unsigned char* lds) {
    constexpr int GT = 4;
    LAS unsigned* T = (LAS unsigned*)lds;
    const int tid = threadIdx.x, nkt = K / 128;
    const __amdgpu_buffer_rsrc_t rs = __builtin_amdgcn_make_buffer_rsrc((void*)dst, 0, dst_bytes, 0x00020000);
    f32x4 ra[GT][4], rb[GT][4];
#define TC_LOAD(tile_, v_) do { const int tl_ = (tile_) < t_end ? (tile_) : (t_end - 1); const int nt_ = tl_ / nkt, kt_ = tl_ - nt_ * nkt, n0_ = nt_ * 64, k0_ = kt_ * 128; int on0_ = n0_; \
        if (REMAP) { if (n0_ < 10240) on0_ = n0_; else if (n0_ < 26624) on0_ = n0_ + 64; else if (n0_ < 26688) on0_ = n0_ - 26624 + 10240; else if (n0_ < 26752) on0_ = n0_; else on0_ = 0; } \
        _Pragma("unroll") for (int i_ = 0; i_ < 2; ++i_) { const int rp_ = (tid >> 4) + 32 * i_, c4_ = tid & 15; const float* s_ = src + (size_t)(k0_ + 2 * rp_) * ldsrc + on0_ + c4_ * 4; \
            v_[2 * i_] = gload_nt_asm(s_); v_[2 * i_ + 1] = gload_nt_asm(s_ + ldsrc); } } while (0)
#define TC_LOADG(tile0_, set_) do { _Pragma("unroll") for (int u_ = 0; u_ < GT; ++u_) TC_LOAD((tile0_) + u_ * t_stride, set_[u_]); } while (0)
#define TC_WAIT(n_, set_) asm volatile("s_waitcnt vmcnt(" #n_ ")" : "+v"(set_[0][0]), "+v"(set_[0][1]), "+v"(set_[0][2]), "+v"(set_[0][3]), "+v"(set_[1][0]), "+v"(set_[1][1]), "+v"(set_[1][2]), "+v"(set_[1][3]), \
        "+v"(set_[2][0]), "+v"(set_[2][1]), "+v"(set_[2][2]), "+v"(set_[2][3]), "+v"(set_[3][0]), "+v"(set_[3][1]), "+v"(set_[3][2]), "+v"(set_[3][3]) :: "memory")
#define TC_PROC(tile0_, set_) do { _Pragma("unroll") for (int u = 0; u < GT; ++u) { const int tile = (tile0_) + u * t_stride; \
        if (tile < t_end) { const int nt = tile / nkt, kt = tile - nt * nkt, n0 = nt * 64, k0 = kt * 128; const bool zero = REMAP && n0 >= 26752; \
            _Pragma("unroll") for (int i = 0; i < 2; ++i) { const int rp = (tid >> 4) + 32 * i, c4 = tid & 15; \
                _Pragma("unroll") for (int j = 0; j < 4; ++j) T[(c4 * 4 + j) * 65 + rp] = zero ? 0u : cvt_pk_bf16(set_[u][2 * i][j], set_[u][2 * i + 1][j]); } \
            __syncthreads(); \
            _Pragma("unroll") for (int i = 0; i < 2; ++i) { const int n = (tid >> 4) + 32 * i, kc = tid & 15; \
                u32x4 v; v[0] = T[n * 65 + kc * 4]; v[1] = T[n * 65 + kc * 4 + 1]; v[2] = T[n * 65 + kc * 4 + 2]; v[3] = T[n * 65 + kc * 4 + 3]; \
                int nn = n0 + n; if (PERM) { const int x = nn & 31; nn = (nn & ~31) + 16 * ((x >> 2) & 1) + 4 * (x >> 3) + (x & 3); } \
                const size_t off = tiled_off(nn, k0 + kc * 8, K); \
                if (SC1) __builtin_amdgcn_raw_buffer_store_b128(v, rs, (int)(off * 2), 0, 16); else *(u32x4*)(dst + off) = v; } \
            __syncthreads(); } } } while (0)
    const int gstep = GT * t_stride;
    TC_LOADG(t_first, ra);
    for (int tile0 = t_first; tile0 < t_end; tile0 += 2 * gstep) {
        TC_LOADG(tile0 + gstep, rb);
        TC_WAIT(16, ra);
        TC_PROC(tile0, ra);
        TC_LOADG(tile0 + 2 * gstep, ra);
        TC_WAIT(16, rb);
        TC_PROC(tile0 + gstep, rb);
    }
    TC_WAIT(0, ra);
#undef TC_LOAD
#undef TC_LOADG
#undef TC_WAIT
#undef TC_PROC
}
__device__ __forceinline__ void phase_convert(const Params& p, LAS unsigned char* lds) {
    bf16_t* Xb = (bf16_t*)(p.ws + OFF_XB);
    const size_t n8 = (size_t)MPAD * DM / 8;
    for (size_t i = (size_t)blockIdx.x * 512 + threadIdx.x; i < n8; i += (size_t)gridDim.x * 512) {
        const size_t e = i * 8; const int row = (int)(e / DM);
        f32x4 a = (f32x4){0.f, 0.f, 0.f, 0.f}, b = a;
        if (row < NTP) { a = __builtin_nontemporal_load((const f32x4*)(p.x_prompt + e)); b = __builtin_nontemporal_load((const f32x4*)(p.x_prompt + e + 4)); }
        else if (row < NTOK) { const size_t e2 = e - (size_t)NTP * DM; a = *(const f32x4*)(p.x_sample + e2); b = *(const f32x4*)(p.x_sample + e2 + 4); }
        u32x4 o; o[0] = cvt_pk_bf16(a[0], a[1]); o[1] = cvt_pk_bf16(a[2], a[3]); o[2] = cvt_pk_bf16(b[0], b[1]); o[3] = cvt_pk_bf16(b[2], b[3]);
        *(u32x4*)(Xb + tiled_off(row, (int)(e - (size_t)row * DM), DM)) = o;
    }
    { u32x4* mz = (u32x4*)((bf16_t*)(p.ws + OFF_MIX) + (size_t)NTOK * MIXW); const size_t nz = (size_t)(MPAD - NTOK) * MIXW / 8;
      for (size_t i = (size_t)blockIdx.x * 512 + threadIdx.x; i < nz; i += (size_t)gridDim.x * 512) mz[i] = (u32x4){0u, 0u, 0u, 0u}; }
    tconv_range<true, true, false>(p.w_in, NPROJ, (bf16_t*)(p.ws + OFF_WB), NPAD * DM * 2, DM, (int)blockIdx.x, WIN_TILES, (int)gridDim.x, lds);
}

constexpr int N_GDN_P = 128, N_SSD_P = 128, N_WOUT = 0, N_GDN_S = 2048, N_SSD_S = 1024, N_ITEMS = N_GDN_P + N_SSD_P + N_WOUT + N_GDN_S + N_SSD_S;
constexpr int GO_LD = 132;
constexpr size_t SF_SXA = 0;
constexpr size_t SF_GQ  = SF_SXA + (size_t)NTS * 6144;
constexpr size_t SF_SDT = SF_GQ + (size_t)NTS * 12288;
constexpr size_t SF_SEA = SF_SDT + (size_t)NTS * 64;
constexpr size_t SF_GB  = SF_SEA + (size_t)NTS * 64;
constexpr size_t SF_GEG = SF_GB + (size_t)NTS * 32;
constexpr size_t SF_GO  = SF_GEG + (size_t)NTS * 32;
constexpr size_t SF_END = SF_GO + (size_t)NTS * 4096;

__device__ __forceinline__ void phase_sample_front(const Params& p) {
    const bf16_t* P = (const bf16_t*)(p.ws + OFF_P); const float* G = (const float*)(p.ws + OFF_G32); float* SF = (float*)(p.ws + OFF_SF);
    const int tid = threadIdx.x, lane = tid & 63;
    for (int item = blockIdx.x; item < NTS * 4; item += gridDim.x) {
        const int tok = item >> 2, sec = item & 3; const size_t row = (size_t)(NTP + tok);
        if (sec == 0) {
#pragma unroll 1
            for (int i = 0; i < 3; ++i) { const int ch = (tid + i * 512) * 4;
                f32x4 a = *(const f32x4*)(p.ssd_conv_b + ch);
#pragma unroll
                for (int j = 0; j < 4; ++j) { const f32x4 wv = *(const f32x4*)(p.ssd_conv_w + j * 6144 + ch);
                    const f32x4 rv = j < 3 ? *(const f32x4*)(p.state_ssd_conv + ((size_t)tok * 3 + j) * 6144 + ch) : ldbf4(P + row * P_LD + C_XBC + ch);
                    if (j >= 1) *(f32x4*)(p.out + O_SSDC_S + ((size_t)tok * 3 + (j - 1)) * 6144 + ch) = rv;
                    a += wv * rv; }
                *(f32x4*)(SF + SF_SXA + (size_t)tok * 6144 + ch) = (f32x4){silu_f(a[0]), silu_f(a[1]), silu_f(a[2]), silu_f(a[3])}; }
            if (tid < 64) { const float dt = softplus_f(G[row * G_LD + tid] + p.ssd_dt_bias[tid]); SF[SF_SDT + tok * 64 + tid] = dt; SF[SF_SEA + tok * 64 + tid] = expf(-expf(p.ssd_a_log[tid]) * dt); }
        } else {
            const int gs = sec - 1;
#pragma unroll 1
            for (int i = 0; i < 2; ++i) { const int cl = (tid + i * 512) * 4, ch = gs * 4096 + cl;
                f32x4 a = (f32x4){0.f, 0.f, 0.f, 0.f};
#pragma unroll
                for (int j = 0; j < 4; ++j) { const f32x4 wv = *(const f32x4*)(p.gdn_conv_w + j * 12288 + ch);
                    const f32x4 rv = j < 3 ? *(const f32x4*)(p.state_gdn_conv + ((size_t)tok * 3 + j) * 12288 + ch) : ldbf4(P + row * P_LD + C_QKV + ch);
                    if (j >= 1) *(f32x4*)(p.out + O_GDNC_S + ((size_t)tok * 3 + (j - 1)) * 12288 + ch) = rv;
                    a += wv * rv; }
                f32x4 o = (f32x4){silu_f(a[0]), silu_f(a[1]), silu_f(a[2]), silu_f(a[3])};
                if (gs < 2) {
                    float ss = o[0] * o[0] + o[1] * o[1] + o[2] * o[2] + o[3] * o[3];
                    ss += __shfl_xor(ss, 1); ss += __shfl_xor(ss, 2); ss += __shfl_xor(ss, 4); ss += __shfl_xor(ss, 8); ss += __shfl_xor(ss, 16);
                    const float rn = rsqrtf(ss + 1e-6f) * (gs == 0 ? 0.08838834764831845f : 1.f); o = o * rn; }
                *(f32x4*)(SF + SF_GQ + (size_t)tok * 12288 + ch) = o; }
            if (gs == 0 && tid < 32) { const float araw = G[row * G_LD + 96 + tid], braw = G[row * G_LD + 64 + tid];
                SF[SF_GB + tok * 32 + tid] = sigmoid_f(braw); SF[SF_GEG + tok * 32 + tid] = expf(-expf(p.gdn_a_log[tid]) * softplus_f(araw + p.gdn_dt_bias[tid])); }
        }
    }
    (void)lane;
}

__device__ __forceinline__ void ssd_sample_item(const Params& p, const int tok, const int g) {
    const float* SF = (const float*)(p.ws + OFF_SF); const bf16_t* P = (const bf16_t*)(p.ws + OFF_P);
    const int tid = opaque_tid(), w = tid >> 6, lane = tid & 63, half = lane >> 5, nq = lane & 31, h = g * 8 + w;
    const f32x4 B4 = *(const f32x4*)(SF + SF_SXA + (size_t)tok * 6144 + 4096 + g * 128 + nq * 4), C4 = *(const f32x4*)(SF + SF_SXA + (size_t)tok * 6144 + 5120 + g * 128 + nq * 4);
    const float xs_mine = SF[SF_SXA + (size_t)tok * 6144 + h * 64 + lane], dt = SF[SF_SDT + tok * 64 + h], eA = SF[SF_SEA + tok * 64 + h];
    const float z = bf2f(P[(size_t)(NTP + tok) * P_LD + C_ZS + h * 64 + lane]);
    const float xdt_mine = xs_mine * dt;
    const float* Hin = p.state_ssd + ((size_t)(tok * 64 + h) * 64 + 32 * half) * 128 + nq * 4; float* Hout = p.out + O_SSD_S + ((size_t)(tok * 64 + h) * 64 + 32 * half) * 128 + nq * 4;
    float y_mine = 0.f;
    f32x4 buf[2][8];
#pragma unroll
    for (int i = 0; i < 8; ++i) buf[0][i] = *(const f32x4*)(Hin + (size_t)i * 128);
#pragma unroll
    for (int bb = 0; bb < 4; ++bb) {
        if (bb < 3) {
#pragma unroll
            for (int i = 0; i < 8; ++i) buf[(bb + 1) & 1][i] = *(const f32x4*)(Hin + (size_t)((bb + 1) * 8 + i) * 128); }
#pragma unroll
        for (int i = 0; i < 8; ++i) { const int it = bb * 8 + i;
            const float xdt = __shfl(xdt_mine, it + 32 * half);
            const f32x4 hn = eA * buf[bb & 1][i] + xdt * B4;
            *(f32x4*)(Hout + (size_t)it * 128) = hn;
            float y = hn[0] * C4[0] + hn[1] * C4[1] + hn[2] * C4[2] + hn[3] * C4[3];
            y += __shfl_xor(y, 1); y += __shfl_xor(y, 2); y += __shfl_xor(y, 4); y += __shfl_xor(y, 8); y += __shfl_xor(y, 16);
            y_mine = (nq == it) ? y : y_mine; }
    }
    ((bf16_t*)(p.ws + OFF_U32))[(size_t)(NTP + tok) * DM + h * 64 + lane] = f2bf((y_mine + xs_mine * p.ssd_d[h]) * silu_f(z));
}
__device__ __forceinline__ void gdn_sample_item(const Params& p, const int tok, const int hp) {
    const float* SF = (const float*)(p.ws + OFF_SF); float* SFo = (float*)(p.ws + OFF_SF);
    const int tid = opaque_tid(), w = tid >> 6, lane = tid & 63, dg = lane >> 3, e4 = lane & 7, h = hp * 2 + (w >> 2), es = w & 3;
    const float* Sin = p.state_gdn + ((size_t)(tok * 32 + h) * 128 + dg * 16) * 128 + es * 32 + e4 * 4; float* Sout = p.out + O_GDN_S + ((size_t)(tok * 32 + h) * 128 + dg * 16) * 128 + es * 32 + e4 * 4;
    f32x4 S[16];
#pragma unroll
    for (int i = 0; i < 16; ++i) S[i] = *(const f32x4*)(Sin + (size_t)i * 128);
    const float* qp = SF + SF_GQ + (size_t)tok * 12288 + h * 128 + dg * 16; const float* kp = qp + 4096;
    f32x4 q4[4], k4[4];
#pragma unroll
    for (int i = 0; i < 4; ++i) { q4[i] = *(const f32x4*)(qp + 4 * i); k4[i] = *(const f32x4*)(kp + 4 * i); }
    const f32x4 v4 = *(const f32x4*)(SF + SF_GQ + (size_t)tok * 12288 + 8192 + h * 128 + es * 32 + e4 * 4);
    const float beta = SF[SF_GB + tok * 32 + h], eg = SF[SF_GEG + tok * 32 + h];
    f32x4 ks = (f32x4){0.f, 0.f, 0.f, 0.f};
#pragma unroll
    for (int i = 0; i < 16; ++i) ks += k4[i >> 2][i & 3] * S[i];
#pragma unroll
    for (int c = 0; c < 4; ++c) { ks[c] += __shfl_xor(ks[c], 8); ks[c] += __shfl_xor(ks[c], 16); ks[c] += __shfl_xor(ks[c], 32); }
    const f32x4 vn = beta * (v4 - eg * ks);
    f32x4 o = (f32x4){0.f, 0.f, 0.f, 0.f};
#pragma unroll
    for (int i = 0; i < 16; ++i) { S[i] = eg * S[i] + k4[i >> 2][i & 3] * vn; *(f32x4*)(Sout + (size_t)i * 128) = S[i]; o += q4[i >> 2][i & 3] * S[i]; }
#pragma unroll
    for (int c = 0; c < 4; ++c) { o[c] += __shfl_xor(o[c], 8); o[c] += __shfl_xor(o[c], 16); o[c] += __shfl_xor(o[c], 32); }
    if (dg == 0) *(f32x4*)(SFo + SF_GO + (size_t)tok * 4096 + h * 128 + es * 32 + e4 * 4) = o;
}

typedef __bf16 bf16x2_t __attribute__((ext_vector_type(2)));
typedef short bf16x4 __attribute__((ext_vector_type(4)));
__device__ __forceinline__ unsigned pk_bf16(float lo, float hi) { const f32x2v v = {lo, hi}; return __builtin_bit_cast(unsigned, __builtin_convertvector(v, bf16x2_t)); }
__device__ __forceinline__ bf16x8 pack2(const f32x4 lo, const f32x4 hi) { u32x4 r; r[0] = pk_bf16(lo[0], lo[1]); r[1] = pk_bf16(lo[2], lo[3]); r[2] = pk_bf16(hi[0], hi[1]); r[3] = pk_bf16(hi[2], hi[3]); return __builtin_bit_cast(bf16x8, r); }
__device__ __forceinline__ bf16x8 ld_perm(const LAS bf16_t* rowp, int q) { const u32x2 a = *(const LAS u32x2*)(rowp + 4 * q), b = *(const LAS u32x2*)(rowp + 16 + 4 * q); u32x4 r; r[0] = a[0]; r[1] = a[1]; r[2] = b[0]; r[3] = b[1]; return __builtin_bit_cast(bf16x8, r); }
__device__ __forceinline__ bf16x8 ld_nat(const LAS bf16_t* rowp, int q) { return *(const LAS bf16x8*)(rowp + 8 * q); }
#define MFMA16(a, b, c) __builtin_amdgcn_mfma_f32_16x16x32_bf16((a), (b), (c), 0, 0, 0)

#define BAR_LDS() do { asm volatile("s_waitcnt lgkmcnt(0)" ::: "memory"); __builtin_amdgcn_s_barrier(); asm volatile("" ::: "memory"); } while (0)
#define WAIT_VM0() asm volatile("s_waitcnt vmcnt(0)" ::: "memory")
#define LDP(base, off) __builtin_bit_cast(bf16x8, (u32x4){(*(const LAS u32x2*)((base) + (off)))[0], (*(const LAS u32x2*)((base) + (off)))[1], (*(const LAS u32x2*)((base) + (off) + 16))[0], (*(const LAS u32x2*)((base) + (off) + 16))[1]})
__device__ __forceinline__ float blo(unsigned v) { return __uint_as_float(v << 16); }
__device__ __forceinline__ float bhi(unsigned v) { return __uint_as_float(v & 0xffff0000u); }
__device__ __forceinline__ int kperm(int c) { return (c & ~31) | (((c >> 2) & 3) << 3) | (((c >> 4) & 1) << 2) | (c & 3); }
#define LDQ(base, off) (*(const LAS bf16x8*)((base) + (off)))
__device__ __forceinline__ void dma_raw(LAS unsigned char* lds_raw, const bf16_t* P, const bf16_t* zsrc, const size_t rowbase, const int t0, const int c0, const int c1, const int c2, const int w, const int lane) {
#pragma unroll
    for (int kk = 0; kk < 7; ++kk) {
        int k = w + 8 * kk; k = k > 50 ? 50 : k;
        int seg = 4 * k + (lane >> 4); seg = seg > 200 ? 200 : seg;
        const int row = seg / 3, sec = seg - row * 3, tt = t0 - 3 + row;
        const bf16_t* src = tt >= 0 ? P + (rowbase + tt) * P_LD + (sec == 0 ? c0 : (sec == 1 ? c1 : c2)) : zsrc;
        __builtin_amdgcn_global_load_lds((const unsigned*)(src + (lane & 15) * 8), (LAS unsigned*)(lds_raw + k * 1024), 16, 0, 0);
    }
}
__device__ __forceinline__ void dma_offsets(unsigned (&doff)[7], const int c0, const int c1, const int c2, const int w, const int lane) {
#pragma unroll
    for (int kk = 0; kk < 7; ++kk) { int k = w + 8 * kk; k = k > 50 ? 50 : k; int seg = 4 * k + (lane >> 4); seg = seg > 200 ? 200 : seg; const int row = seg / 3, sec = seg - row * 3;
        doff[kk] = (unsigned)((row * P_LD + (sec == 0 ? c0 : (sec == 1 ? c1 : c2)) + (lane & 15) * 8) * 2); }
}
__device__ __forceinline__ void dma_fast(LAS unsigned char* lds_raw, const char* base, const unsigned (&doff)[7], const int w) {
#pragma unroll
    for (int kk = 0; kk < 7; ++kk) { int k = w + 8 * kk; k = k > 50 ? 50 : k;
        __builtin_amdgcn_global_load_lds((const unsigned*)(base + doff[kk]), (LAS unsigned*)(lds_raw + k * 1024), 16, 0, 0); }
}
__device__ __forceinline__ float reduce16(float (&v)[16], const int lane) {
#pragma unroll
    for (int i = 0; i < 8; ++i) { const bool up = (lane & 32) != 0; const float send = up ? v[i] : v[i + 8], keep = up ? v[i + 8] : v[i]; v[i] = keep + __shfl_xor(send, 32); }
#pragma unroll
    for (int i = 0; i < 4; ++i) { const bool up = (lane & 16) != 0; const float send = up ? v[i] : v[i + 4], keep = up ? v[i + 4] : v[i]; v[i] = keep + __shfl_xor(send, 16); }
#pragma unroll
    for (int i = 0; i < 2; ++i) { const bool up = (lane & 8) != 0; const float send = up ? v[i] : v[i + 2], keep = up ? v[i + 2] : v[i]; v[i] = keep + __shfl_xor(send, 8); }
    { const bool up = (lane & 4) != 0; const float send = up ? v[0] : v[1], keep = up ? v[1] : v[0]; v[0] = keep + __shfl_xor(send, 4); }
    v[0] += __shfl_xor(v[0], 2); v[0] += __shfl_xor(v[0], 1);
    return v[0];
}

constexpr int GL_RAW = 0, GL_QA = 52224, GL_KA = 69632, GL_OB = GL_KA  , GL_KAT = 87040, GL_WL = 105472, GL_AB = 122880, GL_QK = 132096,
              GL_ADT = 141312, GL_TF = 145408, GL_TOK = 147456, GL_SSQ = 148480, GL_LAST = 148992, GL_WTS = 149056, GL_TOK2 = 155200, GL_NW = 156224;
__device__ __forceinline__ void gdn_chunk_item(const Params& p, LAS unsigned char* lds, const int b, const int h) {
    const bf16_t* P = (const bf16_t*)(p.ws + OFF_P); const float* G = (const float*)(p.ws + OFF_G32); bf16_t* MIX = (bf16_t*)(p.ws + OFF_MIX);
    const bf16_t* zsrc = (const bf16_t*)(p.ws + OFF_XB) + (size_t)NTOK * DM;
    const size_t rowbase = (size_t)b * 2048;
    const float Aneg = -expf(p.gdn_a_log[h]), dtb = p.gdn_dt_bias[h];
    const int c0 = C_QKV + h * 128, c1 = C_QKV + 4096 + h * 128, c2 = C_QKV + 8192 + h * 128;
    f32x4 Sacc[8];
#pragma unroll
    for (int j = 0; j < 8; ++j) Sacc[j] = (f32x4){0.f, 0.f, 0.f, 0.f};
    float g_araw = 0.f, g_braw = 0.f;
    unsigned doff[7];
    {
        const int tid = opaque_tid(), lane = tid & 63, w = __builtin_amdgcn_readfirstlane(tid >> 6);
        dma_offsets(doff, c0, c1, c2, w, lane);
        for (int i = tid; i < (9216 * 2) / 4; i += 512) ((LAS unsigned*)(lds + GL_AB))[i] = 0u;
        for (int i = tid; i < 1536; i += 512) { const int j = i / 384, cc = i - j * 384; ((LAS float*)(lds + GL_WTS))[i] = p.gdn_conv_w[j * 12288 + (cc >> 7) * 4096 + h * 128 + (cc & 127)]; }
        if (tid < 128) ((LAS float*)(lds + GL_NW))[tid] = p.gdn_norm_w[tid];
        if (w == 0) { g_araw = G[(rowbase + lane) * G_LD + 96 + h]; g_braw = G[(rowbase + lane) * G_LD + 64 + h]; }
        asm volatile("" : "+v"(g_araw), "+v"(g_braw));
        dma_raw(lds + GL_RAW, P, zsrc, rowbase, 0, c0, c1, c2, w, lane);
    }
#pragma unroll 1
    for (int c = 0; c < 32; ++c) {
        const int t0 = c * 64;
        if (c == 0) WAIT_VM0(); else asm volatile("s_waitcnt vmcnt(2)" ::: "memory");
        BAR_LDS();
        {
            const int tid = opaque_tid(), lane = tid & 63, w = tid >> 6;
            const LAS unsigned char* rawl = lds + GL_RAW + (8 * w) * 768 + lane * 4; const LAS float* wts = (const LAS float*)(lds + GL_WTS) + 2 * lane;
            float ssv[16];
#pragma unroll
            for (int sec = 0; sec < 2; ++sec) {
                f32x2v wj[4];
#pragma unroll
                for (int j = 0; j < 4; ++j) wj[j] = *(const LAS f32x2v*)(wts + j * 384 + sec * 128);
                float x0[11], x1[11];
#pragma unroll
                for (int rr = 0; rr < 11; ++rr) { const unsigned u = *(const LAS unsigned*)(rawl + rr * 768 + sec * 256); x0[rr] = blo(u); x1[rr] = bhi(u); }
                unsigned pk[8];
#pragma unroll
                for (int t = 0; t < 8; ++t) {
                    const float a0 = silu_f(wj[0][0] * x0[t] + wj[1][0] * x0[t + 1] + wj[2][0] * x0[t + 2] + wj[3][0] * x0[t + 3]);
                    const float a1 = silu_f(wj[0][1] * x1[t] + wj[1][1] * x1[t + 1] + wj[2][1] * x1[t + 2] + wj[3][1] * x1[t + 3]);
                    ssv[2 * t + sec] = a0 * a0 + a1 * a1; pk[t] = pk_bf16(a0, a1);
                    *(LAS unsigned*)(lds + (sec == 0 ? GL_QA : GL_KA) + ((8 * w + t) * 136 + kperm(2 * lane)) * 2) = pk[t];
                }
                if (sec == 1) {
                    u32x4 ke, ko;
#pragma unroll
                    for (int t2 = 0; t2 < 4; ++t2) { ke[t2] = (pk[2 * t2] & 0xffffu) | (pk[2 * t2 + 1] << 16); ko[t2] = (pk[2 * t2] >> 16) | (pk[2 * t2 + 1] & 0xffff0000u); }
                    const int tp = kperm(8 * w);
                    LAS unsigned char* k0 = lds + GL_KAT + ((2 * lane) * 72 + tp) * 2; LAS unsigned char* k1 = k0 + 144;
                    *(LAS u32x2*)k0 = (u32x2){ke[0], ke[1]}; *(LAS u32x2*)(k0 + 16) = (u32x2){ke[2], ke[3]}; *(LAS u32x2*)k1 = (u32x2){ko[0], ko[1]}; *(LAS u32x2*)(k1 + 16) = (u32x2){ko[2], ko[3]};
                }
            }
            const float tot = reduce16(ssv, lane);
            if ((lane & 3) == 0) ((LAS float*)(lds + GL_SSQ))[16 * w + (lane >> 2)] = tot;
            if (c == 31 && w == 7) {
                float* convout = p.out + O_GDNC_P + (size_t)b * 3 * 12288 + h * 128 + 2 * lane;
#pragma unroll
                for (int j = 0; j < 3; ++j)
#pragma unroll
                    for (int sec = 0; sec < 3; ++sec) { const unsigned u = *(const LAS unsigned*)(lds + GL_RAW + ((64 + j) * 3 + sec) * 256 + lane * 4); *(f32x2v*)(convout + j * 12288 + sec * 4096) = (f32x2v){blo(u), bhi(u)}; }
            }
        }
        BAR_LDS();
        u32x4 zreg[2];
        {
            const int tid = opaque_tid(), lane = tid & 63;
#pragma unroll
            for (int it = 0; it < 2; ++it) { const int idx = tid + it * 512; zreg[it] = *(const u32x4*)(P + (rowbase + t0 + (idx >> 4)) * P_LD + C_ZG + h * 128 + (idx & 15) * 8); }
        }
        f32x4 rawt[3]; int jb[3];
        {
            const int tid = opaque_tid(), w = __builtin_amdgcn_readfirstlane(tid >> 6), lane = tid & 63, r = lane & 15, q = lane >> 4;
#define OJ(i_) ((i_) < 6 ? ((i_) + 1 + ((i_) >= 1 ? 1 : 0) + ((i_) >= 3 ? 1 : 0)) : (4 + (i_)))
            if (w < 4) { jb[0] = (w * (w + 3)) / 2; jb[1] = w == 0 ? -1 : OJ(w == 3 ? 2 : w - 1); jb[2] = w == 3 ? OJ(3) : -1; }
            else { const int b0 = 4 + 3 * (w - 4); jb[0] = OJ(b0); jb[1] = OJ(b0 + 1); jb[2] = OJ(b0 + 2); }
#undef OJ
            if (w == 0) {
                const LAS float* ssq = (const LAS float*)(lds + GL_SSQ);
                float cs = Aneg * softplus_f(g_araw + dtb); const float beta = sigmoid_f(g_braw);
                if (c < 31) { const size_t row = rowbase + t0 + 64 + lane; g_araw = G[row * G_LD + 96 + h]; g_braw = G[row * G_LD + 64 + h]; }
#pragma unroll
                for (int d = 1; d < 64; d <<= 1) { const float n = __shfl_up(cs, d); if (lane >= d) cs += n; }
                f32x4 tv; tv[0] = rsqrtf(ssq[lane * 2] + 1e-6f) * 0.08838834764831845f; tv[1] = rsqrtf(ssq[lane * 2 + 1] + 1e-6f); tv[2] = beta; tv[3] = cs;
                ((LAS f32x4*)(lds + GL_TOK))[lane] = (f32x4){tv[0], -tv[1] * beta, tv[1], cs}; if (lane == 63) *(LAS float*)(lds + GL_LAST) = cs;
                const float lastv = __shfl(cs, 63), ec = __expf(cs);
                ((LAS f32x2v*)(lds + GL_TOK2))[lane] = (f32x2v){beta, tv[1] * beta * ec};
                ((LAS f32x2v*)(lds + GL_TOK2 + 512))[lane] = (f32x2v){tv[0] * ec, tv[1] * __expf(lastv - cs)};
            }
#pragma unroll
            for (int k = 0; k < 3; ++k) { rawt[k] = (f32x4){0.f, 0.f, 0.f, 0.f};
                if (jb[k] >= 0) { const int job = jb[k], tj = job < 10 ? job : job - 10; const bool isQK = job >= 10;
                    const int ti = tj >= 6 ? 3 : (tj >= 3 ? 2 : (tj >= 1 ? 1 : 0)), si = tj - (ti * (ti + 1)) / 2;
                    const LAS bf16_t* Ab = (const LAS bf16_t*)(lds + (isQK ? GL_QA : GL_KA)) + (ti * 16 + r) * 136 + 8 * q; const LAS bf16_t* Bb = (const LAS bf16_t*)(lds + GL_KA) + (si * 16 + r) * 136 + 8 * q;
                    f32x4 acc = (f32x4){0.f, 0.f, 0.f, 0.f};
#pragma unroll
                    for (int kk = 0; kk < 4; ++kk) acc = MFMA16(*(const LAS bf16x8*)(Ab + kk * 32), *(const LAS bf16x8*)(Bb + kk * 32), acc);
                    rawt[k] = acc; } }
        }
        BAR_LDS();
        {
            const int tid = opaque_tid(), w = __builtin_amdgcn_readfirstlane(tid >> 6), lane = tid & 63, r = lane & 15, q = lane >> 4;
#pragma unroll
            for (int k = 0; k < 3; ++k) { if (jb[k] >= 0) { const int job = jb[k], tj = job < 10 ? job : job - 10; const bool isQK = job >= 10;
                const int ti = tj >= 6 ? 3 : (tj >= 3 ? 2 : (tj >= 1 ? 1 : 0)), si = tj - (ti * (ti + 1)) / 2;
                const f32x4 acc = rawt[k];
                const int s = si * 16 + r; const f32x4 ts = ((const LAS f32x4*)(lds + GL_TOK))[s];
                const LAS f32x4* tq = (const LAS f32x4*)(lds + GL_TOK) + ti * 16 + 4 * q;
                const f32x4 tt0 = tq[0], tt1 = tq[1], tt2 = tq[2], tt3 = tq[3];
                const int sm = s + (isQK ? 0 : 1), tb = ti * 16 + 4 * q;
                float val[4];
                val[0] = sm <= tb     ? acc[0] * (isQK ? tt0[0] : tt0[1]) * ts[2] * __expf(tt0[3] - ts[3]) : 0.f;
                val[1] = sm <= tb + 1 ? acc[1] * (isQK ? tt1[0] : tt1[1]) * ts[2] * __expf(tt1[3] - ts[3]) : 0.f;
                val[2] = sm <= tb + 2 ? acc[2] * (isQK ? tt2[0] : tt2[1]) * ts[2] * __expf(tt2[3] - ts[3]) : 0.f;
                val[3] = sm <= tb + 3 ? acc[3] * (isQK ? tt3[0] : tt3[1]) * ts[2] * __expf(tt3[3] - ts[3]) : 0.f;
                LAS bf16_t* dst = (LAS bf16_t*)(lds + (isQK ? GL_QK : GL_AB)) + (ti * 16 + 4 * q) * 72 + kperm(s);
                const bool diagKK = (!isQK) && (ti == si);
#pragma unroll
                for (int reg = 0; reg < 4; ++reg) dst[reg * 72] = diagKK ? (bf16_t)0 : (bf16_t)(pk_bf16(val[reg], 0.f) & 0xffffu);
                if (diagKK) *(LAS f32x4*)((LAS float*)(lds + GL_ADT) + (ti * 16 + r) * 16 + 4 * q) = (f32x4){val[0], val[1], val[2], val[3]};
            } }
            if (w < 4) {
                asm volatile("s_waitcnt lgkmcnt(0)" ::: "memory");
                const LAS float* A = (const LAS float*)(lds + GL_ADT) + w * 256;
                float tr[16];
#pragma unroll
                for (int j = 15; j >= 0; --j) { float v = (j == r) ? 1.f : 0.f;
#pragma unroll
                    for (int k = j + 1; k < 16; ++k) v += tr[k] * A[j * 16 + k];
                    tr[j] = v; }
                const float s0 = q == 0 ? tr[0] : (q == 1 ? tr[4] : (q == 2 ? tr[8] : tr[12])), s1 = q == 0 ? tr[1] : (q == 1 ? tr[5] : (q == 2 ? tr[9] : tr[13]));
                const float s2 = q == 0 ? tr[2] : (q == 1 ? tr[6] : (q == 2 ? tr[10] : tr[14])), s3 = q == 0 ? tr[3] : (q == 1 ? tr[7] : (q == 2 ? tr[11] : tr[15]));
                u32x2 tv; tv[0] = pk_bf16(s0, s1); tv[1] = pk_bf16(s2, s3); ((LAS u32x2*)(lds + GL_TF))[w * 64 + lane] = tv;
            }
        }
        BAR_LDS();
        f32x4 U[4];
        {
            const int tid = opaque_tid(), w = tid >> 6, lane = tid & 63, r = lane & 15, q = lane >> 4, E = w * 16 + r;
            const LAS f32x2v* tq = (const LAS f32x2v*)(lds + GL_TOK2) + 4 * q;
            const LAS bf16_t* RvE = (const LAS bf16_t*)(lds + GL_RAW) + ((4 * q) * 3 + 2) * 128 + E; const LAS bf16_t* KaE = (const LAS bf16_t*)(lds + GL_KA) + (4 * q) * 136 + kperm(E);
            const LAS bf16_t* AbR = (const LAS bf16_t*)(lds + GL_AB) + r * 72 + 8 * q;
            const LAS u32x2* TfL = (const LAS u32x2*)(lds + GL_TF) + lane;
            LAS bf16_t* WlE = (LAS bf16_t*)(lds + GL_WL) + (4 * q) * 136 + kperm(E);
            const LAS float* wv = (const LAS float*)(lds + GL_WTS) + 256 + E;
            const float w0 = wv[0], w1 = wv[384], w2 = wv[768], w3 = wv[1152];
            float xr[4][7], ka[4][4]; f32x2v t3[4][4]; bf16x8 af[4]; u32x2 tf[4];
#pragma unroll
            for (int i = 0; i < 4; ++i) {
#pragma unroll
                for (int k = 0; k < 7; ++k) xr[i][k] = bf2f(RvE[(16 * i + k) * 384]);
#pragma unroll
                for (int reg = 0; reg < 4; ++reg) { ka[i][reg] = bf2f(KaE[(16 * i + reg) * 136]); t3[i][reg] = tq[16 * i + reg]; }
                tf[i] = TfL[i * 64];
            }
            af[0] = LDQ(AbR, 16 * 72); af[1] = LDQ(AbR, 32 * 72); af[2] = LDQ(AbR, 48 * 72); af[3] = LDQ(AbR, 48 * 72 + 32);
            __builtin_amdgcn_sched_barrier(0);
            f32x4 au[4], aw[4];
#pragma unroll
            for (int i = 0; i < 4; ++i)
#pragma unroll
                for (int reg = 0; reg < 4; ++reg) { au[i][reg] = silu_f(w0 * xr[i][reg] + w1 * xr[i][reg + 1] + w2 * xr[i][reg + 2] + w3 * xr[i][reg + 3]) * t3[i][reg][0]; aw[i][reg] = ka[i][reg] * t3[i][reg][1]; }
            u32x4 XU[2], XW[2];
            XU[0] = XU[1] = XW[0] = XW[1] = (u32x4){0u, 0u, 0u, 0u};
            const f32x4 z4 = (f32x4){0.f, 0.f, 0.f, 0.f};
#pragma unroll
            for (int i = 0; i < 4; ++i) {
                f32x4 cu = au[i], cw = aw[i];
                if (i >= 1) { cu = MFMA16(af[i - 1], __builtin_bit_cast(bf16x8, XU[0]), cu); cw = MFMA16(af[i - 1], __builtin_bit_cast(bf16x8, XW[0]), cw); }
                if (i == 3) { cu = MFMA16(af[3], __builtin_bit_cast(bf16x8, XU[1]), cu); cw = MFMA16(af[3], __builtin_bit_cast(bf16x8, XW[1]), cw); }
                const u32x4 ta = (u32x4){tf[i][0], tf[i][1], 0u, 0u};
                const u32x4 yu = (u32x4){pk_bf16(cu[0], cu[1]), pk_bf16(cu[2], cu[3]), 0u, 0u}, yw = (u32x4){pk_bf16(cw[0], cw[1]), pk_bf16(cw[2], cw[3]), 0u, 0u};
                const f32x4 xu = MFMA16(__builtin_bit_cast(bf16x8, ta), __builtin_bit_cast(bf16x8, yu), z4), xw = MFMA16(__builtin_bit_cast(bf16x8, ta), __builtin_bit_cast(bf16x8, yw), z4);
                U[i] = xu;
                XU[i >> 1][2 * (i & 1)] = pk_bf16(xu[0], xu[1]); XU[i >> 1][2 * (i & 1) + 1] = pk_bf16(xu[2], xu[3]);
                const unsigned n01 = pk_bf16(-xw[0], -xw[1]), n23 = pk_bf16(-xw[2], -xw[3]);
                XW[i >> 1][2 * (i & 1)] = n01 ^ 0x80008000u; XW[i >> 1][2 * (i & 1) + 1] = n23 ^ 0x80008000u;
                WlE[(16 * i + 0) * 136] = (bf16_t)(n01 & 0xffffu); WlE[(16 * i + 1) * 136] = (bf16_t)(n01 >> 16); WlE[(16 * i + 2) * 136] = (bf16_t)(n23 & 0xffffu); WlE[(16 * i + 3) * 136] = (bf16_t)(n23 >> 16);
            }
        }
        asm volatile("" : "+v"(zreg[0]), "+v"(zreg[1]), "+v"(g_araw), "+v"(g_braw));
        BAR_LDS();
        {
            const int tid = opaque_tid(), w = __builtin_amdgcn_readfirstlane(tid >> 6);
            dma_fast(lds + GL_RAW, (const char*)(P + (rowbase + (c < 31 ? t0 + 61 : t0 - 3)) * P_LD), doff, w);
        }
        {
            const int tid = opaque_tid(), w = tid >> 6, lane = tid & 63, r = lane & 15, q = lane >> 4, E = w * 16 + r;
            const LAS f32x2v* tq = (const LAS f32x2v*)(lds + GL_TOK2 + 512) + 4 * q;
            const LAS bf16_t* WlR = (const LAS bf16_t*)(lds + GL_WL) + r * 136 + 8 * q; const LAS bf16_t* QaR = (const LAS bf16_t*)(lds + GL_QA) + r * 136 + 8 * q;
            const LAS bf16_t* QkR = (const LAS bf16_t*)(lds + GL_QK) + r * 72 + 8 * q; const LAS bf16_t* KtR = (const LAS bf16_t*)(lds + GL_KAT) + r * 72 + 8 * q;
            LAS bf16_t* obE = (LAS bf16_t*)(lds + GL_OB) + (4 * q) * 136 + E;
#define SCHED_B() __builtin_amdgcn_sched_barrier(0)
            bf16x8 fa[8], fb[8];
#pragma unroll
            for (int x = 0; x < 8; ++x) fa[x] = LDQ(WlR, 16 * (x >> 2) * 136 + 32 * (x & 3));
            SCHED_B();
#pragma unroll
            for (int x = 0; x < 8; ++x) fb[x] = LDQ(WlR, 16 * (2 + (x >> 2)) * 136 + 32 * (x & 3));
            bf16x8 Sb[4];
#pragma unroll
            for (int kp = 0; kp < 4; ++kp) Sb[kp] = pack2(Sacc[2 * kp], Sacc[2 * kp + 1]);
            f32x2v t4[4][4];
#pragma unroll
            for (int i = 0; i < 4; ++i)
#pragma unroll
                for (int reg = 0; reg < 4; ++reg) t4[i][reg] = tq[16 * i + reg];
            const float el = __expf(*(const LAS float*)(lds + GL_LAST));
            SCHED_B();
            f32x4 vn[4], oo[4];
#pragma unroll
            for (int i = 0; i < 2; ++i) { f32x4 acc = U[i];
#pragma unroll
                for (int kp = 0; kp < 4; ++kp) acc = MFMA16(fa[4 * i + kp], Sb[kp], acc);
                vn[i] = acc; }
            SCHED_B();
#pragma unroll
            for (int x = 0; x < 8; ++x) fa[x] = LDQ(QaR, 16 * (x >> 2) * 136 + 32 * (x & 3));
            SCHED_B();
#pragma unroll
            for (int i = 0; i < 2; ++i) { f32x4 acc = U[2 + i];
#pragma unroll
                for (int kp = 0; kp < 4; ++kp) acc = MFMA16(fb[4 * i + kp], Sb[kp], acc);
                vn[2 + i] = acc; }
            SCHED_B();
#pragma unroll
            for (int x = 0; x < 8; ++x) fb[x] = LDQ(QaR, 16 * (2 + (x >> 2)) * 136 + 32 * (x & 3));
            SCHED_B();
#pragma unroll
            for (int i = 0; i < 2; ++i) { f32x4 acc = (f32x4){0.f, 0.f, 0.f, 0.f};
#pragma unroll
                for (int kp = 0; kp < 4; ++kp) acc = MFMA16(fa[4 * i + kp], Sb[kp], acc);
                oo[i] = acc; }
            SCHED_B();
            fa[0] = LDQ(QkR, 0); fa[1] = LDQ(QkR, 16 * 72); fa[2] = LDQ(QkR, 32 * 72); fa[3] = LDQ(QkR, 32 * 72 + 32); fa[4] = LDQ(QkR, 48 * 72); fa[5] = LDQ(QkR, 48 * 72 + 32);
            SCHED_B();
#pragma unroll
            for (int i = 0; i < 2; ++i) { f32x4 acc = (f32x4){0.f, 0.f, 0.f, 0.f};
#pragma unroll
                for (int kp = 0; kp < 4; ++kp) acc = MFMA16(fb[4 * i + kp], Sb[kp], acc);
                oo[2 + i] = acc; }
            f32x4 vs[4];
#pragma unroll
            for (int i = 0; i < 4; ++i)
#pragma unroll
                for (int reg = 0; reg < 4; ++reg) { oo[i][reg] *= t4[i][reg][0]; vs[i][reg] = vn[i][reg] * t4[i][reg][1]; }
            bf16x8 Vn[2], Vs[2];
            Vn[0] = pack2(vn[0], vn[1]); Vn[1] = pack2(vn[2], vn[3]); Vs[0] = pack2(vs[0], vs[1]); Vs[1] = pack2(vs[2], vs[3]);
            SCHED_B();
#pragma unroll
            for (int x = 0; x < 8; ++x) fb[x] = LDQ(KtR, 16 * (x >> 1) * 72 + 32 * (x & 1));
            SCHED_B();
            oo[0] = MFMA16(fa[0], Vn[0], oo[0]); oo[1] = MFMA16(fa[1], Vn[0], oo[1]);
            oo[2] = MFMA16(fa[2], Vn[0], oo[2]); oo[2] = MFMA16(fa[3], Vn[1], oo[2]);
            oo[3] = MFMA16(fa[4], Vn[0], oo[3]); oo[3] = MFMA16(fa[5], Vn[1], oo[3]);
            SCHED_B();
#pragma unroll
            for (int x = 0; x < 8; ++x) fa[x] = LDQ(KtR, 16 * (4 + (x >> 1)) * 72 + 32 * (x & 1));
            SCHED_B();
#pragma unroll
            for (int j = 0; j < 4; ++j) { f32x4 acc = Sacc[j] * el; acc = MFMA16(fb[2 * j], Vs[0], acc); acc = MFMA16(fb[2 * j + 1], Vs[1], acc); Sacc[j] = acc; }
#pragma unroll
            for (int i = 0; i < 4; ++i) { const unsigned o01 = pk_bf16(oo[i][0], oo[i][1]), o23 = pk_bf16(oo[i][2], oo[i][3]);
                obE[(16 * i + 0) * 136] = (bf16_t)(o01 & 0xffffu); obE[(16 * i + 1) * 136] = (bf16_t)(o01 >> 16); obE[(16 * i + 2) * 136] = (bf16_t)(o23 & 0xffffu); obE[(16 * i + 3) * 136] = (bf16_t)(o23 >> 16); }
            SCHED_B();
#pragma unroll
            for (int j = 0; j < 4; ++j) { f32x4 acc = Sacc[4 + j] * el; acc = MFMA16(fa[2 * j], Vs[0], acc); acc = MFMA16(fa[2 * j + 1], Vs[1], acc); Sacc[4 + j] = acc; }
        }
        BAR_LDS();
        {
            const int tid = opaque_tid();
#pragma unroll
            for (int it = 0; it < 2; ++it) { const int idx = tid + it * 512, t = idx >> 4, e8 = (idx & 15) * 8;
                const u32x4 ov = *(const LAS u32x4*)(lds + GL_OB + (t * 136 + e8) * 2);
                float o[8];
#pragma unroll
                for (int k = 0; k < 4; ++k) { o[2 * k] = blo(ov[k]); o[2 * k + 1] = bhi(ov[k]); }
                float ss = 0.f;
#pragma unroll
                for (int k = 0; k < 8; ++k) ss += o[k] * o[k];
                ss += __shfl_xor(ss, 1); ss += __shfl_xor(ss, 2); ss += __shfl_xor(ss, 4); ss += __shfl_xor(ss, 8);
                const float rs = rsqrtf(ss * (1.f / 128.f) + 1e-6f);
                const f32x4 n0 = *(const LAS f32x4*)(lds + GL_NW + e8 * 4), n1 = *(const LAS f32x4*)(lds + GL_NW + e8 * 4 + 16);
                u32x4 res;
#pragma unroll
                for (int k = 0; k < 4; ++k) { const float za = blo(zreg[it][k]), zb = bhi(zreg[it][k]); const float na = k < 2 ? n0[2 * k] : n1[2 * k - 4], nb = k < 2 ? n0[2 * k + 1] : n1[2 * k - 3];
                    res[k] = pk_bf16(o[2 * k] * rs * na * silu_f(za), o[2 * k + 1] * rs * nb * silu_f(zb)); }
                *(u32x4*)(MIX + tiled_off((int)(rowbase + t0 + t), 4096 + h * 128 + e8, MIXW)) = res; }
        }
    }
    WAIT_VM0();
    {
        const int tid = opaque_tid(), w = tid >> 6, lane = tid & 63, r = lane & 15, q = lane >> 4, E = w * 16 + r;
        float* So = p.out + O_GDN_P + (size_t)(b * 32 + h) * 16384 + (4 * q) * 128 + E;
#pragma unroll
        for (int j = 0; j < 8; ++j)
#pragma unroll
            for (int reg = 0; reg < 4; ++reg) So[(16 * j + reg) * 128] = Sacc[j][reg];
    }
}

constexpr int SL_RAW = 0, SL_CA = 52224, SL_BA = 69632, SL_BAT = 87040, SL_XST = 105472, SL_CB = 123904, SL_TOK = 133120, SL_LAST = 135168, SL_YB = 135232, SL_WTS = 152640, SL_BIAS = 158784;
__device__ __forceinline__ void ssd_chunk_item(const Params& p, LAS unsigned char* lds, const int b, const int g, const int hp) {
    const bf16_t* P = (const bf16_t*)(p.ws + OFF_P); const float* G = (const float*)(p.ws + OFF_G32); bf16_t* Uo = (bf16_t*)(p.ws + OFF_U32);
    const bf16_t* zsrc = (const bf16_t*)(p.ws + OFF_XB) + (size_t)NTOK * DM;
    const int h0 = g * 8 + hp * 2;
    const size_t rowbase = (size_t)b * 2048;
    const int c0 = C_XBC + h0 * 64, c1 = C_XBC + 4096 + g * 128, c2 = C_XBC + 5120 + g * 128;
    f32x4 Hacc[8];
#pragma unroll
    for (int j = 0; j < 8; ++j) Hacc[j] = (f32x4){0.f, 0.f, 0.f, 0.f};
    float g_dtraw = 0.f, g_A = 0.f, g_dtb = 0.f, g_D = 0.f, g_dtnext = 0.f;
    unsigned doff[7];
    {
        const int tid = opaque_tid(), lane = tid & 63, w = __builtin_amdgcn_readfirstlane(tid >> 6);
        dma_offsets(doff, c0, c1, c2, w, lane);
        for (int i = tid; i < 1536 + 384; i += 512) {
            const int j = i / 384, cc = i - j * 384, sec = cc >> 7, col = cc & 127, ch = sec == 0 ? h0 * 64 + col : (sec == 1 ? 4096 + g * 128 + col : 5120 + g * 128 + col);
            if (j < 4) ((LAS float*)(lds + SL_WTS))[i] = p.ssd_conv_w[j * 6144 + ch]; else ((LAS float*)(lds + SL_BIAS))[cc] = p.ssd_conv_b[ch]; }
        if (w < 2) { const int hh = h0 + w; g_dtraw = G[(rowbase + lane) * G_LD + hh]; g_A = -expf(p.ssd_a_log[hh]); g_dtb = p.ssd_dt_bias[hh]; }
        g_D = p.ssd_d[h0 + (w >> 2)];
        asm volatile("" : "+v"(g_dtraw), "+v"(g_A), "+v"(g_dtb), "+v"(g_D));
        dma_raw(lds + SL_RAW, P, zsrc, rowbase, 0, c0, c1, c2, w, lane);
    }
#pragma unroll 1
    for (int c = 0; c < 32; ++c) {
        const int t0 = c * 64;
        if (c == 0) WAIT_VM0(); else asm volatile("s_waitcnt vmcnt(2)" ::: "memory");
        BAR_LDS();
        u32x4 zreg[2];
        {
            const int tid = opaque_tid(), lane = tid & 63, w = tid >> 6;
#pragma unroll
            for (int it = 0; it < 2; ++it) { const int idx = tid + it * 512; zreg[it] = *(const u32x4*)(P + (rowbase + t0 + (idx >> 4)) * P_LD + C_ZS + h0 * 64 + (idx & 15) * 8); }
            if (w < 2 && c < 31) g_dtnext = G[(rowbase + t0 + 64 + lane) * G_LD + h0 + w];
        }
        {
            const int tid = opaque_tid(), lane = tid & 63, w = tid >> 6;
            const LAS unsigned char* rawl = lds + SL_RAW + (8 * w) * 768 + lane * 4; const LAS float* wts = (const LAS float*)(lds + SL_WTS) + 2 * lane; const LAS float* bia = (const LAS float*)(lds + SL_BIAS) + 2 * lane;
#pragma unroll
            for (int sec = 0; sec < 3; ++sec) {
                f32x2v wj[4];
#pragma unroll
                for (int j = 0; j < 4; ++j) wj[j] = *(const LAS f32x2v*)(wts + j * 384 + sec * 128);
                const f32x2v bj = *(const LAS f32x2v*)(bia + sec * 128);
                float x0[11], x1[11];
#pragma unroll
                for (int rr = 0; rr < 11; ++rr) { const unsigned u = *(const LAS unsigned*)(rawl + rr * 768 + sec * 256); x0[rr] = blo(u); x1[rr] = bhi(u); }
                unsigned pk[8];
#pragma unroll
                for (int t = 0; t < 8; ++t) {
                    const float a0 = silu_f(bj[0] + wj[0][0] * x0[t] + wj[1][0] * x0[t + 1] + wj[2][0] * x0[t + 2] + wj[3][0] * x0[t + 3]);
                    const float a1 = silu_f(bj[1] + wj[0][1] * x1[t] + wj[1][1] * x1[t + 1] + wj[2][1] * x1[t + 2] + wj[3][1] * x1[t + 3]);
                    pk[t] = pk_bf16(a0, a1);
                    if (sec >= 1) *(LAS unsigned*)(lds + (sec == 1 ? SL_BA : SL_CA) + ((8 * w + t) * 136 + kperm(2 * lane)) * 2) = pk[t];
                }
                if (sec <= 1) {
                    u32x4 ke, ko;
#pragma unroll
                    for (int t2 = 0; t2 < 4; ++t2) { ke[t2] = (pk[2 * t2] & 0xffffu) | (pk[2 * t2 + 1] << 16); ko[t2] = (pk[2 * t2] >> 16) | (pk[2 * t2 + 1] & 0xffff0000u); }
                    *(LAS u32x4*)(lds + (sec == 0 ? SL_XST : SL_BAT) + ((2 * lane) * 72 + 8 * w) * 2) = ke; *(LAS u32x4*)(lds + (sec == 0 ? SL_XST : SL_BAT) + ((2 * lane + 1) * 72 + 8 * w) * 2) = ko;
                }
            }
            if (c == 31 && w == 7) {
                float* convout = p.out + O_SSDC_P + (size_t)b * 3 * 6144 + 2 * lane;
#pragma unroll
                for (int j = 0; j < 3; ++j)
#pragma unroll
                    for (int sec = 0; sec < 3; ++sec) { if (sec == 0 || hp == 0) { const unsigned u = *(const LAS unsigned*)(lds + SL_RAW + ((64 + j) * 3 + sec) * 256 + lane * 4);
                        *(f32x2v*)(convout + j * 6144 + (sec == 0 ? h0 * 64 : (sec == 1 ? 4096 + g * 128 : 5120 + g * 128))) = (f32x2v){blo(u), bhi(u)}; } }
            }
        }
        asm volatile("" : "+v"(zreg[0]), "+v"(zreg[1]), "+v"(g_dtnext));
        BAR_LDS();
        {
            const int tid = opaque_tid(), lane = tid & 63, r = lane & 15, q = lane >> 4, w = __builtin_amdgcn_readfirstlane(tid >> 6);
            dma_fast(lds + SL_RAW, (const char*)(P + (rowbase + (c < 31 ? t0 + 61 : t0 - 3)) * P_LD), doff, w);
            if (w < 2) {
                const float dt = softplus_f(g_dtraw + g_dtb); g_dtraw = g_dtnext;
                float cs = g_A * dt;
#pragma unroll
                for (int d = 1; d < 64; d <<= 1) { const float n = __shfl_up(cs, d); if (lane >= d) cs += n; }
                const float lastv = __shfl(cs, 63);
                { LAS float* tb = (LAS float*)(lds + SL_TOK) + w * 256; tb[lane] = dt; tb[64 + lane] = cs; tb[128 + lane] = __expf(cs); tb[192 + lane] = dt * __expf(lastv - cs); }
                if (lane == 63) ((LAS float*)(lds + SL_LAST))[w] = cs;
            } else {
#pragma unroll 1
                for (int job = w - 2; job < 10; job += 6) {
                    const int ti = job >= 6 ? 3 : (job >= 3 ? 2 : (job >= 1 ? 1 : 0)), si = job - (ti * (ti + 1)) / 2;
                    const LAS bf16_t* Ab = (const LAS bf16_t*)(lds + SL_CA) + (ti * 16 + r) * 136 + 8 * q; const LAS bf16_t* Bb = (const LAS bf16_t*)(lds + SL_BA) + (si * 16 + r) * 136 + 8 * q;
                    f32x4 acc = (f32x4){0.f, 0.f, 0.f, 0.f};
#pragma unroll
                    for (int kk = 0; kk < 4; ++kk) acc = MFMA16(*(const LAS bf16x8*)(Ab + kk * 32), *(const LAS bf16x8*)(Bb + kk * 32), acc);
                    LAS bf16_t* dst = (LAS bf16_t*)(lds + SL_CB) + (ti * 16 + 4 * q) * 72 + si * 16 + r;
#pragma unroll
                    for (int reg = 0; reg < 4; ++reg) dst[reg * 72] = (bf16_t)(pk_bf16(acc[reg], 0.f) & 0xffffu);
                }
            }
        }
        BAR_LDS();
        {
            const int tid = opaque_tid(), w = tid >> 6, lane = tid & 63, r = lane & 15, q = lane >> 4, hl = w >> 2, Pc = (w & 3) * 16 + r;
            const float Dh = g_D;
            const LAS float* tb = (const LAS float*)(lds + SL_TOK) + hl * 256; const float last = ((const LAS float*)(lds + SL_LAST))[hl];
            const LAS bf16_t* XsP = (const LAS bf16_t*)(lds + SL_XST) + (hl * 64 + Pc) * 72;
            const LAS bf16_t* CaR = (const LAS bf16_t*)(lds + SL_CA) + r * 136 + 8 * q; const LAS bf16_t* CbR = (const LAS bf16_t*)(lds + SL_CB) + r * 72 + 8 * q;
            const LAS bf16_t* BtR = (const LAS bf16_t*)(lds + SL_BAT) + r * 72 + 8 * q;
            LAS bf16_t* ybE = (LAS bf16_t*)(lds + SL_YB) + (4 * q) * 136 + hl * 64 + Pc;
#define SCHED_B() __builtin_amdgcn_sched_barrier(0)
            bf16x8 fa[8], fb[8];
#pragma unroll
            for (int x = 0; x < 8; ++x) fa[x] = LDQ(CaR, 16 * (x >> 2) * 136 + 32 * (x & 3));
            const u32x4 xv0 = *(const LAS u32x4*)(XsP + 8 * q), xv1 = *(const LAS u32x4*)(XsP + 32 + 8 * q);
            const f32x4 wv00 = *(const LAS f32x4*)(tb + 192 + 8 * q), wv01 = *(const LAS f32x4*)(tb + 192 + 8 * q + 4), wv10 = *(const LAS f32x4*)(tb + 192 + 32 + 8 * q), wv11 = *(const LAS f32x4*)(tb + 192 + 32 + 8 * q + 4);
            SCHED_B();
#pragma unroll
            for (int x = 0; x < 8; ++x) fb[x] = LDQ(CaR, 16 * (2 + (x >> 2)) * 136 + 32 * (x & 3));
            bf16x8 Hb[4];
#pragma unroll
            for (int kp = 0; kp < 4; ++kp) Hb[kp] = pack2(Hacc[2 * kp], Hacc[2 * kp + 1]);
            bf16x8 xf[2], xw[2];
            xf[0] = __builtin_bit_cast(bf16x8, xv0); xf[1] = __builtin_bit_cast(bf16x8, xv1);
            xw[0] = __builtin_bit_cast(bf16x8, (u32x4){pk_bf16(blo(xv0[0]) * wv00[0], bhi(xv0[0]) * wv00[1]), pk_bf16(blo(xv0[1]) * wv00[2], bhi(xv0[1]) * wv00[3]), pk_bf16(blo(xv0[2]) * wv01[0], bhi(xv0[2]) * wv01[1]), pk_bf16(blo(xv0[3]) * wv01[2], bhi(xv0[3]) * wv01[3])});
            xw[1] = __builtin_bit_cast(bf16x8, (u32x4){pk_bf16(blo(xv1[0]) * wv10[0], bhi(xv1[0]) * wv10[1]), pk_bf16(blo(xv1[1]) * wv10[2], bhi(xv1[1]) * wv10[3]), pk_bf16(blo(xv1[2]) * wv11[0], bhi(xv1[2]) * wv11[1]), pk_bf16(blo(xv1[3]) * wv11[2], bhi(xv1[3]) * wv11[3])});
            SCHED_B();
            f32x4 acc[4];
#pragma unroll
            for (int i = 0; i < 2; ++i) { f32x4 a = (f32x4){0.f, 0.f, 0.f, 0.f};
#pragma unroll
                for (int kp = 0; kp < 4; ++kp) a = MFMA16(fa[4 * i + kp], Hb[kp], a);
                acc[i] = a; }
            SCHED_B();
            fa[0] = LDQ(CbR, 0); fa[1] = LDQ(CbR, 16 * 72); fa[2] = LDQ(CbR, 32 * 72); fa[3] = LDQ(CbR, 32 * 72 + 32); fa[4] = LDQ(CbR, 48 * 72); fa[5] = LDQ(CbR, 48 * 72 + 32);
            SCHED_B();
#pragma unroll
            for (int i = 0; i < 2; ++i) { f32x4 a = (f32x4){0.f, 0.f, 0.f, 0.f};
#pragma unroll
                for (int kp = 0; kp < 4; ++kp) a = MFMA16(fb[4 * i + kp], Hb[kp], a);
                acc[2 + i] = a; }
            SCHED_B();
#pragma unroll
            for (int x = 0; x < 8; ++x) fb[x] = LDQ(BtR, 16 * (x >> 1) * 72 + 32 * (x & 1));
            f32x4 cs_[2][2], ds_[2][2], ec[4]; float ct[4]; u32x2 xd[4];
#pragma unroll
            for (int kp = 0; kp < 2; ++kp) { cs_[kp][0] = *(const LAS f32x4*)(tb + 64 + 32 * kp + 8 * q); cs_[kp][1] = *(const LAS f32x4*)(tb + 64 + 32 * kp + 8 * q + 4);
                ds_[kp][0] = *(const LAS f32x4*)(tb + 32 * kp + 8 * q); ds_[kp][1] = *(const LAS f32x4*)(tb + 32 * kp + 8 * q + 4); }
#pragma unroll
            for (int i = 0; i < 4; ++i) { ec[i] = *(const LAS f32x4*)(tb + 128 + 16 * i + 4 * q); ct[i] = tb[64 + 16 * i + r]; xd[i] = *(const LAS u32x2*)(XsP + 16 * i + 4 * q); }
            SCHED_B();
#pragma unroll
            for (int i = 0; i < 4; ++i) {
                f32x4 a = acc[i] * ec[i];
                const int t = 16 * i + r;
#pragma unroll
                for (int kp = 0; kp < 2; ++kp) { if (kp <= (i >> 1)) {
                    const u32x4 cbv = __builtin_bit_cast(u32x4, fa[i < 2 ? i : (2 * i - 2 + kp)]);
                    float lv[8];
#pragma unroll
                    for (int jj = 0; jj < 8; ++jj) { const int s = 32 * kp + 8 * q + jj; const float cb = (jj & 1) ? bhi(cbv[jj >> 1]) : blo(cbv[jj >> 1]);
                        lv[jj] = s <= t ? cb * __expf(ct[i] - cs_[kp][jj >> 2][jj & 3]) * ds_[kp][jj >> 2][jj & 3] : 0.f; }
                    const u32x4 lw = (u32x4){pk_bf16(lv[0], lv[1]), pk_bf16(lv[2], lv[3]), pk_bf16(lv[4], lv[5]), pk_bf16(lv[6], lv[7])};
                    a = MFMA16(__builtin_bit_cast(bf16x8, lw), xf[kp], a); } }
                a[0] += blo(xd[i][0]) * Dh; a[1] += bhi(xd[i][0]) * Dh; a[2] += blo(xd[i][1]) * Dh; a[3] += bhi(xd[i][1]) * Dh;
                const unsigned y01 = pk_bf16(a[0], a[1]), y23 = pk_bf16(a[2], a[3]);
                ybE[(16 * i + 0) * 136] = (bf16_t)(y01 & 0xffffu); ybE[(16 * i + 1) * 136] = (bf16_t)(y01 >> 16); ybE[(16 * i + 2) * 136] = (bf16_t)(y23 & 0xffffu); ybE[(16 * i + 3) * 136] = (bf16_t)(y23 >> 16);
            }
            SCHED_B();
#pragma unroll
            for (int x = 0; x < 8; ++x) fa[x] = LDQ(BtR, 16 * (4 + (x >> 1)) * 72 + 32 * (x & 1));
            const float el = __expf(last);
            SCHED_B();
#pragma unroll
            for (int j = 0; j < 4; ++j) { f32x4 a = Hacc[j] * el; a = MFMA16(fb[2 * j], xw[0], a); a = MFMA16(fb[2 * j + 1], xw[1], a); Hacc[j] = a; }
            SCHED_B();
#pragma unroll
            for (int j = 0; j < 4; ++j) { f32x4 a = Hacc[4 + j] * el; a = MFMA16(fa[2 * j], xw[0], a); a = MFMA16(fa[2 * j + 1], xw[1], a); Hacc[4 + j] = a; }
#undef SCHED_B
        }
        BAR_LDS();
        {
            const int tid = opaque_tid();
#pragma unroll
            for (int it = 0; it < 2; ++it) { const int idx = tid + it * 512, t = idx >> 4, e8 = (idx & 15) * 8;
                const u32x4 yv = *(const LAS u32x4*)(lds + SL_YB + (t * 136 + e8) * 2);
                f32x4 o0, o1;
                o0[0] = blo(yv[0]) * silu_f(blo(zreg[it][0])); o0[1] = bhi(yv[0]) * silu_f(bhi(zreg[it][0])); o0[2] = blo(yv[1]) * silu_f(blo(zreg[it][1])); o0[3] = bhi(yv[1]) * silu_f(bhi(zreg[it][1]));
                o1[0] = blo(yv[2]) * silu_f(blo(zreg[it][2])); o1[1] = bhi(yv[2]) * silu_f(bhi(zreg[it][2])); o1[2] = blo(yv[3]) * silu_f(blo(zreg[it][3])); o1[3] = bhi(yv[3]) * silu_f(bhi(zreg[it][3]));
                *(u32x4*)(Uo + (rowbase + t0 + t) * DM + h0 * 64 + e8) = (u32x4){pk_bf16(o0[0], o0[1]), pk_bf16(o0[2], o0[3]), pk_bf16(o1[0], o1[1]), pk_bf16(o1[2], o1[3])}; }
        }
    }
    WAIT_VM0();
    {
        const int tid = opaque_tid(), w = tid >> 6, lane = tid & 63, r = lane & 15, q = lane >> 4, hl = w >> 2, Pc = (w & 3) * 16 + r;
        float* Ho = p.out + O_SSD_P + ((size_t)(b * 64 + h0 + hl) * 64 + Pc) * 128 + 4 * q;
#pragma unroll
        for (int j = 0; j < 8; ++j) *(f32x4*)(Ho + 16 * j) = Hacc[j];
    }
}

__device__ __forceinline__ void phase_scan(const Params& p, LAS unsigned char* lds, const int qword = QCTR_WORD, const int item0 = 0, const int item_end = N_ITEMS) {
    LAS int* qslot = (LAS int*)(lds + LDS_MISC + 16);
    unsigned* qctr = (unsigned*)(p.ws + OFF_BAR) + qword;
    for (;;) {
        __syncthreads();
        if (threadIdx.x == 0) *qslot = item0 + (int)__hip_atomic_fetch_add(qctr, 1u, __ATOMIC_RELAXED, __HIP_MEMORY_SCOPE_AGENT);
        __syncthreads();
        const int item = __builtin_amdgcn_readfirstlane(*qslot);
        if (item >= item_end) break;
        if (item < N_GDN_P) gdn_chunk_item(p, lds, item >> 5, item & 31);
        else if (item < N_GDN_P + N_SSD_P) { const int i = item - N_GDN_P; ssd_chunk_item(p, lds, i >> 5, (i >> 2) & 7, i & 3); }
        else if (item < N_GDN_P + N_SSD_P + N_WOUT + N_GDN_S) { const int i = item - N_GDN_P - N_SSD_P - N_WOUT; gdn_sample_item(p, i >> 4, i & 15); }
        else { const int i = item - N_GDN_P - N_SSD_P - N_WOUT - N_GDN_S; ssd_sample_item(p, i >> 3, i & 7); }
    }
}

__device__ __forceinline__ void phase_outproj_sample(const Params& p, LAS unsigned char* lds) {
    const int tid = threadIdx.x, wid = __builtin_amdgcn_readfirstlane(tid >> 6), lane = tid & 63, wr = wid >> 2, wc = wid & 3, fr = lane & 15, fq = lane >> 4;
    const int aoff = pg8::lds_byte(wr * 64 + fr, fq * 8), boff = pg8::lds_byte((wc & 1) * 64 + fr, fq * 8) + 16384 + (wc >> 1) * 16384;
    for (int u = blockIdx.x; u < 256; u += gridDim.x) {
        const int pn = u & 15, ks = u >> 4;
        const char* gA = (const char*)(p.ws + OFF_MIX) + ((size_t)64 * 128 + ks * 8) * 16384;
        const char* gB0 = (const char*)(p.ws + OFF_WOB) + ((size_t)(2 * pn) * 128 + ks * 8) * 16384; const char* gB1 = gB0 + (size_t)128 * 16384;
#define OS_ISSUE(kt, st) do { _Pragma("unroll") for (int pc = 0; pc < 6; ++pc) { const char* s_ = (pc < 2 ? gA : (pc < 4 ? gB0 : gB1)) + (size_t)(kt) * 16384 + (pc & 1) * 8192 + tid * 16; \
            __builtin_amdgcn_global_load_lds((const unsigned*)s_, (LAS unsigned*)(lds + (st) * 49152 + pc * 8192 + wid * 1024), 16, 0, 0); } } while (0)
        f32x4 acc[4][4];
#pragma unroll
        for (int m = 0; m < 4; ++m)
#pragma unroll
            for (int n = 0; n < 4; ++n) acc[m][n] = (f32x4){0.f, 0.f, 0.f, 0.f};
        OS_ISSUE(0, 0); OS_ISSUE(1, 1); OS_ISSUE(2, 2);
#pragma unroll
        for (int kt = 0; kt < 8; ++kt) {
            if (kt <= 5) asm volatile("s_waitcnt vmcnt(12)" ::: "memory"); else if (kt == 6) asm volatile("s_waitcnt vmcnt(6)" ::: "memory"); else asm volatile("s_waitcnt vmcnt(0)" ::: "memory");
            __builtin_amdgcn_s_barrier(); asm volatile("" ::: "memory");
            const LAS unsigned char* sb = lds + (kt % 3) * 49152;
            bf16x8 af[4][2], bfr[4][2];
#pragma unroll
            for (int m = 0; m < 4; ++m)
#pragma unroll
                for (int k = 0; k < 2; ++k) { af[m][k] = *(const LAS bf16x8*)(sb + aoff + m * 2048 + k * 1024); bfr[m][k] = *(const LAS bf16x8*)(sb + boff + m * 2048 + k * 1024); }
#pragma unroll
            for (int m = 0; m < 4; ++m)
#pragma unroll
                for (int n = 0; n < 4; ++n)
#pragma unroll
                    for (int k = 0; k < 2; ++k) acc[m][n] = __builtin_amdgcn_mfma_f32_16x16x32_bf16(bfr[n][k], af[m][k], acc[m][n], 0, 0, 0);
            asm volatile("s_waitcnt lgkmcnt(0)" ::: "memory"); __builtin_amdgcn_s_barrier(); asm volatile("" ::: "memory");
            if (kt + 3 < 8) OS_ISSUE(kt + 3, kt % 3);
        }
#undef OS_ISSUE
        float* Rp = (float*)(p.ws + OFF_RPART) + ((size_t)ks * NTS + wr * 64 + fr) * DM + pn * 256 + wc * 64 + 4 * fq;
#pragma unroll
        for (int m = 0; m < 4; ++m)
#pragma unroll
            for (int n = 0; n < 4; ++n) *(f32x4*)(Rp + (size_t)(m * 16) * DM + n * 16) = acc[m][n];
    }
    __syncthreads();
}

__device__ __forceinline__ void phase_ssdnorm(const Params& p) {
    const bf16_t* U = (const bf16_t*)(p.ws + OFF_U32); bf16_t* MIX = (bf16_t*)(p.ws + OFF_MIX);
    const int lane = threadIdx.x & 63, gw = blockIdx.x * 8 + (threadIdx.x >> 6), nw = gridDim.x * 8;
    for (int it = gw; it < NTOK * 8; it += nw) {
        const int row = it >> 3, g = it & 7; const size_t off = (size_t)row * DM + g * 512 + lane * 8;
        const u32x4 uv = *(const u32x4*)(U + off); const f32x4 a = (f32x4){blo(uv[0]), bhi(uv[0]), blo(uv[1]), bhi(uv[1])}, b = (f32x4){blo(uv[2]), bhi(uv[2]), blo(uv[3]), bhi(uv[3])};
        const float ss = wave_sum(a[0] * a[0] + a[1] * a[1] + a[2] * a[2] + a[3] * a[3] + b[0] * b[0] + b[1] * b[1] + b[2] * b[2] + b[3] * b[3]);
        const float rs = rsqrtf(ss * (1.f / 512.f) + 1e-6f);
        const f32x4 wa = *(const f32x4*)(p.ssd_norm_w + g * 512 + lane * 8), wb = *(const f32x4*)(p.ssd_norm_w + g * 512 + lane * 8 + 4);
        u32x4 o; o[0] = cvt_pk_bf16(a[0] * rs * wa[0], a[1] * rs * wa[1]); o[1] = cvt_pk_bf16(a[2] * rs * wa[2], a[3] * rs * wa[3]);
        o[2] = cvt_pk_bf16(b[0] * rs * wb[0], b[1] * rs * wb[1]); o[3] = cvt_pk_bf16(b[2] * rs * wb[2], b[3] * rs * wb[3]);
        *(u32x4*)(MIX + tiled_off(row, g * 512 + lane * 8, MIXW)) = o;
    }
    const float* GO = (const float*)(p.ws + OFF_SF) + SF_GO; const bf16_t* P = (const bf16_t*)(p.ws + OFF_P);
    for (int it = gw; it < NTS * 32; it += nw) {
        const int tok = it >> 5, h = it & 31;
        const float o0 = GO[(size_t)tok * 4096 + h * 128 + lane], o1 = GO[(size_t)tok * 4096 + h * 128 + 64 + lane];
        const float rs = rsqrtf(wave_sum(o0 * o0 + o1 * o1) * (1.f / 128.f) + 1e-6f);
        const size_t prow = (size_t)(NTP + tok) * P_LD + C_ZG + h * 128;
        MIX[tiled_off(NTP + tok, 4096 + h * 128 + lane, MIXW)] = f2bf(o0 * rs * p.gdn_norm_w[lane] * silu_f(bf2f(P[prow + lane])));
        MIX[tiled_off(NTP + tok, 4096 + h * 128 + 64 + lane, MIXW)] = f2bf(o1 * rs * p.gdn_norm_w[64 + lane] * silu_f(bf2f(P[prow + 64 + lane])));
    }
}

__device__ __forceinline__ void phase_ln(const Params& p) {
    const float* R = (const float*)(p.ws + OFF_R);
    const int lane = threadIdx.x & 63, gw = blockIdx.x * 8 + (threadIdx.x >> 6), nw = gridDim.x * 8;
    for (int row = gw; row < NTOK; row += nw) {
        const float* rr = R + (size_t)row * DM;
        f32x4 v[16]; float sum = 0.f;
        if (row < NTP) {
#pragma unroll
            for (int i = 0; i < 16; ++i) v[i] = *(const f32x4*)(rr + (i * 64 + lane) * 4);
        } else {
            const float* xr = p.x_sample + (size_t)(row - NTP) * DM; const float* pr = (const float*)(p.ws + OFF_RPART) + (size_t)(row - NTP) * DM;
#pragma unroll
            for (int i = 0; i < 16; ++i) v[i] = ALPHA * *(const f32x4*)(xr + (i * 64 + lane) * 4);
#pragma unroll 1
            for (int ks = 0; ks < 16; ++ks) {
#pragma unroll
                for (int i = 0; i < 16; ++i) v[i] += *(const f32x4*)(pr + (size_t)ks * NTS * DM + (i * 64 + lane) * 4); }
        }
#pragma unroll
        for (int i = 0; i < 16; ++i) sum += v[i][0] + v[i][1] + v[i][2] + v[i][3];
        const float mu = wave_sum(sum) * (1.f / 4096.f);
        float sq = 0.f;
#pragma unroll
        for (int i = 0; i < 16; ++i) { v[i] = v[i] - mu; sq += v[i][0] * v[i][0] + v[i][1] * v[i][1] + v[i][2] * v[i][2] + v[i][3] * v[i][3]; }
        const float rs = rsqrtf(wave_sum(sq) * (1.f / 4096.f) + 1e-5f);
        float* o = p.out + (row < NTP ? O_YP + (size_t)row * DM : O_YS + (size_t)(row - NTP) * DM);
#pragma unroll
        for (int i = 0; i < 16; ++i) { const int c = (i * 64 + lane) * 4; const f32x4 gg = *(const f32x4*)(p.ln_g + c), bb = *(const f32x4*)(p.ln_b + c);
            *(f32x4*)(o + c) = v[i] * rs * gg + bb; }
    }
}

template <int PH>
__global__ __launch_bounds__(512, 2) void mk_fwd(Params p) {
    extern __shared__ __attribute__((aligned(16))) unsigned char smem[];
    LAS unsigned char* lds = (LAS unsigned char*)smem;
    XcdBarrier bar;
    if (PH < 0) {
        if (threadIdx.x == 0) *(LAS u32x4*)(lds + LDS_MISC) = (u32x4){0u, 0u, 0u, 0u};
        __syncthreads();
        bar = xcd_barrier_post((unsigned*)(p.ws + OFF_BAR), (volatile LAS unsigned*)(lds + LDS_MISC));
    }
    if (PH < 0 || PH == 0) { phase_convert(p, lds); if (PROBE_REP == 1) { __syncthreads(); phase_convert(p, lds); } }
    if (PH < 0) xcd_barrier(bar);
    if (PH < 0 || PH == 1) {
        pg8::Gemm g{(const bf16_t*)(p.ws + OFF_XB), (const bf16_t*)(p.ws + OFF_WB), MPAD, NPAD, DM};
        pg8::StaticOrder S; S.init(MPAD, NPAD, (int)gridDim.x, (int)blockIdx.x, true);
        pg8::EpiProj E{(bf16_t*)(p.ws + OFF_P), (float*)(p.ws + OFF_G32)};
        pg8::gemm_phase<pg8::EpiProj, pg8::StaticOrder, true, true>(lds, g, S, E);
        if (PROBE_REP == 2) { __syncthreads(); pg8::gemm_phase<pg8::EpiProj, pg8::StaticOrder, true, true>(lds, g, S, E); }
        { const int G = (int)gridDim.x, nun = (MPAD / 256) * (NPAD / 256), lastfull = nun % G;
          if (lastfull != 0 && (int)blockIdx.x >= lastfull) { __syncthreads();
              tconv_range<false, false, false>(p.w_out, DM, (bf16_t*)(p.ws + OFF_WOB), DM * MIXW * 2, MIXW, (int)blockIdx.x - lastfull, WOUT_TILES, G - lastfull, lds); }
          else if (lastfull == 0) { __syncthreads(); tconv_range<false, false, false>(p.w_out, DM, (bf16_t*)(p.ws + OFF_WOB), DM * MIXW * 2, MIXW, (int)blockIdx.x, WOUT_TILES, G, lds); } }
    }
    if (PH < 0) xcd_barrier(bar);
    if (PH < 0 || PH == 2) { phase_sample_front(p); if (PH < 0) xcd_barrier(bar); else __syncthreads(); phase_scan(p, lds); if (PROBE_REP == 3) phase_scan(p, lds, QCTR_WORD + 64, 0); if (PROBE_REP == 4) phase_scan(p, lds, QCTR_WORD + 64, N_GDN_P + N_SSD_P + N_WOUT); if (PROBE_REP == 6) phase_scan(p, lds, QCTR_WORD + 64, 0, N_GDN_P); if (PROBE_REP == 7) phase_scan(p, lds, QCTR_WORD + 64, N_GDN_P, N_GDN_P + N_SSD_P); }
    if (PH < 0) xcd_barrier(bar);
    if (PH < 0 || PH == 3) phase_ssdnorm(p);
    if (PH < 0) xcd_barrier(bar);
    if (PH < 0 || PH == 4) {
        phase_outproj_sample(p, lds);
        pg8::Gemm g{(const bf16_t*)(p.ws + OFF_MIX), (const bf16_t*)(p.ws + OFF_WOB), NTP, DM, MIXW};
        pg8::StaticOrder S; S.init(NTP, DM, (int)gridDim.x, (int)blockIdx.x);
        pg8::EpiOut E{(float*)(p.ws + OFF_R), p.x_prompt, p.x_sample};
        pg8::gemm_phase<pg8::EpiOut, pg8::StaticOrder, true, true>(lds, g, S, E);
        if (PROBE_REP == 5) { __syncthreads(); pg8::gemm_phase<pg8::EpiOut, pg8::StaticOrder, true, true>(lds, g, S, E); }
    }
    if (PH < 0) xcd_barrier(bar);
    if (PH < 0 || PH == 5) phase_ln(p);
}

template <int PH> static void launch_phase(const Params& p, int grid, hipStream_t stream) {
    static bool attr = false;
    if (!attr) { (void)hipFuncSetAttribute((const void*)mk_fwd<PH>, hipFuncAttributeMaxDynamicSharedMemorySize, LDS_BYTES); attr = true; }
    hipLaunchKernelGGL((mk_fwd<PH>), dim3(grid), dim3(512), LDS_BYTES, stream, p);
}

extern "C" void kernel_launch(void* const* d_in, const int* in_sizes, int n_in, void* d_out, int out_size, void* d_ws, size_t ws_size, hipStream_t stream) {
    (void)in_sizes; (void)n_in; (void)out_size;
    if (ws_size < WS_END) { fprintf(stderr, "workspace too small: %zu < %zu\n", ws_size, (size_t)WS_END); return; }
    Params p{};
    p.x_prompt = (const float*)d_in[0]; p.x_sample = (const float*)d_in[1]; p.state_ssd = (const float*)d_in[2]; p.state_ssd_conv = (const float*)d_in[3];
    p.state_gdn = (const float*)d_in[4]; p.state_gdn_conv = (const float*)d_in[5]; p.w_in = (const float*)d_in[6]; p.ssd_conv_w = (const float*)d_in[7];
    p.ssd_conv_b = (const float*)d_in[8]; p.ssd_dt_bias = (const float*)d_in[9]; p.ssd_a_log = (const float*)d_in[10]; p.ssd_d = (const float*)d_in[11];
    p.ssd_norm_w = (const float*)d_in[12]; p.gdn_conv_w = (const float*)d_in[13]; p.gdn_dt_bias = (const float*)d_in[14]; p.gdn_a_log = (const float*)d_in[15];
    p.gdn_norm_w = (const float*)d_in[16]; p.w_out = (const float*)d_in[17]; p.ln_g = (const float*)d_in[18]; p.ln_b = (const float*)d_in[19];
    p.out = (float*)d_out; p.ws = (unsigned char*)d_ws;
    static int grid = 0;
    if (!grid) { int dev = 0, cus = 0; (void)hipGetDevice(&dev); (void)hipDeviceGetAttribute(&cus, hipDeviceAttributeMultiprocessorCount, dev); grid = cus > 0 ? cus : 256; }
    (void)hipMemsetAsync(d_ws, 0, 32768, stream);
#if MK_FUSED
    launch_phase<-1>(p, grid, stream);
#else
    launch_phase<0>(p, grid, stream); launch_phase<1>(p, grid, stream); launch_phase<2>(p, grid, stream);
    launch_phase<3>(p, grid, stream); launch_phase<4>(p, grid, stream); launch_phase<5>(p, grid, stream);
#endif
}
```
